# Optimizing an MI355X kernel written in HIP

```python
import jax, jax.numpy as jnp
from jax import lax
import numpy as np

D_MODEL = 1024
BATCH = 16
SEQ = 4096
DEPTH = 2

CHUNK = 64
EPS = 1e-6
D_RNN = 1024
RNN_BLOCKS = 8
RNN_BW = D_RNN // RNN_BLOCKS
CONV_W = 4
RG_C = 8.0
GLA_HEADS = 4
GLA_DK = 128
GLA_DV = 256
GLA_RANK = 16
GLA_TAU = 16.0
N_EXPERTS = 128
TOP_K = 8
D_EXPERT = 256
D_SHARED = 256
ROUTED_SCALE = 2.5
MOE_BLOCK = 64
IN_SPLITS = (D_RNN, D_RNN, GLA_HEADS * GLA_DK, GLA_HEADS * GLA_DK, GLA_HEADS * GLA_DV, GLA_HEADS * GLA_DV, GLA_RANK, D_MODEL, D_MODEL)
N_IN = 2 * D_RNN + 2 * GLA_HEADS * GLA_DK + 2 * GLA_HEADS * GLA_DV + GLA_RANK + 2 * D_MODEL

kernel_name = 'hybrid_rglru_gla_moe_adaln_encoder'


def _rmsnorm(x, g):
    xf = x.astype(jnp.float32)
    y = xf * lax.rsqrt(jnp.mean(xf * xf, axis=-1, keepdims=True) + EPS)
    return (y * g.astype(jnp.float32)).astype(x.dtype)


def _swiglu(x, w_gu, w_down):
    g, up = jnp.split(x @ w_gu, 2, axis=-1)
    return (jax.nn.silu(g) * up) @ w_down


def _causal_conv(x, w, b):
    s = x.shape[1]
    xp = jnp.pad(x, ((0, 0), (CONV_W - 1, 0), (0, 0)))
    y = b + xp[:, 0:s] * w[0]
    for j in range(1, CONV_W):
        y = y + xp[:, j:j + s] * w[j]
    return y


def _rglru(x, w_a, b_a, w_x, b_x, lam):
    bsz, s, _ = x.shape
    xb = x.reshape(bsz, s, RNN_BLOCKS, RNN_BW)
    r = jax.nn.sigmoid(jnp.einsum('bshi,hij->bshj', xb, w_a).reshape(bsz, s, D_RNN) + b_a)
    i = jax.nn.sigmoid(jnp.einsum('bshi,hij->bshj', xb, w_x).reshape(bsz, s, D_RNN) + b_x)
    log_a = -RG_C * r.astype(jnp.float32) * jax.nn.softplus(-lam.astype(jnp.float32))
    a = jnp.exp(log_a)
    mult = jnp.sqrt(-jnp.expm1(2.0 * log_a))
    mult = jnp.where((jnp.arange(s) == 0)[None, :, None], 1.0, mult)
    bt = mult * (i * x).astype(jnp.float32)

    def combine(p, q):
        return p[0] * q[0], q[0] * p[1] + q[1]

    _, h = lax.associative_scan(combine, (a, bt), axis=1)
    return h.astype(x.dtype)


def _gla(q, k, v, log_alpha):
    bsz, s = q.shape[:2]
    nc = s // CHUNK
    f32 = jnp.float32

    def chunks(t):
        return t.astype(f32).reshape(bsz, nc, CHUNK, *t.shape[2:]).swapaxes(0, 1)

    cum = jnp.cumsum(chunks(log_alpha), axis=2)
    tot = cum[:, :, -1]
    k_dec = chunks(k) * jnp.exp(tot[:, :, None] - cum)

    def step(state, inp):
        qc, kc, vc, tc = inp
        state = jnp.exp(tc)[..., None] * state + jnp.einsum('bchk,bchv->bhkv', kc, vc)
        return state, jnp.einsum('bchk,bhkv->bchv', qc, state)

    s0 = jnp.zeros((bsz, GLA_HEADS, GLA_DK, GLA_DV), f32)
    _, o = lax.scan(step, s0, (chunks(q), k_dec, chunks(v), tot))
    return o.swapaxes(0, 1).reshape(bsz, s, GLA_HEADS, GLA_DV).astype(q.dtype)


def _mixer(u, w_in, conv_w, conv_b, rg_wa, rg_ba, rg_wx, rg_bx, rg_lambda,
           gla_w_up, gla_b_up, gla_norm_g, w_branch_a, w_branch_b, w_out):
    bsz, s, _ = u.shape
    w_rx, w_rg, w_q, w_k, w_v, w_og, w_lr, w_ga, w_gb = jnp.split(
        w_in, np.cumsum(IN_SPLITS)[:-1].tolist(), axis=1)
    xr = _causal_conv(u @ w_rx, conv_w, conv_b)
    h_rnn = _rglru(xr, rg_wa, rg_ba, rg_wx, rg_bx, rg_lambda)
    y_a = (h_rnn * jax.nn.gelu(u @ w_rg, approximate=True)) @ w_branch_a
    q = (u @ w_q).reshape(bsz, s, GLA_HEADS, GLA_DK) * (GLA_DK ** -0.5)
    k = (u @ w_k).reshape(bsz, s, GLA_HEADS, GLA_DK)
    v = (u @ w_v).reshape(bsz, s, GLA_HEADS, GLA_DV)
    gate_logit = ((u @ w_lr) @ gla_w_up + gla_b_up).astype(jnp.float32)
    log_alpha = (jax.nn.log_sigmoid(gate_logit) / GLA_TAU).reshape(bsz, s, GLA_HEADS, GLA_DK)
    o = _gla(q, k, v, log_alpha)
    o = _rmsnorm(o, gla_norm_g).reshape(bsz, s, GLA_HEADS * GLA_DV) * jax.nn.silu(u @ w_og)
    y_b = o @ w_branch_b
    m = jax.nn.sigmoid(u @ w_ga) * y_a + jax.nn.sigmoid(u @ w_gb) * y_b
    return m @ w_out


def _routed_experts(u, idx, wts, w_gu, w_down):
    s, d = u.shape
    m = s * TOP_K
    nb = -(-(m + N_EXPERTS * (MOE_BLOCK - 1)) // MOE_BLOCK)
    p = nb * MOE_BLOCK
    e_flat = idx.reshape(m)
    order = jnp.argsort(e_flat, stable=True)
    e_sorted = e_flat[order]
    tok_sorted = (order // TOP_K).astype(jnp.int32)
    w_sorted = wts.reshape(m)[order]
    counts = jnp.bincount(e_flat, length=N_EXPERTS)
    padded = (counts + MOE_BLOCK - 1) // MOE_BLOCK * MOE_BLOCK
    start = jnp.cumsum(counts) - counts
    ends_p = jnp.cumsum(padded)
    pstart = ends_p - padded
    dest = pstart[e_sorted] + jnp.arange(m) - start[e_sorted]
    row_tok = jnp.full((p,), s, jnp.int32).at[dest].set(tok_sorted)
    row_w = jnp.zeros((p,), wts.dtype).at[dest].set(w_sorted)
    block_exp = jnp.minimum(jnp.searchsorted(ends_p, jnp.arange(nb) * MOE_BLOCK, side='right'), N_EXPERTS - 1)
    u_pad = jnp.concatenate([u, jnp.zeros((1, d), u.dtype)], axis=0)[row_tok].reshape(nb, MOE_BLOCK, d)

    def group_fn(args):
        xg, e = args
        return _swiglu(xg, w_gu[e], w_down[e])

    y = lax.map(group_fn, (u_pad, block_exp)).reshape(p, d)
    return jnp.zeros((s + 1, d), u.dtype).at[row_tok].add(y * row_w[:, None])[:s]


def _moe(u, router_w, router_b, exp_w_gu, exp_w_down, shared_w_gu, shared_w_down):
    scores = jax.nn.sigmoid((u @ router_w).astype(jnp.float32))
    _, idx = lax.top_k(scores + router_b.astype(jnp.float32), TOP_K)
    s_sel = jnp.take_along_axis(scores, idx, axis=-1)
    wts = (s_sel / jnp.sum(s_sel, axis=-1, keepdims=True) * ROUTED_SCALE).astype(u.dtype)
    routed = lax.map(lambda a: _routed_experts(a[0], a[1], a[2], exp_w_gu, exp_w_down), (u, idx, wts))
    return routed + _swiglu(u, shared_w_gu, shared_w_down)


def setup_inputs(seed: int = 0) -> dict:
    key = jax.random.key(seed)
    ks = jax.random.split(key, 32)
    L, D = DEPTH, D_MODEL

    def nrm(k, shape, scale):
        return jax.random.normal(k, shape, jnp.float32) * scale

    def gain(k, shape):
        return 1.0 + 0.02 * jax.random.normal(k, shape, jnp.float32)

    a_pow = jax.random.uniform(ks[12], (L, D_RNN), jnp.float32, minval=0.9, maxval=0.999)
    a0 = a_pow ** (1.0 / RG_C)
    rg_lambda = jnp.log(a0) - jnp.log1p(-a0)
    return {
        'x': nrm(ks[0], (BATCH, SEQ, D), 1.0),
        'c': nrm(ks[1], (BATCH, D), 1.0),
        'ada_w': nrm(ks[2], (L, D, 6 * D), 0.5 * D ** -0.5),
        'ada_b': nrm(ks[3], (L, 6 * D), 0.02),
        'norm1_g': gain(ks[4], (L, D)),
        'w_in': nrm(ks[5], (L, D, N_IN), D ** -0.5),
        'conv_w': nrm(ks[6], (L, CONV_W, D_RNN), CONV_W ** -0.5),
        'conv_b': nrm(ks[7], (L, D_RNN), 0.02),
        'rg_wa': nrm(ks[8], (L, RNN_BLOCKS, RNN_BW, RNN_BW), RNN_BW ** -0.5),
        'rg_ba': nrm(ks[9], (L, D_RNN), 0.02),
        'rg_wx': nrm(ks[10], (L, RNN_BLOCKS, RNN_BW, RNN_BW), RNN_BW ** -0.5),
        'rg_bx': nrm(ks[11], (L, D_RNN), 0.02),
        'rg_lambda': rg_lambda,
        'gla_w_up': nrm(ks[13], (L, GLA_RANK, GLA_HEADS * GLA_DK), GLA_RANK ** -0.5),
        'gla_b_up': nrm(ks[14], (L, GLA_HEADS * GLA_DK), 0.02),
        'gla_norm_g': gain(ks[15], (L, GLA_HEADS, GLA_DV)),
        'w_branch_a': nrm(ks[16], (L, D_RNN, D), D_RNN ** -0.5),
        'w_branch_b': nrm(ks[17], (L, GLA_HEADS * GLA_DV, D), (GLA_HEADS * GLA_DV) ** -0.5),
        'w_out': nrm(ks[18], (L, D, D), D ** -0.5),
        'norm2_g': gain(ks[19], (L, D)),
        'router_w': nrm(ks[20], (L, D, N_EXPERTS), D ** -0.5),
        'router_b': nrm(ks[21], (L, N_EXPERTS), 0.01),
        'exp_w_gu': nrm(ks[22], (L, N_EXPERTS, D, 2 * D_EXPERT), D ** -0.5),
        'exp_w_down': nrm(ks[23], (L, N_EXPERTS, D_EXPERT, D), D_EXPERT ** -0.5),
        'shared_w_gu': nrm(ks[24], (L, D, 2 * D_SHARED), D ** -0.5),
        'shared_w_down': nrm(ks[25], (L, D_SHARED, D), D_SHARED ** -0.5),
        'final_g': gain(ks[26], (D,)),
    }


def reference(x, c, ada_w, ada_b, norm1_g, w_in, conv_w, conv_b, rg_wa, rg_ba, rg_wx, rg_bx,
              rg_lambda, gla_w_up, gla_b_up, gla_norm_g, w_branch_a, w_branch_b, w_out, norm2_g,
              router_w, router_b, exp_w_gu, exp_w_down, shared_w_gu, shared_w_down, final_g):
    h = x
    c_act = jax.nn.silu(c)
    for l in range(DEPTH):
        mod = (c_act @ ada_w[l] + ada_b[l])[:, None, :]
        sh1, sc1, g1, sh2, sc2, g2 = jnp.split(mod, 6, axis=-1)
        u = _rmsnorm(h, norm1_g[l]) * (1 + sc1) + sh1
        h = h + g1 * _mixer(u, w_in[l], conv_w[l], conv_b[l], rg_wa[l], rg_ba[l], rg_wx[l], rg_bx[l],
                            rg_lambda[l], gla_w_up[l], gla_b_up[l], gla_norm_g[l],
                            w_branch_a[l], w_branch_b[l], w_out[l])
        u = _rmsnorm(h, norm2_g[l]) * (1 + sc2) + sh2
        h = h + g2 * _moe(u, router_w[l], router_b[l], exp_w_gu[l], exp_w_down[l],
                          shared_w_gu[l], shared_w_down[l])
    return _rmsnorm(h, final_g)
```

```cpp
#include <hip/hip_runtime.h>
#include <cstdio>
#include <cstdint>

#ifndef MK_PER_PHASE
#define MK_PER_PHASE 1
#endif

namespace pg8 {
#define PG8_LAS __attribute__((address_space(3)))
typedef unsigned short bf16_t;
typedef short bf16x8 __attribute__((ext_vector_type(8)));
typedef float f32x4 __attribute__((ext_vector_type(4)));
typedef unsigned u32x4 __attribute__((ext_vector_type(4)));
constexpr int BM = 256, BK = 64, HALF = 128, HTB = HALF * BK * 2, STAGE_BYTES = 8 * HTB, NXCD = 8, WGM = 8;

__host__ __device__ __forceinline__ int lds_byte(int r, int c) { const int st = (r >> 4) * 2 + (c >> 5), rr = r & 15, cc = c & 31, ob = rr * 64 + cc * 2; return st * 1024 + (ob ^ (((ob >> 9) & 1) << 5)); }
__host__ __device__ __forceinline__ void stage_rc(int b, int& R, int& C) { const int st = b / 1024, sb = b % 1024, swz = sb ^ (((sb >> 9) & 1) << 5); R = (st >> 1) * 16 + swz / 64; C = (st & 1) * 32 + (swz % 64) / 2; }
__host__ __device__ __forceinline__ int perm32(int rho) { const int n = rho >> 4, i = rho & 15; return 8 * (i >> 2) + 4 * n + (i & 3); }

struct Unit { int pm, pn; };
struct Gemm { const bf16_t* A; const bf16_t* Bt; int K; const int* rowidx; };

struct StaticOrder {
    int nM, nN, nwg, G, c;
    __host__ __device__ void init(int M, int N, int G_, int c_) { nM = M / BM; nN = N / BM; nwg = nM * nN; G = G_; c = c_; }
    __host__ __device__ bool next(int i, Unit& u) const {
        const long L = (long)i * G + c; if (L >= nwg) return false;
        int wgid = (int)L; { const int q = nwg / NXCD, r = nwg % NXCD, xcd = wgid % NXCD, off = wgid / NXCD; wgid = (xcd < r ? xcd * (q + 1) : r * (q + 1) + (xcd - r) * q) + off; }
        const int nig = WGM * nN, gid = wgid / nig, fm = gid * WGM, gsz = (nM - fm) < WGM ? (nM - fm) : WGM;
        u.pm = fm + ((wgid % nig) % gsz); u.pn = (wgid % nig) / gsz; return true;
    }
};
struct MoeOrder {
    const PG8_LAS int* ts; int npn, G, c, total;
    __device__ __forceinline__ bool next(int i, Unit& u) const {
        const int L = i * G + c; if (L >= total) return false;
        const int tile = L / npn, j = L - tile * npn;
        int lo = 0, hi = 128;
        while (hi - lo > 1) { const int mid = (lo + hi) >> 1; if (ts[mid] <= tile) lo = mid; else hi = mid; }
        u.pm = tile; u.pn = lo * npn + j; return true;
    }
};

__device__ __forceinline__ unsigned cvt_pk_bf16(float lo, float hi) { typedef __bf16 bf2_t __attribute__((ext_vector_type(2))); typedef float f2_t __attribute__((ext_vector_type(2)));
    return __builtin_bit_cast(unsigned, __builtin_convertvector((f2_t){lo, hi}, bf2_t)); }

template <class Epi, class Sched, bool ALIGN_EPI, bool SP2, bool GATHER>
__device__ __forceinline__ void gemm_phase(PG8_LAS unsigned char* lds, const Gemm g, const Sched& S, const Epi& E, const int tid, const int wid) {
    const int lane = tid & 63, wr = wid >> 2, wc = wid & 3, fr = lane & 15, fq = lane >> 4;
    const int K = g.K, nt = K / BK;
    unsigned voffA[2], voffB[2];
#pragma unroll
    for (int i = 0; i < 2; ++i) { int R, C; stage_rc(tid * 16 + i * 8192, R, C); const int Rb = (R & ~31) + perm32(R & 31);
        voffA[i] = (unsigned)(R * K + C) * 2u; voffB[i] = (unsigned)(Rb * K + C) * 2u; }
    const size_t kstep = (size_t)(BK * 2);
    const size_t hstep = (size_t)HALF * K * 2;
    const size_t tstep = 2 * hstep;
    const unsigned ldsw = (unsigned)wid * 1024u;
    const int aoff = lds_byte(wr * 64 + fr, fq * 8), boff = lds_byte(wc * 32 + fr, fq * 8);
    unsigned gc[2][2], gn[2][2];
#define PG8_SA(b, h) (((b) * 2 + (h)) * HTB)
#define PG8_SB(b, h) ((4 + (b) * 2 + (h)) * HTB)
#define PG8_STAGE(bufoff, gbase, voff) do { _Pragma("unroll") for (int _i = 0; _i < 2; ++_i) \
        __builtin_amdgcn_global_load_lds((const unsigned*)((const char*)(gbase) + (voff)[_i]), (PG8_LAS unsigned*)(lds + (bufoff) + ldsw + _i * 8192), 16, 0, 0); } while (0)
#define PG8_STAGE_A(bufoff, kb, h, NX) do { if constexpr (GATHER) { _Pragma("unroll") for (int _i = 0; _i < 2; ++_i) { const unsigned _o = (NX) ? gn[h][_i] : gc[h][_i]; \
        __builtin_amdgcn_global_load_lds((const unsigned*)((const char*)(kb) + _o), (PG8_LAS unsigned*)(lds + (bufoff) + ldsw + _i * 8192), 16, 0, 0); } } \
        else { PG8_STAGE(bufoff, (const char*)(kb) + ((h) ? hstep : (size_t)0), voffA); } } while (0)
#define PG8_LDA(dst, b, h) do { _Pragma("unroll") for (int m = 0; m < 4; ++m) _Pragma("unroll") for (int k = 0; k < 2; ++k) dst[m][k] = *(const PG8_LAS bf16x8*)(lds + PG8_SA(b, h) + aoff + m * 2048 + k * 1024); } while (0)
#define PG8_LDB(dst, b, h) do { _Pragma("unroll") for (int n = 0; n < 2; ++n) _Pragma("unroll") for (int k = 0; k < 2; ++k) dst[n][k] = *(const PG8_LAS bf16x8*)(lds + PG8_SB(b, h) + boff + n * 2048 + k * 1024); } while (0)
#define PG8_MMA(ai, bj, At, Bt) do { __builtin_amdgcn_s_setprio(1); _Pragma("unroll") for (int m = 0; m < 4; ++m) _Pragma("unroll") for (int n = 0; n < 2; ++n) _Pragma("unroll") for (int k = 0; k < 2; ++k) \
        acc[ai][bj][m][n] = __builtin_amdgcn_mfma_f32_16x16x32_bf16(Bt[n][k], At[m][k], acc[ai][bj][m][n], 0, 0, 0); __builtin_amdgcn_s_setprio(0); } while (0)
#define PG8_WAIT_V(n) asm volatile("s_waitcnt vmcnt(" #n ")" ::: "memory")
#define PG8_WAIT_L(n) asm volatile("s_waitcnt lgkmcnt(" #n ")" ::: "memory")
#define PG8_BAR __builtin_amdgcn_s_barrier()
#define PG8_SCHED __builtin_amdgcn_sched_barrier(0)
#define PG8_LOAD_ROWS(dst, un) do { int _ln; asm volatile("v_mbcnt_lo_u32_b32 %0, -1, 0\n\tv_mbcnt_hi_u32_b32 %0, -1, %0" : "=v"(_ln)); const int _t = wid * 64 + _ln; \
        _Pragma("unroll") for (int _i = 0; _i < 2; ++_i) { int _R, _C; stage_rc(_t * 16 + _i * 8192, _R, _C); _Pragma("unroll") for (int _h = 0; _h < 2; ++_h) { \
        const int _tok = ((const __attribute__((address_space(1))) int*)g.rowidx)[(un).pm * BM + _h * HALF + _R]; dst[_h][_i] = (unsigned)_tok * (unsigned)(K * 2) + (unsigned)_C * 2u; } } } while (0)
    Unit cur, nxt; int ui = 0;
    if (!S.next(0, cur)) return;
    f32x4 acc[2][2][4][2];
#pragma unroll
    for (int a = 0; a < 2; ++a)
#pragma unroll
        for (int b = 0; b < 2; ++b)
#pragma unroll
            for (int m = 0; m < 4; ++m)
#pragma unroll
                for (int n = 0; n < 2; ++n) acc[a][b][m][n] = (f32x4){0.f, 0.f, 0.f, 0.f};
    bf16x8 At[4][2], B0[2][2], B1[2][2];
    const char* cA = GATHER ? (const char*)g.A : (const char*)g.A + (size_t)cur.pm * tstep; const char* cB = (const char*)g.Bt + (size_t)cur.pn * tstep;
    if constexpr (GATHER) { PG8_LOAD_ROWS(gc, cur); }
    if constexpr (SP2) {
        PG8_STAGE(PG8_SB(0, 0), cB, voffB); PG8_STAGE(PG8_SB(0, 1), cB + hstep, voffB); PG8_STAGE_A(PG8_SA(0, 0), cA, 0, false); PG8_STAGE_A(PG8_SA(0, 1), cA, 1, false);
        if (wr == 1) PG8_BAR;
        PG8_WAIT_V(2); PG8_BAR;
        PG8_STAGE(PG8_SB(1, 0), cB + kstep, voffB); PG8_STAGE_A(PG8_SA(1, 0), cA + kstep, 0, false); PG8_STAGE(PG8_SB(1, 1), cB + hstep + kstep, voffB);
        PG8_WAIT_V(6); PG8_BAR;
    } else {
        PG8_STAGE(PG8_SB(0, 0), cB, voffB); PG8_STAGE_A(PG8_SA(0, 0), cA, 0, false); PG8_STAGE(PG8_SB(0, 1), cB + hstep, voffB); PG8_STAGE_A(PG8_SA(0, 1), cA, 1, false);
        if (wr == 1) PG8_BAR;
        PG8_WAIT_V(4); PG8_BAR;
        PG8_STAGE(PG8_SB(1, 0), cB + kstep, voffB); PG8_STAGE_A(PG8_SA(1, 0), cA + kstep, 0, false); PG8_STAGE(PG8_SB(1, 1), cB + hstep + kstep, voffB);
        PG8_WAIT_V(6); PG8_BAR;
    }
    for (;;) {
        const bool has_next = S.next(ui + 1, nxt);
        const char* nA = GATHER ? (const char*)g.A : (has_next ? (const char*)g.A + (size_t)nxt.pm * tstep : cA); const char* nB = has_next ? (const char*)g.Bt + (size_t)nxt.pn * tstep : cB;
        if constexpr (GATHER) { if (has_next) { PG8_LOAD_ROWS(gn, nxt); } else {
#pragma unroll
            for (int _h = 0; _h < 2; ++_h)
#pragma unroll
                for (int _i = 0; _i < 2; ++_i) gn[_h][_i] = gc[_h][_i]; } }
#pragma unroll 1
        for (int t = 0; t < nt; t += 2) {
            const bool last = (t == nt - 2);
            const char* a1 = cA + (size_t)(t + 1) * kstep;
            const char* a2 = last ? nA : cA + (size_t)(t + 2) * kstep; const char* b2 = last ? nB : cB + (size_t)(t + 2) * kstep;
            const char* a3 = a2 + kstep; const char* b3 = b2 + kstep;
            if constexpr (SP2) {
            PG8_LDB(B0, 0, 0); PG8_LDB(B1, 0, 1); PG8_SCHED; PG8_LDA(At, 0, 0); PG8_STAGE_A(PG8_SA(1, 1), a1, 1, false);
            PG8_WAIT_V(8); PG8_WAIT_L(0); PG8_BAR; PG8_MMA(0, 0, At, B0); PG8_MMA(0, 1, At, B1); PG8_BAR; PG8_SCHED;
            PG8_LDA(At, 0, 1); PG8_STAGE(PG8_SB(0, 0), b2, voffB); PG8_STAGE(PG8_SB(0, 1), b2 + hstep, voffB); PG8_STAGE_A(PG8_SA(0, 0), a2, 0, last);
            PG8_WAIT_V(8); PG8_WAIT_L(0); PG8_BAR; PG8_MMA(1, 0, At, B0); PG8_MMA(1, 1, At, B1); PG8_BAR; PG8_SCHED;
            PG8_LDB(B0, 1, 0); PG8_LDB(B1, 1, 1); PG8_SCHED; PG8_LDA(At, 1, 0); PG8_STAGE_A(PG8_SA(0, 1), a2, 1, last);
            PG8_WAIT_V(8); PG8_WAIT_L(0); PG8_BAR; PG8_MMA(0, 0, At, B0); PG8_MMA(0, 1, At, B1); PG8_BAR; PG8_SCHED;
            PG8_LDA(At, 1, 1); PG8_STAGE(PG8_SB(1, 0), b3, voffB); PG8_STAGE(PG8_SB(1, 1), b3 + hstep, voffB); PG8_STAGE_A(PG8_SA(1, 0), a3, 0, last);
            PG8_WAIT_V(8); PG8_WAIT_L(0); PG8_BAR; PG8_MMA(1, 0, At, B0); PG8_MMA(1, 1, At, B1); PG8_BAR; PG8_SCHED;
            } else {
            PG8_LDB(B0, 0, 0); PG8_SCHED; PG8_LDA(At, 0, 0); PG8_STAGE_A(PG8_SA(1, 1), a1, 1, false);
            PG8_WAIT_L(8); PG8_BAR; PG8_WAIT_L(0); PG8_MMA(0, 0, At, B0); PG8_BAR; PG8_SCHED;
            PG8_LDB(B1, 0, 1); PG8_STAGE(PG8_SB(0, 0), b2, voffB);
            PG8_BAR; PG8_WAIT_L(0); PG8_MMA(0, 1, At, B1); PG8_BAR;
            PG8_LDA(At, 0, 1); PG8_STAGE_A(PG8_SA(0, 0), a2, 0, last);
            PG8_BAR; PG8_WAIT_L(0); PG8_MMA(1, 0, At, B0); PG8_BAR; PG8_SCHED;
            PG8_STAGE(PG8_SB(0, 1), b2 + hstep, voffB);
            PG8_WAIT_V(6); PG8_BAR; PG8_MMA(1, 1, At, B1); PG8_BAR;
            PG8_LDB(B0, 1, 0); PG8_SCHED; PG8_LDA(At, 1, 0); PG8_STAGE_A(PG8_SA(0, 1), a2, 1, last);
            PG8_WAIT_L(8); PG8_BAR; PG8_WAIT_L(0); PG8_MMA(0, 0, At, B0); PG8_BAR; PG8_SCHED;
            PG8_LDB(B1, 1, 1); PG8_STAGE(PG8_SB(1, 0), b3, voffB);
            PG8_BAR; PG8_WAIT_L(0); PG8_MMA(0, 1, At, B1); PG8_BAR;
            PG8_LDA(At, 1, 1); PG8_STAGE_A(PG8_SA(1, 0), a3, 0, last);
            PG8_BAR; PG8_WAIT_L(0); PG8_MMA(1, 0, At, B0); PG8_BAR; PG8_SCHED;
            PG8_STAGE(PG8_SB(1, 1), b3 + hstep, voffB);
            PG8_WAIT_V(6); PG8_BAR; PG8_MMA(1, 1, At, B1); PG8_BAR;
            }
        }
        if constexpr (ALIGN_EPI) { if (wr == 0) PG8_BAR; }
        E(acc, cur, wr, wc, fr, fq);
        if (!has_next) break;
#pragma unroll
        for (int a = 0; a < 2; ++a)
#pragma unroll
            for (int b = 0; b < 2; ++b)
#pragma unroll
                for (int m = 0; m < 4; ++m)
#pragma unroll
                    for (int n = 0; n < 2; ++n) acc[a][b][m][n] = (f32x4){0.f, 0.f, 0.f, 0.f};
        cur = nxt; cA = nA; cB = nB; ++ui;
        if constexpr (GATHER) {
#pragma unroll
            for (int _h = 0; _h < 2; ++_h)
#pragma unroll
                for (int _i = 0; _i < 2; ++_i) gc[_h][_i] = gn[_h][_i]; }
        if constexpr (ALIGN_EPI) { if (wr == 1) PG8_BAR; }
    }
    PG8_WAIT_V(0);
    if constexpr (!ALIGN_EPI) { if (wr == 0) PG8_BAR; }
    PG8_BAR;
#undef PG8_SA
#undef PG8_SB
#undef PG8_STAGE
#undef PG8_STAGE_A
#undef PG8_LDA
#undef PG8_LDB
#undef PG8_MMA
#undef PG8_WAIT_V
#undef PG8_WAIT_L
#undef PG8_BAR
#undef PG8_SCHED
#undef PG8_LOAD_ROWS
}
}

constexpr int NWAVES = 8, NTHR = 512;
constexpr int D = 1024, BATCH = 16, SEQ = 4096, T = BATCH * SEQ, DEPTH = 2;
constexpr int CHUNK = 64, NCH = SEQ / CHUNK;
constexpr int NSEC = 7168;
constexpr int N_IN = 7184;
constexpr int NE = 128, TOPK = 8, DE = 256;
constexpr int PMAX = T * TOPK + NE * 256;
constexpr float EPS = 1e-6f;

constexpr size_t MiB = 1u << 20;
constexpr size_t WS_CTL = 0, CTL_ZERO_BYTES = 1 * MiB;
constexpr size_t WS_MOD = 1 * MiB;
constexpr size_t WS_WLR = 2 * MiB;
constexpr size_t WS_RGW = 3 * MiB;
constexpr size_t WS_WIN = 4 * MiB;
constexpr size_t WS_WA = 32 * MiB, WS_WB = 36 * MiB, WS_WO = 40 * MiB;
constexpr size_t WS_ROUT = 44 * MiB;
constexpr size_t WS_SGU = 45 * MiB;
constexpr size_t WS_SDN = 47 * MiB;
constexpr size_t WS_EGU = 48 * MiB;
constexpr size_t WS_EDN = 304 * MiB;
constexpr size_t WS_U = 432 * MiB;
constexpr size_t WS_SP = 561 * MiB, WS_SE = 565 * MiB, WS_CIN = 569 * MiB;
constexpr size_t WS_TOT = 573 * MiB;
constexpr size_t WS_PK = 575 * MiB;
constexpr size_t WS_POS = 577 * MiB;
constexpr size_t WS_WTS = 579 * MiB;
constexpr size_t WS_SORT = 581 * MiB;
constexpr size_t WS_BIG = 592 * MiB;
constexpr size_t WS_XRPRE = WS_BIG, WS_RG = WS_BIG + 128 * MiB, WS_Q = WS_BIG + 256 * MiB, WS_K = WS_BIG + 320 * MiB, WS_V = WS_BIG + 384 * MiB,
                 WS_OG = WS_BIG + 512 * MiB, WS_GA = WS_BIG + 640 * MiB, WS_GB = WS_BIG + 768 * MiB, WS_LOGA = WS_BIG + 896 * MiB, WS_IX = WS_BIG + 1024 * MiB,
                 WS_KDEC = WS_BIG + 1152 * MiB;
constexpr size_t WS_O = WS_XRPRE;
constexpr size_t WS_MBUF = WS_LOGA;
constexpr size_t WS_Y = WS_BIG;
constexpr size_t WS_LOGIT = WS_BIG;
constexpr size_t WS_ACT = WS_BIG + 1088 * MiB;
constexpr size_t WS_ACTS = WS_BIG + 1360 * MiB;
constexpr size_t WS_END = WS_BIG + 1392 * MiB;
static_assert((size_t)PMAX * 1024 * 2 <= 1088 * MiB && (size_t)PMAX * 256 * 2 <= 272 * MiB && WS_KDEC + 64 * MiB <= WS_END, "ws map");
constexpr int CW_TMO = 0;
constexpr int CW_BAR = 4096;
constexpr int CW_CNT = 8192;

constexpr int RING_BYTES = 131072;
constexpr int LDS_TS = RING_BYTES;
constexpr int LDS_MISC = RING_BYTES + 1024;
constexpr int LDS_BYTES = 147456;

#define GAS __attribute__((address_space(1)))
#define LAS __attribute__((address_space(3)))
typedef unsigned short bf16;
typedef unsigned v4u __attribute__((ext_vector_type(4)));
typedef unsigned v2u __attribute__((ext_vector_type(2)));
typedef float f32x4 __attribute__((ext_vector_type(4)));
typedef float f32x16 __attribute__((ext_vector_type(16)));
typedef short bf16x8 __attribute__((ext_vector_type(8)));
typedef short s16x4 __attribute__((ext_vector_type(4)));
typedef GAS unsigned gu32;
#define RLX_AGENT __ATOMIC_RELAXED, __HIP_MEMORY_SCOPE_AGENT
#define LDS_WAIT() asm volatile("s_waitcnt lgkmcnt(0)" ::: "memory")
__device__ __forceinline__ unsigned f2bf(float f) { return (unsigned)__builtin_bit_cast(unsigned short, (__bf16)f); }
__device__ __forceinline__ unsigned pk2(float lo, float hi) { return pg8::cvt_pk_bf16(lo, hi); }
__device__ __forceinline__ float bflo(unsigned w) { return __builtin_bit_cast(float, w << 16); }
__device__ __forceinline__ float bfhi(unsigned w) { return __builtin_bit_cast(float, w & 0xffff0000u); }
__device__ __forceinline__ float bf2f(bf16 b) { return __builtin_bit_cast(float, (unsigned)b << 16); }
__device__ __forceinline__ float fsigmoid(float x) { return __builtin_amdgcn_rcpf(1.0f + __builtin_amdgcn_exp2f(-1.442695041f * x)); }
__device__ __forceinline__ float fsilu(float x) { return x * fsigmoid(x); }
__device__ __forceinline__ float fgelu_tanh(float x) { return x * fsigmoid(1.5957691216f * (x + 0.044715f * x * x * x)); }

#define XB_TMO      128
#define XB_XCNT(j)  (256  + 64 * (j))
#define XB_XSUB(j)  (1280 + 64 * (j))
#define XB_XGEN(j)  (2304 + 64 * (j))
#define XB_TOP      3328
#define XB_TOPGEN   3392
#define XCD_BAR_WORDS 3456
#define XB_SPIN_CAP (1u << 18)
__device__ __forceinline__ unsigned xb_ld(unsigned* p)              { return __hip_atomic_load(p, __ATOMIC_RELAXED, __HIP_MEMORY_SCOPE_AGENT); }
__device__ __forceinline__ unsigned xb_add(unsigned* p, unsigned v) { return __hip_atomic_fetch_add(p, v, __ATOMIC_RELAXED, __HIP_MEMORY_SCOPE_AGENT); }
__device__ __forceinline__ unsigned xb_xcc_id() { return (unsigned)__builtin_amdgcn_s_getreg((3 << 11) | 20) & 0xFu; }
#define XB_SPIN(cond, bar) do { unsigned _sp = 0; while (cond) { __builtin_amdgcn_s_sleep(1); \
    if ((++_sp & 255u) == 0u) { if (xb_ld(&(bar)[XB_TMO])) break; if (_sp > XB_SPIN_CAP) { atomicAdd(&(bar)[XB_TMO], 1u); break; } } } } while (0)
struct XcdBarrier { unsigned* bar; unsigned x; volatile LAS unsigned* st; };
__device__ __forceinline__ XcdBarrier xcd_barrier_post(unsigned* bar, volatile LAS unsigned* st) {
    XcdBarrier b; b.bar = bar; b.x = xb_xcc_id(); b.st = st;
    if (threadIdx.x == 0) (void)xb_add(&bar[XB_XCNT(b.x)], 1u);
    return b;
}
__device__ __forceinline__ void xcd_barrier_complete(unsigned* bar, unsigned x, unsigned& nloc, unsigned& nx) {
    const unsigned G = gridDim.x * gridDim.y * gridDim.z;
    unsigned sum, cnt, mine, sp = 0u;
    for (;;) {
        sum = 0u; cnt = 0u; mine = 0u;
#pragma unroll
        for (unsigned j = 0; j < 16; ++j) { const unsigned c = xb_ld(&bar[XB_XCNT(j)]); sum += c; cnt += (c > 0u) ? 1u : 0u; mine = (j == x) ? c : mine; }
        if (sum == G) break;
        __builtin_amdgcn_s_sleep(1);
        if ((++sp & 255u) == 0u) { if (xb_ld(&bar[XB_TMO])) break; if (sp > XB_SPIN_CAP) { atomicAdd(&bar[XB_TMO], 1u); break; } }
    }
    nloc = mine > 0u ? mine : 1u; nx = cnt > 0u ? cnt : 1u;
}
__device__ __forceinline__ void xcd_barrier(const XcdBarrier& b, const bool leader) {
    asm volatile("s_waitcnt vmcnt(0)" ::: "memory");
    __syncthreads();
    if (leader) {
        unsigned* bar = b.bar;
        __builtin_amdgcn_s_waitcnt(0);
        unsigned nloc = b.st[0], nx = b.st[1];
        if (nloc == 0u) { xcd_barrier_complete(bar, b.x, nloc, nx); b.st[0] = nloc; b.st[1] = nx; }
        const unsigned old = xb_add(&bar[XB_XSUB(b.x)], 1u);
        const unsigned gen = old / nloc;
        if (old + 1u == (gen + 1u) * nloc) {
            __builtin_amdgcn_fence(__ATOMIC_RELEASE, "agent");
            asm volatile("s_waitcnt vmcnt(0)" ::: "memory");
            const unsigned og = xb_add(&bar[XB_TOP], 1u);
            const unsigned tg = og / nx;
            if (og + 1u == (tg + 1u) * nx) xb_add(&bar[XB_TOPGEN], 1u);
            else XB_SPIN(xb_ld(&bar[XB_TOPGEN]) == tg, bar);
            __builtin_amdgcn_fence(__ATOMIC_ACQUIRE, "agent");
            xb_add(&bar[XB_XGEN(b.x)], 1u);
            asm volatile("s_waitcnt vmcnt(0)" ::: "memory");
        } else {
            XB_SPIN(xb_ld(&bar[XB_XGEN(b.x)]) == gen, bar);
            __builtin_amdgcn_fence(__ATOMIC_ACQUIRE, "agent");
            asm volatile("s_waitcnt vmcnt(0)" ::: "memory");
        }
    }
    __syncthreads();
}

enum In { I_X = 0, I_C, I_ADAW, I_ADAB, I_N1G, I_WIN, I_CONVW, I_CONVB, I_RGWA, I_RGBA, I_RGWX, I_RGBX, I_RGLAM, I_GWUP, I_GBUP, I_GNG, I_WBA, I_WBB, I_WOUT, I_N2G,
          I_RW, I_RB, I_EGU, I_EDN, I_SGU, I_SDN, I_FG, N_INPUTS };
struct Args { const float* in[N_INPUTS]; float* out; unsigned char* ws; int ph_lo, ph_hi; };
struct Frame { LAS unsigned char* lds; unsigned char* ws; int tid, lane, wave, vcu, G, bx; };

__device__ __forceinline__ float wave_sum(float v, int lane) {
#pragma unroll
    for (int o = 1; o < 64; o <<= 1) v += __builtin_bit_cast(float, __builtin_amdgcn_ds_bpermute((lane ^ o) << 2, __builtin_bit_cast(int, v)));
    return v;
}

template <class RowP>
__device__ __forceinline__ void conv_item(const float* W, int K, int N, LAS float* scr, int item, int lane, RowP rowp) {
    const int nblk = (N + 31) / 32, kb = item / nblk, nb = item % nblk, k0 = 64 * kb, n0 = 32 * nb;
    const int cl = n0 + (lane & 31); const bool okc = cl < N;
#pragma unroll 8
    for (int i = 0; i < 32; ++i) { const int kk = 2 * i + (lane >> 5); scr[kk * 33 + (lane & 31)] = okc ? W[(size_t)(k0 + kk) * N + cl] : 0.f; }
    LDS_WAIT(); asm volatile("" ::: "memory");
    const int c = lane & 7;
#pragma unroll
    for (int j = 0; j < 4; ++j) { const int n = (lane >> 3) + 8 * j; const LAS float* s = scr + (8 * c) * 33 + n;
        v4u o; o.x = pk2(s[0 * 33], s[1 * 33]); o.y = pk2(s[2 * 33], s[3 * 33]); o.z = pk2(s[4 * 33], s[5 * 33]); o.w = pk2(s[6 * 33], s[7 * 33]);
        bf16* rp = (n0 + n < N) ? rowp(n0 + n) : (bf16*)nullptr;
        if (rp) *(GAS v4u*)(rp + k0 + 8 * c) = o; }
    LDS_WAIT(); asm volatile("" ::: "memory");
}
__device__ __forceinline__ bf16* winrow(int c, bf16* win, bf16* wlr) {
    if (c < 5120) {
        if (c >= 2048 && c < 2560) { const int p = c & 15, g = (p >> 2) & 3; const int pp = (g == 1) ? p + 4 : (g == 2) ? p - 4 : p; c = (c & ~15) | pp; }
        return win + (size_t)c * D; }
    if (c < 5136) return wlr + (size_t)(c - 5120) * D;
    return win + (size_t)(c - 16) * D;
}
__device__ __forceinline__ int glurow(int c) { return 256 * ((c & 255) >> 7) + 128 * (c >> 8) + (c & 127); }

__device__ __forceinline__ void p0_prologue(const Frame& F, const Args& a) {
    unsigned char* ws = F.ws;
    if (F.vcu < 96) {
        LAS float* cact = (LAS float*)F.lds;
        LAS float* part = (LAS float*)(F.lds + 65536);
        for (int i = F.tid; i < 16 * 1024; i += NTHR) { const int b = i >> 10, k = i & 1023; const float x = a.in[I_C][i]; cact[k * 16 + b] = fsilu(x); }
        __syncthreads();
        const int l = F.wave >> 2, kq = F.wave & 3, n = F.vcu * 64 + F.lane;
        float acc[16];
#pragma unroll
        for (int b = 0; b < 16; ++b) acc[b] = 0.f;
        const float* w = a.in[I_ADAW] + (size_t)l * 1024 * 6144 + n;
#pragma unroll 4
        for (int k = kq * 256; k < kq * 256 + 256; ++k) { const float wv = w[(size_t)k * 6144];
#pragma unroll
            for (int q = 0; q < 4; ++q) { const f32x4 cv = *(const LAS f32x4*)(cact + k * 16 + 4 * q); acc[4 * q] += wv * cv.x; acc[4 * q + 1] += wv * cv.y; acc[4 * q + 2] += wv * cv.z; acc[4 * q + 3] += wv * cv.w; } }
#pragma unroll
        for (int b = 0; b < 16; ++b) part[(F.wave * 16 + b) * 64 + F.lane] = acc[b];
        __syncthreads();
        for (int i = F.tid; i < 2 * 16 * 64; i += NTHR) { const int ll = i >> 10, b = (i >> 6) & 15, nn = i & 63; float s = a.in[I_ADAB][ll * 6144 + F.vcu * 64 + nn];
#pragma unroll
            for (int q = 0; q < 4; ++q) s += part[((ll * 4 + q) * 16 + b) * 64 + nn];
            ((float*)(ws + WS_MOD))[((size_t)ll * 16 + b) * 6144 + F.vcu * 64 + nn] = s; }
        __syncthreads();
    }
    LAS float* scr = (LAS float*)(F.lds + F.wave * 16384);
    const int gw = F.vcu * NWAVES + F.wave, NGW = F.G * NWAVES;
    constexpr int I_IN = 16 * 225, I_SQ = 16 * 32, I_R = 16 * 4, I_SG = 16 * 16, I_SD = 4 * 32, I_RGI = 2 * 4 * 16, I_EG = 16 * 16, I_ED = 4 * 32;
    constexpr int PER_L = I_IN + 3 * I_SQ + I_R + I_SG + I_SD + I_RGI + NE * I_EG + NE * I_ED;
    for (int it = gw; it < DEPTH * PER_L; it += NGW) {
        const int l = it / PER_L; int r = it - l * PER_L;
        if (r < I_IN) { bf16* win = (bf16*)(ws + WS_WIN) + (size_t)l * NSEC * D; bf16* wlr = (bf16*)(ws + WS_WLR) + (size_t)l * 16 * D;
            conv_item(a.in[I_WIN] + (size_t)l * D * N_IN, D, N_IN, scr, r, F.lane, [=](int c) { return winrow(c, win, wlr); }); continue; } r -= I_IN;
        if (r < 3 * I_SQ) { const int w = r / I_SQ; r -= w * I_SQ; const float* src = a.in[w == 0 ? I_WBA : (w == 1 ? I_WBB : I_WOUT)] + (size_t)l * D * D;
            bf16* dst = (bf16*)(ws + (w == 0 ? WS_WA : (w == 1 ? WS_WB : WS_WO))) + (size_t)l * D * D;
            conv_item(src, D, D, scr, r, F.lane, [=](int c) { return dst + (size_t)c * D; }); continue; } r -= 3 * I_SQ;
        if (r < I_R) { bf16* dst = (bf16*)(ws + WS_ROUT) + (size_t)l * 256 * D;
            conv_item(a.in[I_RW] + (size_t)l * D * NE, D, NE, scr, r, F.lane, [=](int c) { return dst + (size_t)c * D; }); continue; } r -= I_R;
        if (r < I_SG) { bf16* dst = (bf16*)(ws + WS_SGU) + (size_t)l * 512 * D;
            conv_item(a.in[I_SGU] + (size_t)l * D * 512, D, 512, scr, r, F.lane, [=](int c) { return dst + (size_t)glurow(c) * D; }); continue; } r -= I_SG;
        if (r < I_SD) { bf16* dst = (bf16*)(ws + WS_SDN) + (size_t)l * D * DE;
            conv_item(a.in[I_SDN] + (size_t)l * DE * D, DE, D, scr, r, F.lane, [=](int c) { return dst + (size_t)c * DE; }); continue; } r -= I_SD;
        if (r < I_RGI) { const int which = r / 64; r -= which * 64; const int hb = r / 8; r -= hb * 8;
            bf16* dst = (bf16*)(ws + WS_RGW) + ((size_t)(l * 8 + hb) * 256 + which * 128) * 128;
            conv_item(a.in[which ? I_RGWX : I_RGWA] + ((size_t)l * 8 + hb) * 128 * 128, 128, 128, scr, r, F.lane, [=](int c) { return dst + (size_t)c * 128; }); continue; } r -= I_RGI;
        if (r < NE * I_EG) { const int e = r / I_EG; r -= e * I_EG; bf16* dst = (bf16*)(ws + WS_EGU) + ((size_t)l * NE + e) * 512 * D;
            conv_item(a.in[I_EGU] + ((size_t)l * NE + e) * D * 512, D, 512, scr, r, F.lane, [=](int c) { return dst + (size_t)glurow(c) * D; }); continue; } r -= NE * I_EG;
        { const int e = r / I_ED; r -= e * I_ED; bf16* dst = (bf16*)(ws + WS_EDN) + ((size_t)l * NE + e) * D * DE;
            conv_item(a.in[I_EDN] + ((size_t)l * NE + e) * DE * D, DE, D, scr, r, F.lane, [=](int c) { return dst + (size_t)c * DE; }); }
    }
    { const int gt = F.vcu * NTHR + F.tid, NT = F.G * NTHR;
      for (int i = gt; i < 2 * 128 * D / 8; i += NT) { const int l = i / (128 * D / 8), r = i - l * (128 * D / 8);
          *(GAS v4u*)((bf16*)(ws + WS_ROUT) + ((size_t)l * 256 + 128) * D + (size_t)r * 8) = (v4u){0u, 0u, 0u, 0u}; }
      if (gt < D / 8) *(GAS v4u*)((bf16*)(ws + WS_U) + (size_t)T * D + gt * 8) = (v4u){0u, 0u, 0u, 0u}; }
}

template <bool FINAL>
__device__ __forceinline__ void norm_phase(const Frame& F, const float* h, const float* gain, const float* sc, const float* sh, bf16* U, float* outf) {
    const int gw = F.vcu * NWAVES + F.wave, NGW = F.G * NWAVES;
    for (int blk = gw; blk < T / 32; blk += NGW) {
        const int b = (blk * 32) / SEQ;
        f32x4 scl[4], sft[4];
#pragma unroll
        for (int j = 0; j < 4; ++j) { const int c = 4 * F.lane + 256 * j; const f32x4 g = *(const f32x4*)(gain + c);
            if (FINAL) { scl[j] = g; sft[j] = (f32x4){0.f, 0.f, 0.f, 0.f}; }
            else { const f32x4 s1 = *(const f32x4*)(sc + (size_t)b * 6144 + c); sft[j] = *(const f32x4*)(sh + (size_t)b * 6144 + c); scl[j] = g * (s1 + 1.0f); } }
        for (int rr = 0; rr < 32; ++rr) {
            const size_t row = (size_t)blk * 32 + rr;
            const GAS f32x4* xr = (const GAS f32x4*)(h + row * D) + F.lane;
            f32x4 v[4]; float s = 0.f;
#pragma unroll
            for (int j = 0; j < 4; ++j) { v[j] = xr[64 * j]; s += (v[j].x * v[j].x + v[j].y * v[j].y) + (v[j].z * v[j].z + v[j].w * v[j].w); }
            const float rs = 1.0f / sqrtf(wave_sum(s, F.lane) * (1.0f / D) + EPS);
            if (FINAL) { GAS f32x4* o = (GAS f32x4*)(outf + row * D) + F.lane;
#pragma unroll
                for (int j = 0; j < 4; ++j) o[64 * j] = v[j] * rs * scl[j];
            } else { GAS v2u* o = (GAS v2u*)(U + row * D) + F.lane;
#pragma unroll
                for (int j = 0; j < 4; ++j) { const f32x4 y = v[j] * rs * scl[j] + sft[j]; o[64 * j] = (v2u){pk2(y.x, y.y), pk2(y.z, y.w)}; } }
        }
    }
}

#define EPI_ROWS_BEGIN _Pragma("unroll") for (int ai = 0; ai < 2; ++ai) _Pragma("unroll") for (int m = 0; m < 4; ++m) { const int rt = ai * 128 + wr * 64 + m * 16 + fr;
#define EPI_ROWS_END }
typedef const pg8::f32x4 (&AccRef)[2][2][4][2];
__device__ __forceinline__ v4u pack8(const f32x4& a, const f32x4& b) { v4u w; w.x = pg8::cvt_pk_bf16(a[0], a[1]); w.y = pg8::cvt_pk_bf16(a[2], a[3]); w.z = pg8::cvt_pk_bf16(b[0], b[1]); w.w = pg8::cvt_pk_bf16(b[2], b[3]); return w; }
template <int ACT> __device__ __forceinline__ f32x4 act4(f32x4 v) {
    if (ACT == 1) { v[0] = fgelu_tanh(v[0]); v[1] = fgelu_tanh(v[1]); v[2] = fgelu_tanh(v[2]); v[3] = fgelu_tanh(v[3]); }
    if (ACT == 2) v = v * 0.08838834764831845f;
    if (ACT == 3) { v[0] = fsilu(v[0]); v[1] = fsilu(v[1]); v[2] = fsilu(v[2]); v[3] = fsilu(v[3]); }
    if (ACT == 4) { v[0] = fsigmoid(v[0]); v[1] = fsigmoid(v[1]); v[2] = fsigmoid(v[2]); v[3] = fsigmoid(v[3]); }
    return v;
}
template <int ACT> __device__ __forceinline__ void store_tile_bf16(AccRef acc, bf16* dst, int ld, size_t row0, int col0, int wr, int wc, int fr, int fq) {
    EPI_ROWS_BEGIN
        bf16* rp = dst + (row0 + rt) * ld + col0 + wc * 32 + 8 * fq;
#pragma unroll
        for (int bj = 0; bj < 2; ++bj) *(GAS v4u*)(rp + bj * 128) = pack8(act4<ACT>(acc[ai][bj][m][0]), act4<ACT>(acc[ai][bj][m][1]));
    EPI_ROWS_END
}
struct EpiInProj {
    unsigned char* ws;
    __device__ __forceinline__ void operator()(AccRef acc, const pg8::Unit& u, int wr, int wc, int fr, int fq) const {
        asm volatile("" : "+v"(fr), "+v"(fq));
        const int pn = u.pn; const size_t row0 = (size_t)u.pm * 256;
        if (pn < 4)       store_tile_bf16<0>(acc, (bf16*)(ws + WS_XRPRE), 1024, row0, pn * 256, wr, wc, fr, fq);
        else if (pn < 8)  store_tile_bf16<1>(acc, (bf16*)(ws + WS_RG), 1024, row0, (pn - 4) * 256, wr, wc, fr, fq);
        else if (pn < 10) store_tile_bf16<2>(acc, (bf16*)(ws + WS_Q), 512, row0, (pn - 8) * 256, wr, wc, fr, fq);
        else if (pn < 12) store_tile_bf16<0>(acc, (bf16*)(ws + WS_K), 512, row0, (pn - 10) * 256, wr, wc, fr, fq);
        else if (pn < 16) store_tile_bf16<0>(acc, (bf16*)(ws + WS_V), 1024, row0, (pn - 12) * 256, wr, wc, fr, fq);
        else if (pn < 20) store_tile_bf16<3>(acc, (bf16*)(ws + WS_OG), 1024, row0, (pn - 16) * 256, wr, wc, fr, fq);
        else if (pn < 24) store_tile_bf16<4>(acc, (bf16*)(ws + WS_GA), 1024, row0, (pn - 20) * 256, wr, wc, fr, fq);
        else              store_tile_bf16<4>(acc, (bf16*)(ws + WS_GB), 1024, row0, (pn - 24) * 256, wr, wc, fr, fq);
    }
};
template <bool FIRST> struct EpiMerge {
    const bf16* gate; bf16* mbuf;
    __device__ __forceinline__ void operator()(AccRef acc, const pg8::Unit& u, int wr, int wc, int fr, int fq) const {
        asm volatile("" : "+v"(fr), "+v"(fq));
        EPI_ROWS_BEGIN
            const size_t o = ((size_t)u.pm * 256 + rt) * 1024 + u.pn * 256 + wc * 32 + 8 * fq;
#pragma unroll
            for (int bj = 0; bj < 2; ++bj) { const v4u gw = *(const GAS v4u*)(gate + o + bj * 128);
                f32x4 g0 = {bflo(gw.x), bfhi(gw.x), bflo(gw.y), bfhi(gw.y)}, g1 = {bflo(gw.z), bfhi(gw.z), bflo(gw.w), bfhi(gw.w)};
                f32x4 r0 = g0 * acc[ai][bj][m][0], r1 = g1 * acc[ai][bj][m][1];
                if (!FIRST) { const v4u mw = *(const GAS v4u*)(mbuf + o + bj * 128);
                    r0 += (f32x4){bflo(mw.x), bfhi(mw.x), bflo(mw.y), bfhi(mw.y)}; r1 += (f32x4){bflo(mw.z), bfhi(mw.z), bflo(mw.w), bfhi(mw.w)}; }
                *(GAS v4u*)(mbuf + o + bj * 128) = pack8(r0, r1); }
        EPI_ROWS_END
    }
};
struct EpiRes {
    const float* hin; float* hout; const float* gate;
    __device__ __forceinline__ void operator()(AccRef acc, const pg8::Unit& u, int wr, int wc, int fr, int fq) const {
        asm volatile("" : "+v"(fr), "+v"(fq));
        const int b = (u.pm * 256) / SEQ; const int cb = u.pn * 256 + wc * 32 + 8 * fq;
        f32x4 gv[2][2];
#pragma unroll
        for (int bj = 0; bj < 2; ++bj)
#pragma unroll
            for (int n = 0; n < 2; ++n) gv[bj][n] = *(const f32x4*)(gate + (size_t)b * 6144 + cb + bj * 128 + 4 * n);
        EPI_ROWS_BEGIN
            const size_t o = ((size_t)u.pm * 256 + rt) * 1024 + cb;
#pragma unroll
            for (int bj = 0; bj < 2; ++bj)
#pragma unroll
                for (int n = 0; n < 2; ++n) { const f32x4 hv = *(const GAS f32x4*)(hin + o + bj * 128 + 4 * n); *(GAS f32x4*)(hout + o + bj * 128 + 4 * n) = hv + gv[bj][n] * acc[ai][bj][m][n]; }
        EPI_ROWS_END
    }
};
struct EpiLogit {
    float* lg;
    __device__ __forceinline__ void operator()(AccRef acc, const pg8::Unit& u, int wr, int wc, int fr, int fq) const {
        asm volatile("" : "+v"(fr), "+v"(fq));
        EPI_ROWS_BEGIN
            float* rp = lg + ((size_t)u.pm * 256 + rt) * 128 + wc * 32 + 8 * fq;
            *(GAS f32x4*)(rp) = acc[ai][0][m][0]; *(GAS f32x4*)(rp + 4) = acc[ai][0][m][1];
        EPI_ROWS_END
    }
};
struct EpiGlu {
    bf16* act;
    __device__ __forceinline__ void operator()(AccRef acc, const pg8::Unit& u, int wr, int wc, int fr, int fq) const {
        asm volatile("" : "+v"(fr), "+v"(fq));
        const int j = u.pn & 1;
        EPI_ROWS_BEGIN
            f32x4 r0 = act4<3>(acc[ai][0][m][0]) * acc[ai][1][m][0], r1 = act4<3>(acc[ai][0][m][1]) * acc[ai][1][m][1];
            *(GAS v4u*)(act + ((size_t)u.pm * 256 + rt) * 256 + j * 128 + wc * 32 + 8 * fq) = pack8(r0, r1);
        EPI_ROWS_END
    }
};
struct EpiY {
    bf16* y;
    __device__ __forceinline__ void operator()(AccRef acc, const pg8::Unit& u, int wr, int wc, int fr, int fq) const {
        asm volatile("" : "+v"(fr), "+v"(fq));
        store_tile_bf16<0>(acc, y, 1024, (size_t)u.pm * 256, (u.pn & 3) * 256, wr, wc, fr, fq);
    }
};

__device__ __forceinline__ int swz16(int row, int ch) { return row * 256 + ((ch ^ (row & 15)) << 4); }
__device__ __forceinline__ void rg_gate_phase(const Frame& F, const Args& a, int l) {
    unsigned char* ws = F.ws;
    const int hb = F.vcu & 7;
    LAS unsigned char* Ws = F.lds; LAS unsigned char* Xs = F.lds + 65536; LAS float* prm = (LAS float*)(F.lds + 98304);
    const bf16* xpre = (const bf16*)(ws + WS_XRPRE); bf16* loga = (bf16*)(ws + WS_LOGA); bf16* ixo = (bf16*)(ws + WS_IX);
    { const bf16* wsrc = (const bf16*)(ws + WS_RGW) + (size_t)(l * 8 + hb) * 256 * 128;
#pragma unroll
      for (int j = 0; j < 8; ++j) { const int ck = F.tid + NTHR * j, n = ck >> 4, ch = ck & 15; *(LAS v4u*)(Ws + swz16(n, ch)) = *(const GAS v4u*)(wsrc + (size_t)ck * 8); }
      if (F.tid < 128) { const int c = l * D + hb * 128 + F.tid; prm[F.tid] = a.in[I_RGBA][c]; prm[128 + F.tid] = a.in[I_RGBX][c];
          const float lam = a.in[I_RGLAM][c]; prm[256 + F.tid] = fmaxf(-lam, 0.f) + log1pf(__expf(-fabsf(lam))); } }
    const int c8 = F.tid & 15, rg4 = F.tid >> 4, chan0 = hb * 128 + 8 * c8;
    float cw[4][8], cb[8];
#pragma unroll
    for (int j = 0; j < 8; ++j) { cb[j] = a.in[I_CONVB][l * D + chan0 + j];
#pragma unroll
        for (int q = 0; q < 4; ++q) cw[q][j] = a.in[I_CONVW][((size_t)l * 4 + q) * D + chan0 + j]; }
    const int fr = F.lane & 15, fq = F.lane >> 4;
    for (int i = 0; i < 16; ++i) {
        const int rt = (F.vcu >> 3) + 32 * i; const size_t row0 = (size_t)rt * 128;
        __syncthreads();
        {
            const int r0 = 4 * rg4; const int tpos = (int)((row0 + r0) & (SEQ - 1));
            float x[7][8];
#pragma unroll
            for (int q = 0; q < 7; ++q) { const int dt = q - 3; v4u w = {0u, 0u, 0u, 0u};
                if (tpos + dt >= 0) w = *(const GAS v4u*)(xpre + (size_t)((long)(row0 + r0) + dt) * D + chan0);
                x[q][0] = bflo(w.x); x[q][1] = bfhi(w.x); x[q][2] = bflo(w.y); x[q][3] = bfhi(w.y); x[q][4] = bflo(w.z); x[q][5] = bfhi(w.z); x[q][6] = bflo(w.w); x[q][7] = bfhi(w.w); }
#pragma unroll
            for (int rr = 0; rr < 4; ++rr) { float y[8];
#pragma unroll
                for (int j = 0; j < 8; ++j) y[j] = cb[j] + cw[0][j] * x[rr][j] + cw[1][j] * x[rr + 1][j] + cw[2][j] * x[rr + 2][j] + cw[3][j] * x[rr + 3][j];
                v4u o; o.x = pk2(y[0], y[1]); o.y = pk2(y[2], y[3]); o.z = pk2(y[4], y[5]); o.w = pk2(y[6], y[7]);
                *(LAS v4u*)(Xs + swz16(r0 + rr, c8)) = o; }
        }
        __syncthreads();
        f32x4 acc[16];
#pragma unroll
        for (int nb = 0; nb < 16; ++nb) acc[nb] = (f32x4){0.f, 0.f, 0.f, 0.f};
        const int arow = 16 * F.wave + fr;
#pragma unroll
        for (int ks = 0; ks < 4; ++ks) { const bf16x8 af = *(const LAS bf16x8*)(Xs + swz16(arow, 4 * ks + fq));
#pragma unroll
            for (int nb = 0; nb < 16; ++nb) { const bf16x8 bfv = *(const LAS bf16x8*)(Ws + swz16(16 * nb + fr, 4 * ks + fq));
                acc[nb] = __builtin_amdgcn_mfma_f32_16x16x32_bf16(bfv, af, acc[nb], 0, 0, 0); } }
        const size_t grow = row0 + arow;
#pragma unroll
        for (int nb = 0; nb < 8; ++nb) { const int c = 16 * nb + 4 * fq;
            const f32x4 ba = *(const LAS f32x4*)(prm + c), bx = *(const LAS f32x4*)(prm + 128 + c), sp = *(const LAS f32x4*)(prm + 256 + c);
            const v2u xw = *(const LAS v2u*)(Xs + swz16(arow, c >> 3) + (c & 7) * 2);
            const float xv[4] = {bflo(xw.x), bfhi(xw.x), bflo(xw.y), bfhi(xw.y)};
            float la[4], ix[4];
#pragma unroll
            for (int j = 0; j < 4; ++j) { const float r = fsigmoid(acc[nb][j] + ba[j]), ii = fsigmoid(acc[nb + 8][j] + bx[j]); la[j] = -8.0f * r * sp[j]; ix[j] = ii * xv[j]; }
            const size_t o = grow * D + hb * 128 + c;
            *(GAS v2u*)(loga + o) = (v2u){pk2(la[0], la[1]), pk2(la[2], la[3])};
            *(GAS v2u*)(ixo + o) = (v2u){pk2(ix[0], ix[1]), pk2(ix[2], ix[3])}; }
    }
    __syncthreads();
}

__device__ __forceinline__ void scan_pass1(const Frame& F, int unit) {
    unsigned char* ws = F.ws;
    const int b = unit >> 7, seg = (unit >> 1) & 63, ch = (unit & 1) * 512 + F.tid; const size_t row0 = (size_t)b * SEQ + seg * 64;
    const bf16* loga = (const bf16*)(ws + WS_LOGA) + row0 * D + ch; const bf16* ixp = (const bf16*)(ws + WS_IX) + row0 * D + ch;
    float P = 1.f, E = 0.f;
#pragma unroll 16
    for (int r = 0; r < 64; ++r) { const float la = bf2f(loga[(size_t)r * D]), ix = bf2f(ixp[(size_t)r * D]);
        const float av = __expf(la); float mult = sqrtf(-expm1f(2.0f * la)); if (seg == 0 && r == 0) mult = 1.0f;
        E = av * E + mult * ix; P *= av; }
    ((float*)(ws + WS_SP))[((size_t)b * 64 + seg) * D + ch] = P; ((float*)(ws + WS_SE))[((size_t)b * 64 + seg) * D + ch] = E;
}
__device__ __forceinline__ void scan_carry(const Frame& F, int unit) {
    unsigned char* ws = F.ws;
    const int b = unit >> 1, ch = (unit & 1) * 512 + F.tid;
    const float* sp = (const float*)(ws + WS_SP) + (size_t)b * 64 * D + ch; const float* se = (const float*)(ws + WS_SE) + (size_t)b * 64 * D + ch; float* ci = (float*)(ws + WS_CIN) + (size_t)b * 64 * D + ch;
    float st = 0.f;
#pragma unroll 16
    for (int s = 0; s < 64; ++s) { ci[(size_t)s * D] = st; st = sp[(size_t)s * D] * st + se[(size_t)s * D]; }
}
__device__ __forceinline__ void scan_pass3(const Frame& F, int unit) {
    unsigned char* ws = F.ws;
    const int b = unit >> 7, seg = (unit >> 1) & 63, ch = (unit & 1) * 512 + F.tid; const size_t row0 = (size_t)b * SEQ + seg * 64;
    const bf16* loga = (const bf16*)(ws + WS_LOGA) + row0 * D + ch; bf16* ixp = (bf16*)(ws + WS_IX) + row0 * D + ch; const bf16* rg = (const bf16*)(ws + WS_RG) + row0 * D + ch;
    float h = ((const float*)(ws + WS_CIN))[((size_t)b * 64 + seg) * D + ch];
#pragma unroll 16
    for (int r = 0; r < 64; ++r) { const float la = bf2f(loga[(size_t)r * D]), ix = bf2f(ixp[(size_t)r * D]), gt = bf2f(rg[(size_t)r * D]);
        const float av = __expf(la); float mult = sqrtf(-expm1f(2.0f * la)); if (seg == 0 && r == 0) mult = 1.0f;
        h = av * h + mult * ix; ixp[(size_t)r * D] = (bf16)f2bf(h * gt); }
}

__device__ __forceinline__ void gla_prep(const Frame& F, const Args& a, int l, int unit) {
    unsigned char* ws = F.ws;
    LAS float* lrs = (LAS float*)F.lds;
    const size_t row0 = (size_t)unit * 64;
    const int fr = F.lane & 15, fq = F.lane >> 4;
    __syncthreads();
    { const int rb = F.wave & 3, kh = F.wave >> 2;
      const bf16* up = (const bf16*)(ws + WS_U) + (row0 + 16 * rb + fr) * D + kh * 512 + 8 * fq;
      const bf16* wp = (const bf16*)(ws + WS_WLR) + ((size_t)l * 16 + fr) * D + kh * 512 + 8 * fq;
      f32x4 acc = {0.f, 0.f, 0.f, 0.f};
#pragma unroll
      for (int ks = 0; ks < 16; ++ks) { const bf16x8 af = *(const GAS bf16x8*)(up + 32 * ks), bfv = *(const GAS bf16x8*)(wp + 32 * ks);
          acc = __builtin_amdgcn_mfma_f32_16x16x32_bf16(af, bfv, acc, 0, 0, 0); }
#pragma unroll
      for (int j = 0; j < 4; ++j) lrs[(kh * 64 + 16 * rb + 4 * fq + j) * 16 + fr] = acc[j]; }
    __syncthreads();
    const int col = F.tid;
    float wu[16];
#pragma unroll
    for (int r = 0; r < 16; ++r) wu[r] = a.in[I_GWUP][((size_t)l * 16 + r) * 512 + col];
    const float bu = a.in[I_GBUP][l * 512 + col];
    float tot = 0.f;
    for (int t = 0; t < 64; ++t) { float lg = bu;
#pragma unroll
        for (int q = 0; q < 4; ++q) { const f32x4 x0 = *(const LAS f32x4*)(lrs + t * 16 + 4 * q), x1 = *(const LAS f32x4*)(lrs + (64 + t) * 16 + 4 * q);
            lg += (x0.x + x1.x) * wu[4 * q] + (x0.y + x1.y) * wu[4 * q + 1] + (x0.z + x1.z) * wu[4 * q + 2] + (x0.w + x1.w) * wu[4 * q + 3]; }
        tot += (fminf(lg, 0.f) - log1pf(__expf(-fabsf(lg)))) * 0.0625f; }
    ((float*)(ws + WS_TOT))[(size_t)unit * 512 + col] = tot;
    const bf16* kp = (const bf16*)(ws + WS_K) + row0 * 512 + col;
    bf16* kd = (bf16*)(ws + WS_KDEC) + ((size_t)unit * 512 + col) * 64;
    float cum = 0.f;
    for (int t8 = 0; t8 < 8; ++t8) { float o[8];
#pragma unroll
        for (int tt = 0; tt < 8; ++tt) { const int t = 8 * t8 + tt; float lg = bu;
#pragma unroll
            for (int q = 0; q < 4; ++q) { const f32x4 x0 = *(const LAS f32x4*)(lrs + t * 16 + 4 * q), x1 = *(const LAS f32x4*)(lrs + (64 + t) * 16 + 4 * q);
                lg += (x0.x + x1.x) * wu[4 * q] + (x0.y + x1.y) * wu[4 * q + 1] + (x0.z + x1.z) * wu[4 * q + 2] + (x0.w + x1.w) * wu[4 * q + 3]; }
            cum += (fminf(lg, 0.f) - log1pf(__expf(-fabsf(lg)))) * 0.0625f;
            o[tt] = bf2f(kp[(size_t)t * 512]) * __expf(tot - cum); }
        *(GAS v4u*)(kd + 8 * t8) = (v4u){pk2(o[0], o[1]), pk2(o[2], o[3]), pk2(o[4], o[5]), pk2(o[6], o[7])}; }
}

constexpr int GQ_OFF = 0, GK_OFF = 64 * 272, GV_OFF = GK_OFF + 128 * 144, GD_OFF = GV_OFF + 64 * 256, GBUF = GD_OFF + 512;
__device__ __forceinline__ unsigned voff_b(unsigned row, unsigned ch) { return 256u * row + 16u * (ch ^ (((row & 3) << 2) | ((row >> 2) & 3))); }
__device__ __forceinline__ bf16x8 pack_step(const f32x16& x, int s) {
    v4u p; p.x = pk2(x[8 * s], x[8 * s + 1]); p.y = pk2(x[8 * s + 2], x[8 * s + 3]); p.z = pk2(x[8 * s + 4], x[8 * s + 5]); p.w = pk2(x[8 * s + 6], x[8 * s + 7]);
    return __builtin_bit_cast(bf16x8, p);
}
__device__ __forceinline__ void gla_stage(const Frame& F, int b, int h, int vh, int n, LAS unsigned char* buf) {
    unsigned char* ws = F.ws; int lt = F.tid - 256; asm volatile("" : "+v"(lt));
    const size_t row0 = (size_t)b * SEQ + (size_t)n * 64;
    const GAS char* qp = (const GAS char*)((const bf16*)(ws + WS_Q) + row0 * 512 + h * 128);
    const GAS char* vp = (const GAS char*)((const bf16*)(ws + WS_V) + row0 * D + h * 256 + vh * 128);
    const GAS char* kp = (const GAS char*)((const bf16*)(ws + WS_KDEC) + (((size_t)b * 64 + n) * 512 + h * 128) * 64);
    v4u qv[4], kv[4], vv[4];
#pragma unroll
    for (int j = 0; j < 4; ++j) { const unsigned ck = (unsigned)lt + 256u * j;
        qv[j] = *(const GAS v4u*)(qp + ((ck >> 4) * 1024u + (ck & 15u) * 16u));
        vv[j] = *(const GAS v4u*)(vp + ((ck >> 4) * 2048u + (ck & 15u) * 16u));
        kv[j] = *(const GAS v4u*)(kp + ck * 16u); }
    float dv = 0.f; if (lt < 128) dv = __expf(((const float*)(ws + WS_TOT))[((size_t)b * 64 + n) * 512 + h * 128 + lt]);
#pragma unroll
    for (int j = 0; j < 4; ++j) { const unsigned ck = (unsigned)lt + 256u * j;
        *(LAS v4u*)(buf + GQ_OFF + (ck >> 4) * 272u + (ck & 15u) * 16u) = qv[j];
        *(LAS v4u*)(buf + GV_OFF + voff_b(ck >> 4, ck & 15u)) = vv[j];
        *(LAS v4u*)(buf + GK_OFF + (ck >> 3) * 144u + (ck & 7u) * 16u) = kv[j]; }
    if (lt < 128) ((LAS float*)(buf + GD_OFF))[lt] = dv;
}
__device__ __forceinline__ void gla_rec(const Frame& F, int unit) {
    unsigned char* ws = F.ws;
    const int b = unit >> 3, h = (unit >> 1) & 3, vh = unit & 1;
    const int w = F.wave;
    f32x16 S[4];
#pragma unroll
    for (int kt = 0; kt < 4; ++kt)
#pragma unroll
        for (int i = 0; i < 16; ++i) S[kt][i] = 0.f;
    __syncthreads();
    if (w >= 4) gla_stage(F, b, h, vh, 0, F.lds);
    __syncthreads();
#pragma unroll 1
    for (int n = 0; n < NCH; ++n) {
        if (w >= 4) { if (n + 1 < NCH) gla_stage(F, b, h, vh, n + 1, F.lds + ((n + 1) & 1) * GBUF); }
        else {
            int lane = F.lane; asm volatile("" : "+v"(lane));
            const int r = lane & 31, hh = lane >> 5;
            const unsigned blk = (lane >> 4) & 1, q4 = (lane & 15) >> 2, p4 = lane & 3;
            LAS unsigned char* buf = F.lds + (n & 1) * GBUF;
            const LAS unsigned char* kbase = buf + GK_OFF + r * 144 + hh * 16;
            const LAS unsigned char* qbase = buf + GQ_OFF + r * 272 + hh * 16;
            const LAS unsigned char* dbase = buf + GD_OFF + hh * 16;
            const unsigned chv = 4u * (unsigned)w + 2u * blk + (p4 >> 1);
            const unsigned vb0 = (unsigned)(size_t)(buf + GV_OFF) + 256u * (8u * hh + q4) + 16u * (chv ^ ((q4 << 2) | ((2u * hh) & 3u))) + 8u * (p4 & 1u);
            const unsigned vb1 = (unsigned)(size_t)(buf + GV_OFF) + 256u * (8u * hh + 4u + q4) + 16u * (chv ^ ((q4 << 2) | ((2u * hh + 1u) & 3u))) + 8u * (p4 & 1u);
#pragma unroll
            for (int kt = 0; kt < 4; ++kt)
#pragma unroll
                for (int g = 0; g < 4; ++g) { const f32x4 dq = *(const LAS f32x4*)(dbase + kt * 128 + g * 32);
                    S[kt][4 * g] *= dq.x; S[kt][4 * g + 1] *= dq.y; S[kt][4 * g + 2] *= dq.z; S[kt][4 * g + 3] *= dq.w; }
#pragma unroll
            for (int ts = 0; ts < 4; ++ts) {
                s16x4 lo, hi;
                asm volatile("ds_read_b64_tr_b16 %0, %2 offset:%4\n\tds_read_b64_tr_b16 %1, %3 offset:%4\n\ts_waitcnt lgkmcnt(0)" : "=&v"(lo), "=&v"(hi) : "v"(vb0), "v"(vb1), "i"(ts * 4096) : "memory");
                const bf16x8 vb = __builtin_shufflevector(lo, hi, 0, 1, 2, 3, 4, 5, 6, 7);
#pragma unroll
                for (int kt = 0; kt < 4; ++kt) { const bf16x8 ka = *(const LAS bf16x8*)(kbase + kt * 4608 + ts * 32);
                    S[kt] = __builtin_amdgcn_mfma_f32_32x32x16_bf16(ka, vb, S[kt], 0, 0, 0); }
            }
            f32x16 O[2];
#pragma unroll
            for (int tb = 0; tb < 2; ++tb)
#pragma unroll
                for (int i = 0; i < 16; ++i) O[tb][i] = 0.f;
#pragma unroll
            for (int kt = 0; kt < 4; ++kt)
#pragma unroll
                for (int s = 0; s < 2; ++s) { const bf16x8 sb = pack_step(S[kt], s);
#pragma unroll
                    for (int tb = 0; tb < 2; ++tb) { const bf16x8 qa = *(const LAS bf16x8*)(qbase + tb * 8704 + kt * 64 + s * 32);
                        O[tb] = __builtin_amdgcn_mfma_f32_32x32x16_bf16(qa, sb, O[tb], 0, 0, 0); } }
            bf16* op = (bf16*)(ws + WS_O) + ((size_t)b * SEQ + (size_t)n * 64 + 4 * hh) * D + h * 256 + vh * 128 + 32 * w + r;
#pragma unroll
            for (int tb = 0; tb < 2; ++tb)
#pragma unroll
                for (int i = 0; i < 16; ++i) { const int t = 32 * tb + (i & 3) + 8 * (i >> 2); op[(size_t)t * D] = (bf16)f2bf(O[tb][i]); }
        }
        __syncthreads();
    }
}
__device__ __forceinline__ void gla_norm(const Frame& F, const Args& a, int l) {
    unsigned char* ws = F.ws;
    const int gw = F.vcu * NWAVES + F.wave, NGW = F.G * NWAVES;
    f32x4 g[4];
#pragma unroll
    for (int hd = 0; hd < 4; ++hd) g[hd] = *(const f32x4*)(a.in[I_GNG] + (size_t)l * 1024 + hd * 256 + 4 * F.lane);
    for (int blk = gw; blk < T / 32; blk += NGW)
        for (int rr = 0; rr < 32; ++rr) { const size_t row = (size_t)blk * 32 + rr;
            GAS v2u* op = (GAS v2u*)((bf16*)(ws + WS_O) + row * D) + F.lane; const GAS v2u* gp = (const GAS v2u*)((const bf16*)(ws + WS_OG) + row * D) + F.lane;
#pragma unroll
            for (int hd = 0; hd < 4; ++hd) { const v2u ow = op[64 * hd], gw2 = gp[64 * hd];
                const f32x4 o = {bflo(ow.x), bfhi(ow.x), bflo(ow.y), bfhi(ow.y)}, og = {bflo(gw2.x), bfhi(gw2.x), bflo(gw2.y), bfhi(gw2.y)};
                const float ss = wave_sum((o.x * o.x + o.y * o.y) + (o.z * o.z + o.w * o.w), F.lane);
                const float rs = 1.0f / sqrtf(ss * (1.0f / 256.0f) + EPS);
                const f32x4 y = o * rs * g[hd] * og; op[64 * hd] = (v2u){pk2(y.x, y.y), pk2(y.z, y.w)}; } }
}

__device__ __forceinline__ void topk_phase(const Frame& F, const Args& a, int l) {
    unsigned char* ws = F.ws;
    LAS int* hist = (LAS int*)F.lds; LAS int* base = hist + 128; LAS float* bias = (LAS float*)(hist + 256);
    __syncthreads();
    if (F.tid < 128) { hist[F.tid] = 0; bias[F.tid] = a.in[I_RB][l * NE + F.tid]; }
    __syncthreads();
    const int t = F.vcu * 256 + F.tid; const bool act = F.tid < 256;
    float val[8], scv[8]; int idx[8], rank[8];
#pragma unroll
    for (int j = 0; j < 8; ++j) { val[j] = -1e30f; scv[j] = 0.f; idx[j] = 0; rank[j] = 0; }
    if (act) {
        const float* lg = (const float*)(ws + WS_LOGIT) + (size_t)t * NE;
        for (int e4 = 0; e4 < 32; ++e4) { const f32x4 x = *(const GAS f32x4*)(lg + 4 * e4);
#pragma unroll
            for (int q = 0; q < 4; ++q) { const int e = 4 * e4 + q; const float sc = 1.0f / (1.0f + __expf(-x[q])); const float v = sc + bias[e];
#pragma unroll
                for (int j = 7; j >= 0; --j) { if (v > val[j]) { if (j < 7) { val[j + 1] = val[j]; scv[j + 1] = scv[j]; idx[j + 1] = idx[j]; } val[j] = v; scv[j] = sc; idx[j] = e; } } } }
#pragma unroll
        for (int j = 0; j < 8; ++j) rank[j] = __hip_atomic_fetch_add(&hist[idx[j]], 1, __ATOMIC_RELAXED, __HIP_MEMORY_SCOPE_WORKGROUP);
    }
    __syncthreads();
    if (F.tid < 128) base[F.tid] = (int)atomicAdd((unsigned*)(ws + WS_CTL) + CW_CNT + l * NE + F.tid, (unsigned)hist[F.tid]);
    __syncthreads();
    if (act) { float ssum = 0.f;
#pragma unroll
        for (int j = 0; j < 8; ++j) ssum += scv[j];
        const float inv = 2.5f / ssum;
#pragma unroll
        for (int j = 0; j < 8; ++j) { ((unsigned*)(ws + WS_PK))[(size_t)t * 8 + j] = ((unsigned)idx[j] << 24) | (unsigned)(base[idx[j]] + rank[j]); ((float*)(ws + WS_WTS))[(size_t)t * 8 + j] = scv[j] * inv; } }
    __syncthreads();
}
__device__ __forceinline__ void moe_tiles(const Frame& F, int l) {
    LAS int* ts = (LAS int*)(F.lds + LDS_TS);
    __syncthreads();
    if (F.tid == 0) { const unsigned* cnt = (const unsigned*)(F.ws + WS_CTL) + CW_CNT + l * NE; int s = 0;
        for (int e = 0; e < NE; ++e) { ts[e] = s; s += (int)((__hip_atomic_load(cnt + e, RLX_AGENT) + 255u) >> 8); } ts[NE] = s; }
    __syncthreads();
}
__device__ __forceinline__ void scatter_phase(const Frame& F, int l) {
    unsigned char* ws = F.ws;
    moe_tiles(F, l);
    const LAS int* ts = (const LAS int*)(F.lds + LDS_TS);
    if (F.tid < 256) { const int t = F.vcu * 256 + F.tid;
#pragma unroll
        for (int j = 0; j < 8; ++j) { const unsigned pk = ((const unsigned*)(ws + WS_PK))[(size_t)t * 8 + j]; const int e = (int)(pk >> 24), p = ts[e] * 256 + (int)(pk & 0xffffffu);
            ((int*)(ws + WS_POS))[(size_t)t * 8 + j] = p; ((int*)(ws + WS_SORT))[p] = t; } }
}
__device__ __forceinline__ void combine_phase(const Frame& F, float* h, const float* gate) {
    unsigned char* ws = F.ws;
    const int gw = F.vcu * NWAVES + F.wave, NGW = F.G * NWAVES;
    for (int blk = gw; blk < T / 32; blk += NGW) {
        const int b = (blk * 32) / SEQ;
        f32x4 gv[2][2];
#pragma unroll
        for (int j = 0; j < 2; ++j)
#pragma unroll
            for (int n = 0; n < 2; ++n) gv[j][n] = *(const f32x4*)(gate + (size_t)b * 6144 + 512 * j + 8 * F.lane + 4 * n);
        for (int rr = 0; rr < 32; ++rr) { const size_t t = (size_t)blk * 32 + rr;
            f32x4 acc[2][2];
#pragma unroll
            for (int j = 0; j < 2; ++j) { acc[j][0] = (f32x4){0.f, 0.f, 0.f, 0.f}; acc[j][1] = (f32x4){0.f, 0.f, 0.f, 0.f}; }
#pragma unroll
            for (int k = 0; k < 8; ++k) { const int p = ((const int*)(ws + WS_POS))[t * 8 + k]; const float wk = ((const float*)(ws + WS_WTS))[t * 8 + k];
                const bf16* yr = (const bf16*)(ws + WS_Y) + (size_t)p * D + 8 * F.lane;
#pragma unroll
                for (int j = 0; j < 2; ++j) { const v4u yw = *(const GAS v4u*)(yr + 512 * j);
                    acc[j][0] += (f32x4){bflo(yw.x), bfhi(yw.x), bflo(yw.y), bfhi(yw.y)} * wk; acc[j][1] += (f32x4){bflo(yw.z), bfhi(yw.z), bflo(yw.w), bfhi(yw.w)} * wk; } }
            float* hr = h + t * D + 8 * F.lane;
#pragma unroll
            for (int j = 0; j < 2; ++j)
#pragma unroll
                for (int n = 0; n < 2; ++n) { const f32x4 hv = *(const GAS f32x4*)(hr + 512 * j + 4 * n); *(GAS f32x4*)(hr + 512 * j + 4 * n) = hv + gv[j][n] * acc[j][n]; }
        }
    }
}

constexpr int NPH_L = 15, NPHASE = 1 + DEPTH * NPH_L + 1;
__global__ void __launch_bounds__(NTHR, 2) mk_fwd(Args args) {
    extern __shared__ __attribute__((aligned(16))) unsigned char lds_raw[];
    Frame F;
    F.lds = (LAS unsigned char*)lds_raw; F.ws = args.ws;
    F.tid = threadIdx.x; F.lane = F.tid & 63; F.wave = __builtin_amdgcn_readfirstlane(F.tid >> 6);
    F.G = gridDim.x; { const int bx = blockIdx.x; F.bx = bx; F.vcu = (F.G % 8 == 0) ? (bx % 8) * (F.G / 8) + bx / 8 : bx; }
    volatile LAS unsigned* misc = (volatile LAS unsigned*)(F.lds + LDS_MISC);
    if (F.tid < 64) misc[F.tid] = 0u;
    __syncthreads();
    XcdBarrier bar; bar.bar = (unsigned*)(args.ws + WS_CTL) + CW_BAR; bar.x = 0; bar.st = nullptr;
    if (!MK_PER_PHASE) bar = xcd_barrier_post((unsigned*)(args.ws + WS_CTL) + CW_BAR, misc + 8);
    const int lo = args.ph_lo, hi = args.ph_hi;
#ifndef MK_G4_FROM_U
#define MK_G4_FROM_U 0
#endif
#ifndef MK_G3B_FIRST
#define MK_G3B_FIRST false
#endif
#ifndef MK_MASK
#define MK_MASK 0x7ffff
#endif
#define EN(j) (((MK_MASK) >> (j)) & 1)
#define IN(k) (lo <= (k) && (k) < hi)
#define FRESH_TID(t_) int t_; { int l_; asm volatile("v_mbcnt_lo_u32_b32 %0, -1, 0\n\tv_mbcnt_hi_u32_b32 %0, -1, %0" : "=v"(l_)); int wv_ = F.wave; asm volatile("" : "+s"(wv_)); t_ = wv_ * 64 + l_; }
#define FRESH(P) Frame P = F; { FRESH_TID(t_); P.tid = t_; P.lane = t_ & 63; unsigned char* w_ = args.ws; asm volatile("" : "+s"(w_)); P.ws = w_; int g_ = F.G, v_ = F.vcu, b_ = F.bx; asm volatile("" : "+s"(g_), "+s"(v_), "+s"(b_)); P.G = g_; P.vcu = v_; P.bx = b_; } unsigned char* ws = P.ws
#define SEAM(k) do { if (IN(k) && IN((k) + 1)) { FRESH_TID(tb_); xcd_barrier(bar, tb_ == 0); } } while (0)
    float* H = args.out;
    if (EN(15) && IN(0)) { FRESH(P); (void)ws; p0_prologue(P, args); } SEAM(0);
#pragma unroll 1
    for (int l = 0; l < DEPTH; ++l) {
        const int p0 = 1 + NPH_L * l;
        const float* hin = (l == 0) ? args.in[I_X] : H;
#define MODP ((const float*)(ws + WS_MOD) + (size_t)l * 16 * 6144)
        if (EN(0) && IN(p0 + 0)) { FRESH(P); norm_phase<false>(P, hin, args.in[I_N1G] + l * D, MODP + 1024, MODP + 0, (bf16*)(ws + WS_U), nullptr); }
        SEAM(p0 + 0);
        if (EN(1) && IN(p0 + 1)) { FRESH(P); pg8::Gemm g{(const bf16*)(ws + WS_U), (const bf16*)(ws + WS_WIN) + (size_t)l * NSEC * D, D, nullptr}; pg8::StaticOrder S; S.init(T, NSEC, P.G, P.bx);
            EpiInProj E{ws}; pg8::gemm_phase<EpiInProj, pg8::StaticOrder, true, true, false>(P.lds, g, S, E, P.tid, P.wave); }
        SEAM(p0 + 1);
        if (EN(2) && IN(p0 + 2)) { FRESH(P); (void)ws; rg_gate_phase(P, args, l); }
        SEAM(p0 + 2);
        if (EN(3) && IN(p0 + 3)) { FRESH(P); (void)ws; if (EN(18)) for (int u = P.vcu; u < 2048; u += P.G) scan_pass1(P, u); if (EN(17)) for (int u = P.vcu; u < 1024; u += P.G) gla_prep(P, args, l, u); }
        SEAM(p0 + 3);
        if (EN(4) && IN(p0 + 4)) { FRESH(P); (void)ws; for (int u = P.vcu; u < 160; u += P.G) { if (u < 128) { if (EN(17)) gla_rec(P, u); } else { if (EN(18)) scan_carry(P, u - 128); } } }
        SEAM(p0 + 4);
        if (EN(5) && IN(p0 + 5)) { FRESH(P); (void)ws; if (EN(18)) for (int u = P.vcu; u < 2048; u += P.G) scan_pass3(P, u); if (EN(17)) gla_norm(P, args, l); }
        SEAM(p0 + 5);
        if (EN(6) && IN(p0 + 6)) {
            { FRESH(P); pg8::StaticOrder S; S.init(T, D, P.G, P.bx);
              pg8::Gemm g{(const bf16*)(ws + WS_IX), (const bf16*)(ws + WS_WA) + (size_t)l * D * D, D, nullptr}; EpiMerge<true> E{(const bf16*)(ws + WS_GA), (bf16*)(ws + WS_MBUF)};
              pg8::gemm_phase<EpiMerge<true>, pg8::StaticOrder, true, true, false>(P.lds, g, S, E, P.tid, P.wave); }
            { FRESH(P); pg8::StaticOrder S; S.init(T, D, P.G, P.bx);
              pg8::Gemm g{(const bf16*)(ws + WS_O), (const bf16*)(ws + WS_WB) + (size_t)l * D * D, D, nullptr}; EpiMerge<MK_G3B_FIRST> E{(const bf16*)(ws + WS_GB), (bf16*)(ws + WS_MBUF)};
              pg8::gemm_phase<EpiMerge<MK_G3B_FIRST>, pg8::StaticOrder, true, true, false>(P.lds, g, S, E, P.tid, P.wave); } }
        SEAM(p0 + 6);
        if (EN(7) && IN(p0 + 7)) { FRESH(P); pg8::StaticOrder S; S.init(T, D, P.G, P.bx);
            pg8::Gemm g{(const bf16*)(ws + (MK_G4_FROM_U == 1 ? WS_U : (MK_G4_FROM_U == 2 ? WS_XRPRE : (MK_G4_FROM_U == 3 ? WS_GB : (MK_G4_FROM_U == 4 ? WS_V : (MK_G4_FROM_U == 5 ? WS_GA : (MK_G4_FROM_U == 6 ? WS_OG : WS_MBUF))))))), (const bf16*)(ws + WS_WO) + (size_t)l * D * D, D, nullptr}; EpiRes E{hin, H, MODP + 2048};
            pg8::gemm_phase<EpiRes, pg8::StaticOrder, true, true, false>(P.lds, g, S, E, P.tid, P.wave); }
        SEAM(p0 + 7);
        if (EN(8) && IN(p0 + 8)) { FRESH(P); norm_phase<false>(P, H, args.in[I_N2G] + l * D, MODP + 4096, MODP + 3072, (bf16*)(ws + WS_U), nullptr);
            for (int i = P.vcu * NTHR + P.tid; i < PMAX; i += P.G * NTHR) ((int*)(ws + WS_SORT))[i] = T; }
        SEAM(p0 + 8);
        if (EN(9) && IN(p0 + 9)) { FRESH(P); pg8::StaticOrder S; S.init(T, 256, P.G, P.bx);
            pg8::Gemm g{(const bf16*)(ws + WS_U), (const bf16*)(ws + WS_ROUT) + (size_t)l * 256 * D, D, nullptr}; EpiLogit E{(float*)(ws + WS_LOGIT)};
            pg8::gemm_phase<EpiLogit, pg8::StaticOrder, true, true, false>(P.lds, g, S, E, P.tid, P.wave); }
        SEAM(p0 + 9);
        if (EN(10) && IN(p0 + 10)) { FRESH(P); (void)ws; topk_phase(P, args, l); }
        SEAM(p0 + 10);
        if (EN(11) && IN(p0 + 11)) { FRESH(P); (void)ws; scatter_phase(P, l); }
        SEAM(p0 + 11);
        if (EN(12) && IN(p0 + 12)) {
            { FRESH(P); moe_tiles(P, l); const LAS int* ts = (const LAS int*)(P.lds + LDS_TS);
              pg8::MoeOrder S{ts, 2, P.G, P.vcu, ts[NE] * 2};
              pg8::Gemm g{(const bf16*)(ws + WS_U), (const bf16*)(ws + WS_EGU) + (size_t)l * NE * 512 * D, D, (const int*)(ws + WS_SORT)}; EpiGlu E{(bf16*)(ws + WS_ACT)};
              pg8::gemm_phase<EpiGlu, pg8::MoeOrder, true, true, true>(P.lds, g, S, E, P.tid, P.wave); }
            { FRESH(P); pg8::StaticOrder S; S.init(T, 512, P.G, P.bx);
              pg8::Gemm g{(const bf16*)(ws + WS_U), (const bf16*)(ws + WS_SGU) + (size_t)l * 512 * D, D, nullptr}; EpiGlu E{(bf16*)(ws + WS_ACTS)};
              pg8::gemm_phase<EpiGlu, pg8::StaticOrder, true, true, false>(P.lds, g, S, E, P.tid, P.wave); } }
        SEAM(p0 + 12);
        if (EN(13) && IN(p0 + 13)) {
            { FRESH(P); moe_tiles(P, l); const LAS int* ts = (const LAS int*)(P.lds + LDS_TS);
              pg8::MoeOrder S{ts, 4, P.G, P.vcu, ts[NE] * 4};
              pg8::Gemm g{(const bf16*)(ws + WS_ACT), (const bf16*)(ws + WS_EDN) + (size_t)l * NE * D * DE, DE, nullptr}; EpiY E{(bf16*)(ws + WS_Y)};
              pg8::gemm_phase<EpiY, pg8::MoeOrder, true, true, false>(P.lds, g, S, E, P.tid, P.wave); }
            { FRESH(P); pg8::StaticOrder S; S.init(T, D, P.G, P.bx);
              pg8::Gemm g{(const bf16*)(ws + WS_ACTS), (const bf16*)(ws + WS_SDN) + (size_t)l * D * DE, DE, nullptr}; EpiRes E{H, H, MODP + 5120};
              pg8::gemm_phase<EpiRes, pg8::StaticOrder, true, true, false>(P.lds, g, S, E, P.tid, P.wave); } }
        SEAM(p0 + 13);
        if (EN(14) && IN(p0 + 14)) { FRESH(P); combine_phase(P, H, MODP + 5120); }
        SEAM(p0 + 14);
    }
    if (EN(16) && IN(NPHASE - 1)) { FRESH(P); (void)ws; norm_phase<true>(P, H, args.in[I_FG], nullptr, nullptr, nullptr, H); }
#undef MODP
#undef IN
#undef SEAM
}

#ifndef MK_SKIP_LO
#define MK_SKIP_LO 0
#define MK_SKIP_HI 0
#endif
#ifndef MK_NLAUNCH
#define MK_NLAUNCH NPHASE
#endif
extern "C" void kernel_launch(void* const* d_in, const int* in_sizes, int n_in, void* d_out, int out_size, void* d_ws, size_t ws_size, hipStream_t stream) {
    static int grid = 0;
    if (grid == 0) {
        if (n_in != N_INPUTS || out_size != T * D || ws_size < WS_END) { fprintf(stderr, "kernel_launch: unexpected problem shape (n_in %d out %d ws %zu, need %zu)\n", n_in, out_size, ws_size, (size_t)WS_END); grid = -1; return; }
        int dev = 0, cus = 0, per_cu = 0;
        if (hipGetDevice(&dev) != hipSuccess || hipDeviceGetAttribute(&cus, hipDeviceAttributeMultiprocessorCount, dev) != hipSuccess) { grid = -1; return; }
        if (hipFuncSetAttribute((const void*)mk_fwd, hipFuncAttributeMaxDynamicSharedMemorySize, LDS_BYTES) != hipSuccess) { fprintf(stderr, "kernel_launch: hipFuncSetAttribute failed\n"); grid = -1; return; }
        if (hipOccupancyMaxActiveBlocksPerMultiprocessor(&per_cu, (const void*)mk_fwd, NTHR, LDS_BYTES) != hipSuccess || per_cu < 1) { fprintf(stderr, "kernel_launch: occupancy query says %d\n", per_cu); }
        (void)hipGetLastError();
        grid = cus;
    }
    if (grid < 0) return;
    if (hipMemsetAsync((char*)d_ws + WS_CTL, 0, CTL_ZERO_BYTES, stream) != hipSuccess) return;
    Args a{};
    for (int i = 0; i < N_INPUTS; ++i) a.in[i] = (const float*)d_in[i];
    a.out = (float*)d_out; a.ws = (unsigned char*)d_ws;
#if MK_PER_PHASE
    for (int p = 0; p < MK_NLAUNCH; ++p) { if (p >= MK_SKIP_LO && p < MK_SKIP_HI) continue; a.ph_lo = p; a.ph_hi = p + 1; hipLaunchKernelGGL(mk_fwd, dim3(grid), dim3(NTHR), LDS_BYTES, stream, a); }
#else
    a.ph_lo = 0; a.ph_hi = NPHASE; hipLaunchKernelGGL(mk_fwd, dim3(grid), dim3(NTHR), LDS_BYTES, stream, a);
#endif
}
```

```cpp
#include <hip/hip_runtime.h>
#include <cstdio>
#include <cstdint>

#ifndef MK_PER_PHASE
#define MK_PER_PHASE 0
#endif

namespace pg8 {
#define PG8_LAS __attribute__((address_space(3)))
typedef unsigned short bf16_t;
typedef short bf16x8 __attribute__((ext_vector_type(8)));
typedef float f32x4 __attribute__((ext_vector_type(4)));
typedef unsigned u32x4 __attribute__((ext_vector_type(4)));
constexpr int BM = 256, BK = 64, HALF = 128, HTB = HALF * BK * 2, STAGE_BYTES = 8 * HTB, NXCD = 8, WGM = 8;

__host__ __device__ __forceinline__ int lds_byte(int r, int c) { const int st = (r >> 4) * 2 + (c >> 5), rr = r & 15, cc = c & 31, ob = rr * 64 + cc * 2; return st * 1024 + (ob ^ (((ob >> 9) & 1) << 5)); }
__host__ __device__ __forceinline__ void stage_rc(int b, int& R, int& C) { const int st = b / 1024, sb = b % 1024, swz = sb ^ (((sb >> 9) & 1) << 5); R = (st >> 1) * 16 + swz / 64; C = (st & 1) * 32 + (swz % 64) / 2; }
__host__ __device__ __forceinline__ int perm32(int rho) { const int n = rho >> 4, i = rho & 15; return 8 * (i >> 2) + 4 * n + (i & 3); }

struct Unit { int pm, pn; };
struct Gemm { const bf16_t* A; const bf16_t* Bt; int K; const int* rowidx; };

struct StaticOrder {
    int nM, nN, nwg, G, c;
    __host__ __device__ void init(int M, int N, int G_, int c_) { nM = M / BM; nN = N / BM; nwg = nM * nN; G = G_; c = c_; }
    __host__ __device__ bool next(int i, Unit& u) const {
        const long L = (long)i * G + c; if (L >= nwg) return false;
        int wgid = (int)L; { const int q = nwg / NXCD, r = nwg % NXCD, xcd = wgid % NXCD, off = wgid / NXCD; wgid = (xcd < r ? xcd * (q + 1) : r * (q + 1) + (xcd - r) * q) + off; }
        const int nig = WGM * nN, gid = wgid / nig, fm = gid * WGM, gsz = (nM - fm) < WGM ? (nM - fm) : WGM;
        u.pm = fm + ((wgid % nig) % gsz); u.pn = (wgid % nig) / gsz; return true;
    }
};
struct MoeOrder {
    const PG8_LAS int* ts; int npn, G, c, total;
    __device__ __forceinline__ bool next(int i, Unit& u) const {
        const int L = i * G + c; if (L >= total) return false;
        const int tile = L / npn, j = L - tile * npn;
        int lo = 0, hi = 128;
        while (hi - lo > 1) { const int mid = (lo + hi) >> 1; if (ts[mid] <= tile) lo = mid; else hi = mid; }
        u.pm = tile; u.pn = lo * npn + j; return true;
    }
};

__device__ __forceinline__ unsigned cvt_pk_bf16(float lo, float hi) { typedef __bf16 bf2_t __attribute__((ext_vector_type(2))); typedef float f2_t __attribute__((ext_vector_type(2)));
    return __builtin_bit_cast(unsigned, __builtin_convertvector((f2_t){lo, hi}, bf2_t)); }

template <class Epi, class Sched, bool ALIGN_EPI, bool SP2, bool GATHER>
__device__ __forceinline__ void gemm_phase(PG8_LAS unsigned char* lds, const Gemm g, const Sched& S, const Epi& E, const int tid, const int wid) {
    const int lane = tid & 63, wr = wid >> 2, wc = wid & 3, fr = lane & 15, fq = lane >> 4;
    const int K = g.K, nt = K / BK;
    unsigned voffA[2], voffB[2];
#pragma unroll
    for (int i = 0; i < 2; ++i) { int R, C; stage_rc(tid * 16 + i * 8192, R, C); const int Rb = (R & ~31) + perm32(R & 31);
        voffA[i] = (unsigned)(R * K + C) * 2u; voffB[i] = (unsigned)(Rb * K + C) * 2u; }
    const size_t kstep = (size_t)(BK * 2);
    const size_t hstep = (size_t)HALF * K * 2;
    const size_t tstep = 2 * hstep;
    const unsigned ldsw = (unsigned)wid * 1024u;
    const int aoff = lds_byte(wr * 64 + fr, fq * 8), boff = lds_byte(wc * 32 + fr, fq * 8);
    unsigned gc[2][2], gn[2][2];
#define PG8_SA(b, h) (((b) * 2 + (h)) * HTB)
#define PG8_SB(b, h) ((4 + (b) * 2 + (h)) * HTB)
#define PG8_STAGE(bufoff, gbase, voff) do { _Pragma("unroll") for (int _i = 0; _i < 2; ++_i) \
        __builtin_amdgcn_global_load_lds((const unsigned*)((const char*)(gbase) + (voff)[_i]), (PG8_LAS unsigned*)(lds + (bufoff) + ldsw + _i * 8192), 16, 0, 0); } while (0)
#define PG8_STAGE_A(bufoff, kb, h, NX) do { if constexpr (GATHER) { _Pragma("unroll") for (int _i = 0; _i < 2; ++_i) { const unsigned _o = (NX) ? gn[h][_i] : gc[h][_i]; \
        __builtin_amdgcn_global_load_lds((const unsigned*)((const char*)(kb) + _o), (PG8_LAS unsigned*)(lds + (bufoff) + ldsw + _i * 8192), 16, 0, 0); } } \
        else { PG8_STAGE(bufoff, (const char*)(kb) + ((h) ? hstep : (size_t)0), voffA); } } while (0)
#define PG8_LDA(dst, b, h) do { _Pragma("unroll") for (int m = 0; m < 4; ++m) _Pragma("unroll") for (int k = 0; k < 2; ++k) dst[m][k] = *(const PG8_LAS bf16x8*)(lds + PG8_SA(b, h) + aoff + m * 2048 + k * 1024); } while (0)
#define PG8_LDB(dst, b, h) do { _Pragma("unroll") for (int n = 0; n < 2; ++n) _Pragma("unroll") for (int k = 0; k < 2; ++k) dst[n][k] = *(const PG8_LAS bf16x8*)(lds + PG8_SB(b, h) + boff + n * 2048 + k * 1024); } while (0)
#define PG8_MMA(ai, bj, At, Bt) do { __builtin_amdgcn_s_setprio(1); _Pragma("unroll") for (int m = 0; m < 4; ++m) _Pragma("unroll") for (int n = 0; n < 2; ++n) _Pragma("unroll") for (int k = 0; k < 2; ++k) \
        acc[ai][bj][m][n] = __builtin_amdgcn_mfma_f32_16x16x32_bf16(Bt[n][k], At[m][k], acc[ai][bj][m][n], 0, 0, 0); __builtin_amdgcn_s_setprio(0); } while (0)
#define PG8_WAIT_V(n) asm volatile("s_waitcnt vmcnt(" #n ")" ::: "memory")
#define PG8_WAIT_L(n) asm volatile("s_waitcnt lgkmcnt(" #n ")" ::: "memory")
#define PG8_BAR __builtin_amdgcn_s_barrier()
#define PG8_SCHED __builtin_amdgcn_sched_barrier(0)
#define PG8_LOAD_ROWS(dst, un) do { int _ln; asm volatile("v_mbcnt_lo_u32_b32 %0, -1, 0\n\tv_mbcnt_hi_u32_b32 %0, -1, %0" : "=v"(_ln)); const int _t = wid * 64 + _ln; \
        _Pragma("unroll") for (int _i = 0; _i < 2; ++_i) { int _R, _C; stage_rc(_t * 16 + _i * 8192, _R, _C); _Pragma("unroll") for (int _h = 0; _h < 2; ++_h) { \
        const int _tok = ((const __attribute__((address_space(1))) int*)g.rowidx)[(un).pm * BM + _h * HALF + _R]; dst[_h][_i] = (unsigned)_tok * (unsigned)(K * 2) + (unsigned)_C * 2u; } } } while (0)
    Unit cur, nxt; int ui = 0;
    if (!S.next(0, cur)) return;
    f32x4 acc[2][2][4][2];
#pragma unroll
    for (int a = 0; a < 2; ++a)
#pragma unroll
        for (int b = 0; b < 2; ++b)
#pragma unroll
            for (int m = 0; m < 4; ++m)
#pragma unroll
                for (int n = 0; n < 2; ++n) acc[a][b][m][n] = (f32x4){0.f, 0.f, 0.f, 0.f};
    bf16x8 At[4][2], B0[2][2], B1[2][2];
    const char* cA = GATHER ? (const char*)g.A : (const char*)g.A + (size_t)cur.pm * tstep; const char* cB = (const char*)g.Bt + (size_t)cur.pn * tstep;
    if constexpr (GATHER) { PG8_LOAD_ROWS(gc, cur); }
    if constexpr (SP2) {
        PG8_STAGE(PG8_SB(0, 0), cB, voffB); PG8_STAGE(PG8_SB(0, 1), cB + hstep, voffB); PG8_STAGE_A(PG8_SA(0, 0), cA, 0, false); PG8_STAGE_A(PG8_SA(0, 1), cA, 1, false);
        if (wr == 1) PG8_BAR;
        PG8_WAIT_V(2); PG8_BAR;
        PG8_STAGE(PG8_SB(1, 0), cB + kstep, voffB); PG8_STAGE_A(PG8_SA(1, 0), cA + kstep, 0, false); PG8_STAGE(PG8_SB(1, 1), cB + hstep + kstep, voffB);
        PG8_WAIT_V(6); PG8_BAR;
    } else {
        PG8_STAGE(PG8_SB(0, 0), cB, voffB); PG8_STAGE_A(PG8_SA(0, 0), cA, 0, false); PG8_STAGE(PG8_SB(0, 1), cB + hstep, voffB); PG8_STAGE_A(PG8_SA(0, 1), cA, 1, false);
        if (wr == 1) PG8_BAR;
        PG8_WAIT_V(4); PG8_BAR;
        PG8_STAGE(PG8_SB(1, 0), cB + kstep, voffB); PG8_STAGE_A(PG8_SA(1, 0), cA + kstep, 0, false); PG8_STAGE(PG8_SB(1, 1), cB + hstep + kstep, voffB);
        PG8_WAIT_V(6); PG8_BAR;
    }
    for (;;) {
        const bool has_next = S.next(ui + 1, nxt);
        const char* nA = GATHER ? (const char*)g.A : (has_next ? (const char*)g.A + (size_t)nxt.pm * tstep : cA); const char* nB = has_next ? (const char*)g.Bt + (size_t)nxt.pn * tstep : cB;
        if constexpr (GATHER) { if (has_next) { PG8_LOAD_ROWS(gn, nxt); } else {
#pragma unroll
            for (int _h = 0; _h < 2; ++_h)
#pragma unroll
                for (int _i = 0; _i < 2; ++_i) gn[_h][_i] = gc[_h][_i]; } }
#pragma unroll 1
        for (int t = 0; t < nt; t += 2) {
            const bool last = (t == nt - 2);
            const char* a1 = cA + (size_t)(t + 1) * kstep;
            const char* a2 = last ? nA : cA + (size_t)(t + 2) * kstep; const char* b2 = last ? nB : cB + (size_t)(t + 2) * kstep;
            const char* a3 = a2 + kstep; const char* b3 = b2 + kstep;
            if constexpr (SP2) {
            PG8_LDB(B0, 0, 0); PG8_LDB(B1, 0, 1); PG8_SCHED; PG8_LDA(At, 0, 0); PG8_STAGE_A(PG8_SA(1, 1), a1, 1, false);
            PG8_WAIT_V(8); PG8_WAIT_L(0); PG8_BAR; PG8_MMA(0, 0, At, B0); PG8_MMA(0, 1, At, B1); PG8_BAR; PG8_SCHED;
            PG8_LDA(At, 0, 1); PG8_STAGE(PG8_SB(0, 0), b2, voffB); PG8_STAGE(PG8_SB(0, 1), b2 + hstep, voffB); PG8_STAGE_A(PG8_SA(0, 0), a2, 0, last);
            PG8_WAIT_V(8); PG8_WAIT_L(0); PG8_BAR; PG8_MMA(1, 0, At, B0); PG8_MMA(1, 1, At, B1); PG8_BAR; PG8_SCHED;
            PG8_LDB(B0, 1, 0); PG8_LDB(B1, 1, 1); PG8_SCHED; PG8_LDA(At, 1, 0); PG8_STAGE_A(PG8_SA(0, 1), a2, 1, last);
            PG8_WAIT_V(8); PG8_WAIT_L(0); PG8_BAR; PG8_MMA(0, 0, At, B0); PG8_MMA(0, 1, At, B1); PG8_BAR; PG8_SCHED;
            PG8_LDA(At, 1, 1); PG8_STAGE(PG8_SB(1, 0), b3, voffB); PG8_STAGE(PG8_SB(1, 1), b3 + hstep, voffB); PG8_STAGE_A(PG8_SA(1, 0), a3, 0, last);
            PG8_WAIT_V(8); PG8_WAIT_L(0); PG8_BAR; PG8_MMA(1, 0, At, B0); PG8_MMA(1, 1, At, B1); PG8_BAR; PG8_SCHED;
            } else {
            PG8_LDB(B0, 0, 0); PG8_SCHED; PG8_LDA(At, 0, 0); PG8_STAGE_A(PG8_SA(1, 1), a1, 1, false);
            PG8_WAIT_L(8); PG8_BAR; PG8_WAIT_L(0); PG8_MMA(0, 0, At, B0); PG8_BAR; PG8_SCHED;
            PG8_LDB(B1, 0, 1); PG8_STAGE(PG8_SB(0, 0), b2, voffB);
            PG8_BAR; PG8_WAIT_L(0); PG8_MMA(0, 1, At, B1); PG8_BAR;
            PG8_LDA(At, 0, 1); PG8_STAGE_A(PG8_SA(0, 0), a2, 0, last);
            PG8_BAR; PG8_WAIT_L(0); PG8_MMA(1, 0, At, B0); PG8_BAR; PG8_SCHED;
            PG8_STAGE(PG8_SB(0, 1), b2 + hstep, voffB);
            PG8_WAIT_V(6); PG8_BAR; PG8_MMA(1, 1, At, B1); PG8_BAR;
            PG8_LDB(B0, 1, 0); PG8_SCHED; PG8_LDA(At, 1, 0); PG8_STAGE_A(PG8_SA(0, 1), a2, 1, last);
            PG8_WAIT_L(8); PG8_BAR; PG8_WAIT_L(0); PG8_MMA(0, 0, At, B0); PG8_BAR; PG8_SCHED;
            PG8_LDB(B1, 1, 1); PG8_STAGE(PG8_SB(1, 0), b3, voffB);
            PG8_BAR; PG8_WAIT_L(0); PG8_MMA(0, 1, At, B1); PG8_BAR;
            PG8_LDA(At, 1, 1); PG8_STAGE_A(PG8_SA(1, 0), a3, 0, last);
            PG8_BAR; PG8_WAIT_L(0); PG8_MMA(1, 0, At, B0); PG8_BAR; PG8_SCHED;
            PG8_STAGE(PG8_SB(1, 1), b3 + hstep, voffB);
            PG8_WAIT_V(6); PG8_BAR; PG8_MMA(1, 1, At, B1); PG8_BAR;
            }
        }
        if constexpr (ALIGN_EPI) { if (wr == 0) PG8_BAR; }
        E(acc, cur, wr, wc, fr, fq);
        if (!has_next) break;
#pragma unroll
        for (int a = 0; a < 2; ++a)
#pragma unroll
            for (int b = 0; b < 2; ++b)
#pragma unroll
                for (int m = 0; m < 4; ++m)
#pragma unroll
                    for (int n = 0; n < 2; ++n) acc[a][b][m][n] = (f32x4){0.f, 0.f, 0.f, 0.f};
        cur = nxt; cA = nA; cB = nB; ++ui;
        if constexpr (GATHER) {
#pragma unroll
            for (int _h = 0; _h < 2; ++_h)
#pragma unroll
                for (int _i = 0; _i < 2; ++_i) gc[_h][_i] = gn[_h][_i]; }
        if constexpr (ALIGN_EPI) { if (wr == 1) PG8_BAR; }
    }
    PG8_WAIT_V(0);
    if constexpr (!ALIGN_EPI) { if (wr == 0) PG8_BAR; }
    PG8_BAR;
#undef PG8_SA
#undef PG8_SB
#undef PG8_STAGE
#undef PG8_STAGE_A
#undef PG8_LDA
#undef PG8_LDB
#undef PG8_MMA
#undef PG8_WAIT_V
#undef PG8_WAIT_L
#undef PG8_BAR
#undef PG8_SCHED
#undef PG8_LOAD_ROWS
}
}

constexpr int NWAVES = 8, NTHR = 512;
constexpr int D = 1024, BATCH = 16, SEQ = 4096, T = BATCH * SEQ, DEPTH = 2;
constexpr int CHUNK = 64, NCH = SEQ / CHUNK;
constexpr int NSEC = 7168;
constexpr int N_IN = 7184;
constexpr int NE = 128, TOPK = 8, DE = 256;
constexpr int PMAX = T * TOPK + NE * 256;
constexpr float EPS = 1e-6f;

constexpr size_t MiB = 1u << 20;
constexpr size_t WS_CTL = 0, CTL_ZERO_BYTES = 1 * MiB;
constexpr size_t WS_MOD = 1 * MiB;
constexpr size_t WS_WLR = 2 * MiB;
constexpr size_t WS_RGW = 3 * MiB;
constexpr size_t WS_WIN = 4 * MiB;
constexpr size_t WS_WA = 32 * MiB, WS_WB = 36 * MiB, WS_WO = 40 * MiB;
constexpr size_t WS_ROUT = 44 * MiB;
constexpr size_t WS_SGU = 45 * MiB;
constexpr size_t WS_SDN = 47 * MiB;
constexpr size_t WS_EGU = 48 * MiB;
constexpr size_t WS_EDN = 304 * MiB;
constexpr size_t WS_U = 432 * MiB;
constexpr size_t WS_SP = 561 * MiB, WS_SE = 565 * MiB, WS_CIN = 569 * MiB;
constexpr size_t WS_TOT = 573 * MiB;
constexpr size_t WS_PK = 575 * MiB;
constexpr size_t WS_POS = 577 * MiB;
constexpr size_t WS_WTS = 579 * MiB;
constexpr size_t WS_SORT = 581 * MiB;
constexpr size_t WS_BIG = 592 * MiB;
constexpr size_t WS_XRPRE = WS_BIG, WS_RG = WS_BIG + 128 * MiB, WS_Q = WS_BIG + 256 * MiB, WS_K = WS_BIG + 320 * MiB, WS_V = WS_BIG + 384 * MiB,
                 WS_OG = WS_BIG + 512 * MiB, WS_GA = WS_BIG + 640 * MiB, WS_GB = WS_BIG + 768 * MiB, WS_LOGA = WS_BIG + 896 * MiB, WS_IX = WS_BIG + 1024 * MiB,
                 WS_KDEC = WS_BIG + 1152 * MiB;
constexpr size_t WS_O = WS_XRPRE;
constexpr size_t WS_MBUF = WS_LOGA;
constexpr size_t WS_Y = WS_BIG;
constexpr size_t WS_LOGIT = WS_BIG;
constexpr size_t WS_ACT = WS_BIG + 1088 * MiB;
constexpr size_t WS_ACTS = WS_BIG + 1360 * MiB;
constexpr size_t WS_END = WS_BIG + 1392 * MiB;
static_assert((size_t)PMAX * 1024 * 2 <= 1088 * MiB && (size_t)PMAX * 256 * 2 <= 272 * MiB && WS_KDEC + 64 * MiB <= WS_END, "ws map");
constexpr int CW_TMO = 0;
constexpr int CW_BAR = 4096;
constexpr int CW_CNT = 8192;

constexpr int RING_BYTES = 131072;
constexpr int LDS_TS = RING_BYTES;
constexpr int LDS_MISC = RING_BYTES + 1024;
constexpr int LDS_BYTES = 147456;

#define GAS __attribute__((address_space(1)))
#define LAS __attribute__((address_space(3)))
typedef unsigned short bf16;
typedef unsigned v4u __attribute__((ext_vector_type(4)));
typedef unsigned v2u __attribute__((ext_vector_type(2)));
typedef float f32x4 __attribute__((ext_vector_type(4)));
typedef float f32x16 __attribute__((ext_vector_type(16)));
typedef short bf16x8 __attribute__((ext_vector_type(8)));
typedef short s16x4 __attribute__((ext_vector_type(4)));
typedef GAS unsigned gu32;
#define RLX_AGENT __ATOMIC_RELAXED, __HIP_MEMORY_SCOPE_AGENT
#define LDS_WAIT() asm volatile("s_waitcnt lgkmcnt(0)" ::: "memory")
__device__ __forceinline__ unsigned f2bf(float f) { return (unsigned)__builtin_bit_cast(unsigned short, (__bf16)f); }
__device__ __forceinline__ unsigned pk2(float lo, float hi) { return pg8::cvt_pk_bf16(lo, hi); }
__device__ __forceinline__ float bflo(unsigned w) { return __builtin_bit_cast(float, w << 16); }
__device__ __forceinline__ float bfhi(unsigned w) { return __builtin_bit_cast(float, w & 0xffff0000u); }
__device__ __forceinline__ float bf2f(bf16 b) { return __builtin_bit_cast(float, (unsigned)b << 16); }
__device__ __forceinline__ float fsigmoid(float x) { return __builtin_amdgcn_rcpf(1.0f + __builtin_amdgcn_exp2f(-1.442695041f * x)); }
__device__ __forceinline__ float fsilu(float x) { return x * fsigmoid(x); }
__device__ __forceinline__ float fgelu_tanh(float x) { return x * fsigmoid(1.5957691216f * (x + 0.044715f * x * x * x)); }

#define XB_TMO      128
#define XB_XCNT(j)  (256  + 64 * (j))
#define XB_XSUB(j)  (1280 + 64 * (j))
#define XB_XGEN(j)  (2304 + 64 * (j))
#define XB_TOP      3328
#define XB_TOPGEN   3392
#define XCD_BAR_WORDS 3456
#define XB_SPIN_CAP (1u << 18)
__device__ __forceinline__ unsigned xb_ld(unsigned* p)              { return __hip_atomic_load(p, __ATOMIC_RELAXED, __HIP_MEMORY_SCOPE_AGENT); }
__device__ __forceinline__ unsigned xb_add(unsigned* p, unsigned v) { return __hip_atomic_fetch_add(p, v, __ATOMIC_RELAXED, __HIP_MEMORY_SCOPE_AGENT); }
__device__ __forceinline__ unsigned xb_xcc_id() { return (unsigned)__builtin_amdgcn_s_getreg((3 << 11) | 20) & 0xFu; }
#define XB_SPIN(cond, bar) do { unsigned _sp = 0; while (cond) { __builtin_amdgcn_s_sleep(1); \
    if ((++_sp & 255u) == 0u) { if (xb_ld(&(bar)[XB_TMO])) break; if (_sp > XB_SPIN_CAP) { atomicAdd(&(bar)[XB_TMO], 1u); break; } } } } while (0)
struct XcdBarrier { unsigned* bar; unsigned x; volatile LAS unsigned* st; };
__device__ __forceinline__ XcdBarrier xcd_barrier_post(unsigned* bar, volatile LAS unsigned* st) {
    XcdBarrier b; b.bar = bar; b.x = xb_xcc_id(); b.st = st;
    if (threadIdx.x == 0) (void)xb_add(&bar[XB_XCNT(b.x)], 1u);
    return b;
}
__device__ __forceinline__ void xcd_barrier_complete(unsigned* bar, unsigned x, unsigned& nloc, unsigned& nx) {
    const unsigned G = gridDim.x * gridDim.y * gridDim.z;
    unsigned sum, cnt, mine, sp = 0u;
    for (;;) {
        sum = 0u; cnt = 0u; mine = 0u;
#pragma unroll
        for (unsigned j = 0; j < 16; ++j) { const unsigned c = xb_ld(&bar[XB_XCNT(j)]); sum += c; cnt += (c > 0u) ? 1u : 0u; mine = (j == x) ? c : mine; }
        if (sum == G) break;
        __builtin_amdgcn_s_sleep(1);
        if ((++sp & 255u) == 0u) { if (xb_ld(&bar[XB_TMO])) break; if (sp > XB_SPIN_CAP) { atomicAdd(&bar[XB_TMO], 1u); break; } }
    }
    nloc = mine > 0u ? mine : 1u; nx = cnt > 0u ? cnt : 1u;
}
__device__ __forceinline__ void xcd_barrier(const XcdBarrier& b, const bool leader) {
    asm volatile("s_waitcnt vmcnt(0)" ::: "memory");
    __syncthreads();
    if (leader) {
        unsigned* bar = b.bar;
        __builtin_amdgcn_s_waitcnt(0);
        unsigned nloc = b.st[0], nx = b.st[1];
        if (nloc == 0u) { xcd_barrier_complete(bar, b.x, nloc, nx); b.st[0] = nloc; b.st[1] = nx; }
        const unsigned old = xb_add(&bar[XB_XSUB(b.x)], 1u);
        const unsigned gen = old / nloc;
        if (old + 1u == (gen + 1u) * nloc) {
            __builtin_amdgcn_fence(__ATOMIC_RELEASE, "agent");
            asm volatile("s_waitcnt vmcnt(0)" ::: "memory");
            const unsigned og = xb_add(&bar[XB_TOP], 1u);
            const unsigned tg = og / nx;
            if (og + 1u == (tg + 1u) * nx) xb_add(&bar[XB_TOPGEN], 1u);
            else XB_SPIN(xb_ld(&bar[XB_TOPGEN]) == tg, bar);
            __builtin_amdgcn_fence(__ATOMIC_ACQUIRE, "agent");
            xb_add(&bar[XB_XGEN(b.x)], 1u);
            asm volatile("s_waitcnt vmcnt(0)" ::: "memory");
        } else {
            XB_SPIN(xb_ld(&bar[XB_XGEN(b.x)]) == gen, bar);
            __builtin_amdgcn_fence(__ATOMIC_ACQUIRE, "agent");
            asm volatile("s_waitcnt vmcnt(0)" ::: "memory");
        }
    }
    __syncthreads();
}

enum In { I_X = 0, I_C, I_ADAW, I_ADAB, I_N1G, I_WIN, I_CONVW, I_CONVB, I_RGWA, I_RGBA, I_RGWX, I_RGBX, I_RGLAM, I_GWUP, I_GBUP, I_GNG, I_WBA, I_WBB, I_WOUT, I_N2G,
          I_RW, I_RB, I_EGU, I_EDN, I_SGU, I_SDN, I_FG, N_INPUTS };
struct Args { const float* in[N_INPUTS]; float* out; unsigned char* ws; int ph_lo, ph_hi; };
struct Frame { LAS unsigned char* lds; unsigned char* ws; int tid, lane, wave, vcu, G, bx; };

__device__ __forceinline__ float wave_sum(float v, int lane) {
#pragma unroll
    for (int o = 1; o < 64; o <<= 1) v += __builtin_bit_cast(float, __builtin_amdgcn_ds_bpermute((lane ^ o) << 2, __builtin_bit_cast(int, v)));
    return v;
}

template <class RowP>
__device__ __forceinline__ void conv_item(const float* W, int K, int N, LAS float* scr, int item, int lane, RowP rowp) {
    const int nblk = (N + 31) / 32, kb = item / nblk, nb = item % nblk, k0 = 64 * kb, n0 = 32 * nb;
    const int cl = n0 + (lane & 31); const bool okc = cl < N;
#pragma unroll 8
    for (int i = 0; i < 32; ++i) { const int kk = 2 * i + (lane >> 5); scr[kk * 33 + (lane & 31)] = okc ? W[(size_t)(k0 + kk) * N + cl] : 0.f; }
    LDS_WAIT(); asm volatile("" ::: "memory");
    const int c = lane & 7;
#pragma unroll
    for (int j = 0; j < 4; ++j) { const int n = (lane >> 3) + 8 * j; const LAS float* s = scr + (8 * c) * 33 + n;
        v4u o; o.x = pk2(s[0 * 33], s[1 * 33]); o.y = pk2(s[2 * 33], s[3 * 33]); o.z = pk2(s[4 * 33], s[5 * 33]); o.w = pk2(s[6 * 33], s[7 * 33]);
        bf16* rp = (n0 + n < N) ? rowp(n0 + n) : (bf16*)nullptr;
        if (rp) *(GAS v4u*)(rp + k0 + 8 * c) = o; }
    LDS_WAIT(); asm volatile("" ::: "memory");
}
__device__ __forceinline__ bf16* winrow(int c, bf16* win, bf16* wlr) {
    if (c < 5120) {
        if (c >= 2048 && c < 2560) { const int p = c & 15, g = (p >> 2) & 3; const int pp = (g == 1) ? p + 4 : (g == 2) ? p - 4 : p; c = (c & ~15) | pp; }
        return win + (size_t)c * D; }
    if (c < 5136) return wlr + (size_t)(c - 5120) * D;
    return win + (size_t)(c - 16) * D;
}
__device__ __forceinline__ int glurow(int c) { return 256 * ((c & 255) >> 7) + 128 * (c >> 8) + (c & 127); }

__device__ __forceinline__ void p0_prologue(const Frame& F, const Args& a) {
    unsigned char* ws = F.ws;
    if (F.vcu < 96) {
        LAS float* cact = (LAS float*)F.lds;
        LAS float* part = (LAS float*)(F.lds + 65536);
        for (int i = F.tid; i < 16 * 1024; i += NTHR) { const int b = i >> 10, k = i & 1023; const float x = a.in[I_C][i]; cact[k * 16 + b] = fsilu(x); }
        __syncthreads();
        const int l = F.wave >> 2, kq = F.wave & 3, n = F.vcu * 64 + F.lane;
        float acc[16];
#pragma unroll
        for (int b = 0; b < 16; ++b) acc[b] = 0.f;
        const float* w = a.in[I_ADAW] + (size_t)l * 1024 * 6144 + n;
#pragma unroll 4
        for (int k = kq * 256; k < kq * 256 + 256; ++k) { const float wv = w[(size_t)k * 6144];
#pragma unroll
            for (int q = 0; q < 4; ++q) { const f32x4 cv = *(const LAS f32x4*)(cact + k * 16 + 4 * q); acc[4 * q] += wv * cv.x; acc[4 * q + 1] += wv * cv.y; acc[4 * q + 2] += wv * cv.z; acc[4 * q + 3] += wv * cv.w; } }
#pragma unroll
        for (int b = 0; b < 16; ++b) part[(F.wave * 16 + b) * 64 + F.lane] = acc[b];
        __syncthreads();
        for (int i = F.tid; i < 2 * 16 * 64; i += NTHR) { const int ll = i >> 10, b = (i >> 6) & 15, nn = i & 63; float s = a.in[I_ADAB][ll * 6144 + F.vcu * 64 + nn];
#pragma unroll
            for (int q = 0; q < 4; ++q) s += part[((ll * 4 + q) * 16 + b) * 64 + nn];
            ((float*)(ws + WS_MOD))[((size_t)ll * 16 + b) * 6144 + F.vcu * 64 + nn] = s; }
        __syncthreads();
    }
    LAS float* scr = (LAS float*)(F.lds + F.wave * 16384);
    const int gw = F.vcu * NWAVES + F.wave, NGW = F.G * NWAVES;
    constexpr int I_IN = 16 * 225, I_SQ = 16 * 32, I_R = 16 * 4, I_SG = 16 * 16, I_SD = 4 * 32, I_RGI = 2 * 4 * 16, I_EG = 16 * 16, I_ED = 4 * 32;
    constexpr int PER_L = I_IN + 3 * I_SQ + I_R + I_SG + I_SD + I_RGI + NE * I_EG + NE * I_ED;
    for (int it = gw; it < DEPTH * PER_L; it += NGW) {
        const int l = it / PER_L; int r = it - l * PER_L;
        if (r < I_IN) { bf16* win = (bf16*)(ws + WS_WIN) + (size_t)l * NSEC * D; bf16* wlr = (bf16*)(ws + WS_WLR) + (size_t)l * 16 * D;
            conv_item(a.in[I_WIN] + (size_t)l * D * N_IN, D, N_IN, scr, r, F.lane, [=](int c) { return winrow(c, win, wlr); }); continue; } r -= I_IN;
        if (r < 3 * I_SQ) { const int w = r / I_SQ; r -= w * I_SQ; const float* src = a.in[w == 0 ? I_WBA : (w == 1 ? I_WBB : I_WOUT)] + (size_t)l * D * D;
            bf16* dst = (bf16*)(ws + (w == 0 ? WS_WA : (w == 1 ? WS_WB : WS_WO))) + (size_t)l * D * D;
            conv_item(src, D, D, scr, r, F.lane, [=](int c) { return dst + (size_t)c * D; }); continue; } r -= 3 * I_SQ;
        if (r < I_R) { bf16* dst = (bf16*)(ws + WS_ROUT) + (size_t)l * 256 * D;
            conv_item(a.in[I_RW] + (size_t)l * D * NE, D, NE, scr, r, F.lane, [=](int c) { return dst + (size_t)c * D; }); continue; } r -= I_R;
        if (r < I_SG) { bf16* dst = (bf16*)(ws + WS_SGU) + (size_t)l * 512 * D;
            conv_item(a.in[I_SGU] + (size_t)l * D * 512, D, 512, scr, r, F.lane, [=](int c) { return dst + (size_t)glurow(c) * D; }); continue; } r -= I_SG;
        if (r < I_SD) { bf16* dst = (bf16*)(ws + WS_SDN) + (size_t)l * D * DE;
            conv_item(a.in[I_SDN] + (size_t)l * DE * D, DE, D, scr, r, F.lane, [=](int c) { return dst + (size_t)c * DE; }); continue; } r -= I_SD;
        if (r < I_RGI) { const int which = r / 64; r -= which * 64; const int hb = r / 8; r -= hb * 8;
            bf16* dst = (bf16*)(ws + WS_RGW) + ((size_t)(l * 8 + hb) * 256 + which * 128) * 128;
            conv_item(a.in[which ? I_RGWX : I_RGWA] + ((size_t)l * 8 + hb) * 128 * 128, 128, 128, scr, r, F.lane, [=](int c) { return dst + (size_t)c * 128; }); continue; } r -= I_RGI;
        if (r < NE * I_EG) { const int e = r / I_EG; r -= e * I_EG; bf16* dst = (bf16*)(ws + WS_EGU) + ((size_t)l * NE + e) * 512 * D;
            conv_item(a.in[I_EGU] + ((size_t)l * NE + e) * D * 512, D, 512, scr, r, F.lane, [=](int c) { return dst + (size_t)glurow(c) * D; }); continue; } r -= NE * I_EG;
        { const int e = r / I_ED; r -= e * I_ED; bf16* dst = (bf16*)(ws + WS_EDN) + ((size_t)l * NE + e) * D * DE;
            conv_item(a.in[I_EDN] + ((size_t)l * NE + e) * DE * D, DE, D, scr, r, F.lane, [=](int c) { return dst + (size_t)c * DE; }); }
    }
    { const int gt = F.vcu * NTHR + F.tid, NT = F.G * NTHR;
      for (int i = gt; i < 2 * 128 * D / 8; i += NT) { const int l = i / (128 * D / 8), r = i - l * (128 * D / 8);
          *(GAS v4u*)((bf16*)(ws + WS_ROUT) + ((size_t)l * 256 + 128) * D + (size_t)r * 8) = (v4u){0u, 0u, 0u, 0u}; }
      if (gt < D / 8) *(GAS v4u*)((bf16*)(ws + WS_U) + (size_t)T * D + gt * 8) = (v4u){0u, 0u, 0u, 0u}; }
}

template <bool FINAL>
__device__ __forceinline__ void norm_phase(const Frame& F, const float* h, const float* gain, const float* sc, const float* sh, bf16* U, float* outf) {
    const int gw = F.vcu * NWAVES + F.wave, NGW = F.G * NWAVES;
    for (int blk = gw; blk < T / 32; blk += NGW) {
        const int b = (blk * 32) / SEQ;
        f32x4 scl[4], sft[4];
#pragma unroll
        for (int j = 0; j < 4; ++j) { const int c = 4 * F.lane + 256 * j; const f32x4 g = *(const f32x4*)(gain + c);
            if (FINAL) { scl[j] = g; sft[j] = (f32x4){0.f, 0.f, 0.f, 0.f}; }
            else { const f32x4 s1 = *(const f32x4*)(sc + (size_t)b * 6144 + c); sft[j] = *(const f32x4*)(sh + (size_t)b * 6144 + c); scl[j] = g * (s1 + 1.0f); } }
        for (int rr = 0; rr < 32; ++rr) {
            const size_t row = (size_t)blk * 32 + rr;
            const GAS f32x4* xr = (const GAS f32x4*)(h + row * D) + F.lane;
            f32x4 v[4]; float s = 0.f;
#pragma unroll
            for (int j = 0; j < 4; ++j) { v[j] = xr[64 * j]; s += (v[j].x * v[j].x + v[j].y * v[j].y) + (v[j].z * v[j].z + v[j].w * v[j].w); }
            const float rs = 1.0f / sqrtf(wave_sum(s, F.lane) * (1.0f / D) + EPS);
            if (FINAL) { GAS f32x4* o = (GAS f32x4*)(outf + row * D) + F.lane;
#pragma unroll
                for (int j = 0; j < 4; ++j) o[64 * j] = v[j] * rs * scl[j];
            } else { GAS v2u* o = (GAS v2u*)(U + row * D) + F.lane;
#pragma unroll
                for (int j = 0; j < 4; ++j) { const f32x4 y = v[j] * rs * scl[j] + sft[j]; o[64 * j] = (v2u){pk2(y.x, y.y), pk2(y.z, y.w)}; } }
        }
    }
}

#define EPI_ROWS_BEGIN _Pragma("unroll") for (int ai = 0; ai < 2; ++ai) _Pragma("unroll") for (int m = 0; m < 4; ++m) { const int rt = ai * 128 + wr * 64 + m * 16 + fr;
#define EPI_ROWS_END }
typedef const pg8::f32x4 (&AccRef)[2][2][4][2];
__device__ __forceinline__ v4u pack8(const f32x4& a, const f32x4& b) { v4u w; w.x = pg8::cvt_pk_bf16(a[0], a[1]); w.y = pg8::cvt_pk_bf16(a[2], a[3]); w.z = pg8::cvt_pk_bf16(b[0], b[1]); w.w = pg8::cvt_pk_bf16(b[2], b[3]); return w; }
template <int ACT> __device__ __forceinline__ f32x4 act4(f32x4 v) {
    if (ACT == 1) { v[0] = fgelu_tanh(v[0]); v[1] = fgelu_tanh(v[1]); v[2] = fgelu_tanh(v[2]); v[3] = fgelu_tanh(v[3]); }
    if (ACT == 2) v = v * 0.08838834764831845f;
    if (ACT == 3) { v[0] = fsilu(v[0]); v[1] = fsilu(v[1]); v[2] = fsilu(v[2]); v[3] = fsilu(v[3]); }
    if (ACT == 4) { v[0] = fsigmoid(v[0]); v[1] = fsigmoid(v[1]); v[2] = fsigmoid(v[2]); v[3] = fsigmoid(v[3]); }
    return v;
}
template <int ACT> __device__ __forceinline__ void store_tile_bf16(AccRef acc, bf16* dst, int ld, size_t row0, int col0, int wr, int wc, int fr, int fq) {
    EPI_ROWS_BEGIN
        bf16* rp = dst + (row0 + rt) * ld + col0 + wc * 32 + 8 * fq;
#pragma unroll
        for (int bj = 0; bj < 2; ++bj) *(GAS v4u*)(rp + bj * 128) = pack8(act4<ACT>(acc[ai][bj][m][0]), act4<ACT>(acc[ai][bj][m][1]));
    EPI_ROWS_END
}
struct EpiInProj {
    unsigned char* ws;
    __device__ __forceinline__ void operator()(AccRef acc, const pg8::Unit& u, int wr, int wc, int fr, int fq) const {
        asm volatile("" : "+v"(fr), "+v"(fq));
        const int pn = u.pn; const size_t row0 = (size_t)u.pm * 256;
        if (pn < 4)       store_tile_bf16<0>(acc, (bf16*)(ws + WS_XRPRE), 1024, row0, pn * 256, wr, wc, fr, fq);
        else if (pn < 8)  store_tile_bf16<1>(acc, (bf16*)(ws + WS_RG), 1024, row0, (pn - 4) * 256, wr, wc, fr, fq);
        else if (pn < 10) store_tile_bf16<2>(acc, (bf16*)(ws + WS_Q), 512, row0, (pn - 8) * 256, wr, wc, fr, fq);
        else if (pn < 12) store_tile_bf16<0>(acc, (bf16*)(ws + WS_K), 512, row0, (pn - 10) * 256, wr, wc, fr, fq);
        else if (pn < 16) store_tile_bf16<0>(acc, (bf16*)(ws + WS_V), 1024, row0, (pn - 12) * 256, wr, wc, fr, fq);
        else if (pn < 20) store_tile_bf16<3>(acc, (bf16*)(ws + WS_OG), 1024, row0, (pn - 16) * 256, wr, wc, fr, fq);
        else if (pn < 24) store_tile_bf16<4>(acc, (bf16*)(ws + WS_GA), 1024, row0, (pn - 20) * 256, wr, wc, fr, fq);
        else              store_tile_bf16<4>(acc, (bf16*)(ws + WS_GB), 1024, row0, (pn - 24) * 256, wr, wc, fr, fq);
    }
};
template <bool FIRST> struct EpiMerge {
    const bf16* gate; bf16* mbuf;
    __device__ __forceinline__ void operator()(AccRef acc, const pg8::Unit& u, int wr, int wc, int fr, int fq) const {
        asm volatile("" : "+v"(fr), "+v"(fq));
        EPI_ROWS_BEGIN
            const size_t o = ((size_t)u.pm * 256 + rt) * 1024 + u.pn * 256 + wc * 32 + 8 * fq;
#pragma unroll
            for (int bj = 0; bj < 2; ++bj) { const v4u gw = *(const GAS v4u*)(gate + o + bj * 128);
                f32x4 g0 = {bflo(gw.x), bfhi(gw.x), bflo(gw.y), bfhi(gw.y)}, g1 = {bflo(gw.z), bfhi(gw.z), bflo(gw.w), bfhi(gw.w)};
                f32x4 r0 = g0 * acc[ai][bj][m][0], r1 = g1 * acc[ai][bj][m][1];
                if (!FIRST) { const v4u mw = *(const GAS v4u*)(mbuf + o + bj * 128);
                    r0 += (f32x4){bflo(mw.x), bfhi(mw.x), bflo(mw.y), bfhi(mw.y)}; r1 += (f32x4){bflo(mw.z), bfhi(mw.z), bflo(mw.w), bfhi(mw.w)}; }
                *(GAS v4u*)(mbuf + o + bj * 128) = pack8(r0, r1); }
        EPI_ROWS_END
    }
};
struct EpiRes {
    const float* hin; float* hout; const float* gate;
    __device__ __forceinline__ void operator()(AccRef acc, const pg8::Unit& u, int wr, int wc, int fr, int fq) const {
        asm volatile("" : "+v"(fr), "+v"(fq));
        const int b = (u.pm * 256) / SEQ; const int cb = u.pn * 256 + wc * 32 + 8 * fq;
        f32x4 gv[2][2];
#pragma unroll
        for (int bj = 0; bj < 2; ++bj)
#pragma unroll
            for (int n = 0; n < 2; ++n) gv[bj][n] = *(const f32x4*)(gate + (size_t)b * 6144 + cb + bj * 128 + 4 * n);
        EPI_ROWS_BEGIN
            const size_t o = ((size_t)u.pm * 256 + rt) * 1024 + cb;
#pragma unroll
            for (int bj = 0; bj < 2; ++bj)
#pragma unroll
                for (int n = 0; n < 2; ++n) { const f32x4 hv = *(const GAS f32x4*)(hin + o + bj * 128 + 4 * n); *(GAS f32x4*)(hout + o + bj * 128 + 4 * n) = hv + gv[bj][n] * acc[ai][bj][m][n]; }
        EPI_ROWS_END
    }
};
struct EpiLogit {
    float* lg;
    __device__ __forceinline__ void operator()(AccRef acc, const pg8::Unit& u, int wr, int wc, int fr, int fq) const {
        asm volatile("" : "+v"(fr), "+v"(fq));
        EPI_ROWS_BEGIN
            float* rp = lg + ((size_t)u.pm * 256 + rt) * 128 + wc * 32 + 8 * fq;
            *(GAS f32x4*)(rp) = acc[ai][0][m][0]; *(GAS f32x4*)(rp + 4) = acc[ai][0][m][1];
        EPI_ROWS_END
    }
};
struct EpiGlu {
    bf16* act;
    __device__ __forceinline__ void operator()(AccRef acc, const pg8::Unit& u, int wr, int wc, int fr, int fq) const {
        asm volatile("" : "+v"(fr), "+v"(fq));
        const int j = u.pn & 1;
        EPI_ROWS_BEGIN
            f32x4 r0 = act4<3>(acc[ai][0][m][0]) * acc[ai][1][m][0], r1 = act4<3>(acc[ai][0][m][1]) * acc[ai][1][m][1];
            *(GAS v4u*)(act + ((size_t)u.pm * 256 + rt) * 256 + j * 128 + wc * 32 + 8 * fq) = pack8(r0, r1);
        EPI_ROWS_END
    }
};
struct EpiY {
    bf16* y;
    __device__ __forceinline__ void operator()(AccRef acc, const pg8::Unit& u, int wr, int wc, int fr, int fq) const {
        asm volatile("" : "+v"(fr), "+v"(fq));
        store_tile_bf16<0>(acc, y, 1024, (size_t)u.pm * 256, (u.pn & 3) * 256, wr, wc, fr, fq);
    }
};

__device__ __forceinline__ int swz16(int row, int ch) { return row * 256 + ((ch ^ (row & 15)) << 4); }
__device__ __forceinline__ void rg_gate_phase(const Frame& F, const Args& a, int l) {
    unsigned char* ws = F.ws;
    const int hb = F.vcu & 7;
    LAS unsigned char* Ws = F.lds; LAS unsigned char* Xs = F.lds + 65536; LAS float* prm = (LAS float*)(F.lds + 98304);
    const bf16* xpre = (const bf16*)(ws + WS_XRPRE); bf16* loga = (bf16*)(ws + WS_LOGA); bf16* ixo = (bf16*)(ws + WS_IX);
    { const bf16* wsrc = (const bf16*)(ws + WS_RGW) + (size_t)(l * 8 + hb) * 256 * 128;
#pragma unroll
      for (int j = 0; j < 8; ++j) { const int ck = F.tid + NTHR * j, n = ck >> 4, ch = ck & 15; *(LAS v4u*)(Ws + swz16(n, ch)) = *(const GAS v4u*)(wsrc + (size_t)ck * 8); }
      if (F.tid < 128) { const int c = l * D + hb * 128 + F.tid; prm[F.tid] = a.in[I_RGBA][c]; prm[128 + F.tid] = a.in[I_RGBX][c];
          const float lam = a.in[I_RGLAM][c]; prm[256 + F.tid] = fmaxf(-lam, 0.f) + log1pf(__expf(-fabsf(lam))); } }
    const int c8 = F.tid & 15, rg4 = F.tid >> 4, chan0 = hb * 128 + 8 * c8;
    float cw[4][8], cb[8];
#pragma unroll
    for (int j = 0; j < 8; ++j) { cb[j] = a.in[I_CONVB][l * D + chan0 + j];
#pragma unroll
        for (int q = 0; q < 4; ++q) cw[q][j] = a.in[I_CONVW][((size_t)l * 4 + q) * D + chan0 + j]; }
    const int fr = F.lane & 15, fq = F.lane >> 4;
    for (int i = 0; i < 16; ++i) {
        const int rt = (F.vcu >> 3) + 32 * i; const size_t row0 = (size_t)rt * 128;
        __syncthreads();
        {
            const int r0 = 4 * rg4; const int tpos = (int)((row0 + r0) & (SEQ - 1));
            float x[7][8];
#pragma unroll
            for (int q = 0; q < 7; ++q) { const int dt = q - 3; v4u w = {0u, 0u, 0u, 0u};
                if (tpos + dt >= 0) w = *(const GAS v4u*)(xpre + (size_t)((long)(row0 + r0) + dt) * D + chan0);
                x[q][0] = bflo(w.x); x[q][1] = bfhi(w.x); x[q][2] = bflo(w.y); x[q][3] = bfhi(w.y); x[q][4] = bflo(w.z); x[q][5] = bfhi(w.z); x[q][6] = bflo(w.w); x[q][7] = bfhi(w.w); }
#pragma unroll
            for (int rr = 0; rr < 4; ++rr) { float y[8];
#pragma unroll
                for (int j = 0; j < 8; ++j) y[j] = cb[j] + cw[0][j] * x[rr][j] + cw[1][j] * x[rr + 1][j] + cw[2][j] * x[rr + 2][j] + cw[3][j] * x[rr + 3][j];
                v4u o; o.x = pk2(y[0], y[1]); o.y = pk2(y[2], y[3]); o.z = pk2(y[4], y[5]); o.w = pk2(y[6], y[7]);
                *(LAS v4u*)(Xs + swz16(r0 + rr, c8)) = o; }
        }
        __syncthreads();
        f32x4 acc[16];
#pragma unroll
        for (int nb = 0; nb < 16; ++nb) acc[nb] = (f32x4){0.f, 0.f, 0.f, 0.f};
        const int arow = 16 * F.wave + fr;
#pragma unroll
        for (int ks = 0; ks < 4; ++ks) { const bf16x8 af = *(const LAS bf16x8*)(Xs + swz16(arow, 4 * ks + fq));
#pragma unroll
            for (int nb = 0; nb < 16; ++nb) { const bf16x8 bfv = *(const LAS bf16x8*)(Ws + swz16(16 * nb + fr, 4 * ks + fq));
                acc[nb] = __builtin_amdgcn_mfma_f32_16x16x32_bf16(bfv, af, acc[nb], 0, 0, 0); } }
        const size_t grow = row0 + arow;
#pragma unroll
        for (int nb = 0; nb < 8; ++nb) { const int c = 16 * nb + 4 * fq;
            const f32x4 ba = *(const LAS f32x4*)(prm + c), bx = *(const LAS f32x4*)(prm + 128 + c), sp = *(const LAS f32x4*)(prm + 256 + c);
            const v2u xw = *(const LAS v2u*)(Xs + swz16(arow, c >> 3) + (c & 7) * 2);
            const float xv[4] = {bflo(xw.x), bfhi(xw.x), bflo(xw.y), bfhi(xw.y)};
            float la[4], ix[4];
#pragma unroll
            for (int j = 0; j < 4; ++j) { const float r = fsigmoid(acc[nb][j] + ba[j]), ii = fsigmoid(acc[nb + 8][j] + bx[j]); la[j] = -8.0f * r * sp[j]; ix[j] = ii * xv[j]; }
            const size_t o = grow * D + hb * 128 + c;
            *(GAS v2u*)(loga + o) = (v2u){pk2(la[0], la[1]), pk2(la[2], la[3])};
            *(GAS v2u*)(ixo + o) = (v2u){pk2(ix[0], ix[1]), pk2(ix[2], ix[3])}; }
    }
    __syncthreads();
}

__device__ __forceinline__ void scan_pass1(const Frame& F, int unit) {
    unsigned char* ws = F.ws;
    const int b = unit >> 7, seg = (unit >> 1) & 63, ch = (unit & 1) * 512 + F.tid; const size_t row0 = (size_t)b * SEQ + seg * 64;
    const bf16* loga = (const bf16*)(ws + WS_LOGA) + row0 * D + ch; const bf16* ixp = (const bf16*)(ws + WS_IX) + row0 * D + ch;
    float P = 1.f, E = 0.f;
#pragma unroll 16
    for (int r = 0; r < 64; ++r) { const float la = bf2f(loga[(size_t)r * D]), ix = bf2f(ixp[(size_t)r * D]);
        const float av = __expf(la); float mult = sqrtf(-expm1f(2.0f * la)); if (seg == 0 && r == 0) mult = 1.0f;
        E = av * E + mult * ix; P *= av; }
    ((float*)(ws + WS_SP))[((size_t)b * 64 + seg) * D + ch] = P; ((float*)(ws + WS_SE))[((size_t)b * 64 + seg) * D + ch] = E;
}
__device__ __forceinline__ void scan_carry(const Frame& F, int unit) {
    unsigned char* ws = F.ws;
    const int b = unit >> 1, ch = (unit & 1) * 512 + F.tid;
    const float* sp = (const float*)(ws + WS_SP) + (size_t)b * 64 * D + ch; const float* se = (const float*)(ws + WS_SE) + (size_t)b * 64 * D + ch; float* ci = (float*)(ws + WS_CIN) + (size_t)b * 64 * D + ch;
    float st = 0.f;
#pragma unroll 16
    for (int s = 0; s < 64; ++s) { ci[(size_t)s * D] = st; st = sp[(size_t)s * D] * st + se[(size_t)s * D]; }
}
__device__ __forceinline__ void scan_pass3(const Frame& F, int unit) {
    unsigned char* ws = F.ws;
    const int b = unit >> 7, seg = (unit >> 1) & 63, ch = (unit & 1) * 512 + F.tid; const size_t row0 = (size_t)b * SEQ + seg * 64;
    const bf16* loga = (const bf16*)(ws + WS_LOGA) + row0 * D + ch; bf16* ixp = (bf16*)(ws + WS_IX) + row0 * D + ch; const bf16* rg = (const bf16*)(ws + WS_RG) + row0 * D + ch;
    float h = ((const float*)(ws + WS_CIN))[((size_t)b * 64 + seg) * D + ch];
#pragma unroll 16
    for (int r = 0; r < 64; ++r) { const float la = bf2f(loga[(size_t)r * D]), ix = bf2f(ixp[(size_t)r * D]), gt = bf2f(rg[(size_t)r * D]);
        const float av = __expf(la); float mult = sqrtf(-expm1f(2.0f * la)); if (seg == 0 && r == 0) mult = 1.0f;
        h = av * h + mult * ix; ixp[(size_t)r * D] = (bf16)f2bf(h * gt); }
}

__device__ __forceinline__ void gla_prep(const Frame& F, const Args& a, int l, int unit) {
    unsigned char* ws = F.ws;
    LAS float* lrs = (LAS float*)F.lds;
    const size_t row0 = (size_t)unit * 64;
    const int fr = F.lane & 15, fq = F.lane >> 4;
    __syncthreads();
    { const int rb = F.wave & 3, kh = F.wave >> 2;
      const bf16* up = (const bf16*)(ws + WS_U) + (row0 + 16 * rb + fr) * D + kh * 512 + 8 * fq;
      const bf16* wp = (const bf16*)(ws + WS_WLR) + ((size_t)l * 16 + fr) * D + kh * 512 + 8 * fq;
      f32x4 acc = {0.f, 0.f, 0.f, 0.f};
#pragma unroll
      for (int ks = 0; ks < 16; ++ks) { const bf16x8 af = *(const GAS bf16x8*)(up + 32 * ks), bfv = *(const GAS bf16x8*)(wp + 32 * ks);
          acc = __builtin_amdgcn_mfma_f32_16x16x32_bf16(af, bfv, acc, 0, 0, 0); }
#pragma unroll
      for (int j = 0; j < 4; ++j) lrs[(kh * 64 + 16 * rb + 4 * fq + j) * 16 + fr] = acc[j]; }
    __syncthreads();
    const int col = F.tid;
    float wu[16];
#pragma unroll
    for (int r = 0; r < 16; ++r) wu[r] = a.in[I_GWUP][((size_t)l * 16 + r) * 512 + col];
    const float bu = a.in[I_GBUP][l * 512 + col];
    float tot = 0.f;
    for (int t = 0; t < 64; ++t) { float lg = bu;
#pragma unroll
        for (int q = 0; q < 4; ++q) { const f32x4 x0 = *(const LAS f32x4*)(lrs + t * 16 + 4 * q), x1 = *(const LAS f32x4*)(lrs + (64 + t) * 16 + 4 * q);
            lg += (x0.x + x1.x) * wu[4 * q] + (x0.y + x1.y) * wu[4 * q + 1] + (x0.z + x1.z) * wu[4 * q + 2] + (x0.w + x1.w) * wu[4 * q + 3]; }
        tot += (fminf(lg, 0.f) - log1pf(__expf(-fabsf(lg)))) * 0.0625f; }
    ((float*)(ws + WS_TOT))[(size_t)unit * 512 + col] = tot;
    const bf16* kp = (const bf16*)(ws + WS_K) + row0 * 512 + col;
    bf16* kd = (bf16*)(ws + WS_KDEC) + ((size_t)unit * 512 + col) * 64;
    float cum = 0.f;
    for (int t8 = 0; t8 < 8; ++t8) { float o[8];
#pragma unroll
        for (int tt = 0; tt < 8; ++tt) { const int t = 8 * t8 + tt; float lg = bu;
#pragma unroll
            for (int q = 0; q < 4; ++q) { const f32x4 x0 = *(const LAS f32x4*)(lrs + t * 16 + 4 * q), x1 = *(const LAS f32x4*)(lrs + (64 + t) * 16 + 4 * q);
                lg += (x0.x + x1.x) * wu[4 * q] + (x0.y + x1.y) * wu[4 * q + 1] + (x0.z + x1.z) * wu[4 * q + 2] + (x0.w + x1.w) * wu[4 * q + 3]; }
            cum += (fminf(lg, 0.f) - log1pf(__expf(-fabsf(lg)))) * 0.0625f;
            o[tt] = bf2f(kp[(size_t)t * 512]) * __expf(tot - cum); }
        *(GAS v4u*)(kd + 8 * t8) = (v4u){pk2(o[0], o[1]), pk2(o[2], o[3]), pk2(o[4], o[5]), pk2(o[6], o[7])}; }
}

constexpr int GQ_OFF = 0, GK_OFF = 64 * 272, GV_OFF = GK_OFF + 128 * 144, GD_OFF = GV_OFF + 64 * 256, GBUF = GD_OFF + 512;
__device__ __forceinline__ unsigned voff_b(unsigned row, unsigned ch) { return 256u * row + 16u * (ch ^ (((row & 3) << 2) | ((row >> 2) & 3))); }
__device__ __forceinline__ bf16x8 pack_step(const f32x16& x, int s) {
    v4u p; p.x = pk2(x[8 * s], x[8 * s + 1]); p.y = pk2(x[8 * s + 2], x[8 * s + 3]); p.z = pk2(x[8 * s + 4], x[8 * s + 5]); p.w = pk2(x[8 * s + 6], x[8 * s + 7]);
    return __builtin_bit_cast(bf16x8, p);
}
__device__ __forceinline__ void gla_stage(const Frame& F, int b, int h, int vh, int n, LAS unsigned char* buf) {
    unsigned char* ws = F.ws; int lt = F.tid - 256; asm volatile("" : "+v"(lt));
    const size_t row0 = (size_t)b * SEQ + (size_t)n * 64;
    const GAS char* qp = (const GAS char*)((const bf16*)(ws + WS_Q) + row0 * 512 + h * 128);
    const GAS char* vp = (const GAS char*)((const bf16*)(ws + WS_V) + row0 * D + h * 256 + vh * 128);
    const GAS char* kp = (const GAS char*)((const bf16*)(ws + WS_KDEC) + (((size_t)b * 64 + n) * 512 + h * 128) * 64);
    v4u qv[4], kv[4], vv[4];
#pragma unroll
    for (int j = 0; j < 4; ++j) { const unsigned ck = (unsigned)lt + 256u * j;
        qv[j] = *(const GAS v4u*)(qp + ((ck >> 4) * 1024u + (ck & 15u) * 16u));
        vv[j] = *(const GAS v4u*)(vp + ((ck >> 4) * 2048u + (ck & 15u) * 16u));
        kv[j] = *(const GAS v4u*)(kp + ck * 16u); }
    float dv = 0.f; if (lt < 128) dv = __expf(((const float*)(ws + WS_TOT))[((size_t)b * 64 + n) * 512 + h * 128 + lt]);
#pragma unroll
    for (int j = 0; j < 4; ++j) { const unsigned ck = (unsigned)lt + 256u * j;
        *(LAS v4u*)(buf + GQ_OFF + (ck >> 4) * 272u + (ck & 15u) * 16u) = qv[j];
        *(LAS v4u*)(buf + GV_OFF + voff_b(ck >> 4, ck & 15u)) = vv[j];
        *(LAS v4u*)(buf + GK_OFF + (ck >> 3) * 144u + (ck & 7u) * 16u) = kv[j]; }
    if (lt < 128) ((LAS float*)(buf + GD_OFF))[lt] = dv;
}
__device__ __forceinline__ void gla_rec(const Frame& F, int unit) {
    unsigned char* ws = F.ws;
    const int b = unit >> 3, h = (unit >> 1) & 3, vh = unit & 1;
    const int w = F.wave;
    f32x16 S[4];
#pragma unroll
    for (int kt = 0; kt < 4; ++kt)
#pragma unroll
        for (int i = 0; i < 16; ++i) S[kt][i] = 0.f;
    __syncthreads();
    if (w >= 4) gla_stage(F, b, h, vh, 0, F.lds);
    __syncthreads();
#pragma unroll 1
    for (int n = 0; n < NCH; ++n) {
        if (w >= 4) { if (n + 1 < NCH) gla_stage(F, b, h, vh, n + 1, F.lds + ((n + 1) & 1) * GBUF); }
        else {
            int lane = F.lane; asm volatile("" : "+v"(lane));
            const int r = lane & 31, hh = lane >> 5;
            const unsigned blk = (lane >> 4) & 1, q4 = (lane & 15) >> 2, p4 = lane & 3;
            LAS unsigned char* buf = F.lds + (n & 1) * GBUF;
            const LAS unsigned char* kbase = buf + GK_OFF + r * 144 + hh * 16;
            const LAS unsigned char* qbase = buf + GQ_OFF + r * 272 + hh * 16;
            const LAS unsigned char* dbase = buf + GD_OFF + hh * 16;
            const unsigned chv = 4u * (unsigned)w + 2u * blk + (p4 >> 1);
            const unsigned vb0 = (unsigned)(size_t)(buf + GV_OFF) + 256u * (8u * hh + q4) + 16u * (chv ^ ((q4 << 2) | ((2u * hh) & 3u))) + 8u * (p4 & 1u);
            const unsigned vb1 = (unsigned)(size_t)(buf + GV_OFF) + 256u * (8u * hh + 4u + q4) + 16u * (chv ^ ((q4 << 2) | ((2u * hh + 1u) & 3u))) + 8u * (p4 & 1u);
#pragma unroll
            for (int kt = 0; kt < 4; ++kt)
#pragma unroll
                for (int g = 0; g < 4; ++g) { const f32x4 dq = *(const LAS f32x4*)(dbase + kt * 128 + g * 32);
                    S[kt][4 * g] *= dq.x; S[kt][4 * g + 1] *= dq.y; S[kt][4 * g + 2] *= dq.z; S[kt][4 * g + 3] *= dq.w; }
#pragma unroll
            for (int ts = 0; ts < 4; ++ts) {
                s16x4 lo, hi;
                asm volatile("ds_read_b64_tr_b16 %0, %2 offset:%4\n\tds_read_b64_tr_b16 %1, %3 offset:%4\n\ts_waitcnt lgkmcnt(0)" : "=&v"(lo), "=&v"(hi) : "v"(vb0), "v"(vb1), "i"(ts * 4096) : "memory");
                const bf16x8 vb = __builtin_shufflevector(lo, hi, 0, 1, 2, 3, 4, 5, 6, 7);
#pragma unroll
                for (int kt = 0; kt < 4; ++kt) { const bf16x8 ka = *(const LAS bf16x8*)(kbase + kt * 4608 + ts * 32);
                    S[kt] = __builtin_amdgcn_mfma_f32_32x32x16_bf16(ka, vb, S[kt], 0, 0, 0); }
            }
            f32x16 O[2];
#pragma unroll
            for (int tb = 0; tb < 2; ++tb)
#pragma unroll
                for (int i = 0; i < 16; ++i) O[tb][i] = 0.f;
#pragma unroll
            for (int kt = 0; kt < 4; ++kt)
#pragma unroll
                for (int s = 0; s < 2; ++s) { const bf16x8 sb = pack_step(S[kt], s);
#pragma unroll
                    for (int tb = 0; tb < 2; ++tb) { const bf16x8 qa = *(const LAS bf16x8*)(qbase + tb * 8704 + kt * 64 + s * 32);
                        O[tb] = __builtin_amdgcn_mfma_f32_32x32x16_bf16(qa, sb, O[tb], 0, 0, 0); } }
            bf16* op = (bf16*)(ws + WS_O) + ((size_t)b * SEQ + (size_t)n * 64 + 4 * hh) * D + h * 256 + vh * 128 + 32 * w + r;
#pragma unroll
            for (int tb = 0; tb < 2; ++tb)
#pragma unroll
                for (int i = 0; i < 16; ++i) { const int t = 32 * tb + (i & 3) + 8 * (i >> 2); op[(size_t)t * D] = (bf16)f2bf(O[tb][i]); }
        }
        __syncthreads();
    }
}
__device__ __forceinline__ void gla_norm(const Frame& F, const Args& a, int l) {
    unsigned char* ws = F.ws;
    const int gw = F.vcu * NWAVES + F.wave, NGW = F.G * NWAVES;
    f32x4 g[4];
#pragma unroll
    for (int hd = 0; hd < 4; ++hd) g[hd] = *(const f32x4*)(a.in[I_GNG] + (size_t)l * 1024 + hd * 256 + 4 * F.lane);
    for (int blk = gw; blk < T / 32; blk += NGW)
        for (int rr = 0; rr < 32; ++rr) { const size_t row = (size_t)blk * 32 + rr;
            GAS v2u* op = (GAS v2u*)((bf16*)(ws + WS_O) + row * D) + F.lane; const GAS v2u* gp = (const GAS v2u*)((const bf16*)(ws + WS_OG) + row * D) + F.lane;
#pragma unroll
            for (int hd = 0; hd < 4; ++hd) { const v2u ow = op[64 * hd], gw2 = gp[64 * hd];
                const f32x4 o = {bflo(ow.x), bfhi(ow.x), bflo(ow.y), bfhi(ow.y)}, og = {bflo(gw2.x), bfhi(gw2.x), bflo(gw2.y), bfhi(gw2.y)};
                const float ss = wave_sum((o.x * o.x + o.y * o.y) + (o.z * o.z + o.w * o.w), F.lane);
                const float rs = 1.0f / sqrtf(ss * (1.0f / 256.0f) + EPS);
                const f32x4 y = o * rs * g[hd] * og; op[64 * hd] = (v2u){pk2(y.x, y.y), pk2(y.z, y.w)}; } }
}

__device__ __forceinline__ void topk_phase(const Frame& F, const Args& a, int l) {
    unsigned char* ws = F.ws;
    LAS int* hist = (LAS int*)F.lds; LAS int* base = hist + 128; LAS float* bias = (LAS float*)(hist + 256);
    __syncthreads();
    if (F.tid < 128) { hist[F.tid] = 0; bias[F.tid] = a.in[I_RB][l * NE + F.tid]; }
    __syncthreads();
    const int t = F.vcu * 256 + F.tid; const bool act = F.tid < 256;
    float val[8], scv[8]; int idx[8], rank[8];
#pragma unroll
    for (int j = 0; j < 8; ++j) { val[j] = -1e30f; scv[j] = 0.f; idx[j] = 0; rank[j] = 0; }
    if (act) {
        const float* lg = (const float*)(ws + WS_LOGIT) + (size_t)t * NE;
        for (int e4 = 0; e4 < 32; ++e4) { const f32x4 x = *(const GAS f32x4*)(lg + 4 * e4);
#pragma unroll
            for (int q = 0; q < 4; ++q) { const int e = 4 * e4 + q; const float sc = 1.0f / (1.0f + __expf(-x[q])); const float v = sc + bias[e];
#pragma unroll
                for (int j = 7; j >= 0; --j) { if (v > val[j]) { if (j < 7) { val[j + 1] = val[j]; scv[j + 1] = scv[j]; idx[j + 1] = idx[j]; } val[j] = v; scv[j] = sc; idx[j] = e; } } } }
#pragma unroll
        for (int j = 0; j < 8; ++j) rank[j] = __hip_atomic_fetch_add(&hist[idx[j]], 1, __ATOMIC_RELAXED, __HIP_MEMORY_SCOPE_WORKGROUP);
    }
    __syncthreads();
    if (F.tid < 128) base[F.tid] = (int)atomicAdd((unsigned*)(ws + WS_CTL) + CW_CNT + l * NE + F.tid, (unsigned)hist[F.tid]);
    __syncthreads();
    if (act) { float ssum = 0.f;
#pragma unroll
        for (int j = 0; j < 8; ++j) ssum += scv[j];
        const float inv = 2.5f / ssum;
#pragma unroll
        for (int j = 0; j < 8; ++j) { ((unsigned*)(ws + WS_PK))[(size_t)t * 8 + j] = ((unsigned)idx[j] << 24) | (unsigned)(base[idx[j]] + rank[j]); ((float*)(ws + WS_WTS))[(size_t)t * 8 + j] = scv[j] * inv; } }
    __syncthreads();
}
__device__ __forceinline__ void moe_tiles(const Frame& F, int l) {
    LAS int* ts = (LAS int*)(F.lds + LDS_TS);
    __syncthreads();
    if (F.tid == 0) { const unsigned* cnt = (const unsigned*)(F.ws + WS_CTL) + CW_CNT + l * NE; int s = 0;
        for (int e = 0; e < NE; ++e) { ts[e] = s; s += (int)((__hip_atomic_load(cnt + e, RLX_AGENT) + 255u) >> 8); } ts[NE] = s; }
    __syncthreads();
}
__device__ __forceinline__ void scatter_phase(const Frame& F, int l) {
    unsigned char* ws = F.ws;
    moe_tiles(F, l);
    const LAS int* ts = (const LAS int*)(F.lds + LDS_TS);
    if (F.tid < 256) { const int t = F.vcu * 256 + F.tid;
#pragma unroll
        for (int j = 0; j < 8; ++j) { const unsigned pk = ((const unsigned*)(ws + WS_PK))[(size_t)t * 8 + j]; const int e = (int)(pk >> 24), p = ts[e] * 256 + (int)(pk & 0xffffffu);
            ((int*)(ws + WS_POS))[(size_t)t * 8 + j] = p; ((int*)(ws + WS_SORT))[p] = t; } }
}
__device__ __forceinline__ void combine_phase(const Frame& F, float* h, const float* gate) {
    unsigned char* ws = F.ws;
    const int gw = F.vcu * NWAVES + F.wave, NGW = F.G * NWAVES;
    for (int blk = gw; blk < T / 32; blk += NGW) {
        const int b = (blk * 32) / SEQ;
        f32x4 gv[2][2];
#pragma unroll
        for (int j = 0; j < 2; ++j)
#pragma unroll
            for (int n = 0; n < 2; ++n) gv[j][n] = *(const f32x4*)(gate + (size_t)b * 6144 + 512 * j + 8 * F.lane + 4 * n);
        for (int rr = 0; rr < 32; ++rr) { const size_t t = (size_t)blk * 32 + rr;
            f32x4 acc[2][2];
#pragma unroll
            for (int j = 0; j < 2; ++j) { acc[j][0] = (f32x4){0.f, 0.f, 0.f, 0.f}; acc[j][1] = (f32x4){0.f, 0.f, 0.f, 0.f}; }
#pragma unroll
            for (int k = 0; k < 8; ++k) { const int p = ((const int*)(ws + WS_POS))[t * 8 + k]; const float wk = ((const float*)(ws + WS_WTS))[t * 8 + k];
                const bf16* yr = (const bf16*)(ws + WS_Y) + (size_t)p * D + 8 * F.lane;
#pragma unroll
                for (int j = 0; j < 2; ++j) { const v4u yw = *(const GAS v4u*)(yr + 512 * j);
                    acc[j][0] += (f32x4){bflo(yw.x), bfhi(yw.x), bflo(yw.y), bfhi(yw.y)} * wk; acc[j][1] += (f32x4){bflo(yw.z), bfhi(yw.z), bflo(yw.w), bfhi(yw.w)} * wk; } }
            float* hr = h + t * D + 8 * F.lane;
#pragma unroll
            for (int j = 0; j < 2; ++j)
#pragma unroll
                for (int n = 0; n < 2; ++n) { const f32x4 hv = *(const GAS f32x4*)(hr + 512 * j + 4 * n); *(GAS f32x4*)(hr + 512 * j + 4 * n) = hv + gv[j][n] * acc[j][n]; }
        }
    }
}

constexpr int NPH_L = 15, NPHASE = 1 + DEPTH * NPH_L + 1;
__global__ void __launch_bounds__(NTHR, 2) mk_fwd(Args args) {
    extern __shared__ __attribute__((aligned(16))) unsigned char lds_raw[];
    Frame F;
    F.lds = (LAS unsigned char*)lds_raw; F.ws = args.ws;
    F.tid = threadIdx.x; F.lane = F.tid & 63; F.wave = __builtin_amdgcn_readfirstlane(F.tid >> 6);
    F.G = gridDim.x; { const int bx = blockIdx.x; F.bx = bx; F.vcu = (F.G % 8 == 0) ? (bx % 8) * (F.G / 8) + bx / 8 : bx; }
    volatile LAS unsigned* misc = (volatile LAS unsigned*)(F.lds + LDS_MISC);
    if (F.tid < 64) misc[F.tid] = 0u;
    __syncthreads();
    XcdBarrier bar; bar.bar = (unsigned*)(args.ws + WS_CTL) + CW_BAR; bar.x = 0; bar.st = nullptr;
    if (!MK_PER_PHASE) bar = xcd_barrier_post((unsigned*)(args.ws + WS_CTL) + CW_BAR, misc + 8);
    const int lo = args.ph_lo, hi = args.ph_hi;
#ifndef MK_G4_FROM_U
#define MK_G4_FROM_U 0
#endif
#ifndef MK_G3B_FIRST
#define MK_G3B_FIRST false
#endif
#ifndef MK_MASK
#define MK_MASK 0x7ffff
#endif
#define EN(j) (((MK_MASK) >> (j)) & 1)
#define IN(k) (lo <= (k) && (k) < hi)
#define FRESH_TID(t_) int t_; { int l_; asm volatile("v_mbcnt_lo_u32_b32 %0, -1, 0\n\tv_mbcnt_hi_u32_b32 %0, -1, %0" : "=v"(l_)); int wv_ = F.wave; asm volatile("" : "+s"(wv_)); t_ = wv_ * 64 + l_; }
#define FRESH(P) Frame P = F; { FRESH_TID(t_); P.tid = t_; P.lane = t_ & 63; unsigned char* w_ = args.ws; asm volatile("" : "+s"(w_)); P.ws = w_; int g_ = F.G, v_ = F.vcu, b_ = F.bx; asm volatile("" : "+s"(g_), "+s"(v_), "+s"(b_)); P.G = g_; P.vcu = v_; P.bx = b_; } unsigned char* ws = P.ws
#define SEAM(k) do { if (IN(k) && IN((k) + 1)) { FRESH_TID(tb_); xcd_barrier(bar, tb_ == 0); } } while (0)
    float* H = args.out;
    if (EN(15) && IN(0)) { FRESH(P); (void)ws; p0_prologue(P, args); } SEAM(0);
#pragma unroll 1
    for (int l = 0; l < DEPTH; ++l) {
        const int p0 = 1 + NPH_L * l;
        const float* hin = (l == 0) ? args.in[I_X] : H;
#define MODP ((const float*)(ws + WS_MOD) + (size_t)l * 16 * 6144)
        if (EN(0) && IN(p0 + 0)) { FRESH(P); norm_phase<false>(P, hin, args.in[I_N1G] + l * D, MODP + 1024, MODP + 0, (bf16*)(ws + WS_U), nullptr); }
        SEAM(p0 + 0);
        if (EN(1) && IN(p0 + 1)) { FRESH(P); pg8::Gemm g{(const bf16*)(ws + WS_U), (const bf16*)(ws + WS_WIN) + (size_t)l * NSEC * D, D, nullptr}; pg8::StaticOrder S; S.init(T, NSEC, P.G, P.bx);
            EpiInProj E{ws}; pg8::gemm_phase<EpiInProj, pg8::StaticOrder, true, true, false>(P.lds, g, S, E, P.tid, P.wave); }
        SEAM(p0 + 1);
        if (EN(2) && IN(p0 + 2)) { FRESH(P); (void)ws; rg_gate_phase(P, args, l); }
        SEAM(p0 + 2);
        if (EN(3) && IN(p0 + 3)) { FRESH(P); (void)ws; if (EN(18)) for (int u = P.vcu; u < 2048; u += P.G) scan_pass1(P, u); if (EN(17)) for (int u = P.vcu; u < 1024; u += P.G) gla_prep(P, args, l, u); }
        SEAM(p0 + 3);
        if (EN(4) && IN(p0 + 4)) { FRESH(P); (void)ws; for (int u = P.vcu; u < 160; u += P.G) { if (u < 128) { if (EN(17)) gla_rec(P, u); } else { if (EN(18)) scan_carry(P, u - 128); } } }
        SEAM(p0 + 4);
        if (EN(5) && IN(p0 + 5)) { FRESH(P); (void)ws; if (EN(18)) for (int u = P.vcu; u < 2048; u += P.G) scan_pass3(P, u); if (EN(17)) gla_norm(P, args, l); }
        SEAM(p0 + 5);
        if (EN(6) && IN(p0 + 6)) {
            { FRESH(P); pg8::StaticOrder S; S.init(T, D, P.G, P.bx);
              pg8::Gemm g{(const bf16*)(ws + WS_IX), (const bf16*)(ws + WS_WA) + (size_t)l * D * D, D, nullptr}; EpiMerge<true> E{(const bf16*)(ws + WS_GA), (bf16*)(ws + WS_MBUF)};
              pg8::gemm_phase<EpiMerge<true>, pg8::StaticOrder, true, true, false>(P.lds, g, S, E, P.tid, P.wave); }
            { FRESH(P); pg8::StaticOrder S; S.init(T, D, P.G, P.bx);
              pg8::Gemm g{(const bf16*)(ws + WS_O), (const bf16*)(ws + WS_WB) + (size_t)l * D * D, D, nullptr}; EpiMerge<MK_G3B_FIRST> E{(const bf16*)(ws + WS_GB), (bf16*)(ws + WS_MBUF)};
              pg8::gemm_phase<EpiMerge<MK_G3B_FIRST>, pg8::StaticOrder, true, true, false>(P.lds, g, S, E, P.tid, P.wave); } }
        SEAM(p0 + 6);
        if (EN(7) && IN(p0 + 7)) { FRESH(P); pg8::StaticOrder S; S.init(T, D, P.G, P.bx);
            pg8::Gemm g{(const bf16*)(ws + (MK_G4_FROM_U == 1 ? WS_U : (MK_G4_FROM_U == 2 ? WS_XRPRE : (MK_G4_FROM_U == 3 ? WS_GB : (MK_G4_FROM_U == 4 ? WS_V : (MK_G4_FROM_U == 5 ? WS_GA : (MK_G4_FROM_U == 6 ? WS_OG : WS_MBUF))))))), (const bf16*)(ws + WS_WO) + (size_t)l * D * D, D, nullptr}; EpiRes E{hin, H, MODP + 2048};
            pg8::gemm_phase<EpiRes, pg8::StaticOrder, true, true, false>(P.lds, g, S, E, P.tid, P.wave); }
        SEAM(p0 + 7);
        if (EN(8) && IN(p0 + 8)) { FRESH(P); norm_phase<false>(P, H, args.in[I_N2G] + l * D, MODP + 4096, MODP + 3072, (bf16*)(ws + WS_U), nullptr);
            for (int i = P.vcu * NTHR + P.tid; i < PMAX; i += P.G * NTHR) ((int*)(ws + WS_SORT))[i] = T; }
        SEAM(p0 + 8);
        if (EN(9) && IN(p0 + 9)) { FRESH(P); pg8::StaticOrder S; S.init(T, 256, P.G, P.bx);
            pg8::Gemm g{(const bf16*)(ws + WS_U), (const bf16*)(ws + WS_ROUT) + (size_t)l * 256 * D, D, nullptr}; EpiLogit E{(float*)(ws + WS_LOGIT)};
            pg8::gemm_phase<EpiLogit, pg8::StaticOrder, true, true, false>(P.lds, g, S, E, P.tid, P.wave); }
        SEAM(p0 + 9);
        if (EN(10) && IN(p0 + 10)) { FRESH(P); (void)ws; topk_phase(P, args, l); }
        SEAM(p0 + 10);
        if (EN(11) && IN(p0 + 11)) { FRESH(P); (void)ws; scatter_phase(P, l); }
        SEAM(p0 + 11);
        if (EN(12) && IN(p0 + 12)) {
            { FRESH(P); moe_tiles(P, l); const LAS int* ts = (const LAS int*)(P.lds + LDS_TS);
              pg8::MoeOrder S{ts, 2, P.G, P.vcu, ts[NE] * 2};
              pg8::Gemm g{(const bf16*)(ws + WS_U), (const bf16*)(ws + WS_EGU) + (size_t)l * NE * 512 * D, D, (const int*)(ws + WS_SORT)}; EpiGlu E{(bf16*)(ws + WS_ACT)};
              pg8::gemm_phase<EpiGlu, pg8::MoeOrder, true, true, true>(P.lds, g, S, E, P.tid, P.wave); }
            { FRESH(P); pg8::StaticOrder S; S.init(T, 512, P.G, P.bx);
              pg8::Gemm g{(const bf16*)(ws + WS_U), (const bf16*)(ws + WS_SGU) + (size_t)l * 512 * D, D, nullptr}; EpiGlu E{(bf16*)(ws + WS_ACTS)};
              pg8::gemm_phase<EpiGlu, pg8::StaticOrder, true, true, false>(P.lds, g, S, E, P.tid, P.wave); } }
        SEAM(p0 + 12);
        if (EN(13) && IN(p0 + 13)) {
            { FRESH(P); moe_tiles(P, l); const LAS int* ts = (const LAS int*)(P.lds + LDS_TS);
              pg8::MoeOrder S{ts, 4, P.G, P.vcu, ts[NE] * 4};
              pg8::Gemm g{(const bf16*)(ws + WS_ACT), (const bf16*)(ws + WS_EDN) + (size_t)l * NE * D * DE, DE, nullptr}; EpiY E{(bf16*)(ws + WS_Y)};
              pg8::gemm_phase<EpiY, pg8::MoeOrder, true, true, false>(P.lds, g, S, E, P.tid, P.wave); }
            { FRESH(P); pg8::StaticOrder S; S.init(T, D, P.G, P.bx);
              pg8::Gemm g{(const bf16*)(ws + WS_ACTS), (const bf16*)(ws + WS_SDN) + (size_t)l * D * DE, DE, nullptr}; EpiRes E{H, H, MODP + 5120};
              pg8::gemm_phase<EpiRes, pg8::StaticOrder, true, true, false>(P.lds, g, S, E, P.tid, P.wave); } }
        SEAM(p0 + 13);
        if (EN(14) && IN(p0 + 14)) { FRESH(P); combine_phase(P, H, MODP + 5120); }
        SEAM(p0 + 14);
    }
    if (EN(16) && IN(NPHASE - 1)) { FRESH(P); (void)ws; norm_phase<true>(P, H, args.in[I_FG], nullptr, nullptr, nullptr, H); }
#undef MODP
#undef IN
#undef SEAM
}

#ifndef MK_SKIP_LO
#define MK_SKIP_LO 0
#define MK_SKIP_HI 0
#endif
#ifndef MK_NLAUNCH
#define MK_NLAUNCH NPHASE
#endif
extern "C" void kernel_launch(void* const* d_in, const int* in_sizes, int n_in, void* d_out, int out_size, void* d_ws, size_t ws_size, hipStream_t stream) {
    static int grid = 0;
    if (grid == 0) {
        if (n_in != N_INPUTS || out_size != T * D || ws_size < WS_END) { fprintf(stderr, "kernel_launch: unexpected problem shape (n_in %d out %d ws %zu, need %zu)\n", n_in, out_size, ws_size, (size_t)WS_END); grid = -1; return; }
        int dev = 0, cus = 0, per_cu = 0;
        if (hipGetDevice(&dev) != hipSuccess || hipDeviceGetAttribute(&cus, hipDeviceAttributeMultiprocessorCount, dev) != hipSuccess) { grid = -1; return; }
        if (hipFuncSetAttribute((const void*)mk_fwd, hipFuncAttributeMaxDynamicSharedMemorySize, LDS_BYTES) != hipSuccess) { fprintf(stderr, "kernel_launch: hipFuncSetAttribute failed\n"); grid = -1; return; }
        if (hipOccupancyMaxActiveBlocksPerMultiprocessor(&per_cu, (const void*)mk_fwd, NTHR, LDS_BYTES) != hipSuccess || per_cu < 1) { fprintf(stderr, "kernel_launch: occupancy query says %d\n", per_cu); }
        (void)hipGetLastError();
        grid = cus;
    }
    if (grid < 0) return;
    if (hipMemsetAsync((char*)d_ws + WS_CTL, 0, CTL_ZERO_BYTES, stream) != hipSuccess) return;
    Args a{};
    for (int i = 0; i < N_INPUTS; ++i) a.in[i] = (const float*)d_in[i];
    a.out = (float*)d_out; a.ws = (unsigned char*)d_ws;
#if MK_PER_PHASE
    for (int p = 0; p < MK_NLAUNCH; ++p) { if (p >= MK_SKIP_LO && p < MK_SKIP_HI) continue; a.ph_lo = p; a.ph_hi = p + 1; hipLaunchKernelGGL(mk_fwd, dim3(grid), dim3(NTHR), LDS_BYTES, stream, a); }
#else
    a.ph_lo = 0; a.ph_hi = NPHASE; hipLaunchKernelGGL(mk_fwd, dim3(grid), dim3(NTHR), LDS_BYTES, stream, a);
#endif
}
```

```cpp
#include <hip/hip_runtime.h>
#include <cstdio>
#include <cstdint>

#ifndef MK_PER_PHASE
#define MK_PER_PHASE 0
#endif

namespace pg8 {
#define PG8_LAS __attribute__((address_space(3)))
typedef unsigned short bf16_t;
typedef short bf16x8 __attribute__((ext_vector_type(8)));
typedef float f32x4 __attribute__((ext_vector_type(4)));
typedef unsigned u32x4 __attribute__((ext_vector_type(4)));
constexpr int BM = 256, BK = 64, HALF = 128, HTB = HALF * BK * 2, STAGE_BYTES = 8 * HTB, NXCD = 8, WGM = 8;

__host__ __device__ __forceinline__ int lds_byte(int r, int c) { const int st = (r >> 4) * 2 + (c >> 5), rr = r & 15, cc = c & 31, ob = rr * 64 + cc * 2; return st * 1024 + (ob ^ (((ob >> 9) & 1) << 5)); }
__host__ __device__ __forceinline__ void stage_rc(int b, int& R, int& C) { const int st = b / 1024, sb = b % 1024, swz = sb ^ (((sb >> 9) & 1) << 5); R = (st >> 1) * 16 + swz / 64; C = (st & 1) * 32 + (swz % 64) / 2; }
__host__ __device__ __forceinline__ int perm32(int rho) { const int n = rho >> 4, i = rho & 15; return 8 * (i >> 2) + 4 * n + (i & 3); }

struct Unit { int pm, pn; };
struct Gemm { const bf16_t* A; const bf16_t* Bt; int K; const int* rowidx; };

struct StaticOrder {
    int nM, nN, nwg, G, c;
    __host__ __device__ void init(int M, int N, int G_, int c_) { nM = M / BM; nN = N / BM; nwg = nM * nN; G = G_; c = c_; }
    __host__ __device__ bool next(int i, Unit& u) const {
        const long L = (long)i * G + c; if (L >= nwg) return false;
        int wgid = (int)L; { const int q = nwg / NXCD, r = nwg % NXCD, xcd = wgid % NXCD, off = wgid / NXCD; wgid = (xcd < r ? xcd * (q + 1) : r * (q + 1) + (xcd - r) * q) + off; }
        const int nig = WGM * nN, gid = wgid / nig, fm = gid * WGM, gsz = (nM - fm) < WGM ? (nM - fm) : WGM;
        u.pm = fm + ((wgid % nig) % gsz); u.pn = (wgid % nig) / gsz; return true;
    }
};
struct MoeOrder {
    const PG8_LAS int* ts; int npn, G, c, total;
    __device__ __forceinline__ bool next(int i, Unit& u) const {
        const int L = i * G + c; if (L >= total) return false;
        const int tile = L / npn, j = L - tile * npn;
        int lo = 0, hi = 128;
        while (hi - lo > 1) { const int mid = (lo + hi) >> 1; if (ts[mid] <= tile) lo = mid; else hi = mid; }
        u.pm = tile; u.pn = lo * npn + j; return true;
    }
};

__device__ __forceinline__ unsigned cvt_pk_bf16(float lo, float hi) { typedef __bf16 bf2_t __attribute__((ext_vector_type(2))); typedef float f2_t __attribute__((ext_vector_type(2)));
    return __builtin_bit_cast(unsigned, __builtin_convertvector((f2_t){lo, hi}, bf2_t)); }

template <class Epi, class Sched, bool ALIGN_EPI, bool SP2, bool GATHER>
__device__ __forceinline__ void gemm_phase(PG8_LAS unsigned char* lds, const Gemm g, const Sched& S, const Epi& E, const int tid, const int wid) {
    const int lane = tid & 63, wr = wid >> 2, wc = wid & 3, fr = lane & 15, fq = lane >> 4;
    const int K = g.K, nt = K / BK;
    unsigned voffA[2], voffB[2];
#pragma unroll
    for (int i = 0; i < 2; ++i) { int R, C; stage_rc(tid * 16 + i * 8192, R, C); const int Rb = (R & ~31) + perm32(R & 31);
        voffA[i] = (unsigned)(R * K + C) * 2u; voffB[i] = (unsigned)(Rb * K + C) * 2u; }
    const size_t kstep = (size_t)(BK * 2);
    const size_t hstep = (size_t)HALF * K * 2;
    const size_t tstep = 2 * hstep;
    const unsigned ldsw = (unsigned)wid * 1024u;
    const int aoff = lds_byte(wr * 64 + fr, fq * 8), boff = lds_byte(wc * 32 + fr, fq * 8);
    unsigned gc[2][2], gn[2][2];
#define PG8_SA(b, h) (((b) * 2 + (h)) * HTB)
#define PG8_SB(b, h) ((4 + (b) * 2 + (h)) * HTB)
#define PG8_STAGE(bufoff, gbase, voff) do { _Pragma("unroll") for (int _i = 0; _i < 2; ++_i) \
        __builtin_amdgcn_global_load_lds((const unsigned*)((const char*)(gbase) + (voff)[_i]), (PG8_LAS unsigned*)(lds + (bufoff) + ldsw + _i * 8192), 16, 0, 0); } while (0)
#define PG8_STAGE_A(bufoff, kb, h, NX) do { if constexpr (GATHER) { _Pragma("unroll") for (int _i = 0; _i < 2; ++_i) { const unsigned _o = (NX) ? gn[h][_i] : gc[h][_i]; \
        __builtin_amdgcn_global_load_lds((const unsigned*)((const char*)(kb) + _o), (PG8_LAS unsigned*)(lds + (bufoff) + ldsw + _i * 8192), 16, 0, 0); } } \
        else { PG8_STAGE(bufoff, (const char*)(kb) + ((h) ? hstep : (size_t)0), voffA); } } while (0)
#define PG8_LDA(dst, b, h) do { _Pragma("unroll") for (int m = 0; m < 4; ++m) _Pragma("unroll") for (int k = 0; k < 2; ++k) dst[m][k] = *(const PG8_LAS bf16x8*)(lds + PG8_SA(b, h) + aoff + m * 2048 + k * 1024); } while (0)
#define PG8_LDB(dst, b, h) do { _Pragma("unroll") for (int n = 0; n < 2; ++n) _Pragma("unroll") for (int k = 0; k < 2; ++k) dst[n][k] = *(const PG8_LAS bf16x8*)(lds + PG8_SB(b, h) + boff + n * 2048 + k * 1024); } while (0)
#define PG8_MMA(ai, bj, At, Bt) do { __builtin_amdgcn_s_setprio(1); _Pragma("unroll") for (int m = 0; m < 4; ++m) _Pragma("unroll") for (int n = 0; n < 2; ++n) _Pragma("unroll") for (int k = 0; k < 2; ++k) \
        acc[ai][bj][m][n] = __builtin_amdgcn_mfma_f32_16x16x32_bf16(Bt[n][k], At[m][k], acc[ai][bj][m][n], 0, 0, 0); __builtin_amdgcn_s_setprio(0); } while (0)
#define PG8_WAIT_V(n) asm volatile("s_waitcnt vmcnt(" #n ")" ::: "memory")
#define PG8_WAIT_L(n) asm volatile("s_waitcnt lgkmcnt(" #n ")" ::: "memory")
#define PG8_BAR __builtin_amdgcn_s_barrier()
#define PG8_SCHED __builtin_amdgcn_sched_barrier(0)
#define PG8_LOAD_ROWS(dst, un) do { int _ln; asm volatile("v_mbcnt_lo_u32_b32 %0, -1, 0\n\tv_mbcnt_hi_u32_b32 %0, -1, %0" : "=v"(_ln)); const int _t = wid * 64 + _ln; \
        _Pragma("unroll") for (int _i = 0; _i < 2; ++_i) { int _R, _C; stage_rc(_t * 16 + _i * 8192, _R, _C); _Pragma("unroll") for (int _h = 0; _h < 2; ++_h) { \
        const int _tok = ((const __attribute__((address_space(1))) int*)g.rowidx)[(un).pm * BM + _h * HALF + _R]; dst[_h][_i] = (unsigned)_tok * (unsigned)(K * 2) + (unsigned)_C * 2u; } } } while (0)
    Unit cur, nxt; int ui = 0;
    if (!S.next(0, cur)) return;
    f32x4 acc[2][2][4][2];
#pragma unroll
    for (int a = 0; a < 2; ++a)
#pragma unroll
        for (int b = 0; b < 2; ++b)
#pragma unroll
            for (int m = 0; m < 4; ++m)
#pragma unroll
                for (int n = 0; n < 2; ++n) acc[a][b][m][n] = (f32x4){0.f, 0.f, 0.f, 0.f};
    bf16x8 At[4][2], B0[2][2], B1[2][2];
    const char* cA = GATHER ? (const char*)g.A : (const char*)g.A + (size_t)cur.pm * tstep; const char* cB = (const char*)g.Bt + (size_t)cur.pn * tstep;
    if constexpr (GATHER) { PG8_LOAD_ROWS(gc, cur); }
    if constexpr (SP2) {
        PG8_STAGE(PG8_SB(0, 0), cB, voffB); PG8_STAGE(PG8_SB(0, 1), cB + hstep, voffB); PG8_STAGE_A(PG8_SA(0, 0), cA, 0, false); PG8_STAGE_A(PG8_SA(0, 1), cA, 1, false);
        if (wr == 1) PG8_BAR;
        PG8_WAIT_V(2); PG8_BAR;
        PG8_STAGE(PG8_SB(1, 0), cB + kstep, voffB); PG8_STAGE_A(PG8_SA(1, 0), cA + kstep, 0, false); PG8_STAGE(PG8_SB(1, 1), cB + hstep + kstep, voffB);
        PG8_WAIT_V(6); PG8_BAR;
    } else {
        PG8_STAGE(PG8_SB(0, 0), cB, voffB); PG8_STAGE_A(PG8_SA(0, 0), cA, 0, false); PG8_STAGE(PG8_SB(0, 1), cB + hstep, voffB); PG8_STAGE_A(PG8_SA(0, 1), cA, 1, false);
        if (wr == 1) PG8_BAR;
        PG8_WAIT_V(4); PG8_BAR;
        PG8_STAGE(PG8_SB(1, 0), cB + kstep, voffB); PG8_STAGE_A(PG8_SA(1, 0), cA + kstep, 0, false); PG8_STAGE(PG8_SB(1, 1), cB + hstep + kstep, voffB);
        PG8_WAIT_V(6); PG8_BAR;
    }
    for (;;) {
        const bool has_next = S.next(ui + 1, nxt);
        const char* nA = GATHER ? (const char*)g.A : (has_next ? (const char*)g.A + (size_t)nxt.pm * tstep : cA); const char* nB = has_next ? (const char*)g.Bt + (size_t)nxt.pn * tstep : cB;
        if constexpr (GATHER) { if (has_next) { PG8_LOAD_ROWS(gn, nxt); } else {
#pragma unroll
            for (int _h = 0; _h < 2; ++_h)
#pragma unroll
                for (int _i = 0; _i < 2; ++_i) gn[_h][_i] = gc[_h][_i]; } }
#pragma unroll 1
        for (int t = 0; t < nt; t += 2) {
            const bool last = (t == nt - 2);
            const char* a1 = cA + (size_t)(t + 1) * kstep;
            const char* a2 = last ? nA : cA + (size_t)(t + 2) * kstep; const char* b2 = last ? nB : cB + (size_t)(t + 2) * kstep;
            const char* a3 = a2 + kstep; const char* b3 = b2 + kstep;
            if constexpr (SP2) {
            PG8_LDB(B0, 0, 0); PG8_LDB(B1, 0, 1); PG8_SCHED; PG8_LDA(At, 0, 0); PG8_STAGE_A(PG8_SA(1, 1), a1, 1, false);
            PG8_WAIT_V(8); PG8_WAIT_L(0); PG8_BAR; PG8_MMA(0, 0, At, B0); PG8_MMA(0, 1, At, B1); PG8_BAR; PG8_SCHED;
            PG8_LDA(At, 0, 1); PG8_STAGE(PG8_SB(0, 0), b2, voffB); PG8_STAGE(PG8_SB(0, 1), b2 + hstep, voffB); PG8_STAGE_A(PG8_SA(0, 0), a2, 0, last);
            PG8_WAIT_V(8); PG8_WAIT_L(0); PG8_BAR; PG8_MMA(1, 0, At, B0); PG8_MMA(1, 1, At, B1); PG8_BAR; PG8_SCHED;
            PG8_LDB(B0, 1, 0); PG8_LDB(B1, 1, 1); PG8_SCHED; PG8_LDA(At, 1, 0); PG8_STAGE_A(PG8_SA(0, 1), a2, 1, last);
            PG8_WAIT_V(8); PG8_WAIT_L(0); PG8_BAR; PG8_MMA(0, 0, At, B0); PG8_MMA(0, 1, At, B1); PG8_BAR; PG8_SCHED;
            PG8_LDA(At, 1, 1); PG8_STAGE(PG8_SB(1, 0), b3, voffB); PG8_STAGE(PG8_SB(1, 1), b3 + hstep, voffB); PG8_STAGE_A(PG8_SA(1, 0), a3, 0, last);
            PG8_WAIT_V(8); PG8_WAIT_L(0); PG8_BAR; PG8_MMA(1, 0, At, B0); PG8_MMA(1, 1, At, B1); PG8_BAR; PG8_SCHED;
            } else {
            PG8_LDB(B0, 0, 0); PG8_SCHED; PG8_LDA(At, 0, 0); PG8_STAGE_A(PG8_SA(1, 1), a1, 1, false);
            PG8_WAIT_L(8); PG8_BAR; PG8_WAIT_L(0); PG8_MMA(0, 0, At, B0); PG8_BAR; PG8_SCHED;
            PG8_LDB(B1, 0, 1); PG8_STAGE(PG8_SB(0, 0), b2, voffB);
            PG8_BAR; PG8_WAIT_L(0); PG8_MMA(0, 1, At, B1); PG8_BAR;
            PG8_LDA(At, 0, 1); PG8_STAGE_A(PG8_SA(0, 0), a2, 0, last);
            PG8_BAR; PG8_WAIT_L(0); PG8_MMA(1, 0, At, B0); PG8_BAR; PG8_SCHED;
            PG8_STAGE(PG8_SB(0, 1), b2 + hstep, voffB);
            PG8_WAIT_V(6); PG8_BAR; PG8_MMA(1, 1, At, B1); PG8_BAR;
            PG8_LDB(B0, 1, 0); PG8_SCHED; PG8_LDA(At, 1, 0); PG8_STAGE_A(PG8_SA(0, 1), a2, 1, last);
            PG8_WAIT_L(8); PG8_BAR; PG8_WAIT_L(0); PG8_MMA(0, 0, At, B0); PG8_BAR; PG8_SCHED;
            PG8_LDB(B1, 1, 1); PG8_STAGE(PG8_SB(1, 0), b3, voffB);
            PG8_BAR; PG8_WAIT_L(0); PG8_MMA(0, 1, At, B1); PG8_BAR;
            PG8_LDA(At, 1, 1); PG8_STAGE_A(PG8_SA(1, 0), a3, 0, last);
            PG8_BAR; PG8_WAIT_L(0); PG8_MMA(1, 0, At, B0); PG8_BAR; PG8_SCHED;
            PG8_STAGE(PG8_SB(1, 1), b3 + hstep, voffB);
            PG8_WAIT_V(6); PG8_BAR; PG8_MMA(1, 1, At, B1); PG8_BAR;
            }
        }
        if constexpr (ALIGN_EPI) { if (wr == 0) PG8_BAR; }
        E(acc, cur, wr, wc, fr, fq);
        if (!has_next) break;
#pragma unroll
        for (int a = 0; a < 2; ++a)
#pragma unroll
            for (int b = 0; b < 2; ++b)
#pragma unroll
                for (int m = 0; m < 4; ++m)
#pragma unroll
                    for (int n = 0; n < 2; ++n) acc[a][b][m][n] = (f32x4){0.f, 0.f, 0.f, 0.f};
        cur = nxt; cA = nA; cB = nB; ++ui;
        if constexpr (GATHER) {
#pragma unroll
            for (int _h = 0; _h < 2; ++_h)
#pragma unroll
                for (int _i = 0; _i < 2; ++_i) gc[_h][_i] = gn[_h][_i]; }
        if constexpr (ALIGN_EPI) { if (wr == 1) PG8_BAR; }
    }
    PG8_WAIT_V(0);
    if constexpr (!ALIGN_EPI) { if (wr == 0) PG8_BAR; }
    PG8_BAR;
#undef PG8_SA
#undef PG8_SB
#undef PG8_STAGE
#undef PG8_STAGE_A
#undef PG8_LDA
#undef PG8_LDB
#undef PG8_MMA
#undef PG8_WAIT_V
#undef PG8_WAIT_L
#undef PG8_BAR
#undef PG8_SCHED
#undef PG8_LOAD_ROWS
}
}

constexpr int NWAVES = 8, NTHR = 512;
constexpr int D = 1024, BATCH = 16, SEQ = 4096, T = BATCH * SEQ, DEPTH = 2;
constexpr int CHUNK = 64, NCH = SEQ / CHUNK;
constexpr int NSEC = 7168;
constexpr int N_IN = 7184;
constexpr int NE = 128, TOPK = 8, DE = 256;
constexpr int PMAX = T * TOPK + NE * 256;
constexpr float EPS = 1e-6f;

constexpr size_t MiB = 1u << 20;
constexpr size_t WS_CTL = 0, CTL_ZERO_BYTES = 1 * MiB;
constexpr size_t WS_MOD = 1 * MiB;
constexpr size_t WS_WLR = 2 * MiB;
constexpr size_t WS_RGW = 3 * MiB;
constexpr size_t WS_WIN = 4 * MiB;
constexpr size_t WS_WA = 32 * MiB, WS_WB = 36 * MiB, WS_WO = 40 * MiB;
constexpr size_t WS_ROUT = 44 * MiB;
constexpr size_t WS_SGU = 45 * MiB;
constexpr size_t WS_SDN = 47 * MiB;
constexpr size_t WS_EGU = 48 * MiB;
constexpr size_t WS_EDN = 304 * MiB;
constexpr size_t WS_U = 432 * MiB;
constexpr size_t WS_SP = 561 * MiB, WS_SE = 565 * MiB, WS_CIN = 569 * MiB;
constexpr size_t WS_TOT = 573 * MiB;
constexpr size_t WS_PK = 575 * MiB;
constexpr size_t WS_POS = 577 * MiB;
constexpr size_t WS_WTS = 579 * MiB;
constexpr size_t WS_SORT = 581 * MiB;
constexpr size_t WS_BIG = 592 * MiB;
constexpr size_t WS_XRPRE = WS_BIG, WS_RG = WS_BIG + 128 * MiB, WS_Q = WS_BIG + 256 * MiB, WS_K = WS_BIG + 320 * MiB, WS_V = WS_BIG + 384 * MiB,
                 WS_OG = WS_BIG + 512 * MiB, WS_GA = WS_BIG + 640 * MiB, WS_GB = WS_BIG + 768 * MiB, WS_LOGA = WS_BIG + 896 * MiB, WS_IX = WS_BIG + 1024 * MiB,
                 WS_KDEC = WS_BIG + 1152 * MiB;
constexpr size_t WS_O = WS_XRPRE;
constexpr size_t WS_MBUF = WS_LOGA;
constexpr size_t WS_Y = WS_BIG;
constexpr size_t WS_LOGIT = WS_BIG;
constexpr size_t WS_ACT = WS_BIG + 1088 * MiB;
constexpr size_t WS_ACTS = WS_BIG + 1360 * MiB;
constexpr size_t WS_END = WS_BIG + 1392 * MiB;
static_assert((size_t)PMAX * 1024 * 2 <= 1088 * MiB && (size_t)PMAX * 256 * 2 <= 272 * MiB && WS_KDEC + 64 * MiB <= WS_END, "ws map");
constexpr int CW_TMO = 0;
constexpr int CW_BAR = 4096;
constexpr int CW_CNT = 8192;

constexpr int RING_BYTES = 131072;
constexpr int LDS_TS = RING_BYTES;
constexpr int LDS_MISC = RING_BYTES + 1024;
constexpr int LDS_BYTES = 147456;

#define GAS __attribute__((address_space(1)))
#define LAS __attribute__((address_space(3)))
typedef unsigned short bf16;
typedef unsigned v4u __attribute__((ext_vector_type(4)));
typedef unsigned v2u __attribute__((ext_vector_type(2)));
typedef float f32x4 __attribute__((ext_vector_type(4)));
typedef float f32x16 __attribute__((ext_vector_type(16)));
typedef short bf16x8 __attribute__((ext_vector_type(8)));
typedef short s16x4 __attribute__((ext_vector_type(4)));
typedef GAS unsigned gu32;
#define RLX_AGENT __ATOMIC_RELAXED, __HIP_MEMORY_SCOPE_AGENT
#define LDS_WAIT() asm volatile("s_waitcnt lgkmcnt(0)" ::: "memory")
__device__ __forceinline__ unsigned f2bf(float f) { return (unsigned)__builtin_bit_cast(unsigned short, (__bf16)f); }
__device__ __forceinline__ unsigned pk2(float lo, float hi) { return pg8::cvt_pk_bf16(lo, hi); }
__device__ __forceinline__ float bflo(unsigned w) { return __builtin_bit_cast(float, w << 16); }
__device__ __forceinline__ float bfhi(unsigned w) { return __builtin_bit_cast(float, w & 0xffff0000u); }
__device__ __forceinline__ float bf2f(bf16 b) { return __builtin_bit_cast(float, (unsigned)b << 16); }
__device__ __forceinline__ float fsigmoid(float x) { return __builtin_amdgcn_rcpf(1.0f + __builtin_amdgcn_exp2f(-1.442695041f * x)); }
__device__ __forceinline__ float fsilu(float x) { return x * fsigmoid(x); }
__device__ __forceinline__ float fgelu_tanh(float x) { return x * fsigmoid(1.5957691216f * (x + 0.044715f * x * x * x)); }

#define XB_TMO      128
#define XB_XCNT(j)  (256  + 64 * (j))
#define XB_XSUB(j)  (1280 + 64 * (j))
#define XB_XGEN(j)  (2304 + 64 * (j))
#define XB_TOP      3328
#define XB_TOPGEN   3392
#define XCD_BAR_WORDS 3456
#define XB_SPIN_CAP (1u << 18)
__device__ __forceinline__ unsigned xb_ld(unsigned* p)              { return __hip_atomic_load(p, __ATOMIC_RELAXED, __HIP_MEMORY_SCOPE_AGENT); }
__device__ __forceinline__ unsigned xb_add(unsigned* p, unsigned v) { return __hip_atomic_fetch_add(p, v, __ATOMIC_RELAXED, __HIP_MEMORY_SCOPE_AGENT); }
__device__ __forceinline__ unsigned xb_xcc_id() { return (unsigned)__builtin_amdgcn_s_getreg((3 << 11) | 20) & 0xFu; }
#define XB_SPIN(cond, bar) do { unsigned _sp = 0; while (cond) { __builtin_amdgcn_s_sleep(1); \
    if ((++_sp & 255u) == 0u) { if (xb_ld(&(bar)[XB_TMO])) break; if (_sp > XB_SPIN_CAP) { atomicAdd(&(bar)[XB_TMO], 1u); break; } } } } while (0)
struct XcdBarrier { unsigned* bar; unsigned x; volatile LAS unsigned* st; };
__device__ __forceinline__ XcdBarrier xcd_barrier_post(unsigned* bar, volatile LAS unsigned* st) {
    XcdBarrier b; b.bar = bar; b.x = xb_xcc_id(); b.st = st;
    if (threadIdx.x == 0) (void)xb_add(&bar[XB_XCNT(b.x)], 1u);
    return b;
}
__device__ __forceinline__ void xcd_barrier_complete(unsigned* bar, unsigned x, unsigned& nloc, unsigned& nx) {
    const unsigned G = gridDim.x * gridDim.y * gridDim.z;
    unsigned sum, cnt, mine, sp = 0u;
    for (;;) {
        sum = 0u; cnt = 0u; mine = 0u;
#pragma unroll
        for (unsigned j = 0; j < 16; ++j) { const unsigned c = xb_ld(&bar[XB_XCNT(j)]); sum += c; cnt += (c > 0u) ? 1u : 0u; mine = (j == x) ? c : mine; }
        if (sum == G) break;
        __builtin_amdgcn_s_sleep(1);
        if ((++sp & 255u) == 0u) { if (xb_ld(&bar[XB_TMO])) break; if (sp > XB_SPIN_CAP) { atomicAdd(&bar[XB_TMO], 1u); break; } }
    }
    nloc = mine > 0u ? mine : 1u; nx = cnt > 0u ? cnt : 1u;
}
__device__ __forceinline__ void xcd_barrier(const XcdBarrier& b, const bool leader) {
    asm volatile("s_waitcnt vmcnt(0)" ::: "memory");
    __syncthreads();
    if (leader) {
        unsigned* bar = b.bar;
        __builtin_amdgcn_s_waitcnt(0);
        unsigned nloc = b.st[0], nx = b.st[1];
        if (nloc == 0u) { xcd_barrier_complete(bar, b.x, nloc, nx); b.st[0] = nloc; b.st[1] = nx; }
        const unsigned old = xb_add(&bar[XB_XSUB(b.x)], 1u);
        const unsigned gen = old / nloc;
        if (old + 1u == (gen + 1u) * nloc) {
            __builtin_amdgcn_fence(__ATOMIC_RELEASE, "agent");
            asm volatile("s_waitcnt vmcnt(0)" ::: "memory");
            const unsigned og = xb_add(&bar[XB_TOP], 1u);
            const unsigned tg = og / nx;
            if (og + 1u == (tg + 1u) * nx) xb_add(&bar[XB_TOPGEN], 1u);
            else XB_SPIN(xb_ld(&bar[XB_TOPGEN]) == tg, bar);
            __builtin_amdgcn_fence(__ATOMIC_ACQUIRE, "agent");
            xb_add(&bar[XB_XGEN(b.x)], 1u);
            asm volatile("s_waitcnt vmcnt(0)" ::: "memory");
        } else {
            XB_SPIN(xb_ld(&bar[XB_XGEN(b.x)]) == gen, bar);
            __builtin_amdgcn_fence(__ATOMIC_ACQUIRE, "agent");
            asm volatile("s_waitcnt vmcnt(0)" ::: "memory");
        }
    }
    __syncthreads();
}

enum In { I_X = 0, I_C, I_ADAW, I_ADAB, I_N1G, I_WIN, I_CONVW, I_CONVB, I_RGWA, I_RGBA, I_RGWX, I_RGBX, I_RGLAM, I_GWUP, I_GBUP, I_GNG, I_WBA, I_WBB, I_WOUT, I_N2G,
          I_RW, I_RB, I_EGU, I_EDN, I_SGU, I_SDN, I_FG, N_INPUTS };
struct Args { const float* in[N_INPUTS]; float* out; unsigned char* ws; int ph_lo, ph_hi; };
struct Frame { LAS unsigned char* lds; unsigned char* ws; int tid, lane, wave, vcu, G, bx; };

__device__ __forceinline__ float wave_sum(float v, int lane) {
#pragma unroll
    for (int o = 1; o < 64; o <<= 1) v += __builtin_bit_cast(float, __builtin_amdgcn_ds_bpermute((lane ^ o) << 2, __builtin_bit_cast(int, v)));
    return v;
}

template <class RowP>
__device__ __forceinline__ void conv_item(const float* W, int K, int N, LAS float* scr, int item, int lane, RowP rowp) {
    const int nblk = (N + 31) / 32, kb = item / nblk, nb = item % nblk, k0 = 64 * kb, n0 = 32 * nb;
    const int cl = n0 + (lane & 31); const bool okc = cl < N;
#pragma unroll 8
    for (int i = 0; i < 32; ++i) { const int kk = 2 * i + (lane >> 5); scr[kk * 33 + (lane & 31)] = okc ? W[(size_t)(k0 + kk) * N + cl] : 0.f; }
    LDS_WAIT(); asm volatile("" ::: "memory");
    const int c = lane & 7;
#pragma unroll
    for (int j = 0; j < 4; ++j) { const int n = (lane >> 3) + 8 * j; const LAS float* s = scr + (8 * c) * 33 + n;
        v4u o; o.x = pk2(s[0 * 33], s[1 * 33]); o.y = pk2(s[2 * 33], s[3 * 33]); o.z = pk2(s[4 * 33], s[5 * 33]); o.w = pk2(s[6 * 33], s[7 * 33]);
        bf16* rp = (n0 + n < N) ? rowp(n0 + n) : (bf16*)nullptr;
        if (rp) *(GAS v4u*)(rp + k0 + 8 * c) = o; }
    LDS_WAIT(); asm volatile("" ::: "memory");
}
__device__ __forceinline__ bf16* winrow(int c, bf16* win, bf16* wlr) {
    if (c < 5120) {
        if (c >= 2048 && c < 2560) { const int p = c & 15, g = (p >> 2) & 3; const int pp = (g == 1) ? p + 4 : (g == 2) ? p - 4 : p; c = (c & ~15) | pp; }
        return win + (size_t)c * D; }
    if (c < 5136) return wlr + (size_t)(c - 5120) * D;
    return win + (size_t)(c - 16) * D;
}
__device__ __forceinline__ int glurow(int c) { return 256 * ((c & 255) >> 7) + 128 * (c >> 8) + (c & 127); }

__device__ __forceinline__ void p0_prologue(const Frame& F, const Args& a) {
    unsigned char* ws = F.ws;
    if (F.vcu < 96) {
        LAS float* cact = (LAS float*)F.lds;
        LAS float* part = (LAS float*)(F.lds + 65536);
        for (int i = F.tid; i < 16 * 1024; i += NTHR) { const int b = i >> 10, k = i & 1023; const float x = a.in[I_C][i]; cact[k * 16 + b] = fsilu(x); }
        __syncthreads();
        const int l = F.wave >> 2, kq = F.wave & 3, n = F.vcu * 64 + F.lane;
        float acc[16];
#pragma unroll
        for (int b = 0; b < 16; ++b) acc[b] = 0.f;
        const float* w = a.in[I_ADAW] + (size_t)l * 1024 * 6144 + n;
#pragma unroll 4
        for (int k = kq * 256; k < kq * 256 + 256; ++k) { const float wv = w[(size_t)k * 6144];
#pragma unroll
            for (int q = 0; q < 4; ++q) { const f32x4 cv = *(const LAS f32x4*)(cact + k * 16 + 4 * q); acc[4 * q] += wv * cv.x; acc[4 * q + 1] += wv * cv.y; acc[4 * q + 2] += wv * cv.z; acc[4 * q + 3] += wv * cv.w; } }
#pragma unroll
        for (int b = 0; b < 16; ++b) part[(F.wave * 16 + b) * 64 + F.lane] = acc[b];
        __syncthreads();
        for (int i = F.tid; i < 2 * 16 * 64; i += NTHR) { const int ll = i >> 10, b = (i >> 6) & 15, nn = i & 63; float s = a.in[I_ADAB][ll * 6144 + F.vcu * 64 + nn];
#pragma unroll
            for (int q = 0; q < 4; ++q) s += part[((ll * 4 + q) * 16 + b) * 64 + nn];
            ((float*)(ws + WS_MOD))[((size_t)ll * 16 + b) * 6144 + F.vcu * 64 + nn] = s; }
        __syncthreads();
    }
    LAS float* scr = (LAS float*)(F.lds + F.wave * 16384);
    const int gw = F.vcu * NWAVES + F.wave, NGW = F.G * NWAVES;
    constexpr int I_IN = 16 * 225, I_SQ = 16 * 32, I_R = 16 * 4, I_SG = 16 * 16, I_SD = 4 * 32, I_RGI = 2 * 4 * 16, I_EG = 16 * 16, I_ED = 4 * 32;
    constexpr int PER_L = I_IN + 3 * I_SQ + I_R + I_SG + I_SD + I_RGI + NE * I_EG + NE * I_ED;
    for (int it = gw; it < DEPTH * PER_L; it += NGW) {
        const int l = it / PER_L; int r = it - l * PER_L;
        if (r < I_IN) { bf16* win = (bf16*)(ws + WS_WIN) + (size_t)l * NSEC * D; bf16* wlr = (bf16*)(ws + WS_WLR) + (size_t)l * 16 * D;
            conv_item(a.in[I_WIN] + (size_t)l * D * N_IN, D, N_IN, scr, r, F.lane, [=](int c) { return winrow(c, win, wlr); }); continue; } r -= I_IN;
        if (r < 3 * I_SQ) { const int w = r / I_SQ; r -= w * I_SQ; const float* src = a.in[w == 0 ? I_WBA : (w == 1 ? I_WBB : I_WOUT)] + (size_t)l * D * D;
            bf16* dst = (bf16*)(ws + (w == 0 ? WS_WA : (w == 1 ? WS_WB : WS_WO))) + (size_t)l * D * D;
            conv_item(src, D, D, scr, r, F.lane, [=](int c) { return dst + (size_t)c * D; }); continue; } r -= 3 * I_SQ;
        if (r < I_R) { bf16* dst = (bf16*)(ws + WS_ROUT) + (size_t)l * 256 * D;
            conv_item(a.in[I_RW] + (size_t)l * D * NE, D, NE, scr, r, F.lane, [=](int c) { return dst + (size_t)c * D; }); continue; } r -= I_R;
        if (r < I_SG) { bf16* dst = (bf16*)(ws + WS_SGU) + (size_t)l * 512 * D;
            conv_item(a.in[I_SGU] + (size_t)l * D * 512, D, 512, scr, r, F.lane, [=](int c) { return dst + (size_t)glurow(c) * D; }); continue; } r -= I_SG;
        if (r < I_SD) { bf16* dst = (bf16*)(ws + WS_SDN) + (size_t)l * D * DE;
            conv_item(a.in[I_SDN] + (size_t)l * DE * D, DE, D, scr, r, F.lane, [=](int c) { return dst + (size_t)c * DE; }); continue; } r -= I_SD;
        if (r < I_RGI) { const int which = r / 64; r -= which * 64; const int hb = r / 8; r -= hb * 8;
            bf16* dst = (bf16*)(ws + WS_RGW) + ((size_t)(l * 8 + hb) * 256 + which * 128) * 128;
            conv_item(a.in[which ? I_RGWX : I_RGWA] + ((size_t)l * 8 + hb) * 128 * 128, 128, 128, scr, r, F.lane, [=](int c) { return dst + (size_t)c * 128; }); continue; } r -= I_RGI;
        if (r < NE * I_EG) { const int e = r / I_EG; r -= e * I_EG; bf16* dst = (bf16*)(ws + WS_EGU) + ((size_t)l * NE + e) * 512 * D;
            conv_item(a.in[I_EGU] + ((size_t)l * NE + e) * D * 512, D, 512, scr, r, F.lane, [=](int c) { return dst + (size_t)glurow(c) * D; }); continue; } r -= NE * I_EG;
        { const int e = r / I_ED; r -= e * I_ED; bf16* dst = (bf16*)(ws + WS_EDN) + ((size_t)l * NE + e) * D * DE;
            conv_item(a.in[I_EDN] + ((size_t)l * NE + e) * DE * D, DE, D, scr, r, F.lane, [=](int c) { return dst + (size_t)c * DE; }); }
    }
    { const int gt = F.vcu * NTHR + F.tid, NT = F.G * NTHR;
      for (int i = gt; i < 2 * 128 * D / 8; i += NT) { const int l = i / (128 * D / 8), r = i - l * (128 * D / 8);
          *(GAS v4u*)((bf16*)(ws + WS_ROUT) + ((size_t)l * 256 + 128) * D + (size_t)r * 8) = (v4u){0u, 0u, 0u, 0u}; }
      if (gt < D / 8) *(GAS v4u*)((bf16*)(ws + WS_U) + (size_t)T * D + gt * 8) = (v4u){0u, 0u, 0u, 0u}; }
}

template <bool FINAL>
__device__ __forceinline__ void norm_phase(const Frame& F, const float* h, const float* gain, const float* sc, const float* sh, bf16* U, float* outf) {
    const int gw = F.vcu * NWAVES + F.wave, NGW = F.G * NWAVES;
    for (int blk = gw; blk < T / 32; blk += NGW) {
        const int b = (blk * 32) / SEQ;
        f32x4 scl[4], sft[4];
#pragma unroll
        for (int j = 0; j < 4; ++j) { const int c = 4 * F.lane + 256 * j; const f32x4 g = *(const f32x4*)(gain + c);
            if (FINAL) { scl[j] = g; sft[j] = (f32x4){0.f, 0.f, 0.f, 0.f}; }
            else { const f32x4 s1 = *(const f32x4*)(sc + (size_t)b * 6144 + c); sft[j] = *(const f32x4*)(sh + (size_t)b * 6144 + c); scl[j] = g * (s1 + 1.0f); } }
        for (int r4 = 0; r4 < 32; r4 += 4) {
            f32x4 v[4][4];
#pragma unroll
            for (int rr = 0; rr < 4; ++rr) { const GAS f32x4* xr = (const GAS f32x4*)(h + ((size_t)blk * 32 + r4 + rr) * D) + F.lane;
#pragma unroll
                for (int j = 0; j < 4; ++j) v[rr][j] = xr[64 * j]; }
#pragma unroll
            for (int rr = 0; rr < 4; ++rr) { const size_t row = (size_t)blk * 32 + r4 + rr; float s = 0.f;
#pragma unroll
                for (int j = 0; j < 4; ++j) s += (v[rr][j].x * v[rr][j].x + v[rr][j].y * v[rr][j].y) + (v[rr][j].z * v[rr][j].z + v[rr][j].w * v[rr][j].w);
                const float rs = 1.0f / sqrtf(wave_sum(s, F.lane) * (1.0f / D) + EPS);
                if (FINAL) { GAS f32x4* o = (GAS f32x4*)(outf + row * D) + F.lane;
#pragma unroll
                    for (int j = 0; j < 4; ++j) o[64 * j] = v[rr][j] * rs * scl[j];
                } else { GAS v2u* o = (GAS v2u*)(U + row * D) + F.lane;
#pragma unroll
                    for (int j = 0; j < 4; ++j) { const f32x4 y = v[rr][j] * rs * scl[j] + sft[j]; o[64 * j] = (v2u){pk2(y.x, y.y), pk2(y.z, y.w)}; } } }
        }
    }
}

#define EPI_ROWS_BEGIN _Pragma("unroll") for (int ai = 0; ai < 2; ++ai) _Pragma("unroll") for (int m = 0; m < 4; ++m) { const int rt = ai * 128 + wr * 64 + m * 16 + fr;
#define EPI_ROWS_END }
typedef const pg8::f32x4 (&AccRef)[2][2][4][2];
__device__ __forceinline__ v4u pack8(const f32x4& a, const f32x4& b) { v4u w; w.x = pg8::cvt_pk_bf16(a[0], a[1]); w.y = pg8::cvt_pk_bf16(a[2], a[3]); w.z = pg8::cvt_pk_bf16(b[0], b[1]); w.w = pg8::cvt_pk_bf16(b[2], b[3]); return w; }
template <int ACT> __device__ __forceinline__ f32x4 act4(f32x4 v) {
    if (ACT == 1) { v[0] = fgelu_tanh(v[0]); v[1] = fgelu_tanh(v[1]); v[2] = fgelu_tanh(v[2]); v[3] = fgelu_tanh(v[3]); }
    if (ACT == 2) v = v * 0.08838834764831845f;
    if (ACT == 3) { v[0] = fsilu(v[0]); v[1] = fsilu(v[1]); v[2] = fsilu(v[2]); v[3] = fsilu(v[3]); }
    if (ACT == 4) { v[0] = fsigmoid(v[0]); v[1] = fsigmoid(v[1]); v[2] = fsigmoid(v[2]); v[3] = fsigmoid(v[3]); }
    return v;
}
template <int ACT> __device__ __forceinline__ void store_tile_bf16(AccRef acc, bf16* dst, int ld, size_t row0, int col0, int wr, int wc, int fr, int fq) {
    EPI_ROWS_BEGIN
        bf16* rp = dst + (row0 + rt) * ld + col0 + wc * 32 + 8 * fq;
#pragma unroll
        for (int bj = 0; bj < 2; ++bj) *(GAS v4u*)(rp + bj * 128) = pack8(act4<ACT>(acc[ai][bj][m][0]), act4<ACT>(acc[ai][bj][m][1]));
    EPI_ROWS_END
}
struct EpiInProj {
    unsigned char* ws;
    __device__ __forceinline__ void operator()(AccRef acc, const pg8::Unit& u, int wr, int wc, int fr, int fq) const {
        asm volatile("" : "+v"(fr), "+v"(fq));
        const int pn = u.pn; const size_t row0 = (size_t)u.pm * 256;
        if (pn < 4)       store_tile_bf16<0>(acc, (bf16*)(ws + WS_XRPRE), 1024, row0, pn * 256, wr, wc, fr, fq);
        else if (pn < 8)  store_tile_bf16<1>(acc, (bf16*)(ws + WS_RG), 1024, row0, (pn - 4) * 256, wr, wc, fr, fq);
        else if (pn < 10) store_tile_bf16<2>(acc, (bf16*)(ws + WS_Q), 512, row0, (pn - 8) * 256, wr, wc, fr, fq);
        else if (pn < 12) store_tile_bf16<0>(acc, (bf16*)(ws + WS_K), 512, row0, (pn - 10) * 256, wr, wc, fr, fq);
        else if (pn < 16) store_tile_bf16<0>(acc, (bf16*)(ws + WS_V), 1024, row0, (pn - 12) * 256, wr, wc, fr, fq);
        else if (pn < 20) store_tile_bf16<3>(acc, (bf16*)(ws + WS_OG), 1024, row0, (pn - 16) * 256, wr, wc, fr, fq);
        else if (pn < 24) store_tile_bf16<4>(acc, (bf16*)(ws + WS_GA), 1024, row0, (pn - 20) * 256, wr, wc, fr, fq);
        else              store_tile_bf16<4>(acc, (bf16*)(ws + WS_GB), 1024, row0, (pn - 24) * 256, wr, wc, fr, fq);
    }
};
template <bool FIRST> struct EpiMerge {
    const bf16* gate; bf16* mbuf;
    __device__ __forceinline__ void operator()(AccRef acc, const pg8::Unit& u, int wr, int wc, int fr, int fq) const {
        asm volatile("" : "+v"(fr), "+v"(fq));
        EPI_ROWS_BEGIN
            const size_t o = ((size_t)u.pm * 256 + rt) * 1024 + u.pn * 256 + wc * 32 + 8 * fq;
#pragma unroll
            for (int bj = 0; bj < 2; ++bj) { const v4u gw = *(const GAS v4u*)(gate + o + bj * 128);
                f32x4 g0 = {bflo(gw.x), bfhi(gw.x), bflo(gw.y), bfhi(gw.y)}, g1 = {bflo(gw.z), bfhi(gw.z), bflo(gw.w), bfhi(gw.w)};
                f32x4 r0 = g0 * acc[ai][bj][m][0], r1 = g1 * acc[ai][bj][m][1];
                if (!FIRST) { const v4u mw = *(const GAS v4u*)(mbuf + o + bj * 128);
                    r0 += (f32x4){bflo(mw.x), bfhi(mw.x), bflo(mw.y), bfhi(mw.y)}; r1 += (f32x4){bflo(mw.z), bfhi(mw.z), bflo(mw.w), bfhi(mw.w)}; }
                *(GAS v4u*)(mbuf + o + bj * 128) = pack8(r0, r1); }
        EPI_ROWS_END
    }
};
struct EpiRes {
    const float* hin; float* hout; const float* gate;
    __device__ __forceinline__ void operator()(AccRef acc, const pg8::Unit& u, int wr, int wc, int fr, int fq) const {
        asm volatile("" : "+v"(fr), "+v"(fq));
        const int b = (u.pm * 256) / SEQ; const int cb = u.pn * 256 + wc * 32 + 8 * fq;
        f32x4 gv[2][2];
#pragma unroll
        for (int bj = 0; bj < 2; ++bj)
#pragma unroll
            for (int n = 0; n < 2; ++n) gv[bj][n] = *(const f32x4*)(gate + (size_t)b * 6144 + cb + bj * 128 + 4 * n);
        EPI_ROWS_BEGIN
            const size_t o = ((size_t)u.pm * 256 + rt) * 1024 + cb;
#pragma unroll
            for (int bj = 0; bj < 2; ++bj)
#pragma unroll
                for (int n = 0; n < 2; ++n) { const f32x4 hv = *(const GAS f32x4*)(hin + o + bj * 128 + 4 * n); *(GAS f32x4*)(hout + o + bj * 128 + 4 * n) = hv + gv[bj][n] * acc[ai][bj][m][n]; }
        EPI_ROWS_END
    }
};
struct EpiLogit {
    float* lg;
    __device__ __forceinline__ void operator()(AccRef acc, const pg8::Unit& u, int wr, int wc, int fr, int fq) const {
        asm volatile("" : "+v"(fr), "+v"(fq));
        EPI_ROWS_BEGIN
            float* rp = lg + ((size_t)u.pm * 256 + rt) * 128 + wc * 32 + 8 * fq;
            *(GAS f32x4*)(rp) = acc[ai][0][m][0]; *(GAS f32x4*)(rp + 4) = acc[ai][0][m][1];
        EPI_ROWS_END
    }
};
struct EpiGlu {
    bf16* act;
    __device__ __forceinline__ void operator()(AccRef acc, const pg8::Unit& u, int wr, int wc, int fr, int fq) const {
        asm volatile("" : "+v"(fr), "+v"(fq));
        const int j = u.pn & 1;
        EPI_ROWS_BEGIN
            f32x4 r0 = act4<3>(acc[ai][0][m][0]) * acc[ai][1][m][0], r1 = act4<3>(acc[ai][0][m][1]) * acc[ai][1][m][1];
            *(GAS v4u*)(act + ((size_t)u.pm * 256 + rt) * 256 + j * 128 + wc * 32 + 8 * fq) = pack8(r0, r1);
        EPI_ROWS_END
    }
};
struct EpiY {
    bf16* y;
    __device__ __forceinline__ void operator()(AccRef acc, const pg8::Unit& u, int wr, int wc, int fr, int fq) const {
        asm volatile("" : "+v"(fr), "+v"(fq));
        store_tile_bf16<0>(acc, y, 1024, (size_t)u.pm * 256, (u.pn & 3) * 256, wr, wc, fr, fq);
    }
};

__device__ __forceinline__ int swz16(int row, int ch) { return row * 256 + ((ch ^ (row & 15)) << 4); }
__device__ __forceinline__ void rg_gate_phase(const Frame& F, const Args& a, int l) {
    unsigned char* ws = F.ws;
    const int hb = F.vcu & 7;
    LAS unsigned char* Ws = F.lds; LAS unsigned char* Xs = F.lds + 65536; LAS float* prm = (LAS float*)(F.lds + 98304);
    const bf16* xpre = (const bf16*)(ws + WS_XRPRE); bf16* loga = (bf16*)(ws + WS_LOGA); bf16* ixo = (bf16*)(ws + WS_IX);
    { const bf16* wsrc = (const bf16*)(ws + WS_RGW) + (size_t)(l * 8 + hb) * 256 * 128;
#pragma unroll
      for (int j = 0; j < 8; ++j) { const int ck = F.tid + NTHR * j, n = ck >> 4, ch = ck & 15; *(LAS v4u*)(Ws + swz16(n, ch)) = *(const GAS v4u*)(wsrc + (size_t)ck * 8); }
      if (F.tid < 128) { const int c = l * D + hb * 128 + F.tid; prm[F.tid] = a.in[I_RGBA][c]; prm[128 + F.tid] = a.in[I_RGBX][c];
          const float lam = a.in[I_RGLAM][c]; prm[256 + F.tid] = fmaxf(-lam, 0.f) + log1pf(__expf(-fabsf(lam))); } }
    const int c8 = F.tid & 15, rg4 = F.tid >> 4, chan0 = hb * 128 + 8 * c8;
    float cw[4][8], cb[8];
#pragma unroll
    for (int j = 0; j < 8; ++j) { cb[j] = a.in[I_CONVB][l * D + chan0 + j];
#pragma unroll
        for (int q = 0; q < 4; ++q) cw[q][j] = a.in[I_CONVW][((size_t)l * 4 + q) * D + chan0 + j]; }
    const int fr = F.lane & 15, fq = F.lane >> 4;
    for (int i = 0; i < 16; ++i) {
        const int rt = (F.vcu >> 3) + 32 * i; const size_t row0 = (size_t)rt * 128;
        __syncthreads();
        {
            const int r0 = 4 * rg4; const int tpos = (int)((row0 + r0) & (SEQ - 1));
            float x[7][8];
#pragma unroll
            for (int q = 0; q < 7; ++q) { const int dt = q - 3; v4u w = {0u, 0u, 0u, 0u};
                if (tpos + dt >= 0) w = *(const GAS v4u*)(xpre + (size_t)((long)(row0 + r0) + dt) * D + chan0);
                x[q][0] = bflo(w.x); x[q][1] = bfhi(w.x); x[q][2] = bflo(w.y); x[q][3] = bfhi(w.y); x[q][4] = bflo(w.z); x[q][5] = bfhi(w.z); x[q][6] = bflo(w.w); x[q][7] = bfhi(w.w); }
#pragma unroll
            for (int rr = 0; rr < 4; ++rr) { float y[8];
#pragma unroll
                for (int j = 0; j < 8; ++j) y[j] = cb[j] + cw[0][j] * x[rr][j] + cw[1][j] * x[rr + 1][j] + cw[2][j] * x[rr + 2][j] + cw[3][j] * x[rr + 3][j];
                v4u o; o.x = pk2(y[0], y[1]); o.y = pk2(y[2], y[3]); o.z = pk2(y[4], y[5]); o.w = pk2(y[6], y[7]);
                *(LAS v4u*)(Xs + swz16(r0 + rr, c8)) = o; }
        }
        __syncthreads();
        f32x4 acc[16];
#pragma unroll
        for (int nb = 0; nb < 16; ++nb) acc[nb] = (f32x4){0.f, 0.f, 0.f, 0.f};
        const int arow = 16 * F.wave + fr;
#pragma unroll
        for (int ks = 0; ks < 4; ++ks) { const bf16x8 af = *(const LAS bf16x8*)(Xs + swz16(arow, 4 * ks + fq));
#pragma unroll
            for (int nb = 0; nb < 16; ++nb) { const bf16x8 bfv = *(const LAS bf16x8*)(Ws + swz16(16 * nb + fr, 4 * ks + fq));
                acc[nb] = __builtin_amdgcn_mfma_f32_16x16x32_bf16(bfv, af, acc[nb], 0, 0, 0); } }
        const size_t grow = row0 + arow; const bool tzero = (grow & (SEQ - 1)) == 0;
#pragma unroll
        for (int nb = 0; nb < 8; ++nb) { const int c = 16 * nb + 4 * fq;
            const f32x4 ba = *(const LAS f32x4*)(prm + c), bx = *(const LAS f32x4*)(prm + 128 + c), sp = *(const LAS f32x4*)(prm + 256 + c);
            const v2u xw = *(const LAS v2u*)(Xs + swz16(arow, c >> 3) + (c & 7) * 2);
            const float xv[4] = {bflo(xw.x), bfhi(xw.x), bflo(xw.y), bfhi(xw.y)};
            float om[4], bt[4];
#pragma unroll
            for (int j = 0; j < 4; ++j) { const float r = fsigmoid(acc[nb][j] + ba[j]), ii = fsigmoid(acc[nb + 8][j] + bx[j]); const float la = -8.0f * r * sp[j];
                const float o1 = 1.0f - __builtin_amdgcn_exp2f(1.442695041f * la), o2 = -la * (1.0f + la * (0.5f + la * 0.16666667f));
                om[j] = (la > -0.01f) ? o2 : o1; float mult = __builtin_amdgcn_sqrtf(om[j] * (2.0f - om[j])); if (tzero) mult = 1.0f; bt[j] = mult * ii * xv[j]; }
            const size_t o = grow * D + hb * 128 + c;
            *(GAS v2u*)(loga + o) = (v2u){pk2(om[0], om[1]), pk2(om[2], om[3])};
            *(GAS v2u*)(ixo + o) = (v2u){pk2(bt[0], bt[1]), pk2(bt[2], bt[3])}; }
    }
    __syncthreads();
}

typedef float f32x2 __attribute__((ext_vector_type(2)));
__device__ __forceinline__ void scan_pass1(const Frame& F, int unit) {
    unsigned char* ws = F.ws;
    const size_t row0 = (size_t)unit * 64; const int ch = 2 * F.tid;
    const GAS unsigned* om = (const GAS unsigned*)((const bf16*)(ws + WS_LOGA) + row0 * D + ch); const GAS unsigned* bp = (const GAS unsigned*)((const bf16*)(ws + WS_IX) + row0 * D + ch);
    float P0 = 1.f, P1 = 1.f, E0 = 0.f, E1 = 0.f;
#pragma unroll 16
    for (int r = 0; r < 64; ++r) { const unsigned ow = om[(size_t)r * (D / 2)], bw = bp[(size_t)r * (D / 2)];
        const float a0 = 1.0f - bflo(ow), a1 = 1.0f - bfhi(ow); E0 = a0 * E0 + bflo(bw); E1 = a1 * E1 + bfhi(bw); P0 *= a0; P1 *= a1; }
    *(GAS f32x2*)((float*)(ws + WS_SP) + (size_t)unit * D + ch) = (f32x2){P0, P1}; *(GAS f32x2*)((float*)(ws + WS_SE) + (size_t)unit * D + ch) = (f32x2){E0, E1};
}
__device__ __forceinline__ void scan_carry(const Frame& F, int unit) {
    unsigned char* ws = F.ws;
    const int b = unit >> 1, ch = (unit & 1) * 512 + F.tid;
    const float* sp = (const float*)(ws + WS_SP) + (size_t)b * 64 * D + ch; const float* se = (const float*)(ws + WS_SE) + (size_t)b * 64 * D + ch; float* ci = (float*)(ws + WS_CIN) + (size_t)b * 64 * D + ch;
    float st = 0.f;
#pragma unroll 16
    for (int s = 0; s < 64; ++s) { ci[(size_t)s * D] = st; st = sp[(size_t)s * D] * st + se[(size_t)s * D]; }
}
__device__ __forceinline__ void scan_pass3(const Frame& F, int unit) {
    unsigned char* ws = F.ws;
    const size_t row0 = (size_t)unit * 64; const int ch = 2 * F.tid;
    const GAS unsigned* om = (const GAS unsigned*)((const bf16*)(ws + WS_LOGA) + row0 * D + ch); GAS unsigned* bp = (GAS unsigned*)((bf16*)(ws + WS_IX) + row0 * D + ch);
    const GAS unsigned* rg = (const GAS unsigned*)((const bf16*)(ws + WS_RG) + row0 * D + ch);
    const f32x2 c0 = *(const GAS f32x2*)((const float*)(ws + WS_CIN) + (size_t)unit * D + ch); float h0 = c0.x, h1 = c0.y;
#pragma unroll 16
    for (int r = 0; r < 64; ++r) { const unsigned ow = om[(size_t)r * (D / 2)], bw = bp[(size_t)r * (D / 2)], gw = rg[(size_t)r * (D / 2)];
        h0 = (1.0f - bflo(ow)) * h0 + bflo(bw); h1 = (1.0f - bfhi(ow)) * h1 + bfhi(bw); bp[(size_t)r * (D / 2)] = pk2(h0 * bflo(gw), h1 * bfhi(gw)); }
}

__device__ __forceinline__ float flogsig16(float x) {
    const float e = __builtin_amdgcn_exp2f(-1.442695041f * fabsf(x));
    return (fminf(x, 0.f) - 0.6931471806f * __builtin_amdgcn_logf(1.0f + e)) * 0.0625f;
}
__device__ __forceinline__ void gla_prep(const Frame& F, const Args& a, int l, int unit) {
    unsigned char* ws = F.ws;
    LAS float* lrs = (LAS float*)F.lds; LAS float* psum = (LAS float*)(F.lds + 8192); LAS unsigned char* kds = F.lds + 16384;
    const size_t row0 = (size_t)unit * 64;
    const int fr = F.lane & 15, fq = F.lane >> 4;
    __syncthreads();
    { const int rb = F.wave & 3, kh = F.wave >> 2;
      const bf16* up = (const bf16*)(ws + WS_U) + (row0 + 16 * rb + fr) * D + kh * 512 + 8 * fq;
      const bf16* wp = (const bf16*)(ws + WS_WLR) + ((size_t)l * 16 + fr) * D + kh * 512 + 8 * fq;
      f32x4 acc = {0.f, 0.f, 0.f, 0.f};
#pragma unroll
      for (int ks = 0; ks < 16; ++ks) { const bf16x8 af = *(const GAS bf16x8*)(up + 32 * ks), bfv = *(const GAS bf16x8*)(wp + 32 * ks);
          acc = __builtin_amdgcn_mfma_f32_16x16x32_bf16(af, bfv, acc, 0, 0, 0); }
#pragma unroll
      for (int j = 0; j < 4; ++j) lrs[(kh * 64 + 16 * rb + 4 * fq + j) * 16 + fr] = acc[j]; }
    __syncthreads();
    const int cp = F.tid & 255, th = F.tid >> 8, c0 = 2 * cp;
    float wu0[16], wu1[16];
#pragma unroll
    for (int r = 0; r < 16; ++r) { const f32x2 w = *(const GAS f32x2*)(a.in[I_GWUP] + ((size_t)l * 16 + r) * 512 + c0); wu0[r] = w.x; wu1[r] = w.y; }
    const f32x2 bu = *(const GAS f32x2*)(a.in[I_GBUP] + l * 512 + c0);
    float la0[32], la1[32]; float s0 = 0.f, s1 = 0.f;
#pragma unroll
    for (int tt = 0; tt < 32; ++tt) { const int t = 32 * th + tt; float g0 = bu.x, g1 = bu.y;
#pragma unroll
        for (int q = 0; q < 4; ++q) { const f32x4 x = *(const LAS f32x4*)(lrs + t * 16 + 4 * q) + *(const LAS f32x4*)(lrs + (64 + t) * 16 + 4 * q);
            g0 += x.x * wu0[4 * q] + x.y * wu0[4 * q + 1] + x.z * wu0[4 * q + 2] + x.w * wu0[4 * q + 3];
            g1 += x.x * wu1[4 * q] + x.y * wu1[4 * q + 1] + x.z * wu1[4 * q + 2] + x.w * wu1[4 * q + 3]; }
        la0[tt] = flogsig16(g0); la1[tt] = flogsig16(g1); s0 += la0[tt]; s1 += la1[tt]; }
    *(LAS f32x2*)(psum + th * 512 + c0) = (f32x2){s0, s1};
    __syncthreads();
    const f32x2 oth = *(const LAS f32x2*)(psum + (th ^ 1) * 512 + c0);
    const float tot0 = s0 + oth.x, tot1 = s1 + oth.y;
    if (th == 0) *(GAS f32x2*)((float*)(ws + WS_TOT) + (size_t)unit * 512 + c0) = (f32x2){tot0, tot1};
    float cum0 = th ? oth.x : 0.f, cum1 = th ? oth.y : 0.f;
    const GAS unsigned* kp = (const GAS unsigned*)((const bf16*)(ws + WS_K) + (row0 + 32 * th) * 512 + c0);
#pragma unroll
    for (int t8 = 0; t8 < 4; ++t8) { float o0[8], o1[8];
#pragma unroll
        for (int tt = 0; tt < 8; ++tt) { const unsigned kw = kp[(size_t)(8 * t8 + tt) * 256]; cum0 += la0[8 * t8 + tt]; cum1 += la1[8 * t8 + tt];
            o0[tt] = bflo(kw) * __builtin_amdgcn_exp2f(1.442695041f * (tot0 - cum0)); o1[tt] = bfhi(kw) * __builtin_amdgcn_exp2f(1.442695041f * (tot1 - cum1)); }
        *(LAS v4u*)(kds + c0 * 144 + (32 * th + 8 * t8) * 2) = (v4u){pk2(o0[0], o0[1]), pk2(o0[2], o0[3]), pk2(o0[4], o0[5]), pk2(o0[6], o0[7])};
        *(LAS v4u*)(kds + (c0 + 1) * 144 + (32 * th + 8 * t8) * 2) = (v4u){pk2(o1[0], o1[1]), pk2(o1[2], o1[3]), pk2(o1[4], o1[5]), pk2(o1[6], o1[7])}; }
    __syncthreads();
    GAS unsigned char* kd = (GAS unsigned char*)((bf16*)(ws + WS_KDEC) + (size_t)unit * 512 * 64);
#pragma unroll
    for (int j = 0; j < 8; ++j) { const int ck = F.tid + NTHR * j; *(GAS v4u*)(kd + (size_t)ck * 16) = *(const LAS v4u*)(kds + (ck >> 3) * 144 + (ck & 7) * 16); }
}

constexpr int GQ_OFF = 0, GK_OFF = 64 * 272, GV_OFF = GK_OFF + 128 * 144, GD_OFF = GV_OFF + 64 * 256, GBUF = GD_OFF + 512;
__device__ __forceinline__ unsigned voff_b(unsigned row, unsigned ch) { return 256u * row + 16u * (ch ^ (((row & 3) << 2) | ((row >> 2) & 3))); }
__device__ __forceinline__ bf16x8 pack_step(const f32x16& x, int s) {
    v4u p; p.x = pk2(x[8 * s], x[8 * s + 1]); p.y = pk2(x[8 * s + 2], x[8 * s + 3]); p.z = pk2(x[8 * s + 4], x[8 * s + 5]); p.w = pk2(x[8 * s + 6], x[8 * s + 7]);
    return __builtin_bit_cast(bf16x8, p);
}
__device__ __forceinline__ void gla_stage(const Frame& F, int b, int h, int vh, int n, LAS unsigned char* buf) {
    unsigned char* ws = F.ws; int lt = F.tid - 256; asm volatile("" : "+v"(lt));
    const size_t row0 = (size_t)b * SEQ + (size_t)n * 64;
    const GAS char* qp = (const GAS char*)((const bf16*)(ws + WS_Q) + row0 * 512 + h * 128);
    const GAS char* vp = (const GAS char*)((const bf16*)(ws + WS_V) + row0 * D + h * 256 + vh * 128);
    const GAS char* kp = (const GAS char*)((const bf16*)(ws + WS_KDEC) + (((size_t)b * 64 + n) * 512 + h * 128) * 64);
    v4u qv[4], kv[4], vv[4];
#pragma unroll
    for (int j = 0; j < 4; ++j) { const unsigned ck = (unsigned)lt + 256u * j;
        qv[j] = *(const GAS v4u*)(qp + ((ck >> 4) * 1024u + (ck & 15u) * 16u));
        vv[j] = *(const GAS v4u*)(vp + ((ck >> 4) * 2048u + (ck & 15u) * 16u));
        kv[j] = *(const GAS v4u*)(kp + ck * 16u); }
    float dv = 0.f; if (lt < 128) dv = __expf(((const float*)(ws + WS_TOT))[((size_t)b * 64 + n) * 512 + h * 128 + lt]);
#pragma unroll
    for (int j = 0; j < 4; ++j) { const unsigned ck = (unsigned)lt + 256u * j;
        *(LAS v4u*)(buf + GQ_OFF + (ck >> 4) * 272u + (ck & 15u) * 16u) = qv[j];
        *(LAS v4u*)(buf + GV_OFF + voff_b(ck >> 4, ck & 15u)) = vv[j];
        *(LAS v4u*)(buf + GK_OFF + (ck >> 3) * 144u + (ck & 7u) * 16u) = kv[j]; }
    if (lt < 128) ((LAS float*)(buf + GD_OFF))[lt] = dv;
}
__device__ __forceinline__ void gla_rec(const Frame& F, int unit) {
    unsigned char* ws = F.ws;
    const int b = unit >> 3, h = (unit >> 1) & 3, vh = unit & 1;
    const int w = F.wave;
    f32x16 S[4];
#pragma unroll
    for (int kt = 0; kt < 4; ++kt)
#pragma unroll
        for (int i = 0; i < 16; ++i) S[kt][i] = 0.f;
    __syncthreads();
    if (w >= 4) gla_stage(F, b, h, vh, 0, F.lds);
    __syncthreads();
#pragma unroll 1
    for (int n = 0; n < NCH; ++n) {
        if (w >= 4) { if (n + 1 < NCH) gla_stage(F, b, h, vh, n + 1, F.lds + ((n + 1) & 1) * GBUF); }
        else {
            int lane = F.lane; asm volatile("" : "+v"(lane));
            const int r = lane & 31, hh = lane >> 5;
            const unsigned blk = (lane >> 4) & 1, q4 = (lane & 15) >> 2, p4 = lane & 3;
            LAS unsigned char* buf = F.lds + (n & 1) * GBUF;
            const LAS unsigned char* kbase = buf + GK_OFF + r * 144 + hh * 16;
            const LAS unsigned char* qbase = buf + GQ_OFF + r * 272 + hh * 16;
            const LAS unsigned char* dbase = buf + GD_OFF + hh * 16;
            const unsigned chv = 4u * (unsigned)w + 2u * blk + (p4 >> 1);
            const unsigned vb0 = (unsigned)(size_t)(buf + GV_OFF) + 256u * (8u * hh + q4) + 16u * (chv ^ ((q4 << 2) | ((2u * hh) & 3u))) + 8u * (p4 & 1u);
            const unsigned vb1 = (unsigned)(size_t)(buf + GV_OFF) + 256u * (8u * hh + 4u + q4) + 16u * (chv ^ ((q4 << 2) | ((2u * hh + 1u) & 3u))) + 8u * (p4 & 1u);
#pragma unroll
            for (int kt = 0; kt < 4; ++kt)
#pragma unroll
                for (int g = 0; g < 4; ++g) { const f32x4 dq = *(const LAS f32x4*)(dbase + kt * 128 + g * 32);
                    S[kt][4 * g] *= dq.x; S[kt][4 * g + 1] *= dq.y; S[kt][4 * g + 2] *= dq.z; S[kt][4 * g + 3] *= dq.w; }
#pragma unroll
            for (int ts = 0; ts < 4; ++ts) {
                s16x4 lo, hi;
                asm volatile("ds_read_b64_tr_b16 %0, %2 offset:%4\n\tds_read_b64_tr_b16 %1, %3 offset:%4\n\ts_waitcnt lgkmcnt(0)" : "=&v"(lo), "=&v"(hi) : "v"(vb0), "v"(vb1), "i"(ts * 4096) : "memory");
                const bf16x8 vb = __builtin_shufflevector(lo, hi, 0, 1, 2, 3, 4, 5, 6, 7);
#pragma unroll
                for (int kt = 0; kt < 4; ++kt) { const bf16x8 ka = *(const LAS bf16x8*)(kbase + kt * 4608 + ts * 32);
                    S[kt] = __builtin_amdgcn_mfma_f32_32x32x16_bf16(ka, vb, S[kt], 0, 0, 0); }
            }
            f32x16 O[2];
#pragma unroll
            for (int tb = 0; tb < 2; ++tb)
#pragma unroll
                for (int i = 0; i < 16; ++i) O[tb][i] = 0.f;
#pragma unroll
            for (int kt = 0; kt < 4; ++kt)
#pragma unroll
                for (int s = 0; s < 2; ++s) { const bf16x8 sb = pack_step(S[kt], s);
#pragma unroll
                    for (int tb = 0; tb < 2; ++tb) { const bf16x8 qa = *(const LAS bf16x8*)(qbase + tb * 8704 + kt * 64 + s * 32);
                        O[tb] = __builtin_amdgcn_mfma_f32_32x32x16_bf16(qa, sb, O[tb], 0, 0, 0); } }
            bf16* op = (bf16*)(ws + WS_O) + ((size_t)b * SEQ + (size_t)n * 64 + 4 * hh) * D + h * 256 + vh * 128 + 32 * w + r;
#pragma unroll
            for (int tb = 0; tb < 2; ++tb)
#pragma unroll
                for (int i = 0; i < 16; ++i) { const int t = 32 * tb + (i & 3) + 8 * (i >> 2); op[(size_t)t * D] = (bf16)f2bf(O[tb][i]); }
        }
        __syncthreads();
    }
}
__device__ __forceinline__ void gla_norm(const Frame& F, const Args& a, int l) {
    unsigned char* ws = F.ws;
    const int gw = F.vcu * NWAVES + F.wave, NGW = F.G * NWAVES;
    f32x4 g[4];
#pragma unroll
    for (int hd = 0; hd < 4; ++hd) g[hd] = *(const f32x4*)(a.in[I_GNG] + (size_t)l * 1024 + hd * 256 + 4 * F.lane);
    for (int blk = gw; blk < T / 32; blk += NGW)
        for (int r4 = 0; r4 < 32; r4 += 4) {
            v2u ow[4][4], gw2[4][4];
#pragma unroll
            for (int rr = 0; rr < 4; ++rr) { const size_t row = (size_t)blk * 32 + r4 + rr;
                const GAS v2u* op = (const GAS v2u*)((const bf16*)(ws + WS_O) + row * D) + F.lane; const GAS v2u* gp = (const GAS v2u*)((const bf16*)(ws + WS_OG) + row * D) + F.lane;
#pragma unroll
                for (int hd = 0; hd < 4; ++hd) { ow[rr][hd] = op[64 * hd]; gw2[rr][hd] = gp[64 * hd]; } }
#pragma unroll
            for (int rr = 0; rr < 4; ++rr) { const size_t row = (size_t)blk * 32 + r4 + rr; GAS v2u* op = (GAS v2u*)((bf16*)(ws + WS_O) + row * D) + F.lane;
#pragma unroll
                for (int hd = 0; hd < 4; ++hd) {
                    const f32x4 o = {bflo(ow[rr][hd].x), bfhi(ow[rr][hd].x), bflo(ow[rr][hd].y), bfhi(ow[rr][hd].y)}, og = {bflo(gw2[rr][hd].x), bfhi(gw2[rr][hd].x), bflo(gw2[rr][hd].y), bfhi(gw2[rr][hd].y)};
                    const float ss = wave_sum((o.x * o.x + o.y * o.y) + (o.z * o.z + o.w * o.w), F.lane);
                    const float rs = 1.0f / sqrtf(ss * (1.0f / 256.0f) + EPS);
                    const f32x4 y = o * rs * g[hd] * og; op[64 * hd] = (v2u){pk2(y.x, y.y), pk2(y.z, y.w)}; } } }
}

__device__ __forceinline__ void topk_phase(const Frame& F, const Args& a, int l) {
    unsigned char* ws = F.ws;
    LAS int* hist = (LAS int*)F.lds; LAS int* base = hist + 128; LAS float* bias = (LAS float*)(hist + 256);
    __syncthreads();
    if (F.tid < 128) { hist[F.tid] = 0; bias[F.tid] = a.in[I_RB][l * NE + F.tid]; }
    __syncthreads();
    const int t = F.vcu * 256 + F.tid; const bool act = F.tid < 256;
    float val[8], scv[8]; int idx[8], rank[8];
#pragma unroll
    for (int j = 0; j < 8; ++j) { val[j] = -1e30f; scv[j] = 0.f; idx[j] = 0; rank[j] = 0; }
    if (act) {
        const float* lg = (const float*)(ws + WS_LOGIT) + (size_t)t * NE;
        for (int e4 = 0; e4 < 32; ++e4) { const f32x4 x = *(const GAS f32x4*)(lg + 4 * e4);
#pragma unroll
            for (int q = 0; q < 4; ++q) { const int e = 4 * e4 + q; const float sc = 1.0f / (1.0f + __expf(-x[q])); const float v = sc + bias[e];
#pragma unroll
                for (int j = 7; j >= 0; --j) { if (v > val[j]) { if (j < 7) { val[j + 1] = val[j]; scv[j + 1] = scv[j]; idx[j + 1] = idx[j]; } val[j] = v; scv[j] = sc; idx[j] = e; } } } }
#pragma unroll
        for (int j = 0; j < 8; ++j) rank[j] = __hip_atomic_fetch_add(&hist[idx[j]], 1, __ATOMIC_RELAXED, __HIP_MEMORY_SCOPE_WORKGROUP);
    }
    __syncthreads();
    if (F.tid < 128) base[F.tid] = (int)atomicAdd((unsigned*)(ws + WS_CTL) + CW_CNT + l * NE + F.tid, (unsigned)hist[F.tid]);
    __syncthreads();
    if (act) { float ssum = 0.f;
#pragma unroll
        for (int j = 0; j < 8; ++j) ssum += scv[j];
        const float inv = 2.5f / ssum;
#pragma unroll
        for (int j = 0; j < 8; ++j) { ((unsigned*)(ws + WS_PK))[(size_t)t * 8 + j] = ((unsigned)idx[j] << 24) | (unsigned)(base[idx[j]] + rank[j]); ((float*)(ws + WS_WTS))[(size_t)t * 8 + j] = scv[j] * inv; } }
    __syncthreads();
}
__device__ __forceinline__ void moe_tiles(const Frame& F, int l) {
    LAS int* ts = (LAS int*)(F.lds + LDS_TS);
    __syncthreads();
    if (F.tid == 0) { const unsigned* cnt = (const unsigned*)(F.ws + WS_CTL) + CW_CNT + l * NE; int s = 0;
        for (int e = 0; e < NE; ++e) { ts[e] = s; s += (int)((__hip_atomic_load(cnt + e, RLX_AGENT) + 255u) >> 8); } ts[NE] = s; }
    __syncthreads();
}
__device__ __forceinline__ void scatter_phase(const Frame& F, int l) {
    unsigned char* ws = F.ws;
    moe_tiles(F, l);
    const LAS int* ts = (const LAS int*)(F.lds + LDS_TS);
    if (F.tid < 256) { const int t = F.vcu * 256 + F.tid;
#pragma unroll
        for (int j = 0; j < 8; ++j) { const unsigned pk = ((const unsigned*)(ws + WS_PK))[(size_t)t * 8 + j]; const int e = (int)(pk >> 24), p = ts[e] * 256 + (int)(pk & 0xffffffu);
            ((int*)(ws + WS_POS))[(size_t)t * 8 + j] = p; ((int*)(ws + WS_SORT))[p] = t; } }
}
__device__ __forceinline__ void combine_phase(const Frame& F, float* h, const float* gate) {
    unsigned char* ws = F.ws;
    const int gw = F.vcu * NWAVES + F.wave, NGW = F.G * NWAVES;
    for (int blk = gw; blk < T / 32; blk += NGW) {
        const int b = (blk * 32) / SEQ;
        f32x4 gv[2][2];
#pragma unroll
        for (int j = 0; j < 2; ++j)
#pragma unroll
            for (int n = 0; n < 2; ++n) gv[j][n] = *(const f32x4*)(gate + (size_t)b * 6144 + 512 * j + 8 * F.lane + 4 * n);
        const size_t tl = (size_t)blk * 32 + (F.lane & 31);
        const v4u pq = *(const GAS v4u*)((const int*)(ws + WS_POS) + tl * 8 + 4 * (F.lane >> 5)); const f32x4 wq = *(const GAS f32x4*)((const float*)(ws + WS_WTS) + tl * 8 + 4 * (F.lane >> 5));
        for (int rr = 0; rr < 32; ++rr) { const size_t t = (size_t)blk * 32 + rr;
            f32x4 acc[2][2];
#pragma unroll
            for (int j = 0; j < 2; ++j) { acc[j][0] = (f32x4){0.f, 0.f, 0.f, 0.f}; acc[j][1] = (f32x4){0.f, 0.f, 0.f, 0.f}; }
            v4u yw[8][2]; float wk[8];
#pragma unroll
            for (int k = 0; k < 8; ++k) { const int src = rr + 32 * (k >> 2);
                const int p = __builtin_amdgcn_readlane((int)pq[k & 3], src); wk[k] = __builtin_bit_cast(float, __builtin_amdgcn_readlane(__builtin_bit_cast(int, wq[k & 3]), src));
                const bf16* yr = (const bf16*)(ws + WS_Y) + (size_t)p * D + 8 * F.lane;
                yw[k][0] = *(const GAS v4u*)(yr); yw[k][1] = *(const GAS v4u*)(yr + 512); }
            float* hr = h + t * D + 8 * F.lane;
            f32x4 hv[2][2];
#pragma unroll
            for (int j = 0; j < 2; ++j)
#pragma unroll
                for (int n = 0; n < 2; ++n) hv[j][n] = *(const GAS f32x4*)(hr + 512 * j + 4 * n);
#pragma unroll
            for (int k = 0; k < 8; ++k)
#pragma unroll
                for (int j = 0; j < 2; ++j) { const v4u w = yw[k][j];
                    acc[j][0] += (f32x4){bflo(w.x), bfhi(w.x), bflo(w.y), bfhi(w.y)} * wk[k]; acc[j][1] += (f32x4){bflo(w.z), bfhi(w.z), bflo(w.w), bfhi(w.w)} * wk[k]; }
#pragma unroll
            for (int j = 0; j < 2; ++j)
#pragma unroll
                for (int n = 0; n < 2; ++n) *(GAS f32x4*)(hr + 512 * j + 4 * n) = hv[j][n] + gv[j][n] * acc[j][n];
        }
    }
}

constexpr int NPH_L = 15, NPHASE = 1 + DEPTH * NPH_L + 1;
__global__ void __launch_bounds__(NTHR, 2) mk_fwd(Args args) {
    extern __shared__ __attribute__((aligned(16))) unsigned char lds_raw[];
    Frame F;
    F.lds = (LAS unsigned char*)lds_raw; F.ws = args.ws;
    F.tid = threadIdx.x; F.lane = F.tid & 63; F.wave = __builtin_amdgcn_readfirstlane(F.tid >> 6);
    F.G = gridDim.x; { const int bx = blockIdx.x; F.bx = bx; F.vcu = (F.G % 8 == 0) ? (bx % 8) * (F.G / 8) + bx / 8 : bx; }
    volatile LAS unsigned* misc = (volatile LAS unsigned*)(F.lds + LDS_MISC);
    if (F.tid < 64) misc[F.tid] = 0u;
    __syncthreads();
    XcdBarrier bar; bar.bar = (unsigned*)(args.ws + WS_CTL) + CW_BAR; bar.x = 0; bar.st = nullptr;
    if (!MK_PER_PHASE) bar = xcd_barrier_post((unsigned*)(args.ws + WS_CTL) + CW_BAR, misc + 8);
    const int lo = args.ph_lo, hi = args.ph_hi;
#ifndef MK_G4_FROM_U
#define MK_G4_FROM_U 0
#endif
#ifndef MK_G3B_FIRST
#define MK_G3B_FIRST false
#endif
#ifndef MK_MASK
#define MK_MASK 0x7ffff
#endif
#define EN(j) (((MK_MASK) >> (j)) & 1)
#ifndef MK_REP_MASK
#define MK_REP_MASK 0
#endif
#define REP(j) for (int rep_ = 0; rep_ < 1 + (((MK_REP_MASK) >> (j)) & 1); ++rep_)
#define IN(k) (lo <= (k) && (k) < hi)
#define FRESH_TID(t_) int t_; { int l_; asm volatile("v_mbcnt_lo_u32_b32 %0, -1, 0\n\tv_mbcnt_hi_u32_b32 %0, -1, %0" : "=v"(l_)); int wv_ = F.wave; asm volatile("" : "+s"(wv_)); t_ = wv_ * 64 + l_; }
#define FRESH(P) Frame P = F; { FRESH_TID(t_); P.tid = t_; P.lane = t_ & 63; unsigned char* w_ = args.ws; asm volatile("" : "+s"(w_)); P.ws = w_; int g_ = F.G, v_ = F.vcu, b_ = F.bx; asm volatile("" : "+s"(g_), "+s"(v_), "+s"(b_)); P.G = g_; P.vcu = v_; P.bx = b_; } unsigned char* ws = P.ws
#define SEAM(k) do { if (IN(k) && IN((k) + 1)) { FRESH_TID(tb_); xcd_barrier(bar, tb_ == 0); } } while (0)
    float* H = args.out;
    if (EN(15) && IN(0)) REP(15) { FRESH(P); (void)ws; p0_prologue(P, args); } SEAM(0);
#pragma unroll 1
    for (int l = 0; l < DEPTH; ++l) {
        const int p0 = 1 + NPH_L * l;
        const float* hin = (l == 0) ? args.in[I_X] : H;
#define MODP ((const float*)(ws + WS_MOD) + (size_t)l * 16 * 6144)
        if (EN(0) && IN(p0 + 0)) REP(0) { FRESH(P); norm_phase<false>(P, hin, args.in[I_N1G] + l * D, MODP + 1024, MODP + 0, (bf16*)(ws + WS_U), nullptr); }
        SEAM(p0 + 0);
        if (EN(1) && IN(p0 + 1)) REP(1) { FRESH(P); pg8::Gemm g{(const bf16*)(ws + WS_U), (const bf16*)(ws + WS_WIN) + (size_t)l * NSEC * D, D, nullptr}; pg8::StaticOrder S; S.init(T, NSEC, P.G, P.bx);
            EpiInProj E{ws}; pg8::gemm_phase<EpiInProj, pg8::StaticOrder, true, true, false>(P.lds, g, S, E, P.tid, P.wave); }
        SEAM(p0 + 1);
        if (EN(2) && IN(p0 + 2)) REP(2) { FRESH(P); (void)ws; rg_gate_phase(P, args, l); }
        SEAM(p0 + 2);
        if (EN(3) && IN(p0 + 3)) REP(3) { FRESH(P); (void)ws; if (EN(18)) REP(19) for (int u = P.vcu; u < 1024; u += P.G) scan_pass1(P, u); if (EN(17)) REP(20) for (int u = P.vcu; u < 1024; u += P.G) gla_prep(P, args, l, u); }
        SEAM(p0 + 3);
        if (EN(4) && IN(p0 + 4)) REP(4) { FRESH(P); (void)ws; for (int u = P.vcu; u < 160; u += P.G) { if (u < 128) { if (EN(17)) gla_rec(P, u); } else { if (EN(18)) scan_carry(P, u - 128); } } }
        SEAM(p0 + 4);
        if (EN(5) && IN(p0 + 5)) { FRESH(P); (void)ws; if (EN(18)) for (int u = P.vcu; u < 1024; u += P.G) scan_pass3(P, u); if (EN(17)) gla_norm(P, args, l); }
        SEAM(p0 + 5);
        if (EN(6) && IN(p0 + 6)) REP(6) {
            { FRESH(P); pg8::StaticOrder S; S.init(T, D, P.G, P.bx);
              pg8::Gemm g{(const bf16*)(ws + WS_IX), (const bf16*)(ws + WS_WA) + (size_t)l * D * D, D, nullptr}; EpiMerge<true> E{(const bf16*)(ws + WS_GA), (bf16*)(ws + WS_MBUF)};
              pg8::gemm_phase<EpiMerge<true>, pg8::StaticOrder, true, true, false>(P.lds, g, S, E, P.tid, P.wave); }
            { FRESH(P); pg8::StaticOrder S; S.init(T, D, P.G, P.bx);
              pg8::Gemm g{(const bf16*)(ws + WS_O), (const bf16*)(ws + WS_WB) + (size_t)l * D * D, D, nullptr}; EpiMerge<MK_G3B_FIRST> E{(const bf16*)(ws + WS_GB), (bf16*)(ws + WS_MBUF)};
              pg8::gemm_phase<EpiMerge<MK_G3B_FIRST>, pg8::StaticOrder, true, true, false>(P.lds, g, S, E, P.tid, P.wave); } }
        SEAM(p0 + 6);
        if (EN(7) && IN(p0 + 7)) { FRESH(P); pg8::StaticOrder S; S.init(T, D, P.G, P.bx);
            pg8::Gemm g{(const bf16*)(ws + (MK_G4_FROM_U == 1 ? WS_U : (MK_G4_FROM_U == 2 ? WS_XRPRE : (MK_G4_FROM_U == 3 ? WS_GB : (MK_G4_FROM_U == 4 ? WS_V : (MK_G4_FROM_U == 5 ? WS_GA : (MK_G4_FROM_U == 6 ? WS_OG : WS_MBUF))))))), (const bf16*)(ws + WS_WO) + (size_t)l * D * D, D, nullptr}; EpiRes E{hin, H, MODP + 2048};
            pg8::gemm_phase<EpiRes, pg8::StaticOrder, true, true, false>(P.lds, g, S, E, P.tid, P.wave); }
        SEAM(p0 + 7);
        if (EN(8) && IN(p0 + 8)) REP(8) { FRESH(P); norm_phase<false>(P, H, args.in[I_N2G] + l * D, MODP + 4096, MODP + 3072, (bf16*)(ws + WS_U), nullptr);
            for (int i = P.vcu * NTHR + P.tid; i < PMAX; i += P.G * NTHR) ((int*)(ws + WS_SORT))[i] = T; }
        SEAM(p0 + 8);
        if (EN(9) && IN(p0 + 9)) REP(9) { FRESH(P); pg8::StaticOrder S; S.init(T, 256, P.G, P.bx);
            pg8::Gemm g{(const bf16*)(ws + WS_U), (const bf16*)(ws + WS_ROUT) + (size_t)l * 256 * D, D, nullptr}; EpiLogit E{(float*)(ws + WS_LOGIT)};
            pg8::gemm_phase<EpiLogit, pg8::StaticOrder, true, true, false>(P.lds, g, S, E, P.tid, P.wave); }
        SEAM(p0 + 9);
        if (EN(10) && IN(p0 + 10)) { FRESH(P); (void)ws; topk_phase(P, args, l); }
        SEAM(p0 + 10);
        if (EN(11) && IN(p0 + 11)) REP(11) { FRESH(P); (void)ws; scatter_phase(P, l); }
        SEAM(p0 + 11);
        if (EN(12) && IN(p0 + 12)) REP(12) {
            { FRESH(P); moe_tiles(P, l); const LAS int* ts = (const LAS int*)(P.lds + LDS_TS);
              pg8::MoeOrder S{ts, 2, P.G, P.vcu, ts[NE] * 2};
              pg8::Gemm g{(const bf16*)(ws + WS_U), (const bf16*)(ws + WS_EGU) + (size_t)l * NE * 512 * D, D, (const int*)(ws + WS_SORT)}; EpiGlu E{(bf16*)(ws + WS_ACT)};
              pg8::gemm_phase<EpiGlu, pg8::MoeOrder, true, true, true>(P.lds, g, S, E, P.tid, P.wave); }
            { FRESH(P); pg8::StaticOrder S; S.init(T, 512, P.G, P.bx);
              pg8::Gemm g{(const bf16*)(ws + WS_U), (const bf16*)(ws + WS_SGU) + (size_t)l * 512 * D, D, nullptr}; EpiGlu E{(bf16*)(ws + WS_ACTS)};
              pg8::gemm_phase<EpiGlu, pg8::StaticOrder, true, true, false>(P.lds, g, S, E, P.tid, P.wave); } }
        SEAM(p0 + 12);
        if (EN(13) && IN(p0 + 13)) {
            { FRESH(P); moe_tiles(P, l); const LAS int* ts = (const LAS int*)(P.lds + LDS_TS);
              pg8::MoeOrder S{ts, 4, P.G, P.vcu, ts[NE] * 4};
              pg8::Gemm g{(const bf16*)(ws + WS_ACT), (const bf16*)(ws + WS_EDN) + (size_t)l * NE * D * DE, DE, nullptr}; EpiY E{(bf16*)(ws + WS_Y)};
              pg8::gemm_phase<EpiY, pg8::MoeOrder, true, true, false>(P.lds, g, S, E, P.tid, P.wave); }
            { FRESH(P); pg8::StaticOrder S; S.init(T, D, P.G, P.bx);
              pg8::Gemm g{(const bf16*)(ws + WS_ACTS), (const bf16*)(ws + WS_SDN) + (size_t)l * D * DE, DE, nullptr}; EpiRes E{H, H, MODP + 5120};
              pg8::gemm_phase<EpiRes, pg8::StaticOrder, true, true, false>(P.lds, g, S, E, P.tid, P.wave); } }
        SEAM(p0 + 13);
        if (EN(14) && IN(p0 + 14)) { FRESH(P); combine_phase(P, H, MODP + 5120); }
        SEAM(p0 + 14);
    }
    if (EN(16) && IN(NPHASE - 1)) { FRESH(P); (void)ws; norm_phase<true>(P, H, args.in[I_FG], nullptr, nullptr, nullptr, H); }
#undef MODP
#undef IN
#undef SEAM
}

#ifndef MK_SKIP_LO
#define MK_SKIP_LO 0
#define MK_SKIP_HI 0
#endif
#ifndef MK_NLAUNCH
#define MK_NLAUNCH NPHASE
#endif
extern "C" void kernel_launch(void* const* d_in, const int* in_sizes, int n_in, void* d_out, int out_size, void* d_ws, size_t ws_size, hipStream_t stream) {
    static int grid = 0;
    if (grid == 0) {
        if (n_in != N_INPUTS || out_size != T * D || ws_size < WS_END) { fprintf(stderr, "kernel_launch: unexpected problem shape (n_in %d out %d ws %zu, need %zu)\n", n_in, out_size, ws_size, (size_t)WS_END); grid = -1; return; }
        int dev = 0, cus = 0, per_cu = 0;
        if (hipGetDevice(&dev) != hipSuccess || hipDeviceGetAttribute(&cus, hipDeviceAttributeMultiprocessorCount, dev) != hipSuccess) { grid = -1; return; }
        if (hipFuncSetAttribute((const void*)mk_fwd, hipFuncAttributeMaxDynamicSharedMemorySize, LDS_BYTES) != hipSuccess) { fprintf(stderr, "kernel_launch: hipFuncSetAttribute failed\n"); grid = -1; return; }
        if (hipOccupancyMaxActiveBlocksPerMultiprocessor(&per_cu, (const void*)mk_fwd, NTHR, LDS_BYTES) != hipSuccess || per_cu < 1) { fprintf(stderr, "kernel_launch: occupancy query says %d\n", per_cu); }
        (void)hipGetLastError();
        grid = cus;
    }
    if (grid < 0) return;
    if (hipMemsetAsync((char*)d_ws + WS_CTL, 0, CTL_ZERO_BYTES, stream) != hipSuccess) return;
    Args a{};
    for (int i = 0; i < N_INPUTS; ++i) a.in[i] = (const float*)d_in[i];
    a.out = (float*)d_out; a.ws = (unsigned char*)d_ws;
#if MK_PER_PHASE
    for (int p = 0; p < MK_NLAUNCH; ++p) { if (p >= MK_SKIP_LO && p < MK_SKIP_HI) continue; a.ph_lo = p; a.ph_hi = p + 1; hipLaunchKernelGGL(mk_fwd, dim3(grid), dim3(NTHR), LDS_BYTES, stream, a); }
#else
    a.ph_lo = 0; a.ph_hi = NPHASE; hipLaunchKernelGGL(mk_fwd, dim3(grid), dim3(NTHR), LDS_BYTES, stream, a);
#endif
}
```

```cpp
#include <hip/hip_runtime.h>
#include <cstdio>
#include <cstdint>

#ifndef MK_PER_PHASE
#define MK_PER_PHASE 0
#endif

namespace pg8 {
#define PG8_LAS __attribute__((address_space(3)))
typedef unsigned short bf16_t;
typedef short bf16x8 __attribute__((ext_vector_type(8)));
typedef float f32x4 __attribute__((ext_vector_type(4)));
typedef unsigned u32x4 __attribute__((ext_vector_type(4)));
constexpr int BM = 256, BK = 64, HALF = 128, HTB = HALF * BK * 2, STAGE_BYTES = 8 * HTB, NXCD = 8, WGM = 8;

__host__ __device__ __forceinline__ int lds_byte(int r, int c) { const int st = (r >> 4) * 2 + (c >> 5), rr = r & 15, cc = c & 31, ob = rr * 64 + cc * 2; return st * 1024 + (ob ^ (((ob >> 9) & 1) << 5)); }
__host__ __device__ __forceinline__ void stage_rc(int b, int& R, int& C) { const int st = b / 1024, sb = b % 1024, swz = sb ^ (((sb >> 9) & 1) << 5); R = (st >> 1) * 16 + swz / 64; C = (st & 1) * 32 + (swz % 64) / 2; }
__host__ __device__ __forceinline__ int perm32(int rho) { const int n = rho >> 4, i = rho & 15; return 8 * (i >> 2) + 4 * n + (i & 3); }

struct Unit { int pm, pn; };
struct Gemm { const bf16_t* A; const bf16_t* Bt; int K; const int* rowidx; };

struct StaticOrder {
    int nM, nN, nwg, G, c;
    __host__ __device__ void init(int M, int N, int G_, int c_) { nM = M / BM; nN = N / BM; nwg = nM * nN; G = G_; c = c_; }
    __host__ __device__ bool next(int i, Unit& u) const {
        const long L = (long)i * G + c; if (L >= nwg) return false;
        int wgid = (int)L; { const int q = nwg / NXCD, r = nwg % NXCD, xcd = wgid % NXCD, off = wgid / NXCD; wgid = (xcd < r ? xcd * (q + 1) : r * (q + 1) + (xcd - r) * q) + off; }
        const int nig = WGM * nN, gid = wgid / nig, fm = gid * WGM, gsz = (nM - fm) < WGM ? (nM - fm) : WGM;
        u.pm = fm + ((wgid % nig) % gsz); u.pn = (wgid % nig) / gsz; return true;
    }
};
struct MoeOrder {
    const PG8_LAS int* ts; int npn, G, c, total;
    __device__ __forceinline__ bool next(int i, Unit& u) const {
        const int L = i * G + c; if (L >= total) return false;
        const int tile = L / npn, j = L - tile * npn;
        int lo = 0, hi = 128;
        while (hi - lo > 1) { const int mid = (lo + hi) >> 1; if (ts[mid] <= tile) lo = mid; else hi = mid; }
        u.pm = tile; u.pn = lo * npn + j; return true;
    }
};

__device__ __forceinline__ unsigned cvt_pk_bf16(float lo, float hi) { typedef __bf16 bf2_t __attribute__((ext_vector_type(2))); typedef float f2_t __attribute__((ext_vector_type(2)));
    return __builtin_bit_cast(unsigned, __builtin_convertvector((f2_t){lo, hi}, bf2_t)); }

template <class Epi, class Sched, bool ALIGN_EPI, bool SP2, bool GATHER>
__device__ __forceinline__ void gemm_phase(PG8_LAS unsigned char* lds, const Gemm g, const Sched& S, const Epi& E, const int tid, const int wid) {
    const int lane = tid & 63, wr = wid >> 2, wc = wid & 3, fr = lane & 15, fq = lane >> 4;
    const int K = g.K, nt = K / BK;
    unsigned voffA[2], voffB[2];
#pragma unroll
    for (int i = 0; i < 2; ++i) { int R, C; stage_rc(tid * 16 + i * 8192, R, C); const int Rb = (R & ~31) + perm32(R & 31);
        voffA[i] = (unsigned)(R * K + C) * 2u; voffB[i] = (unsigned)(Rb * K + C) * 2u; }
    const size_t kstep = (size_t)(BK * 2);
    const size_t hstep = (size_t)HALF * K * 2;
    const size_t tstep = 2 * hstep;
    const unsigned ldsw = (unsigned)wid * 1024u;
    const int aoff = lds_byte(wr * 64 + fr, fq * 8), boff = lds_byte(wc * 32 + fr, fq * 8);
    unsigned gc[2][2], gn[2][2];
#define PG8_SA(b, h) (((b) * 2 + (h)) * HTB)
#define PG8_SB(b, h) ((4 + (b) * 2 + (h)) * HTB)
#define PG8_STAGE(bufoff, gbase, voff) do { _Pragma("unroll") for (int _i = 0; _i < 2; ++_i) \
        __builtin_amdgcn_global_load_lds((const unsigned*)((const char*)(gbase) + (voff)[_i]), (PG8_LAS unsigned*)(lds + (bufoff) + ldsw + _i * 8192), 16, 0, 0); } while (0)
#define PG8_STAGE_A(bufoff, kb, h, NX) do { if constexpr (GATHER) { _Pragma("unroll") for (int _i = 0; _i < 2; ++_i) { const unsigned _o = (NX) ? gn[h][_i] : gc[h][_i]; \
        __builtin_amdgcn_global_load_lds((const unsigned*)((const char*)(kb) + _o), (PG8_LAS unsigned*)(lds + (bufoff) + ldsw + _i * 8192), 16, 0, 0); } } \
        else { PG8_STAGE(bufoff, (const char*)(kb) + ((h) ? hstep : (size_t)0), voffA); } } while (0)
#define PG8_LDA(dst, b, h) do { _Pragma("unroll") for (int m = 0; m < 4; ++m) _Pragma("unroll") for (int k = 0; k < 2; ++k) dst[m][k] = *(const PG8_LAS bf16x8*)(lds + PG8_SA(b, h) + aoff + m * 2048 + k * 1024); } while (0)
#define PG8_LDB(dst, b, h) do { _Pragma("unroll") for (int n = 0; n < 2; ++n) _Pragma("unroll") for (int k = 0; k < 2; ++k) dst[n][k] = *(const PG8_LAS bf16x8*)(lds + PG8_SB(b, h) + boff + n * 2048 + k * 1024); } while (0)
#define PG8_MMA(ai, bj, At, Bt) do { __builtin_amdgcn_s_setprio(1); _Pragma("unroll") for (int m = 0; m < 4; ++m) _Pragma("unroll") for (int n = 0; n < 2; ++n) _Pragma("unroll") for (int k = 0; k < 2; ++k) \
        acc[ai][bj][m][n] = __builtin_amdgcn_mfma_f32_16x16x32_bf16(Bt[n][k], At[m][k], acc[ai][bj][m][n], 0, 0, 0); __builtin_amdgcn_s_setprio(0); } while (0)
#define PG8_WAIT_V(n) asm volatile("s_waitcnt vmcnt(" #n ")" ::: "memory")
#define PG8_WAIT_L(n) asm volatile("s_waitcnt lgkmcnt(" #n ")" ::: "memory")
#define PG8_BAR __builtin_amdgcn_s_barrier()
#define PG8_SCHED __builtin_amdgcn_sched_barrier(0)
#define PG8_LOAD_ROWS(dst, un) do { int _ln; asm volatile("v_mbcnt_lo_u32_b32 %0, -1, 0\n\tv_mbcnt_hi_u32_b32 %0, -1, %0" : "=v"(_ln)); const int _t = wid * 64 + _ln; \
        _Pragma("unroll") for (int _i = 0; _i < 2; ++_i) { int _R, _C; stage_rc(_t * 16 + _i * 8192, _R, _C); _Pragma("unroll") for (int _h = 0; _h < 2; ++_h) { \
        const int _tok = ((const __attribute__((address_space(1))) int*)g.rowidx)[(un).pm * BM + _h * HALF + _R]; dst[_h][_i] = (unsigned)_tok * (unsigned)(K * 2) + (unsigned)_C * 2u; } } } while (0)
    Unit cur, nxt; int ui = 0;
    if (!S.next(0, cur)) return;
    f32x4 acc[2][2][4][2];
#pragma unroll
    for (int a = 0; a < 2; ++a)
#pragma unroll
        for (int b = 0; b < 2; ++b)
#pragma unroll
            for (int m = 0; m < 4; ++m)
#pragma unroll
                for (int n = 0; n < 2; ++n) acc[a][b][m][n] = (f32x4){0.f, 0.f, 0.f, 0.f};
    bf16x8 At[4][2], B0[2][2], B1[2][2];
    const char* cA = GATHER ? (const char*)g.A : (const char*)g.A + (size_t)cur.pm * tstep; const char* cB = (const char*)g.Bt + (size_t)cur.pn * tstep;
    if constexpr (GATHER) { PG8_LOAD_ROWS(gc, cur); }
    if constexpr (SP2) {
        PG8_STAGE(PG8_SB(0, 0), cB, voffB); PG8_STAGE(PG8_SB(0, 1), cB + hstep, voffB); PG8_STAGE_A(PG8_SA(0, 0), cA, 0, false); PG8_STAGE_A(PG8_SA(0, 1), cA, 1, false);
        if (wr == 1) PG8_BAR;
        PG8_WAIT_V(2); PG8_BAR;
        PG8_STAGE(PG8_SB(1, 0), cB + kstep, voffB); PG8_STAGE_A(PG8_SA(1, 0), cA + kstep, 0, false); PG8_STAGE(PG8_SB(1, 1), cB + hstep + kstep, voffB);
        PG8_WAIT_V(6); PG8_BAR;
    } else {
        PG8_STAGE(PG8_SB(0, 0), cB, voffB); PG8_STAGE_A(PG8_SA(0, 0), cA, 0, false); PG8_STAGE(PG8_SB(0, 1), cB + hstep, voffB); PG8_STAGE_A(PG8_SA(0, 1), cA, 1, false);
        if (wr == 1) PG8_BAR;
        PG8_WAIT_V(4); PG8_BAR;
        PG8_STAGE(PG8_SB(1, 0), cB + kstep, voffB); PG8_STAGE_A(PG8_SA(1, 0), cA + kstep, 0, false); PG8_STAGE(PG8_SB(1, 1), cB + hstep + kstep, voffB);
        PG8_WAIT_V(6); PG8_BAR;
    }
    for (;;) {
        const bool has_next = S.next(ui + 1, nxt);
        const char* nA = GATHER ? (const char*)g.A : (has_next ? (const char*)g.A + (size_t)nxt.pm * tstep : cA); const char* nB = has_next ? (const char*)g.Bt + (size_t)nxt.pn * tstep : cB;
        if constexpr (GATHER) { if (has_next) { PG8_LOAD_ROWS(gn, nxt); } else {
#pragma unroll
            for (int _h = 0; _h < 2; ++_h)
#pragma unroll
                for (int _i = 0; _i < 2; ++_i) gn[_h][_i] = gc[_h][_i]; } }
#pragma unroll 1
        for (int t = 0; t < nt; t += 2) {
            const bool last = (t == nt - 2);
            const char* a1 = cA + (size_t)(t + 1) * kstep;
            const char* a2 = last ? nA : cA + (size_t)(t + 2) * kstep; const char* b2 = last ? nB : cB + (size_t)(t + 2) * kstep;
            const char* a3 = a2 + kstep; const char* b3 = b2 + kstep;
            if constexpr (SP2) {
            PG8_LDB(B0, 0, 0); PG8_LDB(B1, 0, 1); PG8_SCHED; PG8_LDA(At, 0, 0); PG8_STAGE_A(PG8_SA(1, 1), a1, 1, false);
            PG8_WAIT_V(8); PG8_WAIT_L(0); PG8_BAR; PG8_MMA(0, 0, At, B0); PG8_MMA(0, 1, At, B1); PG8_BAR; PG8_SCHED;
            PG8_LDA(At, 0, 1); PG8_STAGE(PG8_SB(0, 0), b2, voffB); PG8_STAGE(PG8_SB(0, 1), b2 + hstep, voffB); PG8_STAGE_A(PG8_SA(0, 0), a2, 0, last);
            PG8_WAIT_V(8); PG8_WAIT_L(0); PG8_BAR; PG8_MMA(1, 0, At, B0); PG8_MMA(1, 1, At, B1); PG8_BAR; PG8_SCHED;
            PG8_LDB(B0, 1, 0); PG8_LDB(B1, 1, 1); PG8_SCHED; PG8_LDA(At, 1, 0); PG8_STAGE_A(PG8_SA(0, 1), a2, 1, last);
            PG8_WAIT_V(8); PG8_WAIT_L(0); PG8_BAR; PG8_MMA(0, 0, At, B0); PG8_MMA(0, 1, At, B1); PG8_BAR; PG8_SCHED;
            PG8_LDA(At, 1, 1); PG8_STAGE(PG8_SB(1, 0), b3, voffB); PG8_STAGE(PG8_SB(1, 1), b3 + hstep, voffB); PG8_STAGE_A(PG8_SA(1, 0), a3, 0, last);
            PG8_WAIT_V(8); PG8_WAIT_L(0); PG8_BAR; PG8_MMA(1, 0, At, B0); PG8_MMA(1, 1, At, B1); PG8_BAR; PG8_SCHED;
            } else {
            PG8_LDB(B0, 0, 0); PG8_SCHED; PG8_LDA(At, 0, 0); PG8_STAGE_A(PG8_SA(1, 1), a1, 1, false);
            PG8_WAIT_L(8); PG8_BAR; PG8_WAIT_L(0); PG8_MMA(0, 0, At, B0); PG8_BAR; PG8_SCHED;
            PG8_LDB(B1, 0, 1); PG8_STAGE(PG8_SB(0, 0), b2, voffB);
            PG8_BAR; PG8_WAIT_L(0); PG8_MMA(0, 1, At, B1); PG8_BAR;
            PG8_LDA(At, 0, 1); PG8_STAGE_A(PG8_SA(0, 0), a2, 0, last);
            PG8_BAR; PG8_WAIT_L(0); PG8_MMA(1, 0, At, B0); PG8_BAR; PG8_SCHED;
            PG8_STAGE(PG8_SB(0, 1), b2 + hstep, voffB);
            PG8_WAIT_V(6); PG8_BAR; PG8_MMA(1, 1, At, B1); PG8_BAR;
            PG8_LDB(B0, 1, 0); PG8_SCHED; PG8_LDA(At, 1, 0); PG8_STAGE_A(PG8_SA(0, 1), a2, 1, last);
            PG8_WAIT_L(8); PG8_BAR; PG8_WAIT_L(0); PG8_MMA(0, 0, At, B0); PG8_BAR; PG8_SCHED;
            PG8_LDB(B1, 1, 1); PG8_STAGE(PG8_SB(1, 0), b3, voffB);
            PG8_BAR; PG8_WAIT_L(0); PG8_MMA(0, 1, At, B1); PG8_BAR;
            PG8_LDA(At, 1, 1); PG8_STAGE_A(PG8_SA(1, 0), a3, 0, last);
            PG8_BAR; PG8_WAIT_L(0); PG8_MMA(1, 0, At, B0); PG8_BAR; PG8_SCHED;
            PG8_STAGE(PG8_SB(1, 1), b3 + hstep, voffB);
            PG8_WAIT_V(6); PG8_BAR; PG8_MMA(1, 1, At, B1); PG8_BAR;
            }
        }
        if constexpr (ALIGN_EPI) { if (wr == 0) PG8_BAR; }
        E(acc, cur, wr, wc, fr, fq);
        if (!has_next) break;
#pragma unroll
        for (int a = 0; a < 2; ++a)
#pragma unroll
            for (int b = 0; b < 2; ++b)
#pragma unroll
                for (int m = 0; m < 4; ++m)
#pragma unroll
                    for (int n = 0; n < 2; ++n) acc[a][b][m][n] = (f32x4){0.f, 0.f, 0.f, 0.f};
        cur = nxt; cA = nA; cB = nB; ++ui;
        if constexpr (GATHER) {
#pragma unroll
            for (int _h = 0; _h < 2; ++_h)
#pragma unroll
                for (int _i = 0; _i < 2; ++_i) gc[_h][_i] = gn[_h][_i]; }
        if constexpr (ALIGN_EPI) { if (wr == 1) PG8_BAR; }
    }
    PG8_WAIT_V(0);
    if constexpr (!ALIGN_EPI) { if (wr == 0) PG8_BAR; }
    PG8_BAR;
#undef PG8_SA
#undef PG8_SB
#undef PG8_STAGE
#undef PG8_STAGE_A
#undef PG8_LDA
#undef PG8_LDB
#undef PG8_MMA
#undef PG8_WAIT_V
#undef PG8_WAIT_L
#undef PG8_BAR
#undef PG8_SCHED
#undef PG8_LOAD_ROWS
}
}

constexpr int NWAVES = 8, NTHR = 512;
constexpr int D = 1024, BATCH = 16, SEQ = 4096, T = BATCH * SEQ, DEPTH = 2;
constexpr int CHUNK = 64, NCH = SEQ / CHUNK;
constexpr int NSEC = 7168;
constexpr int N_IN = 7184;
constexpr int NE = 128, TOPK = 8, DE = 256;
constexpr int PMAX = T * TOPK + NE * 256;
constexpr float EPS = 1e-6f;

constexpr size_t MiB = 1u << 20;
constexpr size_t WS_CTL = 0, CTL_ZERO_BYTES = 1 * MiB;
constexpr size_t WS_MOD = 1 * MiB;
constexpr size_t WS_WLR = 2 * MiB;
constexpr size_t WS_RGW = 3 * MiB;
constexpr size_t WS_WIN = 4 * MiB;
constexpr size_t WS_WA = 32 * MiB, WS_WB = 36 * MiB, WS_WO = 40 * MiB;
constexpr size_t WS_ROUT = 44 * MiB;
constexpr size_t WS_SGU = 45 * MiB;
constexpr size_t WS_SDN = 47 * MiB;
constexpr size_t WS_EGU = 48 * MiB;
constexpr size_t WS_EDN = 304 * MiB;
constexpr size_t WS_U = 432 * MiB;
constexpr size_t WS_SP = 561 * MiB, WS_SE = 565 * MiB, WS_CIN = 569 * MiB;
constexpr size_t WS_TOT = 573 * MiB;
constexpr size_t WS_PK = 575 * MiB;
constexpr size_t WS_POS = 577 * MiB;
constexpr size_t WS_WTS = 579 * MiB;
constexpr size_t WS_SORT = 581 * MiB;
constexpr size_t WS_BIG = 592 * MiB;
constexpr size_t WS_XRPRE = WS_BIG, WS_RG = WS_BIG + 128 * MiB, WS_Q = WS_BIG + 256 * MiB, WS_K = WS_BIG + 320 * MiB, WS_V = WS_BIG + 384 * MiB,
                 WS_OG = WS_BIG + 512 * MiB, WS_GA = WS_BIG + 640 * MiB, WS_GB = WS_BIG + 768 * MiB, WS_LOGA = WS_BIG + 896 * MiB, WS_IX = WS_BIG + 1024 * MiB,
                 WS_KDEC = WS_BIG + 1152 * MiB;
constexpr size_t WS_O = WS_XRPRE;
constexpr size_t WS_MBUF = WS_LOGA;
constexpr size_t WS_Y = WS_BIG;
constexpr size_t WS_LOGIT = WS_BIG;
constexpr size_t WS_ACT = WS_BIG + 1088 * MiB;
constexpr size_t WS_ACTS = WS_BIG + 1360 * MiB;
constexpr size_t WS_END = WS_BIG + 1392 * MiB;
static_assert((size_t)PMAX * 1024 * 2 <= 1088 * MiB && (size_t)PMAX * 256 * 2 <= 272 * MiB && WS_KDEC + 64 * MiB <= WS_END, "ws map");
constexpr int CW_TMO = 0;
constexpr int CW_BAR = 4096;
constexpr int CW_CNT = 8192;

constexpr int RING_BYTES = 131072;
constexpr int LDS_TS = RING_BYTES;
constexpr int LDS_MISC = RING_BYTES + 1024;
constexpr int LDS_BYTES = 147456;

#define GAS __attribute__((address_space(1)))
#define LAS __attribute__((address_space(3)))
typedef unsigned short bf16;
typedef unsigned v4u __attribute__((ext_vector_type(4)));
typedef unsigned v2u __attribute__((ext_vector_type(2)));
typedef float f32x4 __attribute__((ext_vector_type(4)));
typedef float f32x16 __attribute__((ext_vector_type(16)));
typedef short bf16x8 __attribute__((ext_vector_type(8)));
typedef short s16x4 __attribute__((ext_vector_type(4)));
typedef GAS unsigned gu32;
#define RLX_AGENT __ATOMIC_RELAXED, __HIP_MEMORY_SCOPE_AGENT
#define LDS_WAIT() asm volatile("s_waitcnt lgkmcnt(0)" ::: "memory")
__device__ __forceinline__ unsigned f2bf(float f) { return (unsigned)__builtin_bit_cast(unsigned short, (__bf16)f); }
__device__ __forceinline__ unsigned pk2(float lo, float hi) { return pg8::cvt_pk_bf16(lo, hi); }
__device__ __forceinline__ float bflo(unsigned w) { return __builtin_bit_cast(float, w << 16); }
__device__ __forceinline__ float bfhi(unsigned w) { return __builtin_bit_cast(float, w & 0xffff0000u); }
__device__ __forceinline__ float bf2f(bf16 b) { return __builtin_bit_cast(float, (unsigned)b << 16); }
__device__ __forceinline__ float fsigmoid(float x) { return __builtin_amdgcn_rcpf(1.0f + __builtin_amdgcn_exp2f(-1.442695041f * x)); }
__device__ __forceinline__ float fsilu(float x) { return x * fsigmoid(x); }
__device__ __forceinline__ float fgelu_tanh(float x) { return x * fsigmoid(1.5957691216f * (x + 0.044715f * x * x * x)); }

#define XB_TMO      128
#define XB_XCNT(j)  (256  + 64 * (j))
#define XB_XSUB(j)  (1280 + 64 * (j))
#define XB_XGEN(j)  (2304 + 64 * (j))
#define XB_TOP      3328
#define XB_TOPGEN   3392
#define XCD_BAR_WORDS 3456
#define XB_SPIN_CAP (1u << 18)
__device__ __forceinline__ unsigned xb_ld(unsigned* p)              { return __hip_atomic_load(p, __ATOMIC_RELAXED, __HIP_MEMORY_SCOPE_AGENT); }
__device__ __forceinline__ unsigned xb_add(unsigned* p, unsigned v) { return __hip_atomic_fetch_add(p, v, __ATOMIC_RELAXED, __HIP_MEMORY_SCOPE_AGENT); }
__device__ __forceinline__ unsigned xb_xcc_id() { return (unsigned)__builtin_amdgcn_s_getreg((3 << 11) | 20) & 0xFu; }
#define XB_SPIN(cond, bar) do { unsigned _sp = 0; while (cond) { __builtin_amdgcn_s_sleep(1); \
    if ((++_sp & 255u) == 0u) { if (xb_ld(&(bar)[XB_TMO])) break; if (_sp > XB_SPIN_CAP) { atomicAdd(&(bar)[XB_TMO], 1u); break; } } } } while (0)
struct XcdBarrier { unsigned* bar; unsigned x; volatile LAS unsigned* st; };
__device__ __forceinline__ XcdBarrier xcd_barrier_post(unsigned* bar, volatile LAS unsigned* st) {
    XcdBarrier b; b.bar = bar; b.x = xb_xcc_id(); b.st = st;
    if (threadIdx.x == 0) (void)xb_add(&bar[XB_XCNT(b.x)], 1u);
    return b;
}
__device__ __forceinline__ void xcd_barrier_complete(unsigned* bar, unsigned x, unsigned& nloc, unsigned& nx) {
    const unsigned G = gridDim.x * gridDim.y * gridDim.z;
    unsigned sum, cnt, mine, sp = 0u;
    for (;;) {
        sum = 0u; cnt = 0u; mine = 0u;
#pragma unroll
        for (unsigned j = 0; j < 16; ++j) { const unsigned c = xb_ld(&bar[XB_XCNT(j)]); sum += c; cnt += (c > 0u) ? 1u : 0u; mine = (j == x) ? c : mine; }
        if (sum == G) break;
        __builtin_amdgcn_s_sleep(1);
        if ((++sp & 255u) == 0u) { if (xb_ld(&bar[XB_TMO])) break; if (sp > XB_SPIN_CAP) { atomicAdd(&bar[XB_TMO], 1u); break; } }
    }
    nloc = mine > 0u ? mine : 1u; nx = cnt > 0u ? cnt : 1u;
}
__device__ __forceinline__ void xcd_barrier(const XcdBarrier& b, const bool leader) {
    asm volatile("s_waitcnt vmcnt(0)" ::: "memory");
    __syncthreads();
    if (leader) {
        unsigned* bar = b.bar;
        __builtin_amdgcn_s_waitcnt(0);
        unsigned nloc = b.st[0], nx = b.st[1];
        if (nloc == 0u) { xcd_barrier_complete(bar, b.x, nloc, nx); b.st[0] = nloc; b.st[1] = nx; }
        const unsigned old = xb_add(&bar[XB_XSUB(b.x)], 1u);
        const unsigned gen = old / nloc;
        if (old + 1u == (gen + 1u) * nloc) {
            __builtin_amdgcn_fence(__ATOMIC_RELEASE, "agent");
            asm volatile("s_waitcnt vmcnt(0)" ::: "memory");
            const unsigned og = xb_add(&bar[XB_TOP], 1u);
            const unsigned tg = og / nx;
            if (og + 1u == (tg + 1u) * nx) xb_add(&bar[XB_TOPGEN], 1u);
            else XB_SPIN(xb_ld(&bar[XB_TOPGEN]) == tg, bar);
            __builtin_amdgcn_fence(__ATOMIC_ACQUIRE, "agent");
            xb_add(&bar[XB_XGEN(b.x)], 1u);
            asm volatile("s_waitcnt vmcnt(0)" ::: "memory");
        } else {
            XB_SPIN(xb_ld(&bar[XB_XGEN(b.x)]) == gen, bar);
            __builtin_amdgcn_fence(__ATOMIC_ACQUIRE, "agent");
            asm volatile("s_waitcnt vmcnt(0)" ::: "memory");
        }
    }
    __syncthreads();
}

enum In { I_X = 0, I_C, I_ADAW, I_ADAB, I_N1G, I_WIN, I_CONVW, I_CONVB, I_RGWA, I_RGBA, I_RGWX, I_RGBX, I_RGLAM, I_GWUP, I_GBUP, I_GNG, I_WBA, I_WBB, I_WOUT, I_N2G,
          I_RW, I_RB, I_EGU, I_EDN, I_SGU, I_SDN, I_FG, N_INPUTS };
struct Args { const float* in[N_INPUTS]; float* out; unsigned char* ws; int ph_lo, ph_hi; };
struct Frame { LAS unsigned char* lds; unsigned char* ws; int tid, lane, wave, vcu, G, bx; };

__device__ __forceinline__ float wave_sum(float v, int lane) {
#pragma unroll
    for (int o = 1; o < 64; o <<= 1) v += __builtin_bit_cast(float, __builtin_amdgcn_ds_bpermute((lane ^ o) << 2, __builtin_bit_cast(int, v)));
    return v;
}

template <class RowP>
__device__ __forceinline__ void conv_item(const float* W, int K, int N, LAS float* scr, int item, int lane, RowP rowp) {
    const int nblk = (N + 31) / 32, kb = item / nblk, nb = item % nblk, k0 = 64 * kb, n0 = 32 * nb;
    const int cl = n0 + (lane & 31); const bool okc = cl < N;
#pragma unroll 8
    for (int i = 0; i < 32; ++i) { const int kk = 2 * i + (lane >> 5); scr[kk * 33 + (lane & 31)] = okc ? W[(size_t)(k0 + kk) * N + cl] : 0.f; }
    LDS_WAIT(); asm volatile("" ::: "memory");
    const int c = lane & 7;
#pragma unroll
    for (int j = 0; j < 4; ++j) { const int n = (lane >> 3) + 8 * j; const LAS float* s = scr + (8 * c) * 33 + n;
        v4u o; o.x = pk2(s[0 * 33], s[1 * 33]); o.y = pk2(s[2 * 33], s[3 * 33]); o.z = pk2(s[4 * 33], s[5 * 33]); o.w = pk2(s[6 * 33], s[7 * 33]);
        bf16* rp = (n0 + n < N) ? rowp(n0 + n) : (bf16*)nullptr;
        if (rp) *(GAS v4u*)(rp + k0 + 8 * c) = o; }
    LDS_WAIT(); asm volatile("" ::: "memory");
}
__device__ __forceinline__ bf16* winrow(int c, bf16* win, bf16* wlr) {
    if (c < 5120) {
        if (c >= 2048 && c < 2560) { const int p = c & 15, g = (p >> 2) & 3; const int pp = (g == 1) ? p + 4 : (g == 2) ? p - 4 : p; c = (c & ~15) | pp; }
        return win + (size_t)c * D; }
    if (c < 5136) return wlr + (size_t)(c - 5120) * D;
    return win + (size_t)(c - 16) * D;
}
__device__ __forceinline__ int ydrow(int c) { const int cc = c & 255; return (c & ~255) + 128 * ((cc >> 3) & 1) + 32 * (cc >> 6) + 8 * ((cc >> 4) & 3) + (cc & 7); }
__device__ __forceinline__ int glurow(int c) { return 256 * ((c & 255) >> 7) + 128 * (c >> 8) + (c & 127); }

__device__ __forceinline__ void p0_prologue(const Frame& F, const Args& a) {
    unsigned char* ws = F.ws;
    __syncthreads();
    if (F.vcu < 96) {
        LAS float* cact = (LAS float*)F.lds;
        LAS float* part = (LAS float*)(F.lds + 65536);
        for (int i = F.tid; i < 16 * 1024; i += NTHR) { const int b = i >> 10, k = i & 1023; const float x = a.in[I_C][i]; cact[k * 16 + b] = fsilu(x); }
        __syncthreads();
        const int l = F.wave >> 2, kq = F.wave & 3, n = F.vcu * 64 + F.lane;
        float acc[16];
#pragma unroll
        for (int b = 0; b < 16; ++b) acc[b] = 0.f;
        const float* w = a.in[I_ADAW] + (size_t)l * 1024 * 6144 + n;
#pragma unroll 4
        for (int k = kq * 256; k < kq * 256 + 256; ++k) { const float wv = w[(size_t)k * 6144];
#pragma unroll
            for (int q = 0; q < 4; ++q) { const f32x4 cv = *(const LAS f32x4*)(cact + k * 16 + 4 * q); acc[4 * q] += wv * cv.x; acc[4 * q + 1] += wv * cv.y; acc[4 * q + 2] += wv * cv.z; acc[4 * q + 3] += wv * cv.w; } }
#pragma unroll
        for (int b = 0; b < 16; ++b) part[(F.wave * 16 + b) * 64 + F.lane] = acc[b];
        __syncthreads();
        for (int i = F.tid; i < 2 * 16 * 64; i += NTHR) { const int ll = i >> 10, b = (i >> 6) & 15, nn = i & 63; float s = a.in[I_ADAB][ll * 6144 + F.vcu * 64 + nn];
#pragma unroll
            for (int q = 0; q < 4; ++q) s += part[((ll * 4 + q) * 16 + b) * 64 + nn];
            ((float*)(ws + WS_MOD))[((size_t)ll * 16 + b) * 6144 + F.vcu * 64 + nn] = s; }
        __syncthreads();
    }
    LAS float* scr = (LAS float*)(F.lds + F.wave * 16384);
    const int gw = F.vcu * NWAVES + F.wave, NGW = F.G * NWAVES;
    constexpr int I_IN = 16 * 225, I_SQ = 16 * 32, I_R = 16 * 4, I_SG = 16 * 16, I_SD = 4 * 32, I_RGI = 2 * 4 * 16, I_EG = 16 * 16, I_ED = 4 * 32;
    constexpr int PER_L = I_IN + 3 * I_SQ + I_R + I_SG + I_SD + I_RGI + NE * I_EG + NE * I_ED;
    for (int it = gw; it < DEPTH * PER_L; it += NGW) {
        const int l = it / PER_L; int r = it - l * PER_L;
        if (r < I_IN) { bf16* win = (bf16*)(ws + WS_WIN) + (size_t)l * NSEC * D; bf16* wlr = (bf16*)(ws + WS_WLR) + (size_t)l * 16 * D;
            conv_item(a.in[I_WIN] + (size_t)l * D * N_IN, D, N_IN, scr, r, F.lane, [=](int c) { return winrow(c, win, wlr); }); continue; } r -= I_IN;
        if (r < 3 * I_SQ) { const int w = r / I_SQ; r -= w * I_SQ; const float* src = a.in[w == 0 ? I_WBA : (w == 1 ? I_WBB : I_WOUT)] + (size_t)l * D * D;
            bf16* dst = (bf16*)(ws + (w == 0 ? WS_WA : (w == 1 ? WS_WB : WS_WO))) + (size_t)l * D * D;
            conv_item(src, D, D, scr, r, F.lane, [=](int c) { return dst + (size_t)c * D; }); continue; } r -= 3 * I_SQ;
        if (r < I_R) { bf16* dst = (bf16*)(ws + WS_ROUT) + (size_t)l * 256 * D;
            conv_item(a.in[I_RW] + (size_t)l * D * NE, D, NE, scr, r, F.lane, [=](int c) { return dst + (size_t)c * D; }); continue; } r -= I_R;
        if (r < I_SG) { bf16* dst = (bf16*)(ws + WS_SGU) + (size_t)l * 512 * D;
            conv_item(a.in[I_SGU] + (size_t)l * D * 512, D, 512, scr, r, F.lane, [=](int c) { return dst + (size_t)glurow(c) * D; }); continue; } r -= I_SG;
        if (r < I_SD) { bf16* dst = (bf16*)(ws + WS_SDN) + (size_t)l * D * DE;
            conv_item(a.in[I_SDN] + (size_t)l * DE * D, DE, D, scr, r, F.lane, [=](int c) { return dst + (size_t)c * DE; }); continue; } r -= I_SD;
        if (r < I_RGI) { const int which = r / 64; r -= which * 64; const int hb = r / 8; r -= hb * 8;
            bf16* dst = (bf16*)(ws + WS_RGW) + ((size_t)(l * 8 + hb) * 256 + which * 128) * 128;
            conv_item(a.in[which ? I_RGWX : I_RGWA] + ((size_t)l * 8 + hb) * 128 * 128, 128, 128, scr, r, F.lane, [=](int c) { return dst + (size_t)c * 128; }); continue; } r -= I_RGI;
        if (r < NE * I_EG) { const int e = r / I_EG; r -= e * I_EG; bf16* dst = (bf16*)(ws + WS_EGU) + ((size_t)l * NE + e) * 512 * D;
            conv_item(a.in[I_EGU] + ((size_t)l * NE + e) * D * 512, D, 512, scr, r, F.lane, [=](int c) { return dst + (size_t)glurow(c) * D; }); continue; } r -= NE * I_EG;
        { const int e = r / I_ED; r -= e * I_ED; bf16* dst = (bf16*)(ws + WS_EDN) + ((size_t)l * NE + e) * D * DE;
            conv_item(a.in[I_EDN] + ((size_t)l * NE + e) * DE * D, DE, D, scr, r, F.lane, [=](int c) { return dst + (size_t)ydrow(c) * DE; }); }
    }
    { const int gt = F.vcu * NTHR + F.tid, NT = F.G * NTHR;
      for (int i = gt; i < 2 * 128 * D / 8; i += NT) { const int l = i / (128 * D / 8), r = i - l * (128 * D / 8);
          *(GAS v4u*)((bf16*)(ws + WS_ROUT) + ((size_t)l * 256 + 128) * D + (size_t)r * 8) = (v4u){0u, 0u, 0u, 0u}; }
      if (gt < D / 8) *(GAS v4u*)((bf16*)(ws + WS_U) + (size_t)T * D + gt * 8) = (v4u){0u, 0u, 0u, 0u}; }
}

template <bool FINAL>
__device__ __forceinline__ void norm_phase(const Frame& F, const float* h, const float* gain, const float* sc, const float* sh, bf16* U, float* outf) {
    const int gw = F.vcu * NWAVES + F.wave, NGW = F.G * NWAVES;
    for (int blk = gw; blk < T / 32; blk += NGW) {
        const int b = (blk * 32) / SEQ;
        f32x4 scl[4], sft[4];
#pragma unroll
        for (int j = 0; j < 4; ++j) { const int c = 4 * F.lane + 256 * j; const f32x4 g = *(const f32x4*)(gain + c);
            if (FINAL) { scl[j] = g; sft[j] = (f32x4){0.f, 0.f, 0.f, 0.f}; }
            else { const f32x4 s1 = *(const f32x4*)(sc + (size_t)b * 6144 + c); sft[j] = *(const f32x4*)(sh + (size_t)b * 6144 + c); scl[j] = g * (s1 + 1.0f); } }
        for (int r4 = 0; r4 < 32; r4 += 4) {
            f32x4 v[4][4];
#pragma unroll
            for (int rr = 0; rr < 4; ++rr) { const GAS f32x4* xr = (const GAS f32x4*)(h + ((size_t)blk * 32 + r4 + rr) * D) + F.lane;
#pragma unroll
                for (int j = 0; j < 4; ++j) v[rr][j] = xr[64 * j]; }
#pragma unroll
            for (int rr = 0; rr < 4; ++rr) { const size_t row = (size_t)blk * 32 + r4 + rr; float s = 0.f;
#pragma unroll
                for (int j = 0; j < 4; ++j) s += (v[rr][j].x * v[rr][j].x + v[rr][j].y * v[rr][j].y) + (v[rr][j].z * v[rr][j].z + v[rr][j].w * v[rr][j].w);
                const float rs = 1.0f / sqrtf(wave_sum(s, F.lane) * (1.0f / D) + EPS);
                if (FINAL) { GAS f32x4* o = (GAS f32x4*)(outf + row * D) + F.lane;
#pragma unroll
                    for (int j = 0; j < 4; ++j) o[64 * j] = v[rr][j] * rs * scl[j];
                } else { GAS v2u* o = (GAS v2u*)(U + row * D) + F.lane;
#pragma unroll
                    for (int j = 0; j < 4; ++j) { const f32x4 y = v[rr][j] * rs * scl[j] + sft[j]; o[64 * j] = (v2u){pk2(y.x, y.y), pk2(y.z, y.w)}; } } }
        }
    }
}

#define EPI_ROWS_BEGIN _Pragma("unroll") for (int ai = 0; ai < 2; ++ai) _Pragma("unroll") for (int m = 0; m < 4; ++m) { const int rt = ai * 128 + wr * 64 + m * 16 + fr;
#define EPI_ROWS_END }
typedef const pg8::f32x4 (&AccRef)[2][2][4][2];
__device__ __forceinline__ v4u pack8(const f32x4& a, const f32x4& b) { v4u w; w.x = pg8::cvt_pk_bf16(a[0], a[1]); w.y = pg8::cvt_pk_bf16(a[2], a[3]); w.z = pg8::cvt_pk_bf16(b[0], b[1]); w.w = pg8::cvt_pk_bf16(b[2], b[3]); return w; }
template <int ACT> __device__ __forceinline__ f32x4 act4(f32x4 v) {
    if (ACT == 1) { v[0] = fgelu_tanh(v[0]); v[1] = fgelu_tanh(v[1]); v[2] = fgelu_tanh(v[2]); v[3] = fgelu_tanh(v[3]); }
    if (ACT == 2) v = v * 0.08838834764831845f;
    if (ACT == 3) { v[0] = fsilu(v[0]); v[1] = fsilu(v[1]); v[2] = fsilu(v[2]); v[3] = fsilu(v[3]); }
    if (ACT == 4) { v[0] = fsigmoid(v[0]); v[1] = fsigmoid(v[1]); v[2] = fsigmoid(v[2]); v[3] = fsigmoid(v[3]); }
    return v;
}
template <int ACT> __device__ __forceinline__ void store_tile_bf16(AccRef acc, bf16* dst, int ld, size_t row0, int col0, int wr, int wc, int fr, int fq) {
    EPI_ROWS_BEGIN
        bf16* rp = dst + (row0 + rt) * ld + col0 + wc * 32 + 8 * fq;
#pragma unroll
        for (int bj = 0; bj < 2; ++bj) *(GAS v4u*)(rp + bj * 128) = pack8(act4<ACT>(acc[ai][bj][m][0]), act4<ACT>(acc[ai][bj][m][1]));
    EPI_ROWS_END
}
struct EpiInProj {
    unsigned char* ws;
    __device__ __forceinline__ void operator()(AccRef acc, const pg8::Unit& u, int wr, int wc, int fr, int fq) const {
        asm volatile("" : "+v"(fr), "+v"(fq));
        const int pn = u.pn; const size_t row0 = (size_t)u.pm * 256;
        if (pn < 4)       store_tile_bf16<0>(acc, (bf16*)(ws + WS_XRPRE), 1024, row0, pn * 256, wr, wc, fr, fq);
        else if (pn < 8)  store_tile_bf16<1>(acc, (bf16*)(ws + WS_RG), 1024, row0, (pn - 4) * 256, wr, wc, fr, fq);
        else if (pn < 10) store_tile_bf16<2>(acc, (bf16*)(ws + WS_Q), 512, row0, (pn - 8) * 256, wr, wc, fr, fq);
        else if (pn < 12) store_tile_bf16<0>(acc, (bf16*)(ws + WS_K), 512, row0, (pn - 10) * 256, wr, wc, fr, fq);
        else if (pn < 16) store_tile_bf16<0>(acc, (bf16*)(ws + WS_V), 1024, row0, (pn - 12) * 256, wr, wc, fr, fq);
        else if (pn < 20) store_tile_bf16<3>(acc, (bf16*)(ws + WS_OG), 1024, row0, (pn - 16) * 256, wr, wc, fr, fq);
        else if (pn < 24) store_tile_bf16<4>(acc, (bf16*)(ws + WS_GA), 1024, row0, (pn - 20) * 256, wr, wc, fr, fq);
        else              store_tile_bf16<4>(acc, (bf16*)(ws + WS_GB), 1024, row0, (pn - 24) * 256, wr, wc, fr, fq);
    }
};
template <bool FIRST> struct EpiMerge {
    const bf16* gate; bf16* mbuf;
    __device__ __forceinline__ void operator()(AccRef acc, const pg8::Unit& u, int wr, int wc, int fr, int fq) const {
        asm volatile("" : "+v"(fr), "+v"(fq));
        EPI_ROWS_BEGIN
            const size_t o = ((size_t)u.pm * 256 + rt) * 1024 + u.pn * 256 + wc * 32 + 8 * fq;
#pragma unroll
            for (int bj = 0; bj < 2; ++bj) { const v4u gw = *(const GAS v4u*)(gate + o + bj * 128);
                f32x4 g0 = {bflo(gw.x), bfhi(gw.x), bflo(gw.y), bfhi(gw.y)}, g1 = {bflo(gw.z), bfhi(gw.z), bflo(gw.w), bfhi(gw.w)};
                f32x4 r0 = g0 * acc[ai][bj][m][0], r1 = g1 * acc[ai][bj][m][1];
                if (!FIRST) { const v4u mw = *(const GAS v4u*)(mbuf + o + bj * 128);
                    r0 += (f32x4){bflo(mw.x), bfhi(mw.x), bflo(mw.y), bfhi(mw.y)}; r1 += (f32x4){bflo(mw.z), bfhi(mw.z), bflo(mw.w), bfhi(mw.w)}; }
                *(GAS v4u*)(mbuf + o + bj * 128) = pack8(r0, r1); }
        EPI_ROWS_END
    }
};
struct EpiRes {
    const float* hin; float* hout; const float* gate;
    __device__ __forceinline__ void operator()(AccRef acc, const pg8::Unit& u, int wr, int wc, int fr, int fq) const {
        asm volatile("" : "+v"(fr), "+v"(fq));
        const int b = (u.pm * 256) / SEQ; const int cb = u.pn * 256 + wc * 32 + 8 * fq;
        f32x4 gv[2][2];
#pragma unroll
        for (int bj = 0; bj < 2; ++bj)
#pragma unroll
            for (int n = 0; n < 2; ++n) gv[bj][n] = *(const f32x4*)(gate + (size_t)b * 6144 + cb + bj * 128 + 4 * n);
        EPI_ROWS_BEGIN
            const size_t o = ((size_t)u.pm * 256 + rt) * 1024 + cb;
#pragma unroll
            for (int bj = 0; bj < 2; ++bj)
#pragma unroll
                for (int n = 0; n < 2; ++n) { const f32x4 hv = *(const GAS f32x4*)(hin + o + bj * 128 + 4 * n); *(GAS f32x4*)(hout + o + bj * 128 + 4 * n) = hv + gv[bj][n] * acc[ai][bj][m][n]; }
        EPI_ROWS_END
    }
};
struct EpiLogit {
    float* lg;
    __device__ __forceinline__ void operator()(AccRef acc, const pg8::Unit& u, int wr, int wc, int fr, int fq) const {
        asm volatile("" : "+v"(fr), "+v"(fq));
        EPI_ROWS_BEGIN
            float* rp = lg + ((size_t)u.pm * 256 + rt) * 128 + wc * 32 + 8 * fq;
            *(GAS f32x4*)(rp) = acc[ai][0][m][0]; *(GAS f32x4*)(rp + 4) = acc[ai][0][m][1];
        EPI_ROWS_END
    }
};
struct EpiGlu {
    bf16* act;
    __device__ __forceinline__ void operator()(AccRef acc, const pg8::Unit& u, int wr, int wc, int fr, int fq) const {
        asm volatile("" : "+v"(fr), "+v"(fq));
        const int j = u.pn & 1;
        EPI_ROWS_BEGIN
            f32x4 r0 = act4<3>(acc[ai][0][m][0]) * acc[ai][1][m][0], r1 = act4<3>(acc[ai][0][m][1]) * acc[ai][1][m][1];
            *(GAS v4u*)(act + ((size_t)u.pm * 256 + rt) * 256 + j * 128 + wc * 32 + 8 * fq) = pack8(r0, r1);
        EPI_ROWS_END
    }
};
__device__ __forceinline__ unsigned pk4_fp8(float a, float b, float c, float d) { int w = __builtin_amdgcn_cvt_pk_fp8_f32(a, b, 0, false); return (unsigned)__builtin_amdgcn_cvt_pk_fp8_f32(c, d, w, true); }
struct EpiY {
    unsigned char* y;
    __device__ __forceinline__ void operator()(AccRef acc, const pg8::Unit& u, int wr, int wc, int fr, int fq) const {
        asm volatile("" : "+v"(fr), "+v"(fq));
        EPI_ROWS_BEGIN
            const f32x4 a0 = acc[ai][0][m][0] * 16.0f, a1 = acc[ai][0][m][1] * 16.0f, b0 = acc[ai][1][m][0] * 16.0f, b1 = acc[ai][1][m][1] * 16.0f;
            v4u w; w.x = pk4_fp8(a0[0], a0[1], a0[2], a0[3]); w.y = pk4_fp8(a1[0], a1[1], a1[2], a1[3]); w.z = pk4_fp8(b0[0], b0[1], b0[2], b0[3]); w.w = pk4_fp8(b1[0], b1[1], b1[2], b1[3]);
            *(GAS v4u*)(y + ((size_t)u.pm * 256 + rt) * 1024 + (u.pn & 3) * 256 + wc * 64 + fq * 16) = w;
        EPI_ROWS_END
    }
};

__device__ __forceinline__ int swz16(int row, int ch) { return row * 256 + ((ch ^ (row & 15)) << 4); }
__device__ __forceinline__ void rg_gate_phase(const Frame& F, const Args& a, int l) {
    unsigned char* ws = F.ws;
    const int hb = F.vcu & 7;
    LAS unsigned char* Ws = F.lds; LAS unsigned char* Xs = F.lds + 65536; LAS float* prm = (LAS float*)(F.lds + 98304);
    const bf16* xpre = (const bf16*)(ws + WS_XRPRE); bf16* loga = (bf16*)(ws + WS_LOGA); bf16* ixo = (bf16*)(ws + WS_IX);
    { const bf16* wsrc = (const bf16*)(ws + WS_RGW) + (size_t)(l * 8 + hb) * 256 * 128;
#pragma unroll
      for (int j = 0; j < 8; ++j) { const int ck = F.tid + NTHR * j, n = ck >> 4, ch = ck & 15; *(LAS v4u*)(Ws + swz16(n, ch)) = *(const GAS v4u*)(wsrc + (size_t)ck * 8); }
      if (F.tid < 128) { const int c = l * D + hb * 128 + F.tid; prm[F.tid] = a.in[I_RGBA][c]; prm[128 + F.tid] = a.in[I_RGBX][c];
          const float lam = a.in[I_RGLAM][c]; prm[256 + F.tid] = fmaxf(-lam, 0.f) + log1pf(__expf(-fabsf(lam))); } }
    const int c8 = F.tid & 15, rg4 = F.tid >> 4, chan0 = hb * 128 + 8 * c8;
    float cw[4][8], cb[8];
#pragma unroll
    for (int j = 0; j < 8; ++j) { cb[j] = a.in[I_CONVB][l * D + chan0 + j];
#pragma unroll
        for (int q = 0; q < 4; ++q) cw[q][j] = a.in[I_CONVW][((size_t)l * 4 + q) * D + chan0 + j]; }
    const int fr = F.lane & 15, fq = F.lane >> 4;
    for (int i = 0; i < 16; ++i) {
        const int rt = (F.vcu >> 3) + 32 * i; const size_t row0 = (size_t)rt * 128;
        __syncthreads();
        {
            const int r0 = 4 * rg4; const int tpos = (int)((row0 + r0) & (SEQ - 1));
            float x[7][8];
#pragma unroll
            for (int q = 0; q < 7; ++q) { const int dt = q - 3; v4u w = {0u, 0u, 0u, 0u};
                if (tpos + dt >= 0) w = *(const GAS v4u*)(xpre + (size_t)((long)(row0 + r0) + dt) * D + chan0);
                x[q][0] = bflo(w.x); x[q][1] = bfhi(w.x); x[q][2] = bflo(w.y); x[q][3] = bfhi(w.y); x[q][4] = bflo(w.z); x[q][5] = bfhi(w.z); x[q][6] = bflo(w.w); x[q][7] = bfhi(w.w); }
#pragma unroll
            for (int rr = 0; rr < 4; ++rr) { float y[8];
#pragma unroll
                for (int j = 0; j < 8; ++j) y[j] = cb[j] + cw[0][j] * x[rr][j] + cw[1][j] * x[rr + 1][j] + cw[2][j] * x[rr + 2][j] + cw[3][j] * x[rr + 3][j];
                v4u o; o.x = pk2(y[0], y[1]); o.y = pk2(y[2], y[3]); o.z = pk2(y[4], y[5]); o.w = pk2(y[6], y[7]);
                *(LAS v4u*)(Xs + swz16(r0 + rr, c8)) = o; }
        }
        __syncthreads();
        f32x4 acc[16];
#pragma unroll
        for (int nb = 0; nb < 16; ++nb) acc[nb] = (f32x4){0.f, 0.f, 0.f, 0.f};
        const int arow = 16 * F.wave + fr;
#pragma unroll
        for (int ks = 0; ks < 4; ++ks) { const bf16x8 af = *(const LAS bf16x8*)(Xs + swz16(arow, 4 * ks + fq));
#pragma unroll
            for (int nb = 0; nb < 16; ++nb) { const bf16x8 bfv = *(const LAS bf16x8*)(Ws + swz16(16 * nb + fr, 4 * ks + fq));
                acc[nb] = __builtin_amdgcn_mfma_f32_16x16x32_bf16(bfv, af, acc[nb], 0, 0, 0); } }
        const size_t grow = row0 + arow; const bool tzero = (grow & (SEQ - 1)) == 0;
#pragma unroll
        for (int nb = 0; nb < 8; ++nb) { const int c = 16 * nb + 4 * fq;
            const f32x4 ba = *(const LAS f32x4*)(prm + c), bx = *(const LAS f32x4*)(prm + 128 + c), sp = *(const LAS f32x4*)(prm + 256 + c);
            const v2u xw = *(const LAS v2u*)(Xs + swz16(arow, c >> 3) + (c & 7) * 2);
            const float xv[4] = {bflo(xw.x), bfhi(xw.x), bflo(xw.y), bfhi(xw.y)};
            float om[4], bt[4];
#pragma unroll
            for (int j = 0; j < 4; ++j) { const float r = fsigmoid(acc[nb][j] + ba[j]), ii = fsigmoid(acc[nb + 8][j] + bx[j]); const float la = -8.0f * r * sp[j];
                const float o1 = 1.0f - __builtin_amdgcn_exp2f(1.442695041f * la), o2 = -la * (1.0f + la * (0.5f + la * 0.16666667f));
                om[j] = (la > -0.01f) ? o2 : o1; float mult = __builtin_amdgcn_sqrtf(om[j] * (2.0f - om[j])); if (tzero) mult = 1.0f; bt[j] = mult * ii * xv[j]; }
            const size_t o = grow * D + hb * 128 + c;
            *(GAS v2u*)(loga + o) = (v2u){pk2(om[0], om[1]), pk2(om[2], om[3])};
            *(GAS v2u*)(ixo + o) = (v2u){pk2(bt[0], bt[1]), pk2(bt[2], bt[3])}; }
    }
    __syncthreads();
}

typedef float f32x2 __attribute__((ext_vector_type(2)));
__device__ __forceinline__ void scan_pass1(const Frame& F, int unit) {
    unsigned char* ws = F.ws;
    const size_t row0 = (size_t)unit * 64; const int ch = 2 * F.tid;
    const GAS unsigned* om = (const GAS unsigned*)((const bf16*)(ws + WS_LOGA) + row0 * D + ch); const GAS unsigned* bp = (const GAS unsigned*)((const bf16*)(ws + WS_IX) + row0 * D + ch);
    float P0 = 1.f, P1 = 1.f, E0 = 0.f, E1 = 0.f;
#pragma unroll 16
    for (int r = 0; r < 64; ++r) { const unsigned ow = om[(size_t)r * (D / 2)], bw = bp[(size_t)r * (D / 2)];
        const float a0 = 1.0f - bflo(ow), a1 = 1.0f - bfhi(ow); E0 = a0 * E0 + bflo(bw); E1 = a1 * E1 + bfhi(bw); P0 *= a0; P1 *= a1; }
    *(GAS f32x2*)((float*)(ws + WS_SP) + (size_t)unit * D + ch) = (f32x2){P0, P1}; *(GAS f32x2*)((float*)(ws + WS_SE) + (size_t)unit * D + ch) = (f32x2){E0, E1};
}
__device__ __forceinline__ void scan_carry(const Frame& F, int unit) {
    unsigned char* ws = F.ws;
    const int b = unit >> 1, ch = (unit & 1) * 512 + F.tid;
    const float* sp = (const float*)(ws + WS_SP) + (size_t)b * 64 * D + ch; const float* se = (const float*)(ws + WS_SE) + (size_t)b * 64 * D + ch; float* ci = (float*)(ws + WS_CIN) + (size_t)b * 64 * D + ch;
    float st = 0.f;
#pragma unroll 16
    for (int s = 0; s < 64; ++s) { ci[(size_t)s * D] = st; st = sp[(size_t)s * D] * st + se[(size_t)s * D]; }
}
__device__ __forceinline__ void scan_pass3(const Frame& F, int unit) {
    unsigned char* ws = F.ws;
    const size_t row0 = (size_t)unit * 64; const int ch = 2 * F.tid;
    const GAS unsigned* om = (const GAS unsigned*)((const bf16*)(ws + WS_LOGA) + row0 * D + ch); GAS unsigned* bp = (GAS unsigned*)((bf16*)(ws + WS_IX) + row0 * D + ch);
    const GAS unsigned* rg = (const GAS unsigned*)((const bf16*)(ws + WS_RG) + row0 * D + ch);
    const f32x2 c0 = *(const GAS f32x2*)((const float*)(ws + WS_CIN) + (size_t)unit * D + ch); float h0 = c0.x, h1 = c0.y;
#pragma unroll 16
    for (int r = 0; r < 64; ++r) { const unsigned ow = om[(size_t)r * (D / 2)], bw = bp[(size_t)r * (D / 2)], gw = rg[(size_t)r * (D / 2)];
        h0 = (1.0f - bflo(ow)) * h0 + bflo(bw); h1 = (1.0f - bfhi(ow)) * h1 + bfhi(bw); bp[(size_t)r * (D / 2)] = pk2(h0 * bflo(gw), h1 * bfhi(gw)); }
}

__device__ __forceinline__ float flogsig16(float x) {
    const float e = __builtin_amdgcn_exp2f(-1.442695041f * fabsf(x));
    return (fminf(x, 0.f) - 0.6931471806f * __builtin_amdgcn_logf(1.0f + e)) * 0.0625f;
}
__device__ __forceinline__ void gla_prep(const Frame& F, const Args& a, int l, int unit) {
    unsigned char* ws = F.ws;
    LAS float* lrs = (LAS float*)F.lds; LAS float* psum = (LAS float*)(F.lds + 8192); LAS unsigned char* kds = F.lds + 16384;
    const size_t row0 = (size_t)unit * 64;
    const int fr = F.lane & 15, fq = F.lane >> 4;
    __syncthreads();
    { const int rb = F.wave & 3, kh = F.wave >> 2;
      const bf16* up = (const bf16*)(ws + WS_U) + (row0 + 16 * rb + fr) * D + kh * 512 + 8 * fq;
      const bf16* wp = (const bf16*)(ws + WS_WLR) + ((size_t)l * 16 + fr) * D + kh * 512 + 8 * fq;
      f32x4 acc = {0.f, 0.f, 0.f, 0.f};
#pragma unroll
      for (int ks = 0; ks < 16; ++ks) { const bf16x8 af = *(const GAS bf16x8*)(up + 32 * ks), bfv = *(const GAS bf16x8*)(wp + 32 * ks);
          acc = __builtin_amdgcn_mfma_f32_16x16x32_bf16(af, bfv, acc, 0, 0, 0); }
#pragma unroll
      for (int j = 0; j < 4; ++j) lrs[(kh * 64 + 16 * rb + 4 * fq + j) * 16 + fr] = acc[j]; }
    __syncthreads();
    const int cp = F.tid & 255, th = F.tid >> 8, c0 = 2 * cp;
    float wu0[16], wu1[16];
#pragma unroll
    for (int r = 0; r < 16; ++r) { const f32x2 w = *(const GAS f32x2*)(a.in[I_GWUP] + ((size_t)l * 16 + r) * 512 + c0); wu0[r] = w.x; wu1[r] = w.y; }
    const f32x2 bu = *(const GAS f32x2*)(a.in[I_GBUP] + l * 512 + c0);
    float la0[32], la1[32]; float s0 = 0.f, s1 = 0.f;
#pragma unroll
    for (int tt = 0; tt < 32; ++tt) { const int t = 32 * th + tt; float g0 = bu.x, g1 = bu.y;
#pragma unroll
        for (int q = 0; q < 4; ++q) { const f32x4 x = *(const LAS f32x4*)(lrs + t * 16 + 4 * q) + *(const LAS f32x4*)(lrs + (64 + t) * 16 + 4 * q);
            g0 += x.x * wu0[4 * q] + x.y * wu0[4 * q + 1] + x.z * wu0[4 * q + 2] + x.w * wu0[4 * q + 3];
            g1 += x.x * wu1[4 * q] + x.y * wu1[4 * q + 1] + x.z * wu1[4 * q + 2] + x.w * wu1[4 * q + 3]; }
        la0[tt] = flogsig16(g0); la1[tt] = flogsig16(g1); s0 += la0[tt]; s1 += la1[tt]; }
    *(LAS f32x2*)(psum + th * 512 + c0) = (f32x2){s0, s1};
    __syncthreads();
    const f32x2 oth = *(const LAS f32x2*)(psum + (th ^ 1) * 512 + c0);
    const float tot0 = s0 + oth.x, tot1 = s1 + oth.y;
    if (th == 0) *(GAS f32x2*)((float*)(ws + WS_TOT) + (size_t)unit * 512 + c0) = (f32x2){tot0, tot1};
    float cum0 = th ? oth.x : 0.f, cum1 = th ? oth.y : 0.f;
    const GAS unsigned* kp = (const GAS unsigned*)((const bf16*)(ws + WS_K) + (row0 + 32 * th) * 512 + c0);
#pragma unroll
    for (int t8 = 0; t8 < 4; ++t8) { float o0[8], o1[8];
#pragma unroll
        for (int tt = 0; tt < 8; ++tt) { const unsigned kw = kp[(size_t)(8 * t8 + tt) * 256]; cum0 += la0[8 * t8 + tt]; cum1 += la1[8 * t8 + tt];
            o0[tt] = bflo(kw) * __builtin_amdgcn_exp2f(1.442695041f * (tot0 - cum0)); o1[tt] = bfhi(kw) * __builtin_amdgcn_exp2f(1.442695041f * (tot1 - cum1)); }
        *(LAS v4u*)(kds + c0 * 144 + (32 * th + 8 * t8) * 2) = (v4u){pk2(o0[0], o0[1]), pk2(o0[2], o0[3]), pk2(o0[4], o0[5]), pk2(o0[6], o0[7])};
        *(LAS v4u*)(kds + (c0 + 1) * 144 + (32 * th + 8 * t8) * 2) = (v4u){pk2(o1[0], o1[1]), pk2(o1[2], o1[3]), pk2(o1[4], o1[5]), pk2(o1[6], o1[7])}; }
    __syncthreads();
    GAS unsigned char* kd = (GAS unsigned char*)((bf16*)(ws + WS_KDEC) + (size_t)unit * 512 * 64);
#pragma unroll
    for (int j = 0; j < 8; ++j) { const int ck = F.tid + NTHR * j; *(GAS v4u*)(kd + (size_t)ck * 16) = *(const LAS v4u*)(kds + (ck >> 3) * 144 + (ck & 7) * 16); }
}

constexpr int GQ_OFF = 0, GK_OFF = 64 * 272, GV_OFF = GK_OFF + 128 * 144, GD_OFF = GV_OFF + 64 * 256, GBUF = GD_OFF + 512;
__device__ __forceinline__ unsigned voff_b(unsigned row, unsigned ch) { return 256u * row + 16u * (ch ^ (((row & 3) << 2) | ((row >> 2) & 3))); }
__device__ __forceinline__ bf16x8 pack_step(const f32x16& x, int s) {
    v4u p; p.x = pk2(x[8 * s], x[8 * s + 1]); p.y = pk2(x[8 * s + 2], x[8 * s + 3]); p.z = pk2(x[8 * s + 4], x[8 * s + 5]); p.w = pk2(x[8 * s + 6], x[8 * s + 7]);
    return __builtin_bit_cast(bf16x8, p);
}
__device__ __forceinline__ void gla_stage(const Frame& F, int b, int h, int vh, int n, LAS unsigned char* buf) {
    unsigned char* ws = F.ws; int lt = F.tid - 256; asm volatile("" : "+v"(lt));
    const size_t row0 = (size_t)b * SEQ + (size_t)n * 64;
    const GAS char* qp = (const GAS char*)((const bf16*)(ws + WS_Q) + row0 * 512 + h * 128);
    const GAS char* vp = (const GAS char*)((const bf16*)(ws + WS_V) + row0 * D + h * 256 + vh * 128);
    const GAS char* kp = (const GAS char*)((const bf16*)(ws + WS_KDEC) + (((size_t)b * 64 + n) * 512 + h * 128) * 64);
    v4u qv[4], kv[4], vv[4];
#pragma unroll
    for (int j = 0; j < 4; ++j) { const unsigned ck = (unsigned)lt + 256u * j;
        qv[j] = *(const GAS v4u*)(qp + ((ck >> 4) * 1024u + (ck & 15u) * 16u));
        vv[j] = *(const GAS v4u*)(vp + ((ck >> 4) * 2048u + (ck & 15u) * 16u));
        kv[j] = *(const GAS v4u*)(kp + ck * 16u); }
    float dv = 0.f; if (lt < 128) dv = __expf(((const float*)(ws + WS_TOT))[((size_t)b * 64 + n) * 512 + h * 128 + lt]);
#pragma unroll
    for (int j = 0; j < 4; ++j) { const unsigned ck = (unsigned)lt + 256u * j;
        *(LAS v4u*)(buf + GQ_OFF + (ck >> 4) * 272u + (ck & 15u) * 16u) = qv[j];
        *(LAS v4u*)(buf + GV_OFF + voff_b(ck >> 4, ck & 15u)) = vv[j];
        *(LAS v4u*)(buf + GK_OFF + (ck >> 3) * 144u + (ck & 7u) * 16u) = kv[j]; }
    if (lt < 128) ((LAS float*)(buf + GD_OFF))[lt] = dv;
}
__device__ __forceinline__ void gla_rec(const Frame& F, int unit) {
    unsigned char* ws = F.ws;
    const int b = unit >> 3, h = (unit >> 1) & 3, vh = unit & 1;
    const int w = F.wave;
    f32x16 S[4];
#pragma unroll
    for (int kt = 0; kt < 4; ++kt)
#pragma unroll
        for (int i = 0; i < 16; ++i) S[kt][i] = 0.f;
    __syncthreads();
    if (w >= 4) gla_stage(F, b, h, vh, 0, F.lds);
    __syncthreads();
#pragma unroll 1
    for (int n = 0; n < NCH; ++n) {
        if (w >= 4) { if (n + 1 < NCH) gla_stage(F, b, h, vh, n + 1, F.lds + ((n + 1) & 1) * GBUF); }
        else {
            int lane = F.lane; asm volatile("" : "+v"(lane));
            const int r = lane & 31, hh = lane >> 5;
            const unsigned blk = (lane >> 4) & 1, q4 = (lane & 15) >> 2, p4 = lane & 3;
            LAS unsigned char* buf = F.lds + (n & 1) * GBUF;
            const LAS unsigned char* kbase = buf + GK_OFF + r * 144 + hh * 16;
            const LAS unsigned char* qbase = buf + GQ_OFF + r * 272 + hh * 16;
            const LAS unsigned char* dbase = buf + GD_OFF + hh * 16;
            const unsigned chv = 4u * (unsigned)w + 2u * blk + (p4 >> 1);
            const unsigned vb0 = (unsigned)(size_t)(buf + GV_OFF) + 256u * (8u * hh + q4) + 16u * (chv ^ ((q4 << 2) | ((2u * hh) & 3u))) + 8u * (p4 & 1u);
            const unsigned vb1 = (unsigned)(size_t)(buf + GV_OFF) + 256u * (8u * hh + 4u + q4) + 16u * (chv ^ ((q4 << 2) | ((2u * hh + 1u) & 3u))) + 8u * (p4 & 1u);
#pragma unroll
            for (int kt = 0; kt < 4; ++kt)
#pragma unroll
                for (int g = 0; g < 4; ++g) { const f32x4 dq = *(const LAS f32x4*)(dbase + kt * 128 + g * 32);
                    S[kt][4 * g] *= dq.x; S[kt][4 * g + 1] *= dq.y; S[kt][4 * g + 2] *= dq.z; S[kt][4 * g + 3] *= dq.w; }
#pragma unroll
            for (int ts = 0; ts < 4; ++ts) {
                s16x4 lo, hi;
                asm volatile("ds_read_b64_tr_b16 %0, %2 offset:%4\n\tds_read_b64_tr_b16 %1, %3 offset:%4\n\ts_waitcnt lgkmcnt(0)" : "=&v"(lo), "=&v"(hi) : "v"(vb0), "v"(vb1), "i"(ts * 4096) : "memory");
                const bf16x8 vb = __builtin_shufflevector(lo, hi, 0, 1, 2, 3, 4, 5, 6, 7);
#pragma unroll
                for (int kt = 0; kt < 4; ++kt) { const bf16x8 ka = *(const LAS bf16x8*)(kbase + kt * 4608 + ts * 32);
                    S[kt] = __builtin_amdgcn_mfma_f32_32x32x16_bf16(ka, vb, S[kt], 0, 0, 0); }
            }
            f32x16 O[2];
#pragma unroll
            for (int tb = 0; tb < 2; ++tb)
#pragma unroll
                for (int i = 0; i < 16; ++i) O[tb][i] = 0.f;
#pragma unroll
            for (int kt = 0; kt < 4; ++kt)
#pragma unroll
                for (int s = 0; s < 2; ++s) { const bf16x8 sb = pack_step(S[kt], s);
#pragma unroll
                    for (int tb = 0; tb < 2; ++tb) { const bf16x8 qa = *(const LAS bf16x8*)(qbase + tb * 8704 + kt * 64 + s * 32);
                        O[tb] = __builtin_amdgcn_mfma_f32_32x32x16_bf16(qa, sb, O[tb], 0, 0, 0); } }
            bf16* op = (bf16*)(ws + WS_O) + ((size_t)b * SEQ + (size_t)n * 64 + 4 * hh) * D + h * 256 + vh * 128 + 32 * w + r;
#pragma unroll
            for (int tb = 0; tb < 2; ++tb)
#pragma unroll
                for (int i = 0; i < 16; ++i) { const int t = 32 * tb + (i & 3) + 8 * (i >> 2); op[(size_t)t * D] = (bf16)f2bf(O[tb][i]); }
        }
        __syncthreads();
    }
}
__device__ __forceinline__ void gla_norm(const Frame& F, const Args& a, int l) {
    unsigned char* ws = F.ws;
    const int gw = F.vcu * NWAVES + F.wave, NGW = F.G * NWAVES;
    f32x4 g[4];
#pragma unroll
    for (int hd = 0; hd < 4; ++hd) g[hd] = *(const f32x4*)(a.in[I_GNG] + (size_t)l * 1024 + hd * 256 + 4 * F.lane);
    for (int blk = gw; blk < T / 32; blk += NGW)
        for (int r4 = 0; r4 < 32; r4 += 4) {
            v2u ow[4][4], gw2[4][4];
#pragma unroll
            for (int rr = 0; rr < 4; ++rr) { const size_t row = (size_t)blk * 32 + r4 + rr;
                const GAS v2u* op = (const GAS v2u*)((const bf16*)(ws + WS_O) + row * D) + F.lane; const GAS v2u* gp = (const GAS v2u*)((const bf16*)(ws + WS_OG) + row * D) + F.lane;
#pragma unroll
                for (int hd = 0; hd < 4; ++hd) { ow[rr][hd] = op[64 * hd]; gw2[rr][hd] = gp[64 * hd]; } }
#pragma unroll
            for (int rr = 0; rr < 4; ++rr) { const size_t row = (size_t)blk * 32 + r4 + rr; GAS v2u* op = (GAS v2u*)((bf16*)(ws + WS_O) + row * D) + F.lane;
#pragma unroll
                for (int hd = 0; hd < 4; ++hd) {
                    const f32x4 o = {bflo(ow[rr][hd].x), bfhi(ow[rr][hd].x), bflo(ow[rr][hd].y), bfhi(ow[rr][hd].y)}, og = {bflo(gw2[rr][hd].x), bfhi(gw2[rr][hd].x), bflo(gw2[rr][hd].y), bfhi(gw2[rr][hd].y)};
                    const float ss = wave_sum((o.x * o.x + o.y * o.y) + (o.z * o.z + o.w * o.w), F.lane);
                    const float rs = 1.0f / sqrtf(ss * (1.0f / 256.0f) + EPS);
                    const f32x4 y = o * rs * g[hd] * og; op[64 * hd] = (v2u){pk2(y.x, y.y), pk2(y.z, y.w)}; } } }
}

__device__ __forceinline__ void topk_phase(const Frame& F, const Args& a, int l) {
    unsigned char* ws = F.ws;
    LAS int* hist = (LAS int*)F.lds; LAS int* base = hist + 128; LAS float* bias = (LAS float*)(hist + 256);
    __syncthreads();
    if (F.tid < 128) { hist[F.tid] = 0; bias[F.tid] = a.in[I_RB][l * NE + F.tid]; }
    __syncthreads();
    const int t = F.vcu * 256 + F.tid; const bool act = F.tid < 256;
    float val[8], scv[8]; int idx[8], rank[8];
#pragma unroll
    for (int j = 0; j < 8; ++j) { val[j] = -1e30f; scv[j] = 0.f; idx[j] = 0; rank[j] = 0; }
    if (act) {
        const float* lg = (const float*)(ws + WS_LOGIT) + (size_t)t * NE;
        for (int e4 = 0; e4 < 32; ++e4) { const f32x4 x = *(const GAS f32x4*)(lg + 4 * e4);
#pragma unroll
            for (int q = 0; q < 4; ++q) { const int e = 4 * e4 + q; const float sc = 1.0f / (1.0f + __expf(-x[q])); const float v = sc + bias[e];
#pragma unroll
                for (int j = 7; j >= 0; --j) { if (v > val[j]) { if (j < 7) { val[j + 1] = val[j]; scv[j + 1] = scv[j]; idx[j + 1] = idx[j]; } val[j] = v; scv[j] = sc; idx[j] = e; } } } }
#pragma unroll
        for (int j = 0; j < 8; ++j) rank[j] = __hip_atomic_fetch_add(&hist[idx[j]], 1, __ATOMIC_RELAXED, __HIP_MEMORY_SCOPE_WORKGROUP);
    }
    __syncthreads();
    if (F.tid < 128) base[F.tid] = (int)atomicAdd((unsigned*)(ws + WS_CTL) + CW_CNT + l * NE + F.tid, (unsigned)hist[F.tid]);
    __syncthreads();
    if (act) { float ssum = 0.f;
#pragma unroll
        for (int j = 0; j < 8; ++j) ssum += scv[j];
        const float inv = 2.5f / ssum;
#pragma unroll
        for (int j = 0; j < 8; ++j) { ((unsigned*)(ws + WS_PK))[(size_t)t * 8 + j] = ((unsigned)idx[j] << 24) | (unsigned)(base[idx[j]] + rank[j]); ((float*)(ws + WS_WTS))[(size_t)t * 8 + j] = scv[j] * inv; } }
    __syncthreads();
}
__device__ __forceinline__ void moe_tiles(const Frame& F, int l) {
    LAS int* ts = (LAS int*)(F.lds + LDS_TS);
    __syncthreads();
    if (F.tid == 0) { const unsigned* cnt = (const unsigned*)(F.ws + WS_CTL) + CW_CNT + l * NE; int s = 0;
        for (int e = 0; e < NE; ++e) { ts[e] = s; s += (int)((__hip_atomic_load(cnt + e, RLX_AGENT) + 255u) >> 8); } ts[NE] = s; }
    __syncthreads();
}
__device__ __forceinline__ void scatter_phase(const Frame& F, int l) {
    unsigned char* ws = F.ws;
    moe_tiles(F, l);
    const LAS int* ts = (const LAS int*)(F.lds + LDS_TS);
    if (F.tid < 256) { const int t = F.vcu * 256 + F.tid;
#pragma unroll
        for (int j = 0; j < 8; ++j) { const unsigned pk = ((const unsigned*)(ws + WS_PK))[(size_t)t * 8 + j]; const int e = (int)(pk >> 24), p = ts[e] * 256 + (int)(pk & 0xffffffu);
            ((int*)(ws + WS_POS))[(size_t)t * 8 + j] = p; ((int*)(ws + WS_SORT))[p] = t; } }
}
__device__ __forceinline__ void combine_phase(const Frame& F, float* h, const float* gate) {
    unsigned char* ws = F.ws;
    const int gw = F.vcu * NWAVES + F.wave, NGW = F.G * NWAVES;
    typedef float f2_t __attribute__((ext_vector_type(2)));
    for (int blk = gw; blk < T / 32; blk += NGW) {
        const int b = (blk * 32) / SEQ;
        f32x4 gv[4];
#pragma unroll
        for (int n = 0; n < 4; ++n) gv[n] = *(const f32x4*)(gate + (size_t)b * 6144 + 16 * F.lane + 4 * n);
        const size_t tl = (size_t)blk * 32 + (F.lane & 31);
        const v4u pq = *(const GAS v4u*)((const int*)(ws + WS_POS) + tl * 8 + 4 * (F.lane >> 5)); const f32x4 wq = *(const GAS f32x4*)((const float*)(ws + WS_WTS) + tl * 8 + 4 * (F.lane >> 5));
        for (int rr = 0; rr < 32; rr += 2) {
            v4u yw[2][8]; float wk[2][8]; f32x4 hv[2][4];
#pragma unroll
            for (int q = 0; q < 2; ++q) {
#pragma unroll
                for (int k = 0; k < 8; ++k) { const int src = rr + q + 32 * (k >> 2);
                    const int p = __builtin_amdgcn_readlane((int)pq[k & 3], src); wk[q][k] = __builtin_bit_cast(float, __builtin_amdgcn_readlane(__builtin_bit_cast(int, wq[k & 3]), src)) * 0.0625f;
                    yw[q][k] = *(const GAS v4u*)(ws + WS_Y + (size_t)p * 1024 + 16 * F.lane); }
                const float* hr = h + ((size_t)blk * 32 + rr + q) * D + 16 * F.lane;
#pragma unroll
                for (int n = 0; n < 4; ++n) hv[q][n] = *(const GAS f32x4*)(hr + 4 * n); }
#pragma unroll
            for (int q = 0; q < 2; ++q) { f32x4 acc[4];
#pragma unroll
                for (int n = 0; n < 4; ++n) acc[n] = (f32x4){0.f, 0.f, 0.f, 0.f};
#pragma unroll
                for (int k = 0; k < 8; ++k)
#pragma unroll
                    for (int n = 0; n < 4; ++n) { const f2_t lo = __builtin_amdgcn_cvt_pk_f32_fp8((int)yw[q][k][n], false), hi = __builtin_amdgcn_cvt_pk_f32_fp8((int)yw[q][k][n], true);
                        acc[n] += (f32x4){lo.x, lo.y, hi.x, hi.y} * wk[q][k]; }
                float* hr = h + ((size_t)blk * 32 + rr + q) * D + 16 * F.lane;
#pragma unroll
                for (int n = 0; n < 4; ++n) *(GAS f32x4*)(hr + 4 * n) = hv[q][n] + gv[n] * acc[n]; }
        }
    }
}

constexpr int NPH_L = 15, NPHASE = 1 + DEPTH * NPH_L + 1;
__global__ void __launch_bounds__(NTHR, 2) mk_fwd(Args args) {
    extern __shared__ __attribute__((aligned(16))) unsigned char lds_raw[];
    Frame F;
    F.lds = (LAS unsigned char*)lds_raw; F.ws = args.ws;
    F.tid = threadIdx.x; F.lane = F.tid & 63; F.wave = __builtin_amdgcn_readfirstlane(F.tid >> 6);
    F.G = gridDim.x; { const int bx = blockIdx.x; F.bx = bx; F.vcu = (F.G % 8 == 0) ? (bx % 8) * (F.G / 8) + bx / 8 : bx; }
    volatile LAS unsigned* misc = (volatile LAS unsigned*)(F.lds + LDS_MISC);
    if (F.tid < 64) misc[F.tid] = 0u;
    __syncthreads();
    XcdBarrier bar; bar.bar = (unsigned*)(args.ws + WS_CTL) + CW_BAR; bar.x = 0; bar.st = nullptr;
    if (!MK_PER_PHASE) bar = xcd_barrier_post((unsigned*)(args.ws + WS_CTL) + CW_BAR, misc + 8);
    const int lo = args.ph_lo, hi = args.ph_hi;
#ifndef MK_G4_FROM_U
#define MK_G4_FROM_U 0
#endif
#ifndef MK_G3B_FIRST
#define MK_G3B_FIRST false
#endif
#ifndef MK_MASK
#define MK_MASK 0x7ffff
#endif
#define EN(j) (((MK_MASK) >> (j)) & 1)
#ifndef MK_REP_MASK
#define MK_REP_MASK 0
#endif
#define REP(j) for (int rep_ = 0; rep_ < 1 + (((MK_REP_MASK) >> (j)) & 1); ++rep_)
#define IN(k) (lo <= (k) && (k) < hi)
#define FRESH_TID(t_) int t_; { int l_; asm volatile("v_mbcnt_lo_u32_b32 %0, -1, 0\n\tv_mbcnt_hi_u32_b32 %0, -1, %0" : "=v"(l_)); int wv_ = F.wave; asm volatile("" : "+s"(wv_)); t_ = wv_ * 64 + l_; }
#define FRESH(P) Frame P = F; { FRESH_TID(t_); P.tid = t_; P.lane = t_ & 63; unsigned char* w_ = args.ws; asm volatile("" : "+s"(w_)); P.ws = w_; int g_ = F.G, v_ = F.vcu, b_ = F.bx; asm volatile("" : "+s"(g_), "+s"(v_), "+s"(b_)); P.G = g_; P.vcu = v_; P.bx = b_; } unsigned char* ws = P.ws
#define SEAM(k) do { if (IN(k) && IN((k) + 1)) { FRESH_TID(tb_); xcd_barrier(bar, tb_ == 0); } } while (0)
    float* H = args.out;
    if (EN(15) && IN(0)) REP(15) { FRESH(P); (void)ws; p0_prologue(P, args); } SEAM(0);
#pragma unroll 1
    for (int l = 0; l < DEPTH; ++l) {
        const int p0 = 1 + NPH_L * l;
        const float* hin = (l == 0) ? args.in[I_X] : H;
#define MODP ((const float*)(ws + WS_MOD) + (size_t)l * 16 * 6144)
        if (EN(0) && IN(p0 + 0)) REP(0) { FRESH(P); norm_phase<false>(P, hin, args.in[I_N1G] + l * D, MODP + 1024, MODP + 0, (bf16*)(ws + WS_U), nullptr); }
        SEAM(p0 + 0);
        if (EN(1) && IN(p0 + 1)) REP(1) { FRESH(P); pg8::Gemm g{(const bf16*)(ws + WS_U), (const bf16*)(ws + WS_WIN) + (size_t)l * NSEC * D, D, nullptr}; pg8::StaticOrder S; S.init(T, NSEC, P.G, P.bx);
            EpiInProj E{ws}; pg8::gemm_phase<EpiInProj, pg8::StaticOrder, true, true, false>(P.lds, g, S, E, P.tid, P.wave); }
        SEAM(p0 + 1);
        if (EN(2) && IN(p0 + 2)) REP(2) { FRESH(P); (void)ws; rg_gate_phase(P, args, l); }
        SEAM(p0 + 2);
        if (EN(3) && IN(p0 + 3)) REP(3) { FRESH(P); (void)ws; if (EN(18)) REP(19) for (int u = P.vcu; u < 1024; u += P.G) scan_pass1(P, u); if (EN(17)) REP(20) for (int u = P.vcu; u < 1024; u += P.G) gla_prep(P, args, l, u); }
        SEAM(p0 + 3);
        if (EN(4) && IN(p0 + 4)) REP(4) { FRESH(P); (void)ws; for (int u = P.vcu; u < 160; u += P.G) { if (u < 128) { if (EN(17)) gla_rec(P, u); } else { if (EN(18)) scan_carry(P, u - 128); } } }
        SEAM(p0 + 4);
        if (EN(5) && IN(p0 + 5)) { FRESH(P); (void)ws; if (EN(18)) for (int u = P.vcu; u < 1024; u += P.G) scan_pass3(P, u); if (EN(17)) gla_norm(P, args, l); }
        SEAM(p0 + 5);
        if (EN(6) && IN(p0 + 6)) REP(6) {
            { FRESH(P); pg8::StaticOrder S; S.init(T, D, P.G, P.bx);
              pg8::Gemm g{(const bf16*)(ws + WS_IX), (const bf16*)(ws + WS_WA) + (size_t)l * D * D, D, nullptr}; EpiMerge<true> E{(const bf16*)(ws + WS_GA), (bf16*)(ws + WS_MBUF)};
              pg8::gemm_phase<EpiMerge<true>, pg8::StaticOrder, true, true, false>(P.lds, g, S, E, P.tid, P.wave); }
            { FRESH(P); pg8::StaticOrder S; S.init(T, D, P.G, P.bx);
              pg8::Gemm g{(const bf16*)(ws + WS_O), (const bf16*)(ws + WS_WB) + (size_t)l * D * D, D, nullptr}; EpiMerge<MK_G3B_FIRST> E{(const bf16*)(ws + WS_GB), (bf16*)(ws + WS_MBUF)};
              pg8::gemm_phase<EpiMerge<MK_G3B_FIRST>, pg8::StaticOrder, true, true, false>(P.lds, g, S, E, P.tid, P.wave); } }
        SEAM(p0 + 6);
        if (EN(7) && IN(p0 + 7)) { FRESH(P); pg8::StaticOrder S; S.init(T, D, P.G, P.bx);
            pg8::Gemm g{(const bf16*)(ws + (MK_G4_FROM_U == 1 ? WS_U : (MK_G4_FROM_U == 2 ? WS_XRPRE : (MK_G4_FROM_U == 3 ? WS_GB : (MK_G4_FROM_U == 4 ? WS_V : (MK_G4_FROM_U == 5 ? WS_GA : (MK_G4_FROM_U == 6 ? WS_OG : WS_MBUF))))))), (const bf16*)(ws + WS_WO) + (size_t)l * D * D, D, nullptr}; EpiRes E{hin, H, MODP + 2048};
            pg8::gemm_phase<EpiRes, pg8::StaticOrder, true, true, false>(P.lds, g, S, E, P.tid, P.wave); }
        SEAM(p0 + 7);
        if (EN(8) && IN(p0 + 8)) REP(8) { FRESH(P); norm_phase<false>(P, H, args.in[I_N2G] + l * D, MODP + 4096, MODP + 3072, (bf16*)(ws + WS_U), nullptr);
            for (int i = P.vcu * NTHR + P.tid; i < PMAX; i += P.G * NTHR) ((int*)(ws + WS_SORT))[i] = T; }
        SEAM(p0 + 8);
        if (EN(9) && IN(p0 + 9)) REP(9) { FRESH(P); pg8::StaticOrder S; S.init(T, 256, P.G, P.bx);
            pg8::Gemm g{(const bf16*)(ws + WS_U), (const bf16*)(ws + WS_ROUT) + (size_t)l * 256 * D, D, nullptr}; EpiLogit E{(float*)(ws + WS_LOGIT)};
            pg8::gemm_phase<EpiLogit, pg8::StaticOrder, true, true, false>(P.lds, g, S, E, P.tid, P.wave); }
        SEAM(p0 + 9);
        if (EN(10) && IN(p0 + 10)) { FRESH(P); (void)ws; topk_phase(P, args, l); }
        SEAM(p0 + 10);
        if (EN(11) && IN(p0 + 11)) REP(11) { FRESH(P); (void)ws; scatter_phase(P, l); }
        SEAM(p0 + 11);
        if (EN(12) && IN(p0 + 12)) REP(12) {
            { FRESH(P); moe_tiles(P, l); const LAS int* ts = (const LAS int*)(P.lds + LDS_TS);
              pg8::MoeOrder S{ts, 2, P.G, P.vcu, ts[NE] * 2};
              pg8::Gemm g{(const bf16*)(ws + WS_U), (const bf16*)(ws + WS_EGU) + (size_t)l * NE * 512 * D, D, (const int*)(ws + WS_SORT)}; EpiGlu E{(bf16*)(ws + WS_ACT)};
              pg8::gemm_phase<EpiGlu, pg8::MoeOrder, true, true, true>(P.lds, g, S, E, P.tid, P.wave); }
            { FRESH(P); pg8::StaticOrder S; S.init(T, 512, P.G, P.bx);
              pg8::Gemm g{(const bf16*)(ws + WS_U), (const bf16*)(ws + WS_SGU) + (size_t)l * 512 * D, D, nullptr}; EpiGlu E{(bf16*)(ws + WS_ACTS)};
              pg8::gemm_phase<EpiGlu, pg8::StaticOrder, true, true, false>(P.lds, g, S, E, P.tid, P.wave); } }
        SEAM(p0 + 12);
        if (EN(13) && IN(p0 + 13)) {
            REP(21) { FRESH(P); moe_tiles(P, l); const LAS int* ts = (const LAS int*)(P.lds + LDS_TS);
              pg8::MoeOrder S{ts, 4, P.G, P.vcu, ts[NE] * 4};
              pg8::Gemm g{(const bf16*)(ws + WS_ACT), (const bf16*)(ws + WS_EDN) + (size_t)l * NE * D * DE, DE, nullptr}; EpiY E{ws + WS_Y};
              pg8::gemm_phase<EpiY, pg8::MoeOrder, true, true, false>(P.lds, g, S, E, P.tid, P.wave); }
            { FRESH(P); pg8::StaticOrder S; S.init(T, D, P.G, P.bx);
              pg8::Gemm g{(const bf16*)(ws + WS_ACTS), (const bf16*)(ws + WS_SDN) + (size_t)l * D * DE, DE, nullptr}; EpiRes E{H, H, MODP + 5120};
              pg8::gemm_phase<EpiRes, pg8::StaticOrder, true, true, false>(P.lds, g, S, E, P.tid, P.wave); } }
        SEAM(p0 + 13);
        if (EN(14) && IN(p0 + 14)) { FRESH(P); combine_phase(P, H, MODP + 5120); }
        SEAM(p0 + 14);
    }
    if (EN(16) && IN(NPHASE - 1)) { FRESH(P); (void)ws; norm_phase<true>(P, H, args.in[I_FG], nullptr, nullptr, nullptr, H); }
#undef MODP
#undef IN
#undef SEAM
}

#ifndef MK_SKIP_LO
#define MK_SKIP_LO 0
#define MK_SKIP_HI 0
#endif
#ifndef MK_NLAUNCH
#define MK_NLAUNCH NPHASE
#endif
extern "C" void kernel_launch(void* const* d_in, const int* in_sizes, int n_in, void* d_out, int out_size, void* d_ws, size_t ws_size, hipStream_t stream) {
    static int grid = 0;
    if (grid == 0) {
        if (n_in != N_INPUTS || out_size != T * D || ws_size < WS_END) { fprintf(stderr, "kernel_launch: unexpected problem shape (n_in %d out %d ws %zu, need %zu)\n", n_in, out_size, ws_size, (size_t)WS_END); grid = -1; return; }
        int dev = 0, cus = 0, per_cu = 0;
        if (hipGetDevice(&dev) != hipSuccess || hipDeviceGetAttribute(&cus, hipDeviceAttributeMultiprocessorCount, dev) != hipSuccess) { grid = -1; return; }
        if (hipFuncSetAttribute((const void*)mk_fwd, hipFuncAttributeMaxDynamicSharedMemorySize, LDS_BYTES) != hipSuccess) { fprintf(stderr, "kernel_launch: hipFuncSetAttribute failed\n"); grid = -1; return; }
        if (hipOccupancyMaxActiveBlocksPerMultiprocessor(&per_cu, (const void*)mk_fwd, NTHR, LDS_BYTES) != hipSuccess || per_cu < 1) { fprintf(stderr, "kernel_launch: occupancy query says %d\n", per_cu); }
        (void)hipGetLastError();
        grid = cus;
    }
    if (grid < 0) return;
    if (hipMemsetAsync((char*)d_ws + WS_CTL, 0, CTL_ZERO_BYTES, stream) != hipSuccess) return;
    Args a{};
    for (int i = 0; i < N_INPUTS; ++i) a.in[i] = (const float*)d_in[i];
    a.out = (float*)d_out; a.ws = (unsigned char*)d_ws;
#if MK_PER_PHASE
    for (int p = 0; p < MK_NLAUNCH; ++p) { if (p >= MK_SKIP_LO && p < MK_SKIP_HI) continue; a.ph_lo = p; a.ph_hi = p + 1; hipLaunchKernelGGL(mk_fwd, dim3(grid), dim3(NTHR), LDS_BYTES, stream, a); }
#else
    a.ph_lo = 0; a.ph_hi = NPHASE; hipLaunchKernelGGL(mk_fwd, dim3(grid), dim3(NTHR), LDS_BYTES, stream, a);
#endif
}
```

```cpp
#include <hip/hip_runtime.h>
#include <cstdio>
#include <cstdint>

#ifndef MK_PER_PHASE
#define MK_PER_PHASE 0
#define MK_SCAN3_NEW 1
#ifndef MK_FP8_EXP1_FROM
#define MK_FP8_EXP1_FROM 0
#endif
#ifndef MK_RG_LIGHT
#define MK_RG_LIGHT 4
#endif
#endif

namespace pg8 {
#define PG8_LAS __attribute__((address_space(3)))
typedef unsigned short bf16_t;
typedef short bf16x8 __attribute__((ext_vector_type(8)));
typedef float f32x4 __attribute__((ext_vector_type(4)));
typedef unsigned u32x4 __attribute__((ext_vector_type(4)));
constexpr int BM = 256, BK = 64, HALF = 128, HTB = HALF * BK * 2, STAGE_BYTES = 8 * HTB, NXCD = 8, WGM = 8;

__host__ __device__ __forceinline__ int lds_byte(int r, int c) { const int st = (r >> 4) * 2 + (c >> 5), rr = r & 15, cc = c & 31, ob = rr * 64 + cc * 2; return st * 1024 + (ob ^ (((ob >> 9) & 1) << 5)); }
__host__ __device__ __forceinline__ void stage_rc(int b, int& R, int& C) { const int st = b / 1024, sb = b % 1024, swz = sb ^ (((sb >> 9) & 1) << 5); R = (st >> 1) * 16 + swz / 64; C = (st & 1) * 32 + (swz % 64) / 2; }
__host__ __device__ __forceinline__ int perm32(int rho) { const int n = rho >> 4, i = rho & 15; return 8 * (i >> 2) + 4 * n + (i & 3); }

struct Unit { int pm, pn; };
struct Gemm { const bf16_t* A; const bf16_t* Bt; int K; const int* rowidx; };

struct StaticOrder {
    int nM, nN, nwg, G, c;
    __host__ __device__ void init(int M, int N, int G_, int c_) { nM = M / BM; nN = N / BM; nwg = nM * nN; G = G_; c = c_; }
    __host__ __device__ bool next(int i, Unit& u) const {
        const long L = (long)i * G + c; if (L >= nwg) return false;
        int wgid = (int)L; { const int q = nwg / NXCD, r = nwg % NXCD, xcd = wgid % NXCD, off = wgid / NXCD; wgid = (xcd < r ? xcd * (q + 1) : r * (q + 1) + (xcd - r) * q) + off; }
        const int nig = WGM * nN, gid = wgid / nig, fm = gid * WGM, gsz = (nM - fm) < WGM ? (nM - fm) : WGM;
        u.pm = fm + ((wgid % nig) % gsz); u.pn = (wgid % nig) / gsz; return true;
    }
};
struct PanelOrder {
    int pm, nN;
    __device__ __forceinline__ bool next(int i, Unit& u) const { if (i >= nN) return false; u.pm = pm; u.pn = i; return true; }
};
struct MoeOrder {
    const PG8_LAS int* ts; int npn, G, c, total;
    __device__ __forceinline__ bool next(int i, Unit& u) const {
        const int L = i * G + c; if (L >= total) return false;
        const int tile = L / npn, j = L - tile * npn;
        int lo = 0, hi = 128;
        while (hi - lo > 1) { const int mid = (lo + hi) >> 1; if (ts[mid] <= tile) lo = mid; else hi = mid; }
        u.pm = tile; u.pn = lo * npn + j; return true;
    }
};

__device__ __forceinline__ unsigned cvt_pk_bf16(float lo, float hi) { typedef __bf16 bf2_t __attribute__((ext_vector_type(2))); typedef float f2_t __attribute__((ext_vector_type(2)));
    return __builtin_bit_cast(unsigned, __builtin_convertvector((f2_t){lo, hi}, bf2_t)); }

template <class Epi, class Sched, bool ALIGN_EPI, bool SP2, bool GATHER, bool FP8 = false>
__device__ __forceinline__ void gemm_phase(PG8_LAS unsigned char* lds, const Gemm g, const Sched& S, const Epi& E, const int tid, const int wid) {
    const int lane = tid & 63, wr = wid >> 2, wc = wid & 3, fr = lane & 15, fq = lane >> 4;
    const int K = g.K, nt = K / BK;
    unsigned voffA[2], voffB[2];
#pragma unroll
    for (int i = 0; i < 2; ++i) { int R, C; stage_rc(tid * 16 + i * 8192, R, C); const int Rb = (R & ~31) + perm32(R & 31);
        voffA[i] = (unsigned)(R * K + C) * 2u; voffB[i] = (unsigned)(Rb * K + C) * 2u; }
    const size_t kstep = (size_t)(BK * 2);
    const size_t hstep = (size_t)HALF * K * 2;
    const size_t tstep = 2 * hstep;
    const unsigned ldsw = (unsigned)wid * 1024u;
    const int aoff = lds_byte(wr * 64 + fr, fq * 8), boff = lds_byte(wc * 32 + fr, fq * 8);
    unsigned gc[2][2], gn[2][2];
#define PG8_SA(b, h) (((b) * 2 + (h)) * HTB)
#define PG8_SB(b, h) ((4 + (b) * 2 + (h)) * HTB)
#define PG8_STAGE(bufoff, gbase, voff) do { _Pragma("unroll") for (int _i = 0; _i < 2; ++_i) \
        __builtin_amdgcn_global_load_lds((const unsigned*)((const char*)(gbase) + (voff)[_i]), (PG8_LAS unsigned*)(lds + (bufoff) + ldsw + _i * 8192), 16, 0, 0); } while (0)
#define PG8_STAGE_A(bufoff, kb, h, NX) do { if constexpr (GATHER) { _Pragma("unroll") for (int _i = 0; _i < 2; ++_i) { const unsigned _o = (NX) ? gn[h][_i] : gc[h][_i]; \
        __builtin_amdgcn_global_load_lds((const unsigned*)((const char*)(kb) + _o), (PG8_LAS unsigned*)(lds + (bufoff) + ldsw + _i * 8192), 16, 0, 0); } } \
        else { PG8_STAGE(bufoff, (const char*)(kb) + ((h) ? hstep : (size_t)0), voffA); } } while (0)
#define PG8_LD32(dst, off) do { const v4i_ lo_ = *(const PG8_LAS v4i_*)(lds + (off)), hi_ = *(const PG8_LAS v4i_*)(lds + (off) + 1024); dst = __builtin_shufflevector(lo_, hi_, 0, 1, 2, 3, 4, 5, 6, 7); } while (0)
#define PG8_LDA(dst, b, h) do { if constexpr (FP8) { _Pragma("unroll") for (int m = 0; m < 4; ++m) PG8_LD32(dst##8[m], PG8_SA(b, h) + aoff + m * 2048); } \
        else { _Pragma("unroll") for (int m = 0; m < 4; ++m) _Pragma("unroll") for (int k = 0; k < 2; ++k) dst[m][k] = *(const PG8_LAS bf16x8*)(lds + PG8_SA(b, h) + aoff + m * 2048 + k * 1024); } } while (0)
#define PG8_LDB(dst, b, h) do { if constexpr (FP8) { _Pragma("unroll") for (int n = 0; n < 2; ++n) PG8_LD32(dst##8[n], PG8_SB(b, h) + boff + n * 2048); } \
        else { _Pragma("unroll") for (int n = 0; n < 2; ++n) _Pragma("unroll") for (int k = 0; k < 2; ++k) dst[n][k] = *(const PG8_LAS bf16x8*)(lds + PG8_SB(b, h) + boff + n * 2048 + k * 1024); } } while (0)
#define PG8_MMA(ai, bj, At, Bt) do { __builtin_amdgcn_s_setprio(1); if constexpr (FP8) { _Pragma("unroll") for (int m = 0; m < 4; ++m) _Pragma("unroll") for (int n = 0; n < 2; ++n) \
        asm volatile("v_mfma_scale_f32_16x16x128_f8f6f4 %0, %1, %2, %0, %3, %4 op_sel_hi:[0,0,0]" : "+v"(acc[ai][bj][m][n]) : "v"(Bt##8[n]), "v"(At##8[m]), "v"(0x79797979), "v"(0x7F7F7F7F)); } \
    else { _Pragma("unroll") for (int m = 0; m < 4; ++m) _Pragma("unroll") for (int n = 0; n < 2; ++n) _Pragma("unroll") for (int k = 0; k < 2; ++k) \
        acc[ai][bj][m][n] = __builtin_amdgcn_mfma_f32_16x16x32_bf16(Bt[n][k], At[m][k], acc[ai][bj][m][n], 0, 0, 0); } __builtin_amdgcn_s_setprio(0); } while (0)
#define PG8_WAIT_V(n) asm volatile("s_waitcnt vmcnt(" #n ")" ::: "memory")
#define PG8_WAIT_L(n) asm volatile("s_waitcnt lgkmcnt(" #n ")" ::: "memory")
#define PG8_BAR __builtin_amdgcn_s_barrier()
#define PG8_SCHED __builtin_amdgcn_sched_barrier(0)
#define PG8_LOAD_ROWS(dst, un) do { int _ln; asm volatile("v_mbcnt_lo_u32_b32 %0, -1, 0\n\tv_mbcnt_hi_u32_b32 %0, -1, %0" : "=v"(_ln)); const int _t = wid * 64 + _ln; \
        _Pragma("unroll") for (int _i = 0; _i < 2; ++_i) { int _R, _C; stage_rc(_t * 16 + _i * 8192, _R, _C); _Pragma("unroll") for (int _h = 0; _h < 2; ++_h) { \
        const int _tok = ((const __attribute__((address_space(1))) int*)g.rowidx)[(un).pm * BM + _h * HALF + _R]; dst[_h][_i] = (unsigned)_tok * (unsigned)(K * 2) + (unsigned)_C * 2u; } } } while (0)
#define PG8_ROWS_ISSUE(tk, un) do { int _ln; asm volatile("v_mbcnt_lo_u32_b32 %0, -1, 0\n\tv_mbcnt_hi_u32_b32 %0, -1, %0" : "=v"(_ln)); const int _t = wid * 64 + _ln; \
        _Pragma("unroll") for (int _i = 0; _i < 2; ++_i) { int _R, _C; stage_rc(_t * 16 + _i * 8192, _R, _C); _Pragma("unroll") for (int _h = 0; _h < 2; ++_h) \
        tk[_h][_i] = ((const __attribute__((address_space(1))) int*)g.rowidx)[(un).pm * BM + _h * HALF + _R]; } } while (0)
#define PG8_ROWS_FINISH(dst, tk) do { int _ln; asm volatile("v_mbcnt_lo_u32_b32 %0, -1, 0\n\tv_mbcnt_hi_u32_b32 %0, -1, %0" : "=v"(_ln)); const int _t = wid * 64 + _ln; \
        _Pragma("unroll") for (int _i = 0; _i < 2; ++_i) { int _R, _C; stage_rc(_t * 16 + _i * 8192, _R, _C); _Pragma("unroll") for (int _h = 0; _h < 2; ++_h) \
        dst[_h][_i] = (unsigned)tk[_h][_i] * (unsigned)(K * 2) + (unsigned)_C * 2u; } } while (0)
    Unit cur, nxt, nx2; int ui = 0;
    if (!S.next(0, cur)) return;
    bool has_next = S.next(1, nxt);
    f32x4 acc[2][2][4][2];
#pragma unroll
    for (int a = 0; a < 2; ++a)
#pragma unroll
        for (int b = 0; b < 2; ++b)
#pragma unroll
            for (int m = 0; m < 4; ++m)
#pragma unroll
                for (int n = 0; n < 2; ++n) acc[a][b][m][n] = (f32x4){0.f, 0.f, 0.f, 0.f};
    bf16x8 At[4][2], B0[2][2], B1[2][2];
    typedef int v4i_ __attribute__((ext_vector_type(4))); typedef int v8i_ __attribute__((ext_vector_type(8)));
    v8i_ At8[4], B08[2], B18[2];
    const char* cA = GATHER ? (const char*)g.A : (const char*)g.A + (size_t)cur.pm * tstep; const char* cB = (const char*)g.Bt + (size_t)cur.pn * tstep;
    if constexpr (GATHER) { PG8_LOAD_ROWS(gc, cur); if (has_next) { PG8_LOAD_ROWS(gn, nxt); } else {
#pragma unroll
        for (int _h = 0; _h < 2; ++_h)
#pragma unroll
            for (int _i = 0; _i < 2; ++_i) gn[_h][_i] = gc[_h][_i]; } }
    if constexpr (SP2) {
        PG8_STAGE(PG8_SB(0, 0), cB, voffB); PG8_STAGE(PG8_SB(0, 1), cB + hstep, voffB); PG8_STAGE_A(PG8_SA(0, 0), cA, 0, false); PG8_STAGE_A(PG8_SA(0, 1), cA, 1, false);
        if (wr == 1) PG8_BAR;
        PG8_WAIT_V(2); PG8_BAR;
        PG8_STAGE(PG8_SB(1, 0), cB + kstep, voffB); PG8_STAGE_A(PG8_SA(1, 0), cA + kstep, 0, false); PG8_STAGE(PG8_SB(1, 1), cB + hstep + kstep, voffB);
        PG8_WAIT_V(6); PG8_BAR;
    } else {
        PG8_STAGE(PG8_SB(0, 0), cB, voffB); PG8_STAGE_A(PG8_SA(0, 0), cA, 0, false); PG8_STAGE(PG8_SB(0, 1), cB + hstep, voffB); PG8_STAGE_A(PG8_SA(0, 1), cA, 1, false);
        if (wr == 1) PG8_BAR;
        PG8_WAIT_V(4); PG8_BAR;
        PG8_STAGE(PG8_SB(1, 0), cB + kstep, voffB); PG8_STAGE_A(PG8_SA(1, 0), cA + kstep, 0, false); PG8_STAGE(PG8_SB(1, 1), cB + hstep + kstep, voffB);
        PG8_WAIT_V(6); PG8_BAR;
    }
    for (;;) {
        const char* nA = GATHER ? (const char*)g.A : (has_next ? (const char*)g.A + (size_t)nxt.pm * tstep : cA); const char* nB = has_next ? (const char*)g.Bt + (size_t)nxt.pn * tstep : cB;
#pragma unroll 1
        for (int t = 0; t < nt; t += 2) {
            const bool last = (t == nt - 2);
            const char* a1 = cA + (size_t)(t + 1) * kstep;
            const char* a2 = last ? nA : cA + (size_t)(t + 2) * kstep; const char* b2 = last ? nB : cB + (size_t)(t + 2) * kstep;
            const char* a3 = a2 + kstep; const char* b3 = b2 + kstep;
            if constexpr (SP2) {
            PG8_LDB(B0, 0, 0); PG8_LDB(B1, 0, 1); PG8_SCHED; PG8_LDA(At, 0, 0); PG8_STAGE_A(PG8_SA(1, 1), a1, 1, false);
            PG8_WAIT_V(8); PG8_WAIT_L(0); PG8_BAR; PG8_MMA(0, 0, At, B0); PG8_MMA(0, 1, At, B1); PG8_BAR; PG8_SCHED;
            PG8_LDA(At, 0, 1); PG8_STAGE(PG8_SB(0, 0), b2, voffB); PG8_STAGE(PG8_SB(0, 1), b2 + hstep, voffB); PG8_STAGE_A(PG8_SA(0, 0), a2, 0, last);
            PG8_WAIT_V(8); PG8_WAIT_L(0); PG8_BAR; PG8_MMA(1, 0, At, B0); PG8_MMA(1, 1, At, B1); PG8_BAR; PG8_SCHED;
            PG8_LDB(B0, 1, 0); PG8_LDB(B1, 1, 1); PG8_SCHED; PG8_LDA(At, 1, 0); PG8_STAGE_A(PG8_SA(0, 1), a2, 1, last);
            PG8_WAIT_V(8); PG8_WAIT_L(0); PG8_BAR; PG8_MMA(0, 0, At, B0); PG8_MMA(0, 1, At, B1); PG8_BAR; PG8_SCHED;
            PG8_LDA(At, 1, 1); PG8_STAGE(PG8_SB(1, 0), b3, voffB); PG8_STAGE(PG8_SB(1, 1), b3 + hstep, voffB); PG8_STAGE_A(PG8_SA(1, 0), a3, 0, last);
            PG8_WAIT_V(8); PG8_WAIT_L(0); PG8_BAR; PG8_MMA(1, 0, At, B0); PG8_MMA(1, 1, At, B1); PG8_BAR; PG8_SCHED;
            } else {
            PG8_LDB(B0, 0, 0); PG8_SCHED; PG8_LDA(At, 0, 0); PG8_STAGE_A(PG8_SA(1, 1), a1, 1, false);
            PG8_WAIT_L(8); PG8_BAR; PG8_WAIT_L(0); PG8_MMA(0, 0, At, B0); PG8_BAR; PG8_SCHED;
            PG8_LDB(B1, 0, 1); PG8_STAGE(PG8_SB(0, 0), b2, voffB);
            PG8_BAR; PG8_WAIT_L(0); PG8_MMA(0, 1, At, B1); PG8_BAR;
            PG8_LDA(At, 0, 1); PG8_STAGE_A(PG8_SA(0, 0), a2, 0, last);
            PG8_BAR; PG8_WAIT_L(0); PG8_MMA(1, 0, At, B0); PG8_BAR; PG8_SCHED;
            PG8_STAGE(PG8_SB(0, 1), b2 + hstep, voffB);
            PG8_WAIT_V(6); PG8_BAR; PG8_MMA(1, 1, At, B1); PG8_BAR;
            PG8_LDB(B0, 1, 0); PG8_SCHED; PG8_LDA(At, 1, 0); PG8_STAGE_A(PG8_SA(0, 1), a2, 1, last);
            PG8_WAIT_L(8); PG8_BAR; PG8_WAIT_L(0); PG8_MMA(0, 0, At, B0); PG8_BAR; PG8_SCHED;
            PG8_LDB(B1, 1, 1); PG8_STAGE(PG8_SB(1, 0), b3, voffB);
            PG8_BAR; PG8_WAIT_L(0); PG8_MMA(0, 1, At, B1); PG8_BAR;
            PG8_LDA(At, 1, 1); PG8_STAGE_A(PG8_SA(1, 0), a3, 0, last);
            PG8_BAR; PG8_WAIT_L(0); PG8_MMA(1, 0, At, B0); PG8_BAR; PG8_SCHED;
            PG8_STAGE(PG8_SB(1, 1), b3 + hstep, voffB);
            PG8_WAIT_V(6); PG8_BAR; PG8_MMA(1, 1, At, B1); PG8_BAR;
            }
        }
        const bool has_nx2 = has_next && S.next(ui + 2, nx2);
        int tk[2][2];
        if constexpr (GATHER) { if (has_nx2) { PG8_ROWS_ISSUE(tk, nx2); } }
        if constexpr (ALIGN_EPI) { if (wr == 0) PG8_BAR; }
        if constexpr (FP8) asm volatile("s_nop 15\n\ts_nop 15" ::: "memory");
        E(acc, cur, wr, wc, fr, fq);
        if (!has_next) break;
#pragma unroll
        for (int a = 0; a < 2; ++a)
#pragma unroll
            for (int b = 0; b < 2; ++b)
#pragma unroll
                for (int m = 0; m < 4; ++m)
#pragma unroll
                    for (int n = 0; n < 2; ++n) acc[a][b][m][n] = (f32x4){0.f, 0.f, 0.f, 0.f};
        cur = nxt; cA = nA; cB = nB; ++ui;
        if constexpr (GATHER) {
#pragma unroll
            for (int _h = 0; _h < 2; ++_h)
#pragma unroll
                for (int _i = 0; _i < 2; ++_i) gc[_h][_i] = gn[_h][_i];
            if (has_nx2) { PG8_ROWS_FINISH(gn, tk); } }
        nxt = nx2; has_next = has_nx2;
        if constexpr (ALIGN_EPI) { if (wr == 1) PG8_BAR; }
    }
    PG8_WAIT_V(0);
    if constexpr (!ALIGN_EPI) { if (wr == 0) PG8_BAR; }
    PG8_BAR;
#undef PG8_SA
#undef PG8_SB
#undef PG8_STAGE
#undef PG8_STAGE_A
#undef PG8_LDA
#undef PG8_LD32
#undef PG8_LDB
#undef PG8_MMA
#undef PG8_WAIT_V
#undef PG8_ROWS_ISSUE
#undef PG8_ROWS_FINISH
#undef PG8_WAIT_L
#undef PG8_BAR
#undef PG8_SCHED
#undef PG8_LOAD_ROWS
}
}

constexpr int NWAVES = 8, NTHR = 512;
constexpr int D = 1024, BATCH = 16, SEQ = 4096, T = BATCH * SEQ, DEPTH = 2;
constexpr int CHUNK = 64, NCH = SEQ / CHUNK;
constexpr int NSEC = 7168;
constexpr int N_IN = 7184;
constexpr int NE = 128, TOPK = 8, DE = 256;
constexpr int PMAX = T * TOPK + NE * 256;
constexpr float EPS = 1e-6f;

constexpr size_t MiB = 1u << 20;
constexpr size_t WS_CTL = 0, CTL_ZERO_BYTES = 1 * MiB;
constexpr size_t WS_MOD = 1 * MiB;
constexpr size_t WS_WLR = 2 * MiB;
constexpr size_t WS_RGW = 3 * MiB;
constexpr size_t WS_WIN8 = 4 * MiB;
constexpr size_t WS_WA = 32 * MiB, WS_WB = 36 * MiB, WS_WO = 40 * MiB;
constexpr size_t WS_ROUT = 44 * MiB;
constexpr size_t WS_SGU = 45 * MiB;
constexpr size_t WS_SDN = 47 * MiB;
constexpr size_t WS_EGU = 48 * MiB;
constexpr size_t WS_EDN = 304 * MiB;
constexpr size_t WS_U = 432 * MiB;
constexpr size_t WS_SP = 561 * MiB, WS_SE = 565 * MiB, WS_CIN = 569 * MiB;
constexpr size_t WS_TOT = 573 * MiB;
constexpr size_t WS_PK = 575 * MiB;
constexpr size_t WS_POS = 577 * MiB;
constexpr size_t WS_WTS = 579 * MiB;
constexpr size_t WS_SORT = 581 * MiB;
constexpr size_t WS_BIG = 592 * MiB;
constexpr size_t WS_XRPRE = WS_BIG + 192 * MiB, WS_RG = WS_BIG + 128 * MiB, WS_Q = WS_BIG + 256 * MiB, WS_K = WS_BIG + 320 * MiB, WS_V = WS_BIG + 384 * MiB,
                 WS_OG = WS_BIG + 512 * MiB, WS_GA = WS_BIG + 640 * MiB, WS_GB = WS_BIG + 768 * MiB, WS_LOGA = WS_BIG + 896 * MiB, WS_IX = WS_BIG + 1024 * MiB,
                 WS_KDEC = WS_BIG + 1152 * MiB;
constexpr size_t WS_U8 = WS_BIG + 960 * MiB;
constexpr size_t WS_O = WS_BIG;
constexpr size_t WS_MBUF = WS_LOGA;
constexpr size_t WS_Y = WS_BIG;
constexpr size_t WS_YS = WS_BIG + 544 * MiB;
constexpr size_t WS_LOGIT = WS_BIG + 1392 * MiB;
constexpr size_t WS_ACT = WS_BIG + 672 * MiB;
constexpr size_t WS_H = WS_BIG + 1216 * MiB;
constexpr size_t WS_ACTS = WS_BIG + 1360 * MiB;
constexpr size_t WS_END = WS_BIG + 1424 * MiB;
static_assert((size_t)PMAX * 1024 <= 544 * MiB && (size_t)PMAX * 256 * 2 <= 272 * MiB && WS_KDEC + 64 * MiB <= WS_H && WS_H + 128 * MiB <= WS_ACTS && WS_ACT + 272 * MiB <= WS_H && WS_YS + 128 * MiB <= WS_ACT, "ws map");
constexpr int CW_TMO = 0;
constexpr int CW_BAR = 4096;
constexpr int CW_CNT = 8192;

constexpr int RING_BYTES = 131072;
constexpr int LDS_TS = RING_BYTES;
constexpr int LDS_MISC = RING_BYTES + 1024;
constexpr int LDS_BYTES = 147456;

#define GAS __attribute__((address_space(1)))
#define LAS __attribute__((address_space(3)))
typedef unsigned short bf16;
typedef unsigned v4u __attribute__((ext_vector_type(4)));
typedef unsigned v2u __attribute__((ext_vector_type(2)));
typedef float f32x4 __attribute__((ext_vector_type(4)));
typedef float f32x16 __attribute__((ext_vector_type(16)));
typedef short bf16x8 __attribute__((ext_vector_type(8)));
typedef short s16x4 __attribute__((ext_vector_type(4)));
typedef GAS unsigned gu32;
#define RLX_AGENT __ATOMIC_RELAXED, __HIP_MEMORY_SCOPE_AGENT
#define LDS_WAIT() asm volatile("s_waitcnt lgkmcnt(0)" ::: "memory")
__device__ __forceinline__ unsigned f2bf(float f) { return (unsigned)__builtin_bit_cast(unsigned short, (__bf16)f); }
__device__ __forceinline__ unsigned pk2(float lo, float hi) { return pg8::cvt_pk_bf16(lo, hi); }
__device__ __forceinline__ float bflo(unsigned w) { return __builtin_bit_cast(float, w << 16); }
__device__ __forceinline__ float bfhi(unsigned w) { return __builtin_bit_cast(float, w & 0xffff0000u); }
__device__ __forceinline__ float bf2f(bf16 b) { return __builtin_bit_cast(float, (unsigned)b << 16); }
__device__ __forceinline__ float fsigmoid(float x) { return __builtin_amdgcn_rcpf(1.0f + __builtin_amdgcn_exp2f(-1.442695041f * x)); }
__device__ __forceinline__ float fsilu(float x) { return x * fsigmoid(x); }
__device__ __forceinline__ float fgelu_tanh(float x) { return x * fsigmoid(1.5957691216f * (x + 0.044715f * x * x * x)); }

#define XB_TMO      128
#define XB_XCNT(j)  (256  + 64 * (j))
#define XB_XSUB(j)  (1280 + 64 * (j))
#define XB_XGEN(j)  (2304 + 64 * (j))
#define XB_TOP      3328
#define XB_TOPGEN   3392
#define XCD_BAR_WORDS 3456
#define XB_SPIN_CAP (1u << 18)
__device__ __forceinline__ unsigned xb_ld(unsigned* p)              { return __hip_atomic_load(p, __ATOMIC_RELAXED, __HIP_MEMORY_SCOPE_AGENT); }
__device__ __forceinline__ unsigned xb_add(unsigned* p, unsigned v) { return __hip_atomic_fetch_add(p, v, __ATOMIC_RELAXED, __HIP_MEMORY_SCOPE_AGENT); }
__device__ __forceinline__ unsigned xb_xcc_id() { return (unsigned)__builtin_amdgcn_s_getreg((3 << 11) | 20) & 0xFu; }
#define XB_SPIN(cond, bar) do { unsigned _sp = 0; while (cond) { __builtin_amdgcn_s_sleep(1); \
    if ((++_sp & 255u) == 0u) { if (xb_ld(&(bar)[XB_TMO])) break; if (_sp > XB_SPIN_CAP) { atomicAdd(&(bar)[XB_TMO], 1u); break; } } } } while (0)
struct XcdBarrier { unsigned* bar; unsigned x; volatile LAS unsigned* st; };
__device__ __forceinline__ XcdBarrier xcd_barrier_post(unsigned* bar, volatile LAS unsigned* st) {
    XcdBarrier b; b.bar = bar; b.x = xb_xcc_id(); b.st = st;
    if (threadIdx.x == 0) (void)xb_add(&bar[XB_XCNT(b.x)], 1u);
    return b;
}
__device__ __forceinline__ void xcd_barrier_complete(unsigned* bar, unsigned x, unsigned& nloc, unsigned& nx) {
    const unsigned G = gridDim.x * gridDim.y * gridDim.z;
    unsigned sum, cnt, mine, sp = 0u;
    for (;;) {
        sum = 0u; cnt = 0u; mine = 0u;
#pragma unroll
        for (unsigned j = 0; j < 16; ++j) { const unsigned c = xb_ld(&bar[XB_XCNT(j)]); sum += c; cnt += (c > 0u) ? 1u : 0u; mine = (j == x) ? c : mine; }
        if (sum == G) break;
        __builtin_amdgcn_s_sleep(1);
        if ((++sp & 255u) == 0u) { if (xb_ld(&bar[XB_TMO])) break; if (sp > XB_SPIN_CAP) { atomicAdd(&bar[XB_TMO], 1u); break; } }
    }
    nloc = mine > 0u ? mine : 1u; nx = cnt > 0u ? cnt : 1u;
}
__device__ __forceinline__ void xcd_barrier(const XcdBarrier& b, const bool leader) {
    asm volatile("s_waitcnt vmcnt(0)" ::: "memory");
    __syncthreads();
    if (leader) {
        unsigned* bar = b.bar;
        __builtin_amdgcn_s_waitcnt(0);
        unsigned nloc = b.st[0], nx = b.st[1];
        if (nloc == 0u) { xcd_barrier_complete(bar, b.x, nloc, nx); b.st[0] = nloc; b.st[1] = nx; }
        const unsigned old = xb_add(&bar[XB_XSUB(b.x)], 1u);
        const unsigned gen = old / nloc;
        if (old + 1u == (gen + 1u) * nloc) {
            __builtin_amdgcn_fence(__ATOMIC_RELEASE, "agent");
            asm volatile("s_waitcnt vmcnt(0)" ::: "memory");
            const unsigned og = xb_add(&bar[XB_TOP], 1u);
            const unsigned tg = og / nx;
            if (og + 1u == (tg + 1u) * nx) xb_add(&bar[XB_TOPGEN], 1u);
            else XB_SPIN(xb_ld(&bar[XB_TOPGEN]) == tg, bar);
            __builtin_amdgcn_fence(__ATOMIC_ACQUIRE, "agent");
            xb_add(&bar[XB_XGEN(b.x)], 1u);
            asm volatile("s_waitcnt vmcnt(0)" ::: "memory");
        } else {
            XB_SPIN(xb_ld(&bar[XB_XGEN(b.x)]) == gen, bar);
            __builtin_amdgcn_fence(__ATOMIC_ACQUIRE, "agent");
            asm volatile("s_waitcnt vmcnt(0)" ::: "memory");
        }
    }
    __syncthreads();
}

enum In { I_X = 0, I_C, I_ADAW, I_ADAB, I_N1G, I_WIN, I_CONVW, I_CONVB, I_RGWA, I_RGBA, I_RGWX, I_RGBX, I_RGLAM, I_GWUP, I_GBUP, I_GNG, I_WBA, I_WBB, I_WOUT, I_N2G,
          I_RW, I_RB, I_EGU, I_EDN, I_SGU, I_SDN, I_FG, N_INPUTS };
struct Args { const float* in[N_INPUTS]; float* out; unsigned char* ws; int ph_lo, ph_hi; };
struct Frame { LAS unsigned char* lds; unsigned char* ws; int tid, lane, wave, vcu, G, bx; };

__device__ __forceinline__ unsigned pk4_fp8(float a, float b, float c, float d) { int w = __builtin_amdgcn_cvt_pk_fp8_f32(a, b, 0, false); return (unsigned)__builtin_amdgcn_cvt_pk_fp8_f32(c, d, w, true); }
__device__ __forceinline__ float wave_sum(float v, int lane) {
#pragma unroll
    for (int o = 1; o < 64; o <<= 1) v += __builtin_bit_cast(float, __builtin_amdgcn_ds_bpermute((lane ^ o) << 2, __builtin_bit_cast(int, v)));
    return v;
}

template <class RowP>
__device__ __forceinline__ void conv_item(const float* W, int K, int N, LAS float* scr, int item, int lane, RowP rowp) {
    const int nblk = (N + 31) / 32, kb = item / nblk, nb = item % nblk, k0 = 64 * kb, n0 = 32 * nb;
    const int cl = n0 + (lane & 31); const bool okc = cl < N;
#pragma unroll 8
    for (int i = 0; i < 32; ++i) { const int kk = 2 * i + (lane >> 5); scr[kk * 33 + (lane & 31)] = okc ? W[(size_t)(k0 + kk) * N + cl] : 0.f; }
    LDS_WAIT(); asm volatile("" ::: "memory");
    const int c = lane & 7;
#pragma unroll
    for (int j = 0; j < 4; ++j) { const int n = (lane >> 3) + 8 * j; const LAS float* s = scr + (8 * c) * 33 + n;
        v4u o; o.x = pk2(s[0 * 33], s[1 * 33]); o.y = pk2(s[2 * 33], s[3 * 33]); o.z = pk2(s[4 * 33], s[5 * 33]); o.w = pk2(s[6 * 33], s[7 * 33]);
        bf16* rp = (n0 + n < N) ? rowp(n0 + n) : (bf16*)nullptr;
        if (rp) *(GAS v4u*)(rp + k0 + 8 * c) = o; }
    LDS_WAIT(); asm volatile("" ::: "memory");
}
template <class RowP>
__device__ __forceinline__ void conv_item8(const float* W, int K, int N, LAS float* scr, int item, int lane, float scale, RowP rowp) {
    const int nblk = (N + 31) / 32, kb = item / nblk, nb = item % nblk, k0 = 64 * kb, n0 = 32 * nb;
    const int cl = n0 + (lane & 31); const bool okc = cl < N;
#pragma unroll 8
    for (int i = 0; i < 32; ++i) { const int kk = 2 * i + (lane >> 5); scr[kk * 33 + (lane & 31)] = okc ? W[(size_t)(k0 + kk) * N + cl] * scale : 0.f; }
    LDS_WAIT(); asm volatile("" ::: "memory");
    const int c = lane & 7;
#pragma unroll
    for (int j = 0; j < 4; ++j) { const int n = (lane >> 3) + 8 * j; const LAS float* s = scr + (8 * c) * 33 + n;
        v2u o; o.x = pk4_fp8(s[0 * 33], s[1 * 33], s[2 * 33], s[3 * 33]); o.y = pk4_fp8(s[4 * 33], s[5 * 33], s[6 * 33], s[7 * 33]);
        unsigned char* rp = (n0 + n < N) ? rowp(n0 + n) : (unsigned char*)nullptr;
        if (rp) *(GAS v2u*)(rp + k0 + 8 * c) = o; }
    LDS_WAIT(); asm volatile("" ::: "memory");
}
template <bool FP8, class RowP>
__device__ __forceinline__ void conv_item64(const float* W, int K, int N, LAS float* scr, int item, int lane, float scale, RowP rowp) {
    asm volatile("" : "+v"(lane));
    const int nblk = (N + 63) / 64, kb = item / nblk, nb = item - kb * nblk, k0 = 64 * kb, n0 = 64 * nb;
    const int l15 = lane & 15, g = lane >> 4, cl = n0 + 4 * l15; const bool okc = cl < N;
    const float* src = W + (size_t)(k0 + g) * N + cl;
    f32x4 v[16];
#pragma unroll
    for (int i = 0; i < 16; ++i) { v[i] = (f32x4){0.f, 0.f, 0.f, 0.f}; if (okc) v[i] = *(const GAS f32x4*)(src + (size_t)(4 * i) * N); }
    __builtin_amdgcn_sched_barrier(0);
#pragma unroll
    for (int i = 0; i < 16; ++i) { const int k = 4 * i + g; LAS float* d = scr + k * 64 + ((4 * l15) ^ (4 * i));
        d[0 ^ g] = v[i].x * scale; d[1 ^ g] = v[i].y * scale; d[2 ^ g] = v[i].z * scale; d[3 ^ g] = v[i].w * scale; }
    LDS_WAIT(); asm volatile("" ::: "memory");
    asm volatile("" : "+v"(lane));
    if (!FP8) { const int c = lane & 7;
#pragma unroll
        for (int j = 0; j < 8; ++j) { const int n = (lane >> 3) + 8 * j, bn = n ^ (8 * c); const LAS float* s = scr + (8 * c) * 64;
            v4u o; o.x = pk2(s[0 * 64 + (bn ^ 0)], s[1 * 64 + (bn ^ 1)]); o.y = pk2(s[2 * 64 + (bn ^ 2)], s[3 * 64 + (bn ^ 3)]);
            o.z = pk2(s[4 * 64 + (bn ^ 4)], s[5 * 64 + (bn ^ 5)]); o.w = pk2(s[6 * 64 + (bn ^ 6)], s[7 * 64 + (bn ^ 7)]);
            auto rp = rowp((n0 + n < N) ? n0 + n : -1);
            if (rp) *(GAS v4u*)((unsigned char*)rp + (size_t)(k0 + 8 * c) * 2) = o; } }
    else { const int c = lane & 3;
#pragma unroll
        for (int j = 0; j < 4; ++j) { const int n = (lane >> 2) + 16 * j, bn = n ^ (16 * c); const LAS float* s = scr + (16 * c) * 64;
            v4u o; o.x = pk4_fp8(s[0 * 64 + (bn ^ 0)], s[1 * 64 + (bn ^ 1)], s[2 * 64 + (bn ^ 2)], s[3 * 64 + (bn ^ 3)]);
            o.y = pk4_fp8(s[4 * 64 + (bn ^ 4)], s[5 * 64 + (bn ^ 5)], s[6 * 64 + (bn ^ 6)], s[7 * 64 + (bn ^ 7)]);
            o.z = pk4_fp8(s[8 * 64 + (bn ^ 8)], s[9 * 64 + (bn ^ 9)], s[10 * 64 + (bn ^ 10)], s[11 * 64 + (bn ^ 11)]);
            o.w = pk4_fp8(s[12 * 64 + (bn ^ 12)], s[13 * 64 + (bn ^ 13)], s[14 * 64 + (bn ^ 14)], s[15 * 64 + (bn ^ 15)]);
            auto rp = rowp((n0 + n < N) ? n0 + n : -1);
            if (rp) *(GAS v4u*)((unsigned char*)rp + (size_t)(k0 + 16 * c)) = o; } }
    LDS_WAIT(); asm volatile("" ::: "memory");
}
__device__ __forceinline__ int ydrow(int c) { const int cc = c & 255; return (c & ~255) + 128 * ((cc >> 3) & 1) + 32 * (cc >> 6) + 8 * ((cc >> 4) & 3) + (cc & 7); }
__device__ __forceinline__ bf16* winrow(int c, bf16* win, bf16* wlr) {
    if (c >= 5120 && c < 5136) return wlr + (size_t)(c - 5120) * D;
    int d = (c < 5120) ? c : c - 16;
    if (d >= 2048 && d < 2560) { const int p = d & 15, g = (p >> 2) & 3; const int pp = (g == 1) ? p + 4 : (g == 2) ? p - 4 : p; d = (d & ~15) | pp; }
    else if (d < 2048 || d >= 4096) d = ydrow(d);
    return win + (size_t)d * D;
}
__device__ __forceinline__ int glurow(int c) { return 256 * ((c & 255) >> 7) + 128 * (c >> 8) + (c & 127); }

__device__ __forceinline__ void p0_prologue(const Frame& F, const Args& a) {
    unsigned char* ws = F.ws;
    __syncthreads();
    if (F.vcu < 96) {
        LAS float* cact = (LAS float*)F.lds;
        LAS float* part = (LAS float*)(F.lds + 65536);
        for (int i = F.tid; i < 16 * 1024; i += NTHR) { const int b = i >> 10, k = i & 1023; const float x = a.in[I_C][i]; cact[k * 16 + b] = fsilu(x); }
        __syncthreads();
        const int l = F.wave >> 2, kq = F.wave & 3, n = F.vcu * 64 + F.lane;
        float acc[16];
#pragma unroll
        for (int b = 0; b < 16; ++b) acc[b] = 0.f;
        const float* w = a.in[I_ADAW] + (size_t)l * 1024 * 6144 + n;
#pragma unroll 8
        for (int k = kq * 256; k < kq * 256 + 256; ++k) { const float wv = w[(size_t)k * 6144];
#pragma unroll
            for (int q = 0; q < 4; ++q) { const f32x4 cv = *(const LAS f32x4*)(cact + k * 16 + 4 * q); acc[4 * q] += wv * cv.x; acc[4 * q + 1] += wv * cv.y; acc[4 * q + 2] += wv * cv.z; acc[4 * q + 3] += wv * cv.w; } }
#pragma unroll
        for (int b = 0; b < 16; ++b) part[(F.wave * 16 + b) * 64 + F.lane] = acc[b];
        __syncthreads();
        for (int i = F.tid; i < 2 * 16 * 64; i += NTHR) { const int ll = i >> 10, b = (i >> 6) & 15, nn = i & 63; float s = a.in[I_ADAB][ll * 6144 + F.vcu * 64 + nn];
#pragma unroll
            for (int q = 0; q < 4; ++q) s += part[((ll * 4 + q) * 16 + b) * 64 + nn];
            ((float*)(ws + WS_MOD))[((size_t)ll * 16 + b) * 6144 + F.vcu * 64 + nn] = s; }
        __syncthreads();
    }
    LAS float* scr = (LAS float*)(F.lds + F.wave * 16384);
    const int gw = F.vcu * NWAVES + F.wave, NGW = F.G * NWAVES;
    constexpr int NB_IN = (N_IN + 63) / 64;
    constexpr int I_IN = 16 * NB_IN, I_SQ = 16 * 16, I_R = 16 * 2, I_SG = 16 * 8, I_SD = 4 * 16, I_RGI = 2 * 8 * 4, I_EG = 16 * 8, I_ED = 4 * 16;
    constexpr int PER_L = I_IN + 3 * I_SQ + I_R + I_SG + I_SD + I_RGI + NE * I_EG + NE * I_ED;
    int f8from = MK_FP8_EXP1_FROM; asm volatile("" : "+s"(f8from));
    for (int it = gw; it < DEPTH * PER_L; it += NGW) {
        const int l = it / PER_L; int r = it - l * PER_L;
        if (r < I_IN) { bf16* win = nullptr; bf16* wlr = (bf16*)(ws + WS_WLR) + (size_t)l * 16 * D;
            if (r % NB_IN == 5120 / 64)
                conv_item64<false>(a.in[I_WIN] + (size_t)l * D * N_IN, D, N_IN, scr, r, F.lane, 1.0f, [=](int c) { return (c >= 5120 && c < 5136) ? winrow(c, win, wlr) : (bf16*)nullptr; });
            unsigned char* win8 = ws + WS_WIN8 + (size_t)l * NSEC * D;
            conv_item64<true>(a.in[I_WIN] + (size_t)l * D * N_IN, D, N_IN, scr, r, F.lane, 64.0f, [=](int c) { return (c < 0 || (c >= 5120 && c < 5136)) ? (unsigned char*)nullptr : win8 + (size_t)(winrow(c, (bf16*)nullptr, (bf16*)nullptr) - (bf16*)nullptr); }); continue; } r -= I_IN;
        if (r < 3 * I_SQ) { const int w = r / I_SQ; r -= w * I_SQ; const float* src = a.in[w == 0 ? I_WBA : (w == 1 ? I_WBB : I_WOUT)] + (size_t)l * D * D;
            bf16* dst = (bf16*)(ws + (w == 0 ? WS_WA : (w == 1 ? WS_WB : WS_WO))) + (size_t)l * D * D;
            conv_item64<false>(src, D, D, scr, r, F.lane, 1.0f, [=](int c) { return c < 0 ? (bf16*)nullptr : dst + (size_t)c * D; }); continue; } r -= 3 * I_SQ;
        if (r < I_R) { bf16* dst = (bf16*)(ws + WS_ROUT) + (size_t)l * 256 * D;
            conv_item64<false>(a.in[I_RW] + (size_t)l * D * NE, D, NE, scr, r, F.lane, 1.0f, [=](int c) { return c < 0 ? (bf16*)nullptr : dst + (size_t)c * D; }); continue; } r -= I_R;
        if (r < I_SG) { bf16* dst = (bf16*)(ws + WS_SGU) + (size_t)l * 512 * D; unsigned char* dst8 = ws + WS_SGU + (size_t)l * 512 * D * 2;
            if (l >= f8from) conv_item64<true>(a.in[I_SGU] + (size_t)l * D * 512, D, 512, scr, r, F.lane, 64.0f, [=](int c) { return c < 0 ? (unsigned char*)nullptr : dst8 + (size_t)glurow(c) * D; });
            else conv_item64<false>(a.in[I_SGU] + (size_t)l * D * 512, D, 512, scr, r, F.lane, 1.0f, [=](int c) { return c < 0 ? (bf16*)nullptr : dst + (size_t)glurow(c) * D; }); continue; } r -= I_SG;
        if (r < I_SD) { bf16* dst = (bf16*)(ws + WS_SDN) + (size_t)l * D * DE;
            conv_item64<false>(a.in[I_SDN] + (size_t)l * DE * D, DE, D, scr, r, F.lane, 16.0f, [=](int c) { return c < 0 ? (bf16*)nullptr : dst + (size_t)ydrow(c) * DE; }); continue; } r -= I_SD;
        if (r < I_RGI) { const int which = r / 32; r -= which * 32; const int hb = r / 4; r -= hb * 4;
            bf16* dst = (bf16*)(ws + WS_RGW) + ((size_t)(l * 8 + hb) * 256 + which * 128) * 128;
            conv_item64<false>(a.in[which ? I_RGWX : I_RGWA] + ((size_t)l * 8 + hb) * 128 * 128, 128, 128, scr, r, F.lane, 1.0f, [=](int c) { return c < 0 ? (bf16*)nullptr : dst + (size_t)c * 128; }); continue; } r -= I_RGI;
        if (r < NE * I_EG) { const int e = r / I_EG; r -= e * I_EG; bf16* dst = (bf16*)(ws + WS_EGU) + ((size_t)l * NE + e) * 512 * D; unsigned char* dst8 = ws + WS_EGU + (size_t)l * NE * 512 * D * 2 + (size_t)e * 512 * D;
            if (l >= f8from) conv_item64<true>(a.in[I_EGU] + ((size_t)l * NE + e) * D * 512, D, 512, scr, r, F.lane, 64.0f, [=](int c) { return c < 0 ? (unsigned char*)nullptr : dst8 + (size_t)glurow(c) * D; });
            else conv_item64<false>(a.in[I_EGU] + ((size_t)l * NE + e) * D * 512, D, 512, scr, r, F.lane, 1.0f, [=](int c) { return c < 0 ? (bf16*)nullptr : dst + (size_t)glurow(c) * D; }); continue; } r -= NE * I_EG;
        { const int e = r / I_ED; r -= e * I_ED; bf16* dst = (bf16*)(ws + WS_EDN) + ((size_t)l * NE + e) * D * DE;
            conv_item64<false>(a.in[I_EDN] + ((size_t)l * NE + e) * DE * D, DE, D, scr, r, F.lane, 16.0f, [=](int c) { return c < 0 ? (bf16*)nullptr : dst + (size_t)ydrow(c) * DE; }); }
    }
    { const int gt = F.vcu * NTHR + F.tid, NT = F.G * NTHR;
      for (int i = gt; i < 2 * 128 * D / 8; i += NT) { const int l = i / (128 * D / 8), r = i - l * (128 * D / 8);
          *(GAS v4u*)((bf16*)(ws + WS_ROUT) + ((size_t)l * 256 + 128) * D + (size_t)r * 8) = (v4u){0u, 0u, 0u, 0u}; }
      if (gt < D / 8) *(GAS v4u*)((bf16*)(ws + WS_U) + (size_t)T * D + gt * 8) = (v4u){0u, 0u, 0u, 0u}; }
}

template <bool FINAL, bool IN_BF16>
__device__ __forceinline__ void norm_phase(const Frame& F, const void* hv_, const float* gain, const float* sc, const float* sh, bf16* U, float* outf, unsigned char* U8 = nullptr) {
    constexpr int RB = IN_BF16 ? 8 : 4;
    const int gw = F.vcu * NWAVES + F.wave, NGW = F.G * NWAVES;
    const int c0 = 16 * F.lane;
    for (int blk = gw; blk < T / 32; blk += NGW) {
        const int b = (blk * 32) / SEQ;
        f32x4 scl[4], sft[4];
#pragma unroll
        for (int j = 0; j < 4; ++j) { const int c = c0 + 4 * j; const f32x4 g = *(const f32x4*)(gain + c);
            if (FINAL) { scl[j] = g; sft[j] = (f32x4){0.f, 0.f, 0.f, 0.f}; }
            else { const f32x4 s1 = *(const f32x4*)(sc + (size_t)b * 6144 + c); sft[j] = *(const f32x4*)(sh + (size_t)b * 6144 + c); scl[j] = g * (s1 + 1.0f); } }
#pragma unroll 1
        for (int r8 = 0; r8 < 32; r8 += RB) {
            const size_t row0 = (size_t)blk * 32 + r8;
            v4u w[RB][IN_BF16 ? 2 : 4];
            if (IN_BF16) { const unsigned char* hb = (const unsigned char*)hv_ + row0 * (D * 2); const unsigned vo = 32u * F.lane;
#pragma unroll
                for (int rr = 0; rr < RB; ++rr) { w[rr][0] = *(const GAS v4u*)(hb + rr * (D * 2) + vo); w[rr][1] = *(const GAS v4u*)(hb + rr * (D * 2) + vo + 16); } }
            else { const unsigned char* hb = (const unsigned char*)hv_ + row0 * (D * 4); const unsigned vo = 64u * F.lane;
#pragma unroll
                for (int rr = 0; rr < RB; ++rr)
#pragma unroll
                    for (int j = 0; j < (IN_BF16 ? 2 : 4); ++j) w[rr][j] = *(const GAS v4u*)(hb + rr * (D * 4) + vo + 16 * j); }
            __builtin_amdgcn_sched_barrier(0);
#pragma unroll
            for (int rr = 0; rr < RB; ++rr) { const size_t row = row0 + rr; f32x4 v[4];
                if (IN_BF16) {
#pragma unroll
                    for (int j = 0; j < 2; ++j) { const v4u x = w[rr][j]; v[2 * j] = (f32x4){bflo(x.x), bfhi(x.x), bflo(x.y), bfhi(x.y)}; v[2 * j + 1] = (f32x4){bflo(x.z), bfhi(x.z), bflo(x.w), bfhi(x.w)}; } }
                else {
#pragma unroll
                    for (int j = 0; j < (IN_BF16 ? 2 : 4); ++j) v[j] = __builtin_bit_cast(f32x4, w[rr][j]); }
                float s = 0.f;
#pragma unroll
                for (int j = 0; j < 4; ++j) s += (v[j].x * v[j].x + v[j].y * v[j].y) + (v[j].z * v[j].z + v[j].w * v[j].w);
                const float rs = 1.0f / sqrtf(wave_sum(s, F.lane) * (1.0f / D) + EPS);
                if (FINAL) { GAS f32x4* o = (GAS f32x4*)(outf + row * D + c0);
#pragma unroll
                    for (int j = 0; j < 4; ++j) o[j] = v[j] * rs * scl[j];
                } else { f32x4 y[4];
#pragma unroll
                    for (int j = 0; j < 4; ++j) y[j] = v[j] * rs * scl[j] + sft[j];
                    if (U) { GAS v4u* o = (GAS v4u*)(U + row * D + c0);
                    o[0] = (v4u){pk2(y[0].x, y[0].y), pk2(y[0].z, y[0].w), pk2(y[1].x, y[1].y), pk2(y[1].z, y[1].w)};
                    o[1] = (v4u){pk2(y[2].x, y[2].y), pk2(y[2].z, y[2].w), pk2(y[3].x, y[3].y), pk2(y[3].z, y[3].w)}; }
                    if (U8) *(GAS v4u*)(U8 + row * D + c0) = (v4u){pk4_fp8(y[0].x, y[0].y, y[0].z, y[0].w), pk4_fp8(y[1].x, y[1].y, y[1].z, y[1].w), pk4_fp8(y[2].x, y[2].y, y[2].z, y[2].w), pk4_fp8(y[3].x, y[3].y, y[3].z, y[3].w)}; }
                __builtin_amdgcn_sched_barrier(0); }
        }
    }
}

#define EPI_ROWS_BEGIN _Pragma("unroll") for (int ai = 0; ai < 2; ++ai) _Pragma("unroll") for (int m = 0; m < 4; ++m) { const int rt = ai * 128 + wr * 64 + m * 16 + fr;
#define EPI_ROWS_END }
typedef const pg8::f32x4 (&AccRef)[2][2][4][2];
__device__ __forceinline__ v4u pack8(const f32x4& a, const f32x4& b) { v4u w; w.x = pg8::cvt_pk_bf16(a[0], a[1]); w.y = pg8::cvt_pk_bf16(a[2], a[3]); w.z = pg8::cvt_pk_bf16(b[0], b[1]); w.w = pg8::cvt_pk_bf16(b[2], b[3]); return w; }
template <int ACT> __device__ __forceinline__ f32x4 act4(f32x4 v) {
    if (ACT == 1) { v[0] = fgelu_tanh(v[0]); v[1] = fgelu_tanh(v[1]); v[2] = fgelu_tanh(v[2]); v[3] = fgelu_tanh(v[3]); }
    if (ACT == 2) v = v * 0.08838834764831845f;
    if (ACT == 3) { v[0] = fsilu(v[0]); v[1] = fsilu(v[1]); v[2] = fsilu(v[2]); v[3] = fsilu(v[3]); }
    if (ACT == 4) { v[0] = fsigmoid(v[0]); v[1] = fsigmoid(v[1]); v[2] = fsigmoid(v[2]); v[3] = fsigmoid(v[3]); }
    return v;
}
template <int ACT> __device__ __forceinline__ void store_tile_bf16(AccRef acc, bf16* dst, int ld, size_t row0, int col0, int wr, int wc, int fr, int fq) {
    EPI_ROWS_BEGIN
        bf16* rp = dst + (row0 + rt) * ld + col0 + wc * 32 + 8 * fq;
#pragma unroll
        for (int bj = 0; bj < 2; ++bj) *(GAS v4u*)(rp + bj * 128) = pack8(act4<ACT>(acc[ai][bj][m][0]), act4<ACT>(acc[ai][bj][m][1]));
    EPI_ROWS_END
}
template <int ACT> __device__ __forceinline__ void store_tile_fp8(AccRef acc, unsigned char* dst, size_t row0, int col0, int wr, int wc, int fr, int fq) {
    EPI_ROWS_BEGIN
        const f32x4 a0 = act4<ACT>(acc[ai][0][m][0]) * 16.0f, a1 = act4<ACT>(acc[ai][0][m][1]) * 16.0f, b0 = act4<ACT>(acc[ai][1][m][0]) * 16.0f, b1 = act4<ACT>(acc[ai][1][m][1]) * 16.0f;
        v4u w; w.x = pk4_fp8(a0[0], a0[1], a0[2], a0[3]); w.y = pk4_fp8(a1[0], a1[1], a1[2], a1[3]); w.z = pk4_fp8(b0[0], b0[1], b0[2], b0[3]); w.w = pk4_fp8(b1[0], b1[1], b1[2], b1[3]);
        *(GAS v4u*)(dst + (row0 + rt) * 1024 + col0 + wc * 64 + fq * 16) = w;
    EPI_ROWS_END
}
__device__ __forceinline__ f32x4 fp8x4(unsigned w) { typedef float f2_t __attribute__((ext_vector_type(2))); const f2_t lo = __builtin_amdgcn_cvt_pk_f32_fp8((int)w, false), hi = __builtin_amdgcn_cvt_pk_f32_fp8((int)w, true); return (f32x4){lo.x, lo.y, hi.x, hi.y}; }
struct EpiInProj {
    unsigned char* ws;
    __device__ __forceinline__ void operator()(AccRef acc, const pg8::Unit& u, int wr, int wc, int fr, int fq) const {
        asm volatile("" : "+v"(fr), "+v"(fq));
        const int pn = u.pn; const size_t row0 = (size_t)u.pm * 256;
        if (pn < 4)       store_tile_fp8<0>(acc, ws + WS_XRPRE, row0, pn * 256, wr, wc, fr, fq);
        else if (pn < 8)  store_tile_fp8<1>(acc, ws + WS_RG, row0, (pn - 4) * 256, wr, wc, fr, fq);
        else if (pn < 10) store_tile_bf16<2>(acc, (bf16*)(ws + WS_Q), 512, row0, (pn - 8) * 256, wr, wc, fr, fq);
        else if (pn < 12) store_tile_bf16<0>(acc, (bf16*)(ws + WS_K), 512, row0, (pn - 10) * 256, wr, wc, fr, fq);
        else if (pn < 16) store_tile_bf16<0>(acc, (bf16*)(ws + WS_V), 1024, row0, (pn - 12) * 256, wr, wc, fr, fq);
        else if (pn < 20) store_tile_fp8<3>(acc, ws + WS_OG, row0, (pn - 16) * 256, wr, wc, fr, fq);
        else if (pn < 24) store_tile_fp8<4>(acc, ws + WS_GA, row0, (pn - 20) * 256, wr, wc, fr, fq);
        else              store_tile_fp8<4>(acc, ws + WS_GB, row0, (pn - 24) * 256, wr, wc, fr, fq);
    }
};
template <bool FIRST> struct EpiMerge {
    const unsigned char* gate; bf16* mbuf;
    __device__ __forceinline__ void operator()(AccRef acc, const pg8::Unit& u, int wr, int wc, int fr, int fq) const {
        asm volatile("" : "+v"(fr), "+v"(fq));
        EPI_ROWS_BEGIN
            const size_t o = ((size_t)u.pm * 256 + rt) * 1024 + u.pn * 256 + wc * 32 + 8 * fq;
#pragma unroll
            for (int bj = 0; bj < 2; ++bj) { const v2u gw = *(const GAS v2u*)(gate + o + bj * 128);
                const f32x4 g0 = fp8x4(gw.x) * 0.0625f, g1 = fp8x4(gw.y) * 0.0625f;
                f32x4 r0 = g0 * acc[ai][bj][m][0], r1 = g1 * acc[ai][bj][m][1];
                if (!FIRST) { const v4u mw = *(const GAS v4u*)(mbuf + o + bj * 128);
                    r0 += (f32x4){bflo(mw.x), bfhi(mw.x), bflo(mw.y), bfhi(mw.y)}; r1 += (f32x4){bflo(mw.z), bfhi(mw.z), bflo(mw.w), bfhi(mw.w)}; }
                *(GAS v4u*)(mbuf + o + bj * 128) = pack8(r0, r1); }
        EPI_ROWS_END
    }
};
template <bool HIN_F32> struct EpiRes {
    const void* hin; bf16* hout; const float* gate;
    __device__ __forceinline__ void operator()(AccRef acc, const pg8::Unit& u, int wr, int wc, int fr, int fq) const {
        asm volatile("" : "+v"(fr), "+v"(fq));
        const int b = (u.pm * 256) / SEQ; const int cb = u.pn * 256 + wc * 32 + 8 * fq;
        f32x4 gv[2][2];
#pragma unroll
        for (int bj = 0; bj < 2; ++bj)
#pragma unroll
            for (int n = 0; n < 2; ++n) gv[bj][n] = *(const GAS f32x4*)(gate + (size_t)b * 6144 + cb + bj * 128 + 4 * n);
        EPI_ROWS_BEGIN
            const size_t o = ((size_t)u.pm * 256 + rt) * 1024 + cb;
#pragma unroll
            for (int bj = 0; bj < 2; ++bj) { f32x4 h0, h1;
                if (HIN_F32) { h0 = *(const GAS f32x4*)((const float*)hin + o + bj * 128); h1 = *(const GAS f32x4*)((const float*)hin + o + bj * 128 + 4); }
                else { const v4u w = *(const GAS v4u*)((const bf16*)hin + o + bj * 128); h0 = (f32x4){bflo(w.x), bfhi(w.x), bflo(w.y), bfhi(w.y)}; h1 = (f32x4){bflo(w.z), bfhi(w.z), bflo(w.w), bfhi(w.w)}; }
                *(GAS v4u*)(hout + o + bj * 128) = pack8(h0 + gv[bj][0] * acc[ai][bj][m][0], h1 + gv[bj][1] * acc[ai][bj][m][1]); }
        EPI_ROWS_END
    }
};
struct EpiLogit {
    float* lg;
    __device__ __forceinline__ void operator()(AccRef acc, const pg8::Unit& u, int wr, int wc, int fr, int fq) const {
        asm volatile("" : "+v"(fr), "+v"(fq));
        EPI_ROWS_BEGIN
            float* rp = lg + ((size_t)u.pm * 256 + rt) * 128 + wc * 32 + 8 * fq;
            *(GAS f32x4*)(rp) = acc[ai][0][m][0]; *(GAS f32x4*)(rp + 4) = acc[ai][0][m][1];
        EPI_ROWS_END
    }
};
struct EpiGlu {
    bf16* act;
    __device__ __forceinline__ void operator()(AccRef acc, const pg8::Unit& u, int wr, int wc, int fr, int fq) const {
        asm volatile("" : "+v"(fr), "+v"(fq));
        const int j = u.pn & 1;
        EPI_ROWS_BEGIN
            f32x4 r0 = act4<3>(acc[ai][0][m][0]) * acc[ai][1][m][0], r1 = act4<3>(acc[ai][0][m][1]) * acc[ai][1][m][1];
            *(GAS v4u*)(act + ((size_t)u.pm * 256 + rt) * 256 + j * 128 + wc * 32 + 8 * fq) = pack8(r0, r1);
        EPI_ROWS_END
    }
};
struct EpiPlain {
    bf16* o;
    __device__ __forceinline__ void operator()(AccRef acc, const pg8::Unit& u, int wr, int wc, int fr, int fq) const {
        asm volatile("" : "+v"(fr), "+v"(fq));
        store_tile_bf16<0>(acc, o, 1024, (size_t)u.pm * 256, u.pn * 256, wr, wc, fr, fq);
    }
};
struct EpiY {
    unsigned char* y;
    __device__ __forceinline__ void operator()(AccRef acc, const pg8::Unit& u, int wr, int wc, int fr, int fq) const {
        asm volatile("" : "+v"(fr), "+v"(fq));
        EPI_ROWS_BEGIN
            const f32x4 a0 = acc[ai][0][m][0], a1 = acc[ai][0][m][1], b0 = acc[ai][1][m][0], b1 = acc[ai][1][m][1];
            v4u w; w.x = pk4_fp8(a0[0], a0[1], a0[2], a0[3]); w.y = pk4_fp8(a1[0], a1[1], a1[2], a1[3]); w.z = pk4_fp8(b0[0], b0[1], b0[2], b0[3]); w.w = pk4_fp8(b1[0], b1[1], b1[2], b1[3]);
            *(GAS v4u*)(y + ((size_t)u.pm * 256 + rt) * 1024 + (u.pn & 3) * 256 + wc * 64 + fq * 16) = w;
        EPI_ROWS_END
    }
};

__device__ __forceinline__ int swz16(int row, int ch) { return row * 256 + ((ch ^ (row & 15)) << 4); }
__device__ __forceinline__ void rg_gate_phase(const Frame& F, const Args& a, int l, const int hb, const int t0, const int nt) {
    unsigned char* ws = F.ws;
    __syncthreads();
    LAS unsigned char* Ws = F.lds; LAS unsigned char* Xs = F.lds + 65536; LAS float* prm = (LAS float*)(F.lds + 98304);
    const unsigned char* xpre = ws + WS_XRPRE; bf16* loga = (bf16*)(ws + WS_LOGA); bf16* ixo = (bf16*)(ws + WS_IX);
    { const bf16* wsrc = (const bf16*)(ws + WS_RGW) + (size_t)(l * 8 + hb) * 256 * 128;
#pragma unroll
      for (int j = 0; j < 8; ++j) { const int ck = F.tid + NTHR * j, n = ck >> 4, ch = ck & 15; *(LAS v4u*)(Ws + swz16(n, ch)) = *(const GAS v4u*)(wsrc + (size_t)ck * 8); }
      if (F.tid < 128) { const int c = l * D + hb * 128 + F.tid; prm[F.tid] = a.in[I_RGBA][c]; prm[128 + F.tid] = a.in[I_RGBX][c];
          const float lam = a.in[I_RGLAM][c]; prm[256 + F.tid] = fmaxf(-lam, 0.f) + log1pf(__expf(-fabsf(lam))); } }
    const int c8 = F.tid & 15, rg4 = F.tid >> 4, chan0 = hb * 128 + 8 * c8;
    float cw[4][8], cb[8];
#pragma unroll
    for (int j = 0; j < 8; ++j) { cb[j] = a.in[I_CONVB][l * D + chan0 + j];
#pragma unroll
        for (int q = 0; q < 4; ++q) cw[q][j] = a.in[I_CONVW][((size_t)l * 4 + q) * D + chan0 + j]; }
    const int fr = F.lane & 15, fq = F.lane >> 4;
    v2u wq[7];
#define RG_LOAD_ROWS(ii) do { const size_t r0g_ = (size_t)(t0 + (ii)) * 128 + 4 * rg4; const int tp_ = (int)(r0g_ & (SEQ - 1)); \
        _Pragma("unroll") for (int q = 0; q < 7; ++q) { wq[q] = (v2u){0u, 0u}; if (tp_ + q - 3 >= 0) wq[q] = *(const GAS v2u*)(xpre + (size_t)((long)r0g_ + q - 3) * D + chan0); } } while (0)
    RG_LOAD_ROWS(0);
    for (int i = 0; i < nt; ++i) {
        const int rt = t0 + i; const size_t row0 = (size_t)rt * 128;
        __syncthreads();
        {
            const int r0 = 4 * rg4;
            float x[7][8];
#pragma unroll
            for (int q = 0; q < 7; ++q) { const f32x4 lo = fp8x4(wq[q].x) * 0.0625f, hi = fp8x4(wq[q].y) * 0.0625f;
                x[q][0] = lo.x; x[q][1] = lo.y; x[q][2] = lo.z; x[q][3] = lo.w; x[q][4] = hi.x; x[q][5] = hi.y; x[q][6] = hi.z; x[q][7] = hi.w; }
#pragma unroll
            for (int rr = 0; rr < 4; ++rr) { float y[8];
#pragma unroll
                for (int j = 0; j < 8; ++j) y[j] = cb[j] + cw[0][j] * x[rr][j] + cw[1][j] * x[rr + 1][j] + cw[2][j] * x[rr + 2][j] + cw[3][j] * x[rr + 3][j];
                v4u o; o.x = pk2(y[0], y[1]); o.y = pk2(y[2], y[3]); o.z = pk2(y[4], y[5]); o.w = pk2(y[6], y[7]);
                *(LAS v4u*)(Xs + swz16(r0 + rr, c8)) = o; }
        }
        if (i + 1 < nt) RG_LOAD_ROWS(i + 1);
        __syncthreads();
        f32x4 acc[16];
#pragma unroll
        for (int nb = 0; nb < 16; ++nb) acc[nb] = (f32x4){0.f, 0.f, 0.f, 0.f};
        const int arow = 16 * F.wave + fr;
#pragma unroll
        for (int ks = 0; ks < 4; ++ks) { const bf16x8 af = *(const LAS bf16x8*)(Xs + swz16(arow, 4 * ks + fq));
#pragma unroll
            for (int nb = 0; nb < 16; ++nb) { const bf16x8 bfv = *(const LAS bf16x8*)(Ws + swz16(16 * nb + fr, 4 * ks + fq));
                acc[nb] = __builtin_amdgcn_mfma_f32_16x16x32_bf16(bfv, af, acc[nb], 0, 0, 0); } }
        const size_t grow = row0 + arow; const bool tzero = (grow & (SEQ - 1)) == 0;
#pragma unroll
        for (int nb = 0; nb < 8; ++nb) { const int c = 16 * nb + 4 * fq;
            const f32x4 ba = *(const LAS f32x4*)(prm + c), bx = *(const LAS f32x4*)(prm + 128 + c), sp = *(const LAS f32x4*)(prm + 256 + c);
            const v2u xw = *(const LAS v2u*)(Xs + swz16(arow, c >> 3) + (c & 7) * 2);
            const float xv[4] = {bflo(xw.x), bfhi(xw.x), bflo(xw.y), bfhi(xw.y)};
            float om[4], bt[4];
#pragma unroll
            for (int j = 0; j < 4; ++j) { const float r = fsigmoid(acc[nb][j] + ba[j]), ii = fsigmoid(acc[nb + 8][j] + bx[j]); const float la = -8.0f * r * sp[j];
                const float o1 = 1.0f - __builtin_amdgcn_exp2f(1.442695041f * la), o2 = -la * (1.0f + la * (0.5f + la * 0.16666667f));
                om[j] = (la > -0.01f) ? o2 : o1; float mult = __builtin_amdgcn_sqrtf(om[j] * (2.0f - om[j])); if (tzero) mult = 1.0f; bt[j] = mult * ii * xv[j]; }
            const size_t o = grow * D + hb * 128 + c;
            *(GAS v2u*)(loga + o) = (v2u){pk2(om[0], om[1]), pk2(om[2], om[3])};
            *(GAS v2u*)(ixo + o) = (v2u){pk2(bt[0], bt[1]), pk2(bt[2], bt[3])}; }
    }
    __syncthreads();
}

typedef float f32x2 __attribute__((ext_vector_type(2)));
__device__ __forceinline__ void unpack8(const v4u w, float (&o)[8]) { o[0] = bflo(w.x); o[1] = bfhi(w.x); o[2] = bflo(w.y); o[3] = bfhi(w.y); o[4] = bflo(w.z); o[5] = bfhi(w.z); o[6] = bflo(w.w); o[7] = bfhi(w.w); }
__device__ __forceinline__ void scan_pass1(const Frame& F, int unit) {
    unsigned char* ws = F.ws;
    LAS f32x2* pe = (LAS f32x2*)F.lds;
    const int g = F.tid >> 7, c8 = F.tid & 127, ch = 8 * c8;
    const unsigned voff = (unsigned)(16 * g * D + ch) * 2u;
    const unsigned char* omb = ws + WS_LOGA + (size_t)unit * 64 * D * 2; const unsigned char* btb = ws + WS_IX + (size_t)unit * 64 * D * 2;
    v4u ow[16], bw[16];
#pragma unroll
    for (int r = 0; r < 16; ++r) { ow[r] = *(const GAS v4u*)(omb + r * (D * 2) + voff); bw[r] = *(const GAS v4u*)(btb + r * (D * 2) + voff); }
    __builtin_amdgcn_sched_barrier(0);
    float P[8], E[8];
#pragma unroll
    for (int j = 0; j < 8; ++j) { P[j] = 1.f; E[j] = 0.f; }
#pragma unroll
    for (int r = 0; r < 16; ++r) { float a[8], bt[8]; unpack8(ow[r], a); unpack8(bw[r], bt);
#pragma unroll
        for (int j = 0; j < 8; ++j) { const float av = 1.0f - a[j]; E[j] = av * E[j] + bt[j]; P[j] *= av; } }
    __syncthreads();
#pragma unroll
    for (int j = 0; j < 8; ++j) pe[g * 1024 + ch + j] = (f32x2){P[j], E[j]};
    __syncthreads();
    if (g == 0) { f32x4 Po[2], Eo[2];
#pragma unroll
        for (int j = 0; j < 8; ++j) { float p = P[j], e = E[j];
#pragma unroll
            for (int q = 1; q < 4; ++q) { const f32x2 x = pe[q * 1024 + ch + j]; e = x.x * e + x.y; p *= x.x; }
            Po[j >> 2][j & 3] = p; Eo[j >> 2][j & 3] = e; }
        GAS f32x4* spp = (GAS f32x4*)((float*)(ws + WS_SP) + (size_t)unit * D + ch); GAS f32x4* sep = (GAS f32x4*)((float*)(ws + WS_SE) + (size_t)unit * D + ch);
        spp[0] = Po[0]; spp[1] = Po[1]; sep[0] = Eo[0]; sep[1] = Eo[1]; }
}
__device__ __forceinline__ void scan_pass3(const Frame& F, int unit) {
    unsigned char* ws = F.ws;
    const size_t row0 = (size_t)unit * 64; const int ch = 2 * F.tid;
    const GAS unsigned* om = (const GAS unsigned*)((const bf16*)(ws + WS_LOGA) + row0 * D + ch); GAS unsigned* bp = (GAS unsigned*)((bf16*)(ws + WS_IX) + row0 * D + ch);
    const GAS unsigned short* rg = (const GAS unsigned short*)(ws + WS_RG + row0 * D + ch);
    float h0 = 0.f, h1 = 0.f;
    { const int seg = unit & 63; const GAS f32x2* sp = (const GAS f32x2*)((const float*)(ws + WS_SP) + (size_t)(unit - seg) * D + ch); const GAS f32x2* se = (const GAS f32x2*)((const float*)(ws + WS_SE) + (size_t)(unit - seg) * D + ch);
#pragma unroll 8
      for (int s = 0; s < seg; ++s) { const f32x2 p = sp[(size_t)s * (D / 2)], e = se[(size_t)s * (D / 2)]; h0 = p.x * h0 + e.x; h1 = p.y * h1 + e.y; } }
#pragma unroll 16
    for (int r = 0; r < 64; ++r) { const unsigned ow = om[(size_t)r * (D / 2)], bw = bp[(size_t)r * (D / 2)]; const f32x4 gt = fp8x4((unsigned)rg[(size_t)r * (D / 2)]);
        h0 = (1.0f - bflo(ow)) * h0 + bflo(bw); h1 = (1.0f - bfhi(ow)) * h1 + bfhi(bw); bp[(size_t)r * (D / 2)] = pk2(h0 * gt.x * 0.0625f, h1 * gt.y * 0.0625f); }
}
#if MK_SCAN3_NEW
__device__ __forceinline__ void scan_pass3_panel(const Frame& F, int pm) {
    unsigned char* ws = F.ws;
    LAS f32x2* pe = (LAS f32x2*)F.lds; LAS float* cin = (LAS float*)(F.lds + 32768);
    const int g = F.tid >> 7, c8 = F.tid & 127, ch = 8 * c8;
    __syncthreads();
    { const int u0 = 4 * pm, seg0 = u0 & 63, qn = (seg0 + 3) >> 2, sb = g * qn, sen = (sb + qn < seg0) ? sb + qn : seg0;
      f32x4 P0 = {1.f, 1.f, 1.f, 1.f}, P1 = P0, E0 = {0.f, 0.f, 0.f, 0.f}, E1 = E0;
      const float* spb = (const float*)(ws + WS_SP) + (size_t)(u0 - seg0) * D + ch; const float* seb = (const float*)(ws + WS_SE) + (size_t)(u0 - seg0) * D + ch;
#pragma unroll 4
      for (int s = sb; s < sen; ++s) { const f32x4 p0 = *(const GAS f32x4*)(spb + (size_t)s * D), p1 = *(const GAS f32x4*)(spb + (size_t)s * D + 4), e0 = *(const GAS f32x4*)(seb + (size_t)s * D), e1 = *(const GAS f32x4*)(seb + (size_t)s * D + 4);
          E0 = p0 * E0 + e0; P0 *= p0; E1 = p1 * E1 + e1; P1 *= p1; }
#pragma unroll
      for (int j = 0; j < 4; ++j) { pe[g * 1024 + ch + j] = (f32x2){P0[j], E0[j]}; pe[g * 1024 + ch + 4 + j] = (f32x2){P1[j], E1[j]}; }
      __syncthreads();
      if (g == 0) {
#pragma unroll
          for (int j = 0; j < 8; ++j) { float h = 0.f;
#pragma unroll
              for (int q = 0; q < 4; ++q) { const f32x2 x = pe[q * 1024 + ch + j]; h = x.x * h + x.y; }
              cin[ch + j] = h; } } }
    for (int k = 0; k < 4; ++k) {
        const int unit = 4 * pm + k;
        const unsigned voff = (unsigned)(16 * g * D + ch) * 2u, voffg = (unsigned)(16 * g * D + ch);
        const unsigned char* omb = ws + WS_LOGA + (size_t)unit * 64 * D * 2; unsigned char* btb = ws + WS_IX + (size_t)unit * 64 * D * 2;
        const unsigned char* rgb = ws + WS_RG + (size_t)unit * 64 * D;
        v4u ow[16], bw[16]; v2u gw[16];
#pragma unroll
        for (int r = 0; r < 16; ++r) { ow[r] = *(const GAS v4u*)(omb + r * (D * 2) + voff); bw[r] = *(const GAS v4u*)(btb + r * (D * 2) + voff); gw[r] = *(const GAS v2u*)(rgb + r * D + voffg); }
        __builtin_amdgcn_sched_barrier(0);
        float P[8], E[8];
#pragma unroll
        for (int j = 0; j < 8; ++j) { P[j] = 1.f; E[j] = 0.f; }
#pragma unroll
        for (int r = 0; r < 16; ++r) { float a[8], bt[8]; unpack8(ow[r], a); unpack8(bw[r], bt);
#pragma unroll
            for (int j = 0; j < 8; ++j) { const float av = 1.0f - a[j]; E[j] = av * E[j] + bt[j]; P[j] *= av; asm volatile("" : "+v"(P[j]), "+v"(E[j])); }
            __builtin_amdgcn_sched_barrier(0); }
        __syncthreads();
#pragma unroll
        for (int j = 0; j < 8; ++j) pe[g * 1024 + ch + j] = (f32x2){P[j], E[j]};
        __syncthreads();
#pragma unroll
        for (int r = 0; r < 16; ++r) asm volatile("" : "+v"(ow[r]), "+v"(bw[r]));
        float h[8];
#pragma unroll
        for (int j = 0; j < 8; ++j) { float e = cin[ch + j];
#pragma unroll
            for (int q = 0; q < 3; ++q) if (q < g) { const f32x2 x = pe[q * 1024 + ch + j]; e = x.x * e + x.y; }
            h[j] = e; }
#pragma unroll
        for (int r = 0; r < 16; ++r) { float a[8], bt[8]; unpack8(ow[r], a); unpack8(bw[r], bt); const f32x4 g0 = fp8x4(gw[r].x) * 0.0625f, g1 = fp8x4(gw[r].y) * 0.0625f;
            float o[8];
#pragma unroll
            for (int j = 0; j < 8; ++j) { h[j] = (1.0f - a[j]) * h[j] + bt[j]; o[j] = h[j] * (j < 4 ? g0[j & 3] : g1[j & 3]); }
            *(GAS v4u*)(btb + r * (D * 2) + voff) = (v4u){pk2(o[0], o[1]), pk2(o[2], o[3]), pk2(o[4], o[5]), pk2(o[6], o[7])};
            __builtin_amdgcn_sched_barrier(0); }
        __syncthreads();
        if (g == 3) {
#pragma unroll
            for (int j = 0; j < 8; ++j) cin[ch + j] = h[j]; }
    }
}
#endif

__device__ __forceinline__ float flogsig16(float x) {
    const float e = __builtin_amdgcn_exp2f(-1.442695041f * fabsf(x));
    return (fminf(x, 0.f) - 0.6931471806f * __builtin_amdgcn_logf(1.0f + e)) * 0.0625f;
}
__device__ __forceinline__ void gla_prep(const Frame& F, const Args& a, int l, int unit) {
    unsigned char* ws = F.ws;
    LAS float* lrs = (LAS float*)F.lds; LAS float* psum = (LAS float*)(F.lds + 8192); LAS unsigned char* kds = F.lds + 16384;
    const size_t row0 = (size_t)unit * 64;
    const int fr = F.lane & 15, fq = F.lane >> 4;
    __syncthreads();
    { const int rb = F.wave & 3, kh = F.wave >> 2;
      const unsigned char* up = ws + WS_U8 + (row0 + 16 * rb + fr) * D + kh * 512 + 8 * fq;
      const bf16* wp = (const bf16*)(ws + WS_WLR) + ((size_t)l * 16 + fr) * D + kh * 512 + 8 * fq;
      f32x4 acc = {0.f, 0.f, 0.f, 0.f};
      v2u aw[16];
#pragma unroll
      for (int ks = 0; ks < 16; ++ks) aw[ks] = *(const GAS v2u*)(up + 32 * ks);
#pragma unroll
      for (int ks = 0; ks < 16; ++ks) { const bf16x8 bfv = *(const GAS bf16x8*)(wp + 32 * ks);
          const f32x4 lo = fp8x4(aw[ks].x), hi = fp8x4(aw[ks].y);
          const v4u ap = (v4u){pk2(lo.x, lo.y), pk2(lo.z, lo.w), pk2(hi.x, hi.y), pk2(hi.z, hi.w)};
          acc = __builtin_amdgcn_mfma_f32_16x16x32_bf16(__builtin_bit_cast(bf16x8, ap), bfv, acc, 0, 0, 0); }
#pragma unroll
      for (int j = 0; j < 4; ++j) lrs[(kh * 64 + 16 * rb + 4 * fq + j) * 16 + fr] = acc[j]; }
    __syncthreads();
    const int cp = F.tid & 255, th = F.tid >> 8, c0 = 2 * cp;
    float wu0[16], wu1[16];
#pragma unroll
    for (int r = 0; r < 16; ++r) { const f32x2 w = *(const GAS f32x2*)(a.in[I_GWUP] + ((size_t)l * 16 + r) * 512 + c0); wu0[r] = w.x; wu1[r] = w.y; }
    const f32x2 bu = *(const GAS f32x2*)(a.in[I_GBUP] + l * 512 + c0);
    float la0[32], la1[32]; float s0 = 0.f, s1 = 0.f;
#pragma unroll
    for (int tt = 0; tt < 32; ++tt) { const int t = 32 * th + tt; float g0 = bu.x, g1 = bu.y;
#pragma unroll
        for (int q = 0; q < 4; ++q) { const f32x4 x = *(const LAS f32x4*)(lrs + t * 16 + 4 * q) + *(const LAS f32x4*)(lrs + (64 + t) * 16 + 4 * q);
            g0 += x.x * wu0[4 * q] + x.y * wu0[4 * q + 1] + x.z * wu0[4 * q + 2] + x.w * wu0[4 * q + 3];
            g1 += x.x * wu1[4 * q] + x.y * wu1[4 * q + 1] + x.z * wu1[4 * q + 2] + x.w * wu1[4 * q + 3]; }
        la0[tt] = flogsig16(g0); la1[tt] = flogsig16(g1); s0 += la0[tt]; s1 += la1[tt]; }
    *(LAS f32x2*)(psum + th * 512 + c0) = (f32x2){s0, s1};
    __syncthreads();
    const f32x2 oth = *(const LAS f32x2*)(psum + (th ^ 1) * 512 + c0);
    const float tot0 = s0 + oth.x, tot1 = s1 + oth.y;
    if (th == 0) *(GAS f32x2*)((float*)(ws + WS_TOT) + (size_t)unit * 512 + c0) = (f32x2){tot0, tot1};
    float cum0 = th ? oth.x : 0.f, cum1 = th ? oth.y : 0.f;
    const GAS unsigned* kp = (const GAS unsigned*)((const bf16*)(ws + WS_K) + (row0 + 32 * th) * 512 + c0);
#pragma unroll
    for (int t8 = 0; t8 < 4; ++t8) { float o0[8], o1[8];
#pragma unroll
        for (int tt = 0; tt < 8; ++tt) { const unsigned kw = kp[(size_t)(8 * t8 + tt) * 256]; cum0 += la0[8 * t8 + tt]; cum1 += la1[8 * t8 + tt];
            o0[tt] = bflo(kw) * __builtin_amdgcn_exp2f(1.442695041f * (tot0 - cum0)); o1[tt] = bfhi(kw) * __builtin_amdgcn_exp2f(1.442695041f * (tot1 - cum1)); }
        *(LAS v4u*)(kds + c0 * 144 + (32 * th + 8 * t8) * 2) = (v4u){pk2(o0[0], o0[1]), pk2(o0[2], o0[3]), pk2(o0[4], o0[5]), pk2(o0[6], o0[7])};
        *(LAS v4u*)(kds + (c0 + 1) * 144 + (32 * th + 8 * t8) * 2) = (v4u){pk2(o1[0], o1[1]), pk2(o1[2], o1[3]), pk2(o1[4], o1[5]), pk2(o1[6], o1[7])}; }
    __syncthreads();
    GAS unsigned char* kd = (GAS unsigned char*)((bf16*)(ws + WS_KDEC) + (size_t)unit * 512 * 64);
#pragma unroll
    for (int j = 0; j < 8; ++j) { const int ck = F.tid + NTHR * j; *(GAS v4u*)(kd + (size_t)ck * 16) = *(const LAS v4u*)(kds + (ck >> 3) * 144 + (ck & 7) * 16); }
}

constexpr int GQ_OFF = 0, GK_OFF = 64 * 272, GV_OFF = GK_OFF + 128 * 144, GD_OFF = GV_OFF + 64 * 256, GBUF = GD_OFF + 512;
__device__ __forceinline__ unsigned voff_b(unsigned row, unsigned ch) { return 256u * row + 16u * (ch ^ (((row & 3) << 2) | ((row >> 2) & 3))); }
__device__ __forceinline__ bf16x8 pack_step(const f32x16& x, int s) {
    v4u p; p.x = pk2(x[8 * s], x[8 * s + 1]); p.y = pk2(x[8 * s + 2], x[8 * s + 3]); p.z = pk2(x[8 * s + 4], x[8 * s + 5]); p.w = pk2(x[8 * s + 6], x[8 * s + 7]);
    return __builtin_bit_cast(bf16x8, p);
}
struct GlaRegs { v4u qv[4], kv[4], vv[4]; float dv; };
__device__ __forceinline__ void gla_load(const Frame& F, int b, int h, int vh, int n, GlaRegs& R) {
    unsigned char* ws = F.ws; int lt = F.tid - 256; asm volatile("" : "+v"(lt));
    const size_t row0 = (size_t)b * SEQ + (size_t)n * 64;
    const GAS char* qp = (const GAS char*)((const bf16*)(ws + WS_Q) + row0 * 512 + h * 128);
    const GAS char* vp = (const GAS char*)((const bf16*)(ws + WS_V) + row0 * D + h * 256 + vh * 128);
    const GAS char* kp = (const GAS char*)((const bf16*)(ws + WS_KDEC) + (((size_t)b * 64 + n) * 512 + h * 128) * 64);
#pragma unroll
    for (int j = 0; j < 4; ++j) { const unsigned ck = (unsigned)lt + 256u * j;
        R.qv[j] = *(const GAS v4u*)(qp + ((ck >> 4) * 1024u + (ck & 15u) * 16u));
        R.vv[j] = *(const GAS v4u*)(vp + ((ck >> 4) * 2048u + (ck & 15u) * 16u));
        R.kv[j] = *(const GAS v4u*)(kp + ck * 16u); }
    R.dv = 0.f; if (lt < 128) R.dv = ((const float*)(ws + WS_TOT))[((size_t)b * 64 + n) * 512 + h * 128 + lt];
}
__device__ __forceinline__ void gla_put(const Frame& F, const GlaRegs& R, LAS unsigned char* buf) {
    int lt = F.tid - 256; asm volatile("" : "+v"(lt));
#pragma unroll
    for (int j = 0; j < 4; ++j) { const unsigned ck = (unsigned)lt + 256u * j;
        *(LAS v4u*)(buf + GQ_OFF + (ck >> 4) * 272u + (ck & 15u) * 16u) = R.qv[j];
        *(LAS v4u*)(buf + GV_OFF + voff_b(ck >> 4, ck & 15u)) = R.vv[j];
        *(LAS v4u*)(buf + GK_OFF + (ck >> 3) * 144u + (ck & 7u) * 16u) = R.kv[j]; }
    if (lt < 128) ((LAS float*)(buf + GD_OFF))[lt] = __expf(R.dv);
}
__device__ __forceinline__ void gla_rec(const Frame& F, int unit) {
    unsigned char* ws = F.ws;
    const int b = unit >> 3, h = (unit >> 1) & 3, vh = unit & 1;
    const int w = F.wave;
#define GLA_BAR() do { asm volatile("s_waitcnt lgkmcnt(0)" ::: "memory"); __builtin_amdgcn_s_barrier(); asm volatile("" ::: "memory"); } while (0)
    __syncthreads();
    if (w >= 4) {
        GlaRegs Ra, Rb;
        gla_load(F, b, h, vh, 0, Ra); gla_put(F, Ra, F.lds); gla_load(F, b, h, vh, 1, Ra); gla_load(F, b, h, vh, 2, Rb);
        GLA_BAR();
#pragma unroll 1
        for (int n = 0; n < NCH; n += 2) {
            gla_put(F, Ra, F.lds + GBUF); if (n + 3 < NCH) gla_load(F, b, h, vh, n + 3, Ra);
            GLA_BAR();
            if (n + 2 < NCH) { gla_put(F, Rb, F.lds); if (n + 4 < NCH) gla_load(F, b, h, vh, n + 4, Rb); }
            GLA_BAR();
        }
    } else {
        f32x16 S[4];
#pragma unroll
        for (int kt = 0; kt < 4; ++kt)
#pragma unroll
            for (int i = 0; i < 16; ++i) S[kt][i] = 0.f;
        GLA_BAR();
#pragma unroll 1
        for (int n = 0; n < NCH; ++n) {
            int lane = F.lane; asm volatile("" : "+v"(lane));
            const int r = lane & 31, hh = lane >> 5;
            const unsigned blk = (lane >> 4) & 1, q4 = (lane & 15) >> 2, p4 = lane & 3;
            LAS unsigned char* buf = F.lds + (n & 1) * GBUF;
            const LAS unsigned char* kbase = buf + GK_OFF + r * 144 + hh * 16;
            const LAS unsigned char* qbase = buf + GQ_OFF + r * 272 + hh * 16;
            const LAS unsigned char* dbase = buf + GD_OFF + hh * 16;
            const unsigned chv = 4u * (unsigned)w + 2u * blk + (p4 >> 1);
            const unsigned vb0 = (unsigned)(size_t)(buf + GV_OFF) + 256u * (8u * hh + q4) + 16u * (chv ^ ((q4 << 2) | ((2u * hh) & 3u))) + 8u * (p4 & 1u);
            const unsigned vb1 = (unsigned)(size_t)(buf + GV_OFF) + 256u * (8u * hh + 4u + q4) + 16u * (chv ^ ((q4 << 2) | ((2u * hh + 1u) & 3u))) + 8u * (p4 & 1u);
            s16x4 l0, h0, l1, h1, l2, h2, l3, h3;
            asm volatile("ds_read_b64_tr_b16 %0, %8\n\tds_read_b64_tr_b16 %1, %9\n\tds_read_b64_tr_b16 %2, %8 offset:4096\n\tds_read_b64_tr_b16 %3, %9 offset:4096\n\t"
                         "ds_read_b64_tr_b16 %4, %8 offset:8192\n\tds_read_b64_tr_b16 %5, %9 offset:8192\n\tds_read_b64_tr_b16 %6, %8 offset:12288\n\tds_read_b64_tr_b16 %7, %9 offset:12288\n\ts_waitcnt lgkmcnt(0)"
                         : "=&v"(l0), "=&v"(h0), "=&v"(l1), "=&v"(h1), "=&v"(l2), "=&v"(h2), "=&v"(l3), "=&v"(h3) : "v"(vb0), "v"(vb1) : "memory");
            bf16x8 vbf[4];
            vbf[0] = __builtin_shufflevector(l0, h0, 0, 1, 2, 3, 4, 5, 6, 7); vbf[1] = __builtin_shufflevector(l1, h1, 0, 1, 2, 3, 4, 5, 6, 7);
            vbf[2] = __builtin_shufflevector(l2, h2, 0, 1, 2, 3, 4, 5, 6, 7); vbf[3] = __builtin_shufflevector(l3, h3, 0, 1, 2, 3, 4, 5, 6, 7);
#pragma unroll
            for (int kt = 0; kt < 4; ++kt)
#pragma unroll
                for (int g = 0; g < 4; ++g) { const f32x4 dq = *(const LAS f32x4*)(dbase + kt * 128 + g * 32);
                    S[kt][4 * g] *= dq.x; S[kt][4 * g + 1] *= dq.y; S[kt][4 * g + 2] *= dq.z; S[kt][4 * g + 3] *= dq.w; }
#pragma unroll
            for (int ts = 0; ts < 4; ++ts)
#pragma unroll
                for (int kt = 0; kt < 4; ++kt) { const bf16x8 ka = *(const LAS bf16x8*)(kbase + kt * 4608 + ts * 32);
                    S[kt] = __builtin_amdgcn_mfma_f32_32x32x16_bf16(ka, vbf[ts], S[kt], 0, 0, 0); }
            f32x16 O[2];
#pragma unroll
            for (int tb = 0; tb < 2; ++tb)
#pragma unroll
                for (int i = 0; i < 16; ++i) O[tb][i] = 0.f;
#pragma unroll
            for (int kt = 0; kt < 4; ++kt)
#pragma unroll
                for (int s = 0; s < 2; ++s) { const bf16x8 sb = pack_step(S[kt], s);
#pragma unroll
                    for (int tb = 0; tb < 2; ++tb) { const bf16x8 qa = *(const LAS bf16x8*)(qbase + tb * 8704 + kt * 64 + s * 32);
                        O[tb] = __builtin_amdgcn_mfma_f32_32x32x16_bf16(qa, sb, O[tb], 0, 0, 0); } }
            GAS bf16* op = (GAS bf16*)((bf16*)(ws + WS_O) + ((size_t)b * SEQ + (size_t)n * 64 + 4 * hh) * D + h * 256 + vh * 128 + 32 * w + r);
#pragma unroll
            for (int tb = 0; tb < 2; ++tb)
#pragma unroll
                for (int i = 0; i < 16; ++i) { const int t = 32 * tb + (i & 3) + 8 * (i >> 2); op[(size_t)t * D] = (bf16)f2bf(O[tb][i]); }
            GLA_BAR();
        }
    }
#undef GLA_BAR
    asm volatile("s_waitcnt vmcnt(0)" ::: "memory");
}
__device__ __forceinline__ float row16_sum(float v) {
    v += __builtin_bit_cast(float, __builtin_amdgcn_update_dpp(0, __builtin_bit_cast(int, v), 0x128, 0xf, 0xf, false));
    v += __builtin_bit_cast(float, __builtin_amdgcn_update_dpp(0, __builtin_bit_cast(int, v), 0x124, 0xf, 0xf, false));
    v += __builtin_bit_cast(float, __builtin_amdgcn_update_dpp(0, __builtin_bit_cast(int, v), 0x122, 0xf, 0xf, false));
    v += __builtin_bit_cast(float, __builtin_amdgcn_update_dpp(0, __builtin_bit_cast(int, v), 0x121, 0xf, 0xf, false));
    return v;
}
__device__ __forceinline__ void gla_norm(const Frame& F, const Args& a, int l) {
    unsigned char* ws = F.ws;
    const int gw = F.vcu * NWAVES + F.wave, NGW = F.G * NWAVES;
    f32x4 g[4];
#pragma unroll
    for (int q = 0; q < 4; ++q) g[q] = *(const GAS f32x4*)(a.in[I_GNG] + (size_t)l * 1024 + 16 * F.lane + 4 * q) * 0.0625f;
    const unsigned vo = 32u * F.lane, vg = 16u * F.lane;
    for (int blk = gw; blk < T / 32; blk += NGW)
#pragma unroll 1
        for (int r8 = 0; r8 < 32; r8 += 8) {
            unsigned char* ob = ws + WS_O + ((size_t)blk * 32 + r8) * (D * 2); const unsigned char* gb = ws + WS_OG + ((size_t)blk * 32 + r8) * D;
            v4u o0[8], o1[8], og[8];
#pragma unroll
            for (int rr = 0; rr < 8; ++rr) { o0[rr] = *(const GAS v4u*)(ob + rr * (D * 2) + vo); o1[rr] = *(const GAS v4u*)(ob + rr * (D * 2) + vo + 16); og[rr] = *(const GAS v4u*)(gb + rr * D + vg); }
            __builtin_amdgcn_sched_barrier(0);
#pragma unroll
            for (int rr = 0; rr < 8; ++rr) {
                f32x4 o[4];
                o[0] = (f32x4){bflo(o0[rr].x), bfhi(o0[rr].x), bflo(o0[rr].y), bfhi(o0[rr].y)}; o[1] = (f32x4){bflo(o0[rr].z), bfhi(o0[rr].z), bflo(o0[rr].w), bfhi(o0[rr].w)};
                o[2] = (f32x4){bflo(o1[rr].x), bfhi(o1[rr].x), bflo(o1[rr].y), bfhi(o1[rr].y)}; o[3] = (f32x4){bflo(o1[rr].z), bfhi(o1[rr].z), bflo(o1[rr].w), bfhi(o1[rr].w)};
                float s = 0.f;
#pragma unroll
                for (int q = 0; q < 4; ++q) s += (o[q].x * o[q].x + o[q].y * o[q].y) + (o[q].z * o[q].z + o[q].w * o[q].w);
                const float rs = 1.0f / sqrtf(row16_sum(s) * (1.0f / 256.0f) + EPS);
                f32x4 y[4];
                y[0] = o[0] * rs * g[0] * fp8x4(og[rr].x); y[1] = o[1] * rs * g[1] * fp8x4(og[rr].y); y[2] = o[2] * rs * g[2] * fp8x4(og[rr].z); y[3] = o[3] * rs * g[3] * fp8x4(og[rr].w);
                *(GAS v4u*)(ob + rr * (D * 2) + vo) = (v4u){pk2(y[0].x, y[0].y), pk2(y[0].z, y[0].w), pk2(y[1].x, y[1].y), pk2(y[1].z, y[1].w)};
                *(GAS v4u*)(ob + rr * (D * 2) + vo + 16) = (v4u){pk2(y[2].x, y[2].y), pk2(y[2].z, y[2].w), pk2(y[3].x, y[3].y), pk2(y[3].z, y[3].w)};
                __builtin_amdgcn_sched_barrier(0); }
        }
}

__device__ __forceinline__ void topk_phase(const Frame& F, const Args& a, int l, int cset) {
    unsigned char* ws = F.ws;
    LAS int* hist = (LAS int*)F.lds; LAS int* base = hist + 128; LAS float* bias = (LAS float*)(hist + 256);
    LAS float* xv = (LAS float*)(F.lds + 2048); LAS float* xs = xv + 2048; LAS int* xi = (LAS int*)(xs + 2048);
    __syncthreads();
    if (F.tid < 128) { hist[F.tid] = 0; bias[F.tid] = a.in[I_RB][l * NE + F.tid]; }
    __syncthreads();
    const int tok = F.tid & 255, half = F.tid >> 8, t = F.vcu * 256 + tok; const bool act = half == 0;
    float val[8], scv[8]; int idx[8], rank[8];
#pragma unroll
    for (int j = 0; j < 8; ++j) { val[j] = -1e30f; scv[j] = 0.f; idx[j] = 0; rank[j] = 0; }
#define TOPK_INSERT(v_, sc_, e_) do { _Pragma("unroll") for (int j = 7; j >= 0; --j) { if ((v_) > val[j]) { if (j < 7) { val[j + 1] = val[j]; scv[j + 1] = scv[j]; idx[j + 1] = idx[j]; } val[j] = (v_); scv[j] = (sc_); idx[j] = (e_); } } } while (0)
    { const float* lg = (const float*)(ws + WS_LOGIT) + (size_t)t * NE + 64 * half;
#pragma unroll 1
      for (int e16 = 0; e16 < 4; ++e16) { f32x4 x[4];
#pragma unroll
          for (int r = 0; r < 4; ++r) x[r] = *(const GAS f32x4*)(lg + 16 * e16 + 4 * r);
#pragma unroll
          for (int r = 0; r < 4; ++r)
#pragma unroll
              for (int q = 0; q < 4; ++q) { const int e = 64 * half + 16 * e16 + 4 * r + q; const float sc = 1.0f / (1.0f + __expf(-x[r][q])); const float v = sc + bias[e]; TOPK_INSERT(v, sc, e); } } }
    if (!act) {
#pragma unroll
        for (int j = 0; j < 8; ++j) { xv[j * 256 + tok] = val[j]; xs[j * 256 + tok] = scv[j]; xi[j * 256 + tok] = idx[j]; } }
    __syncthreads();
    if (act) {
#pragma unroll
        for (int c = 0; c < 8; ++c) { const float v = xv[c * 256 + tok], sc = xs[c * 256 + tok]; const int e = xi[c * 256 + tok]; TOPK_INSERT(v, sc, e); }
#pragma unroll
        for (int j = 0; j < 8; ++j) rank[j] = __hip_atomic_fetch_add(&hist[idx[j]], 1, __ATOMIC_RELAXED, __HIP_MEMORY_SCOPE_WORKGROUP);
    }
#undef TOPK_INSERT
    __syncthreads();
    if (F.tid < 128) base[F.tid] = (int)atomicAdd((unsigned*)(ws + WS_CTL) + CW_CNT + cset * NE + F.tid, (unsigned)hist[F.tid]);
    __syncthreads();
    if (act) { float ssum = 0.f;
#pragma unroll
        for (int j = 0; j < 8; ++j) ssum += scv[j];
        const float inv = 2.5f / ssum;
#pragma unroll
        for (int j = 0; j < 8; ++j) { ((unsigned*)(ws + WS_PK))[(size_t)t * 8 + j] = ((unsigned)idx[j] << 24) | (unsigned)(base[idx[j]] + rank[j]); ((float*)(ws + WS_WTS))[(size_t)t * 8 + j] = scv[j] * inv; } }
    __syncthreads();
}
__device__ __forceinline__ void moe_tiles(const Frame& F, int l) {
    LAS int* ts = (LAS int*)(F.lds + LDS_TS);
    __syncthreads();
    if (F.tid == 0) { const unsigned* cnt = (const unsigned*)(F.ws + WS_CTL) + CW_CNT + l * NE; int s = 0;
        for (int e = 0; e < NE; ++e) { ts[e] = s; s += (int)((__hip_atomic_load(cnt + e, RLX_AGENT) + 255u) >> 8); } ts[NE] = s; }
    __syncthreads();
}
__device__ __forceinline__ void scatter_phase(const Frame& F, int l) {
    unsigned char* ws = F.ws;
    moe_tiles(F, l);
    const LAS int* ts = (const LAS int*)(F.lds + LDS_TS);
    if (F.tid < 256) { const int t = F.vcu * 256 + F.tid;
#pragma unroll
        for (int j = 0; j < 8; ++j) { const unsigned pk = ((const unsigned*)(ws + WS_PK))[(size_t)t * 8 + j]; const int e = (int)(pk >> 24), p = ts[e] * 256 + (int)(pk & 0xffffffu);
            ((int*)(ws + WS_POS))[(size_t)t * 8 + j] = p; ((int*)(ws + WS_SORT))[p] = t; } }
}
template <int MODE>
__device__ __forceinline__ void combine_phase(const Frame& F, bf16* h, const float* gate, float* outf, const float* ng, const float* sc, const float* sh, bf16* U) {
    unsigned char* ws = F.ws;
    const int gw = F.vcu * NWAVES + F.wave, NGW = F.G * NWAVES;
    typedef float f2_t __attribute__((ext_vector_type(2)));
    for (int blk = gw; blk < T / 32; blk += NGW) {
        const int b = (blk * 32) / SEQ;
        f32x4 gv[4], scl[4], sft[4];
#pragma unroll
        for (int n = 0; n < 4; ++n) { const int c = 16 * F.lane + 4 * n; gv[n] = *(const GAS f32x4*)(gate + (size_t)b * 6144 + c); const f32x4 g = *(const GAS f32x4*)(ng + c);
            if (MODE == 0) { scl[n] = g * (*(const GAS f32x4*)(sc + (size_t)b * 6144 + c) + 1.0f); sft[n] = *(const GAS f32x4*)(sh + (size_t)b * 6144 + c); } else { scl[n] = g; sft[n] = (f32x4){0.f, 0.f, 0.f, 0.f}; } }
        const size_t tl = (size_t)blk * 32 + (F.lane & 31);
        const v4u pq = *(const GAS v4u*)((const int*)(ws + WS_POS) + tl * 8 + 4 * (F.lane >> 5)); const f32x4 wq = *(const GAS f32x4*)((const float*)(ws + WS_WTS) + tl * 8 + 4 * (F.lane >> 5));
        for (int rr = 0; rr < 32; rr += 2) {
            v4u yw[2][8], ys[2]; float wk[2][8]; f32x4 hv[2][4];
#pragma unroll
            for (int q = 0; q < 2; ++q) {
#pragma unroll
                for (int k = 0; k < 8; ++k) { const int src = rr + q + 32 * (k >> 2);
                    const int p = __builtin_amdgcn_readlane((int)pq[k & 3], src); wk[q][k] = __builtin_bit_cast(float, __builtin_amdgcn_readlane(__builtin_bit_cast(int, wq[k & 3]), src)) * 0.0625f;
                    yw[q][k] = *(const GAS v4u*)(ws + WS_Y + (size_t)p * 1024 + 16 * F.lane); }
                const bf16* hr = h + ((size_t)blk * 32 + rr + q) * D + 16 * F.lane;
                { const v4u w0 = *(const GAS v4u*)(hr), w1 = *(const GAS v4u*)(hr + 8);
                  hv[q][0] = (f32x4){bflo(w0.x), bfhi(w0.x), bflo(w0.y), bfhi(w0.y)}; hv[q][1] = (f32x4){bflo(w0.z), bfhi(w0.z), bflo(w0.w), bfhi(w0.w)};
                  hv[q][2] = (f32x4){bflo(w1.x), bfhi(w1.x), bflo(w1.y), bfhi(w1.y)}; hv[q][3] = (f32x4){bflo(w1.z), bfhi(w1.z), bflo(w1.w), bfhi(w1.w)}; }
                ys[q] = *(const GAS v4u*)(ws + WS_YS + ((size_t)blk * 32 + rr + q) * D + 16 * F.lane); }
#pragma unroll
            for (int q = 0; q < 2; ++q) { f32x4 acc[4];
#pragma unroll
                for (int n = 0; n < 4; ++n) acc[n] = fp8x4(ys[q][n]) * 0.0625f;
#pragma unroll
                for (int k = 0; k < 8; ++k)
#pragma unroll
                    for (int n = 0; n < 4; ++n) { const f2_t lo = __builtin_amdgcn_cvt_pk_f32_fp8((int)yw[q][k][n], false), hi = __builtin_amdgcn_cvt_pk_f32_fp8((int)yw[q][k][n], true);
                        acc[n] += (f32x4){lo.x, lo.y, hi.x, hi.y} * wk[q][k]; }
                const size_t row = (size_t)blk * 32 + rr + q; float s = 0.f;
#pragma unroll
                for (int n = 0; n < 4; ++n) { acc[n] = hv[q][n] + gv[n] * acc[n]; s += (acc[n].x * acc[n].x + acc[n].y * acc[n].y) + (acc[n].z * acc[n].z + acc[n].w * acc[n].w); }
                const float rs = 1.0f / sqrtf(wave_sum(s, F.lane) * (1.0f / D) + EPS);
                if (MODE == 0) {
                    GAS v4u* hp = (GAS v4u*)(h + row * D + 16 * F.lane);
                    hp[0] = (v4u){pk2(acc[0].x, acc[0].y), pk2(acc[0].z, acc[0].w), pk2(acc[1].x, acc[1].y), pk2(acc[1].z, acc[1].w)};
                    hp[1] = (v4u){pk2(acc[2].x, acc[2].y), pk2(acc[2].z, acc[2].w), pk2(acc[3].x, acc[3].y), pk2(acc[3].z, acc[3].w)};
                    f32x4 y[4];
#pragma unroll
                    for (int n = 0; n < 4; ++n) y[n] = acc[n] * rs * scl[n] + sft[n];
                    (void)U;
                    *(GAS v4u*)(ws + WS_U8 + row * D + 16 * F.lane) = (v4u){pk4_fp8(y[0].x, y[0].y, y[0].z, y[0].w), pk4_fp8(y[1].x, y[1].y, y[1].z, y[1].w), pk4_fp8(y[2].x, y[2].y, y[2].z, y[2].w), pk4_fp8(y[3].x, y[3].y, y[3].z, y[3].w)};
                } else {
                    float* orow = outf + row * D + 16 * F.lane;
#pragma unroll
                    for (int n = 0; n < 4; ++n) *(GAS f32x4*)(orow + 4 * n) = acc[n] * rs * scl[n];
                } }
        }
    }
}

__device__ __forceinline__ void stagger(int bx, int us) {
    const unsigned long long t0 = __builtin_amdgcn_s_memrealtime(); const unsigned long long wait = (unsigned long long)(((bx >> 3) & 3) * us) * 100ull;
    while (__builtin_amdgcn_s_memrealtime() - t0 < wait) __builtin_amdgcn_s_sleep(8);
}
#ifndef MK_STAG_IN
#define MK_STAG_IN 0
#endif
__device__ __forceinline__ void wg_seam(int tid) {
    asm volatile("s_waitcnt vmcnt(0)" ::: "memory");
    __syncthreads();
    if (tid < 64) { __builtin_amdgcn_fence(__ATOMIC_ACQUIRE, "agent"); asm volatile("s_waitcnt vmcnt(0)" ::: "memory"); }
    __syncthreads();
}
constexpr int NPH_L = 15, NPHASE = 1 + DEPTH * NPH_L + 1;
#ifndef MK_DBG_A
#define MK_DBG_A -1
#define MK_DBG_B -1
#endif
__global__ void __launch_bounds__(NTHR, 2) mk_fwd(Args args) {
    extern __shared__ __attribute__((aligned(16))) unsigned char lds_raw[];
    Frame F;
    F.lds = (LAS unsigned char*)lds_raw; F.ws = args.ws;
    F.tid = threadIdx.x; F.lane = F.tid & 63; F.wave = __builtin_amdgcn_readfirstlane(F.tid >> 6);
    F.G = gridDim.x; { const int bx = blockIdx.x; F.bx = bx; F.vcu = (F.G % 8 == 0) ? (bx % 8) * (F.G / 8) + bx / 8 : bx; }
    volatile LAS unsigned* misc = (volatile LAS unsigned*)(F.lds + LDS_MISC);
    if (F.tid < 64) misc[F.tid] = 0u;
    __syncthreads();
    XcdBarrier bar; bar.bar = (unsigned*)(args.ws + WS_CTL) + CW_BAR; bar.x = 0; bar.st = nullptr;
    if (!MK_PER_PHASE) bar = xcd_barrier_post((unsigned*)(args.ws + WS_CTL) + CW_BAR, misc + 8);
    const int lo = args.ph_lo, hi = args.ph_hi;
    if (MK_DBG_A >= 0 && F.tid == 0) misc[15] = (unsigned)__builtin_amdgcn_s_memrealtime();
#ifndef MK_G4_FROM_U
#define MK_G4_FROM_U 0
#endif
#ifndef MK_G3B_FIRST
#define MK_G3B_FIRST false
#endif
#ifndef MK_MASK
#define MK_MASK 0x7ffff
#endif
#define EN(j) (((MK_MASK) >> (j)) & 1)
#ifndef MK_REP_MASK
#define MK_REP_MASK 0
#endif
#define REP(j) for (int rep_ = 0; rep_ < 1 + (((MK_REP_MASK) >> (j)) & 1); ++rep_)
#define IN(k) (lo <= (k) && (k) < hi)
#define FRESH_TID(t_) int t_; { int l_; asm volatile("v_mbcnt_lo_u32_b32 %0, -1, 0\n\tv_mbcnt_hi_u32_b32 %0, -1, %0" : "=v"(l_)); int wv_ = F.wave; asm volatile("" : "+s"(wv_)); t_ = wv_ * 64 + l_; }
#define FRESH(P) Frame P = F; { FRESH_TID(t_); P.tid = t_; P.lane = t_ & 63; unsigned char* w_ = args.ws; asm volatile("" : "+s"(w_)); P.ws = w_; int g_ = F.G, v_ = F.vcu, b_ = F.bx; asm volatile("" : "+s"(g_), "+s"(v_), "+s"(b_)); P.G = g_; P.vcu = v_; P.bx = b_; } unsigned char* ws = P.ws
#define LSEAM(k) do { if (IN(k) && IN((k) + 1)) { FRESH_TID(tl_); wg_seam(tl_); } } while (0)
#define SEAM(k) do { if (IN(k) && IN((k) + 1)) { FRESH_TID(tb_); xcd_barrier(bar, tb_ == 0); \
    if (MK_DBG_A >= 0 && tb_ == 0 && F.bx == 0) { const unsigned now_ = (unsigned)__builtin_amdgcn_s_memrealtime(); misc[16 + (k)] = now_ - misc[15]; misc[15] = now_; } } } while (0)
    bf16* H = (bf16*)(args.ws + WS_H);
    if (EN(15) && IN(0)) REP(15) { FRESH(P); (void)ws; p0_prologue(P, args); } SEAM(0);
#pragma unroll 1
    for (int l = 0; l < DEPTH; ++l) {
        const int p0 = 1 + NPH_L * l;
        int f8from = MK_FP8_EXP1_FROM; asm volatile("" : "+s"(f8from));
#define MODP ((const float*)(ws + WS_MOD) + (size_t)l * 16 * 6144)
        if (l == 0) { if (EN(0) && IN(p0 + 0)) REP(0) { FRESH(P); norm_phase<false, false>(P, args.in[I_X], args.in[I_N1G] + l * D, MODP + 1024, MODP + 0, (bf16*)nullptr, nullptr, ws + WS_U8); }
            SEAM(p0 + 0); }
        if (EN(1) && IN(p0 + 1)) REP(1) { FRESH(P); pg8::Gemm g{(const bf16*)(ws + WS_U8), (const bf16*)(ws + WS_WIN8 + (size_t)l * NSEC * D), D / 2, nullptr}; pg8::StaticOrder S; S.init(T, NSEC, P.G, P.bx);
            EpiInProj E{ws}; pg8::gemm_phase<EpiInProj, pg8::StaticOrder, true, true, false, true>(P.lds, g, S, E, P.tid, P.wave); }
        SEAM(p0 + 1);
        if (EN(2) && IN(p0 + 2)) REP(2) { FRESH(P); (void)ws; if (EN(17)) REP(20) for (int u = P.vcu; u < 1024; u += P.G) gla_prep(P, args, l, u); }
        SEAM(p0 + 2);
        if (EN(3) && IN(p0 + 3)) REP(3) { FRESH(P); (void)ws;
            const bool light = P.vcu < 128; const int j = P.vcu & 127, hb = j & 7, grp = j >> 3;
            const int t0 = light ? 16 * (32 - MK_RG_LIGHT) + grp * MK_RG_LIGHT : grp * (32 - MK_RG_LIGHT), nt = light ? MK_RG_LIGHT : 32 - MK_RG_LIGHT;
            if (light && EN(17)) gla_rec(P, P.vcu);
            if (EN(18) && nt > 0) rg_gate_phase(P, args, l, hb, t0, nt); }
        SEAM(p0 + 3);
        if (EN(4) && IN(p0 + 4)) REP(4) { FRESH(P); (void)ws; if (EN(18)) for (int u = P.vcu; u < 1024; u += P.G) scan_pass1(P, u); }
        SEAM(p0 + 4);
        if (EN(5) && IN(p0 + 5)) { FRESH(P); (void)ws; if (EN(18)) {
#if MK_SCAN3_NEW
            scan_pass3_panel(P, P.vcu);
#else
            for (int k = 0; k < 4; ++k) scan_pass3(P, 4 * P.vcu + k);
#endif
            } if (EN(17)) gla_norm(P, args, l); }
        LSEAM(p0 + 5);
        if (EN(6) && IN(p0 + 6)) REP(6) {
            { FRESH(P); pg8::PanelOrder S{P.vcu, 4};
              pg8::Gemm g{(const bf16*)(ws + WS_IX), (const bf16*)(ws + WS_WA) + (size_t)l * D * D, D, nullptr}; EpiMerge<true> E{ws + WS_GA, (bf16*)(ws + WS_MBUF)};
              pg8::gemm_phase<EpiMerge<true>, pg8::PanelOrder, true, true, false>(P.lds, g, S, E, P.tid, P.wave); }
            { FRESH(P); pg8::PanelOrder S{P.vcu, 4};
              pg8::Gemm g{(const bf16*)(ws + WS_O), (const bf16*)(ws + WS_WB) + (size_t)l * D * D, D, nullptr}; EpiMerge<MK_G3B_FIRST> E{ws + WS_GB, (bf16*)(ws + WS_MBUF)};
              pg8::gemm_phase<EpiMerge<MK_G3B_FIRST>, pg8::PanelOrder, true, true, false>(P.lds, g, S, E, P.tid, P.wave); } }
        LSEAM(p0 + 6);
        if (EN(7) && IN(p0 + 7)) { FRESH(P); pg8::PanelOrder S{P.vcu, 4};
            pg8::Gemm g{(const bf16*)(ws + WS_MBUF), (const bf16*)(ws + WS_WO) + (size_t)l * D * D, D, nullptr};
            if (l == 0) { EpiRes<true> E{args.in[I_X], H, MODP + 2048}; pg8::gemm_phase<EpiRes<true>, pg8::PanelOrder, true, true, false>(P.lds, g, S, E, P.tid, P.wave); }
            else { EpiRes<false> E{H, H, MODP + 2048}; pg8::gemm_phase<EpiRes<false>, pg8::PanelOrder, true, true, false>(P.lds, g, S, E, P.tid, P.wave); } }
        LSEAM(p0 + 7);
        if (EN(8) && IN(p0 + 8)) REP(8) { FRESH(P); norm_phase<false, true>(P, H, args.in[I_N2G] + l * D, MODP + 4096, MODP + 3072, (bf16*)(ws + WS_U), nullptr, (l >= f8from) ? (unsigned char*)args.out : (unsigned char*)nullptr);
            if (l >= f8from && P.vcu == 0 && P.tid < D / 16) { unsigned z_ = 0u; asm volatile("" : "+v"(z_)); *(GAS v4u*)((unsigned char*)args.out + (size_t)T * D + P.tid * 16) = (v4u){z_, z_, z_, z_}; }
            for (int i = P.vcu * NTHR + P.tid; i < PMAX; i += P.G * NTHR) ((int*)(ws + WS_SORT))[i] = T; }
        LSEAM(p0 + 8);
        if (EN(9) && IN(p0 + 9)) REP(9) { FRESH(P); pg8::PanelOrder S{P.vcu, 1};
            pg8::Gemm g{(const bf16*)(ws + WS_U), (const bf16*)(ws + WS_ROUT) + (size_t)l * 256 * D, D, nullptr}; EpiLogit E{(float*)(ws + WS_LOGIT)};
            pg8::gemm_phase<EpiLogit, pg8::PanelOrder, true, true, false>(P.lds, g, S, E, P.tid, P.wave); }
        LSEAM(p0 + 9);
        if (EN(10) && IN(p0 + 10)) { if ((MK_REP_MASK >> 23) & 1) { FRESH(P); (void)ws; topk_phase(P, args, l, l + 2); } { FRESH(P); (void)ws; topk_phase(P, args, l, l); } }
        SEAM(p0 + 10);
        if (EN(11) && IN(p0 + 11)) REP(11) { FRESH(P); (void)ws; scatter_phase(P, l); }
        SEAM(p0 + 11);
        if (EN(12) && IN(p0 + 12)) REP(12) {
            if (l >= f8from) {
              { FRESH(P); moe_tiles(P, l); const LAS int* ts = (const LAS int*)(P.lds + LDS_TS);
                pg8::MoeOrder S{ts, 2, P.G, P.vcu, ts[NE] * 2};
                pg8::Gemm g{(const bf16*)args.out, (const bf16*)(ws + WS_EGU + (size_t)l * NE * 512 * D * 2), D / 2, (const int*)(ws + WS_SORT)}; EpiGlu E{(bf16*)(ws + WS_ACT)};
                pg8::gemm_phase<EpiGlu, pg8::MoeOrder, true, true, true, true>(P.lds, g, S, E, P.tid, P.wave); }
              { FRESH(P); pg8::StaticOrder S; S.init(T, 512, P.G, P.bx);
                pg8::Gemm g{(const bf16*)args.out, (const bf16*)(ws + WS_SGU + (size_t)l * 512 * D * 2), D / 2, nullptr}; EpiGlu E{(bf16*)(ws + WS_ACTS)};
                pg8::gemm_phase<EpiGlu, pg8::StaticOrder, true, true, false, true>(P.lds, g, S, E, P.tid, P.wave); }
            } else {
              { FRESH(P); moe_tiles(P, l); const LAS int* ts = (const LAS int*)(P.lds + LDS_TS);
                pg8::MoeOrder S{ts, 2, P.G, P.vcu, ts[NE] * 2};
                pg8::Gemm g{(const bf16*)(ws + WS_U), (const bf16*)(ws + WS_EGU) + (size_t)l * NE * 512 * D, D, (const int*)(ws + WS_SORT)}; EpiGlu E{(bf16*)(ws + WS_ACT)};
                pg8::gemm_phase<EpiGlu, pg8::MoeOrder, true, true, true>(P.lds, g, S, E, P.tid, P.wave); }
              { FRESH(P); pg8::StaticOrder S; S.init(T, 512, P.G, P.bx);
                pg8::Gemm g{(const bf16*)(ws + WS_U), (const bf16*)(ws + WS_SGU) + (size_t)l * 512 * D, D, nullptr}; EpiGlu E{(bf16*)(ws + WS_ACTS)};
                pg8::gemm_phase<EpiGlu, pg8::StaticOrder, true, true, false>(P.lds, g, S, E, P.tid, P.wave); } } }
        SEAM(p0 + 12);
        if (EN(13) && IN(p0 + 13)) {
            REP(21) { FRESH(P); moe_tiles(P, l); const LAS int* ts = (const LAS int*)(P.lds + LDS_TS);
              pg8::MoeOrder S{ts, 4, P.G, P.vcu, ts[NE] * 4};
              pg8::Gemm g{(const bf16*)(ws + WS_ACT), (const bf16*)(ws + WS_EDN) + (size_t)l * NE * D * DE, DE, nullptr}; EpiY E{ws + WS_Y};
              pg8::gemm_phase<EpiY, pg8::MoeOrder, true, true, false>(P.lds, g, S, E, P.tid, P.wave); }
            { FRESH(P); pg8::StaticOrder S; S.init(T, D, P.G, P.bx);
              pg8::Gemm g{(const bf16*)(ws + WS_ACTS), (const bf16*)(ws + WS_SDN) + (size_t)l * D * DE, DE, nullptr}; EpiY E{ws + WS_YS};
              pg8::gemm_phase<EpiY, pg8::StaticOrder, true, true, false>(P.lds, g, S, E, P.tid, P.wave); } }
        SEAM(p0 + 13);
        if (EN(14) && IN(p0 + 14)) { FRESH(P);
            if (l + 1 < DEPTH) { const float* modn = (const float*)(ws + WS_MOD) + (size_t)(l + 1) * 16 * 6144;
                combine_phase<0>(P, H, MODP + 5120, nullptr, args.in[I_N1G] + (l + 1) * D, modn + 1024, modn + 0, (bf16*)(ws + WS_U)); }
            else combine_phase<1>(P, H, MODP + 5120, args.out, args.in[I_FG], nullptr, nullptr, nullptr); }
        if (l + 1 < DEPTH) SEAM(p0 + 14);
    }
    if (MK_DBG_A >= 0 && F.bx == 0) {
        __syncthreads(); asm volatile("s_waitcnt vmcnt(0)" ::: "memory");
        if (F.tid == 0) { const unsigned now_ = (unsigned)__builtin_amdgcn_s_memrealtime(); misc[16 + NPHASE - 2] = now_ - misc[15]; }
        __syncthreads();
        const int sa = MK_DBG_A, sb = MK_DBG_B;
        const float dA = (sa == 15) ? misc[16] * 0.01f : (misc[16 + 1 + sa] + misc[16 + 1 + NPH_L + sa]) * 0.01f;
        const float dB = (sb == 15) ? misc[16] * 0.01f : (misc[16 + 1 + sb] + misc[16 + 1 + NPH_L + sb]) * 0.01f;
        if (F.tid == 0) args.out[0] = 10.0f * dA; else if (F.tid <= 670) args.out[F.tid] = dB;
    }
#undef MODP
#undef IN
#undef SEAM
}

#ifndef MK_SKIP_LO
#define MK_SKIP_LO 0
#define MK_SKIP_HI 0
#endif
#ifndef MK_NLAUNCH
#define MK_NLAUNCH NPHASE
#endif
extern "C" void kernel_launch(void* const* d_in, const int* in_sizes, int n_in, void* d_out, int out_size, void* d_ws, size_t ws_size, hipStream_t stream) {
    static int grid = 0;
    if (grid == 0) {
        if (n_in != N_INPUTS || out_size != T * D || ws_size < WS_END) { fprintf(stderr, "kernel_launch: unexpected problem shape (n_in %d out %d ws %zu, need %zu)\n", n_in, out_size, ws_size, (size_t)WS_END); grid = -1; return; }
        int dev = 0, cus = 0, per_cu = 0;
        if (hipGetDevice(&dev) != hipSuccess || hipDeviceGetAttribute(&cus, hipDeviceAttributeMultiprocessorCount, dev) != hipSuccess) { grid = -1; return; }
        if (hipFuncSetAttribute((const void*)mk_fwd, hipFuncAttributeMaxDynamicSharedMemorySize, LDS_BYTES) != hipSuccess) { fprintf(stderr, "kernel_launch: hipFuncSetAttribute failed\n"); grid = -1; return; }
        if (hipOccupancyMaxActiveBlocksPerMultiprocessor(&per_cu, (const void*)mk_fwd, NTHR, LDS_BYTES) != hipSuccess || per_cu < 1) { fprintf(stderr, "kernel_launch: occupancy query says %d\n", per_cu); }
        (void)hipGetLastError();
        if (cus != T / 256) { fprintf(stderr, "kernel_launch: built for %d CUs (one 256-row panel per workgroup), device has %d\n", T / 256, cus); grid = -1; return; }
        grid = cus;
    }
    if (grid < 0) return;
    if (hipMemsetAsync((char*)d_ws + WS_CTL, 0, CTL_ZERO_BYTES, stream) != hipSuccess) return;
    Args a{};
    for (int i = 0; i < N_INPUTS; ++i) a.in[i] = (const float*)d_in[i];
    a.out = (float*)d_out; a.ws = (unsigned char*)d_ws;
#if MK_PER_PHASE
    for (int p = 0; p < MK_NLAUNCH; ++p) { if (p >= MK_SKIP_LO && p < MK_SKIP_HI) continue; a.ph_lo = p; a.ph_hi = p + 1; hipLaunchKernelGGL(mk_fwd, dim3(grid), dim3(NTHR), LDS_BYTES, stream, a); }
#else
    a.ph_lo = 0; a.ph_hi = NPHASE; hipLaunchKernelGGL(mk_fwd, dim3(grid), dim3(NTHR), LDS_BYTES, stream, a);
#endif
}
```

```cpp
#include <hip/hip_runtime.h>
#include <cstdio>
#include <cstdint>

#ifndef MK_PER_PHASE
#define MK_PER_PHASE 0
#define MK_SCAN3_NEW 1
#ifndef MK_FP8_EXP1_FROM
#define MK_FP8_EXP1_FROM 0
#endif
#ifndef MK_TLB_WARM
#define MK_TLB_WARM 1
#endif
#ifndef MK_RG_LIGHT
#define MK_RG_LIGHT 4
#endif
#endif

namespace pg8 {
#define PG8_LAS __attribute__((address_space(3)))
typedef unsigned short bf16_t;
typedef short bf16x8 __attribute__((ext_vector_type(8)));
typedef float f32x4 __attribute__((ext_vector_type(4)));
typedef unsigned u32x4 __attribute__((ext_vector_type(4)));
constexpr int BM = 256, BK = 64, HALF = 128, HTB = HALF * BK * 2, STAGE_BYTES = 8 * HTB, NXCD = 8, WGM = 8;

__host__ __device__ __forceinline__ int lds_byte(int r, int c) { const int st = (r >> 4) * 2 + (c >> 5), rr = r & 15, cc = c & 31, ob = rr * 64 + cc * 2; return st * 1024 + (ob ^ (((ob >> 9) & 1) << 5)); }
__host__ __device__ __forceinline__ void stage_rc(int b, int& R, int& C) { const int st = b / 1024, sb = b % 1024, swz = sb ^ (((sb >> 9) & 1) << 5); R = (st >> 1) * 16 + swz / 64; C = (st & 1) * 32 + (swz % 64) / 2; }
__host__ __device__ __forceinline__ int perm32(int rho) { const int n = rho >> 4, i = rho & 15; return 8 * (i >> 2) + 4 * n + (i & 3); }

struct Unit { int pm, pn; };
struct Gemm { const bf16_t* A; const bf16_t* Bt; int K; const int* rowidx; };

struct StaticOrder {
    int nM, nN, nwg, G, c;
    __host__ __device__ void init(int M, int N, int G_, int c_) { nM = M / BM; nN = N / BM; nwg = nM * nN; G = G_; c = c_; }
    __host__ __device__ bool next(int i, Unit& u) const {
        const long L = (long)i * G + c; if (L >= nwg) return false;
        int wgid = (int)L; { const int q = nwg / NXCD, r = nwg % NXCD, xcd = wgid % NXCD, off = wgid / NXCD; wgid = (xcd < r ? xcd * (q + 1) : r * (q + 1) + (xcd - r) * q) + off; }
        const int nig = WGM * nN, gid = wgid / nig, fm = gid * WGM, gsz = (nM - fm) < WGM ? (nM - fm) : WGM;
        u.pm = fm + ((wgid % nig) % gsz); u.pn = (wgid % nig) / gsz; return true;
    }
};
struct PanelOrder {
    int pm, nN;
    __device__ __forceinline__ bool next(int i, Unit& u) const { if (i >= nN) return false; u.pm = pm; u.pn = i; return true; }
};
struct MoeOrder {
    const PG8_LAS int* ts; int npn, G, c, total;
    __device__ __forceinline__ bool next(int i, Unit& u) const {
        const int L = i * G + c; if (L >= total) return false;
        const int tile = L / npn, j = L - tile * npn;
        int lo = 0, hi = 128;
        while (hi - lo > 1) { const int mid = (lo + hi) >> 1; if (ts[mid] <= tile) lo = mid; else hi = mid; }
        u.pm = tile; u.pn = lo * npn + j; return true;
    }
};

__device__ __forceinline__ unsigned cvt_pk_bf16(float lo, float hi) { typedef __bf16 bf2_t __attribute__((ext_vector_type(2))); typedef float f2_t __attribute__((ext_vector_type(2)));
    return __builtin_bit_cast(unsigned, __builtin_convertvector((f2_t){lo, hi}, bf2_t)); }

template <class Epi, class Sched, bool ALIGN_EPI, bool SP2, bool GATHER, bool FP8 = false>
__device__ __forceinline__ void gemm_phase(PG8_LAS unsigned char* lds, const Gemm g, const Sched& S, const Epi& E, const int tid, const int wid) {
    const int lane = tid & 63, wr = wid >> 2, wc = wid & 3, fr = lane & 15, fq = lane >> 4;
    const int K = g.K, nt = K / BK;
    unsigned voffA[2], voffB[2];
#pragma unroll
    for (int i = 0; i < 2; ++i) { int R, C; stage_rc(tid * 16 + i * 8192, R, C); const int Rb = (R & ~31) + perm32(R & 31);
        voffA[i] = (unsigned)(R * K + C) * 2u; voffB[i] = (unsigned)(Rb * K + C) * 2u; }
    const size_t kstep = (size_t)(BK * 2);
    const size_t hstep = (size_t)HALF * K * 2;
    const size_t tstep = 2 * hstep;
    const unsigned ldsw = (unsigned)wid * 1024u;
    const int aoff = lds_byte(wr * 64 + fr, fq * 8), boff = lds_byte(wc * 32 + fr, fq * 8);
    unsigned gc[2][2], gn[2][2];
#define PG8_SA(b, h) (((b) * 2 + (h)) * HTB)
#define PG8_SB(b, h) ((4 + (b) * 2 + (h)) * HTB)
#define PG8_STAGE(bufoff, gbase, voff) do { _Pragma("unroll") for (int _i = 0; _i < 2; ++_i) \
        __builtin_amdgcn_global_load_lds((const unsigned*)((const char*)(gbase) + (voff)[_i]), (PG8_LAS unsigned*)(lds + (bufoff) + ldsw + _i * 8192), 16, 0, 0); } while (0)
#define PG8_STAGE_A(bufoff, kb, h, NX) do { if constexpr (GATHER) { _Pragma("unroll") for (int _i = 0; _i < 2; ++_i) { const unsigned _o = (NX) ? gn[h][_i] : gc[h][_i]; \
        __builtin_amdgcn_global_load_lds((const unsigned*)((const char*)(kb) + _o), (PG8_LAS unsigned*)(lds + (bufoff) + ldsw + _i * 8192), 16, 0, 0); } } \
        else { PG8_STAGE(bufoff, (const char*)(kb) + ((h) ? hstep : (size_t)0), voffA); } } while (0)
#define PG8_LD32(dst, off) do { const v4i_ lo_ = *(const PG8_LAS v4i_*)(lds + (off)), hi_ = *(const PG8_LAS v4i_*)(lds + (off) + 1024); dst = __builtin_shufflevector(lo_, hi_, 0, 1, 2, 3, 4, 5, 6, 7); } while (0)
#define PG8_LDA(dst, b, h) do { if constexpr (FP8) { _Pragma("unroll") for (int m = 0; m < 4; ++m) PG8_LD32(dst##8[m], PG8_SA(b, h) + aoff + m * 2048); } \
        else { _Pragma("unroll") for (int m = 0; m < 4; ++m) _Pragma("unroll") for (int k = 0; k < 2; ++k) dst[m][k] = *(const PG8_LAS bf16x8*)(lds + PG8_SA(b, h) + aoff + m * 2048 + k * 1024); } } while (0)
#define PG8_LDB(dst, b, h) do { if constexpr (FP8) { _Pragma("unroll") for (int n = 0; n < 2; ++n) PG8_LD32(dst##8[n], PG8_SB(b, h) + boff + n * 2048); } \
        else { _Pragma("unroll") for (int n = 0; n < 2; ++n) _Pragma("unroll") for (int k = 0; k < 2; ++k) dst[n][k] = *(const PG8_LAS bf16x8*)(lds + PG8_SB(b, h) + boff + n * 2048 + k * 1024); } } while (0)
#define PG8_MMA(ai, bj, At, Bt) do { __builtin_amdgcn_s_setprio(1); if constexpr (FP8) { _Pragma("unroll") for (int m = 0; m < 4; ++m) _Pragma("unroll") for (int n = 0; n < 2; ++n) \
        asm volatile("v_mfma_scale_f32_16x16x128_f8f6f4 %0, %1, %2, %0, %3, %4 op_sel_hi:[0,0,0]" : "+v"(acc[ai][bj][m][n]) : "v"(Bt##8[n]), "v"(At##8[m]), "v"(0x79797979), "v"(0x7F7F7F7F)); } \
    else { _Pragma("unroll") for (int m = 0; m < 4; ++m) _Pragma("unroll") for (int n = 0; n < 2; ++n) _Pragma("unroll") for (int k = 0; k < 2; ++k) \
        acc[ai][bj][m][n] = __builtin_amdgcn_mfma_f32_16x16x32_bf16(Bt[n][k], At[m][k], acc[ai][bj][m][n], 0, 0, 0); } __builtin_amdgcn_s_setprio(0); } while (0)
#define PG8_WAIT_V(n) asm volatile("s_waitcnt vmcnt(" #n ")" ::: "memory")
#define PG8_WAIT_L(n) asm volatile("s_waitcnt lgkmcnt(" #n ")" ::: "memory")
#define PG8_BAR __builtin_amdgcn_s_barrier()
#define PG8_SCHED __builtin_amdgcn_sched_barrier(0)
#define PG8_LOAD_ROWS(dst, un) do { int _ln; asm volatile("v_mbcnt_lo_u32_b32 %0, -1, 0\n\tv_mbcnt_hi_u32_b32 %0, -1, %0" : "=v"(_ln)); const int _t = wid * 64 + _ln; \
        _Pragma("unroll") for (int _i = 0; _i < 2; ++_i) { int _R, _C; stage_rc(_t * 16 + _i * 8192, _R, _C); _Pragma("unroll") for (int _h = 0; _h < 2; ++_h) { \
        const int _tok = ((const __attribute__((address_space(1))) int*)g.rowidx)[(un).pm * BM + _h * HALF + _R]; dst[_h][_i] = (unsigned)_tok * (unsigned)(K * 2) + (unsigned)_C * 2u; } } } while (0)
#define PG8_ROWS_ISSUE(tk, un) do { int _ln; asm volatile("v_mbcnt_lo_u32_b32 %0, -1, 0\n\tv_mbcnt_hi_u32_b32 %0, -1, %0" : "=v"(_ln)); const int _t = wid * 64 + _ln; \
        _Pragma("unroll") for (int _i = 0; _i < 2; ++_i) { int _R, _C; stage_rc(_t * 16 + _i * 8192, _R, _C); _Pragma("unroll") for (int _h = 0; _h < 2; ++_h) \
        tk[_h][_i] = ((const __attribute__((address_space(1))) int*)g.rowidx)[(un).pm * BM + _h * HALF + _R]; } } while (0)
#define PG8_ROWS_FINISH(dst, tk) do { int _ln; asm volatile("v_mbcnt_lo_u32_b32 %0, -1, 0\n\tv_mbcnt_hi_u32_b32 %0, -1, %0" : "=v"(_ln)); const int _t = wid * 64 + _ln; \
        _Pragma("unroll") for (int _i = 0; _i < 2; ++_i) { int _R, _C; stage_rc(_t * 16 + _i * 8192, _R, _C); _Pragma("unroll") for (int _h = 0; _h < 2; ++_h) \
        dst[_h][_i] = (unsigned)tk[_h][_i] * (unsigned)(K * 2) + (unsigned)_C * 2u; } } while (0)
    Unit cur, nxt, nx2; int ui = 0;
    if (!S.next(0, cur)) return;
    bool has_next = S.next(1, nxt);
    f32x4 acc[2][2][4][2];
#pragma unroll
    for (int a = 0; a < 2; ++a)
#pragma unroll
        for (int b = 0; b < 2; ++b)
#pragma unroll
            for (int m = 0; m < 4; ++m)
#pragma unroll
                for (int n = 0; n < 2; ++n) acc[a][b][m][n] = (f32x4){0.f, 0.f, 0.f, 0.f};
    bf16x8 At[4][2], B0[2][2], B1[2][2];
    typedef int v4i_ __attribute__((ext_vector_type(4))); typedef int v8i_ __attribute__((ext_vector_type(8)));
    v8i_ At8[4], B08[2], B18[2];
    const char* cA = GATHER ? (const char*)g.A : (const char*)g.A + (size_t)cur.pm * tstep; const char* cB = (const char*)g.Bt + (size_t)cur.pn * tstep;
    if constexpr (GATHER) { PG8_LOAD_ROWS(gc, cur); if (has_next) { PG8_LOAD_ROWS(gn, nxt); } else {
#pragma unroll
        for (int _h = 0; _h < 2; ++_h)
#pragma unroll
            for (int _i = 0; _i < 2; ++_i) gn[_h][_i] = gc[_h][_i]; } }
    if constexpr (SP2) {
        PG8_STAGE(PG8_SB(0, 0), cB, voffB); PG8_STAGE(PG8_SB(0, 1), cB + hstep, voffB); PG8_STAGE_A(PG8_SA(0, 0), cA, 0, false); PG8_STAGE_A(PG8_SA(0, 1), cA, 1, false);
        if (wr == 1) PG8_BAR;
        PG8_WAIT_V(2); PG8_BAR;
        PG8_STAGE(PG8_SB(1, 0), cB + kstep, voffB); PG8_STAGE_A(PG8_SA(1, 0), cA + kstep, 0, false); PG8_STAGE(PG8_SB(1, 1), cB + hstep + kstep, voffB);
        PG8_WAIT_V(6); PG8_BAR;
    } else {
        PG8_STAGE(PG8_SB(0, 0), cB, voffB); PG8_STAGE_A(PG8_SA(0, 0), cA, 0, false); PG8_STAGE(PG8_SB(0, 1), cB + hstep, voffB); PG8_STAGE_A(PG8_SA(0, 1), cA, 1, false);
        if (wr == 1) PG8_BAR;
        PG8_WAIT_V(4); PG8_BAR;
        PG8_STAGE(PG8_SB(1, 0), cB + kstep, voffB); PG8_STAGE_A(PG8_SA(1, 0), cA + kstep, 0, false); PG8_STAGE(PG8_SB(1, 1), cB + hstep + kstep, voffB);
        PG8_WAIT_V(6); PG8_BAR;
    }
    for (;;) {
        const char* nA = GATHER ? (const char*)g.A : (has_next ? (const char*)g.A + (size_t)nxt.pm * tstep : cA); const char* nB = has_next ? (const char*)g.Bt + (size_t)nxt.pn * tstep : cB;
#pragma unroll 1
        for (int t = 0; t < nt; t += 2) {
            const bool last = (t == nt - 2);
            const char* a1 = cA + (size_t)(t + 1) * kstep;
            const char* a2 = last ? nA : cA + (size_t)(t + 2) * kstep; const char* b2 = last ? nB : cB + (size_t)(t + 2) * kstep;
            const char* a3 = a2 + kstep; const char* b3 = b2 + kstep;
            if constexpr (SP2) {
            PG8_LDB(B0, 0, 0); PG8_LDB(B1, 0, 1); PG8_SCHED; PG8_LDA(At, 0, 0); PG8_STAGE_A(PG8_SA(1, 1), a1, 1, false);
            PG8_WAIT_V(8); PG8_WAIT_L(0); PG8_BAR; PG8_MMA(0, 0, At, B0); PG8_MMA(0, 1, At, B1); PG8_BAR; PG8_SCHED;
            PG8_LDA(At, 0, 1); PG8_STAGE(PG8_SB(0, 0), b2, voffB); PG8_STAGE(PG8_SB(0, 1), b2 + hstep, voffB); PG8_STAGE_A(PG8_SA(0, 0), a2, 0, last);
            PG8_WAIT_V(8); PG8_WAIT_L(0); PG8_BAR; PG8_MMA(1, 0, At, B0); PG8_MMA(1, 1, At, B1); PG8_BAR; PG8_SCHED;
            PG8_LDB(B0, 1, 0); PG8_LDB(B1, 1, 1); PG8_SCHED; PG8_LDA(At, 1, 0); PG8_STAGE_A(PG8_SA(0, 1), a2, 1, last);
            PG8_WAIT_V(8); PG8_WAIT_L(0); PG8_BAR; PG8_MMA(0, 0, At, B0); PG8_MMA(0, 1, At, B1); PG8_BAR; PG8_SCHED;
            PG8_LDA(At, 1, 1); PG8_STAGE(PG8_SB(1, 0), b3, voffB); PG8_STAGE(PG8_SB(1, 1), b3 + hstep, voffB); PG8_STAGE_A(PG8_SA(1, 0), a3, 0, last);
            PG8_WAIT_V(8); PG8_WAIT_L(0); PG8_BAR; PG8_MMA(1, 0, At, B0); PG8_MMA(1, 1, At, B1); PG8_BAR; PG8_SCHED;
            } else {
            PG8_LDB(B0, 0, 0); PG8_SCHED; PG8_LDA(At, 0, 0); PG8_STAGE_A(PG8_SA(1, 1), a1, 1, false);
            PG8_WAIT_L(8); PG8_BAR; PG8_WAIT_L(0); PG8_MMA(0, 0, At, B0); PG8_BAR; PG8_SCHED;
            PG8_LDB(B1, 0, 1); PG8_STAGE(PG8_SB(0, 0), b2, voffB);
            PG8_BAR; PG8_WAIT_L(0); PG8_MMA(0, 1, At, B1); PG8_BAR;
            PG8_LDA(At, 0, 1); PG8_STAGE_A(PG8_SA(0, 0), a2, 0, last);
            PG8_BAR; PG8_WAIT_L(0); PG8_MMA(1, 0, At, B0); PG8_BAR; PG8_SCHED;
            PG8_STAGE(PG8_SB(0, 1), b2 + hstep, voffB);
            PG8_WAIT_V(6); PG8_BAR; PG8_MMA(1, 1, At, B1); PG8_BAR;
            PG8_LDB(B0, 1, 0); PG8_SCHED; PG8_LDA(At, 1, 0); PG8_STAGE_A(PG8_SA(0, 1), a2, 1, last);
            PG8_WAIT_L(8); PG8_BAR; PG8_WAIT_L(0); PG8_MMA(0, 0, At, B0); PG8_BAR; PG8_SCHED;
            PG8_LDB(B1, 1, 1); PG8_STAGE(PG8_SB(1, 0), b3, voffB);
            PG8_BAR; PG8_WAIT_L(0); PG8_MMA(0, 1, At, B1); PG8_BAR;
            PG8_LDA(At, 1, 1); PG8_STAGE_A(PG8_SA(1, 0), a3, 0, last);
            PG8_BAR; PG8_WAIT_L(0); PG8_MMA(1, 0, At, B0); PG8_BAR; PG8_SCHED;
            PG8_STAGE(PG8_SB(1, 1), b3 + hstep, voffB);
            PG8_WAIT_V(6); PG8_BAR; PG8_MMA(1, 1, At, B1); PG8_BAR;
            }
        }
        const bool has_nx2 = has_next && S.next(ui + 2, nx2);
        int tk[2][2];
        if constexpr (GATHER) { if (has_nx2) { PG8_ROWS_ISSUE(tk, nx2); } }
        if constexpr (ALIGN_EPI) { if (wr == 0) PG8_BAR; }
        if constexpr (FP8) asm volatile("s_nop 15\n\ts_nop 15" ::: "memory");
        E(acc, cur, wr, wc, fr, fq);
        if (!has_next) break;
#pragma unroll
        for (int a = 0; a < 2; ++a)
#pragma unroll
            for (int b = 0; b < 2; ++b)
#pragma unroll
                for (int m = 0; m < 4; ++m)
#pragma unroll
                    for (int n = 0; n < 2; ++n) acc[a][b][m][n] = (f32x4){0.f, 0.f, 0.f, 0.f};
        cur = nxt; cA = nA; cB = nB; ++ui;
        if constexpr (GATHER) {
#pragma unroll
            for (int _h = 0; _h < 2; ++_h)
#pragma unroll
                for (int _i = 0; _i < 2; ++_i) gc[_h][_i] = gn[_h][_i];
            if (has_nx2) { PG8_ROWS_FINISH(gn, tk); } }
        nxt = nx2; has_next = has_nx2;
        if constexpr (ALIGN_EPI) { if (wr == 1) PG8_BAR; }
    }
    PG8_WAIT_V(0);
    if constexpr (!ALIGN_EPI) { if (wr == 0) PG8_BAR; }
    PG8_BAR;
#undef PG8_SA
#undef PG8_SB
#undef PG8_STAGE
#undef PG8_STAGE_A
#undef PG8_LDA
#undef PG8_LD32
#undef PG8_LDB
#undef PG8_MMA
#undef PG8_WAIT_V
#undef PG8_ROWS_ISSUE
#undef PG8_ROWS_FINISH
#undef PG8_WAIT_L
#undef PG8_BAR
#undef PG8_SCHED
#undef PG8_LOAD_ROWS
}
}

constexpr int NWAVES = 8, NTHR = 512;
constexpr int D = 1024, BATCH = 16, SEQ = 4096, T = BATCH * SEQ, DEPTH = 2;
constexpr int CHUNK = 64, NCH = SEQ / CHUNK;
constexpr int NSEC = 7168;
constexpr int N_IN = 7184;
constexpr int NE = 128, TOPK = 8, DE = 256;
constexpr int PMAX = T * TOPK + NE * 256;
constexpr float EPS = 1e-6f;

constexpr size_t MiB = 1u << 20;
constexpr size_t WS_CTL = 0, CTL_ZERO_BYTES = 1 * MiB;
constexpr size_t WS_MOD = 1 * MiB;
constexpr size_t WS_WLR = 2 * MiB;
constexpr size_t WS_RGW = 3 * MiB;
constexpr size_t WS_WIN8 = 4 * MiB;
constexpr size_t WS_WA = 32 * MiB, WS_WB = 36 * MiB, WS_WO = 40 * MiB;
constexpr size_t WS_ROUT = 44 * MiB;
constexpr size_t WS_SGU = 45 * MiB;
constexpr size_t WS_SDN = 47 * MiB;
constexpr size_t WS_EGU = 48 * MiB;
constexpr size_t WS_EDN = 304 * MiB;
constexpr size_t WS_U = 432 * MiB;
constexpr size_t WS_SP = 561 * MiB, WS_SE = 565 * MiB, WS_CIN = 569 * MiB;
constexpr size_t WS_TOT = 573 * MiB;
constexpr size_t WS_PK = 575 * MiB;
constexpr size_t WS_POS = 577 * MiB;
constexpr size_t WS_WTS = 579 * MiB;
constexpr size_t WS_SORT = 581 * MiB;
constexpr size_t WS_BIG = 592 * MiB;
constexpr size_t WS_XRPRE = WS_BIG + 192 * MiB, WS_RG = WS_BIG + 128 * MiB, WS_Q = WS_BIG + 256 * MiB, WS_K = WS_BIG + 320 * MiB, WS_V = WS_BIG + 384 * MiB,
                 WS_OG = WS_BIG + 512 * MiB, WS_GA = WS_BIG + 640 * MiB, WS_GB = WS_BIG + 768 * MiB, WS_LOGA = WS_BIG + 896 * MiB, WS_IX = WS_BIG + 1024 * MiB,
                 WS_KDEC = WS_BIG + 1152 * MiB;
constexpr size_t WS_U8 = WS_BIG + 960 * MiB;
constexpr size_t WS_O = WS_BIG;
constexpr size_t WS_MBUF = WS_LOGA;
constexpr size_t WS_Y = WS_BIG;
constexpr size_t WS_YS = WS_BIG + 544 * MiB;
constexpr size_t WS_LOGIT = WS_BIG + 1392 * MiB;
constexpr size_t WS_ACT = WS_BIG + 672 * MiB;
constexpr size_t WS_H = WS_BIG + 1216 * MiB;
constexpr size_t WS_ACTS = WS_BIG + 1360 * MiB;
constexpr size_t WS_END = WS_BIG + 1424 * MiB;
static_assert((size_t)PMAX * 1024 <= 544 * MiB && (size_t)PMAX * 256 * 2 <= 272 * MiB && WS_KDEC + 64 * MiB <= WS_H && WS_H + 128 * MiB <= WS_ACTS && WS_ACT + 272 * MiB <= WS_H && WS_YS + 128 * MiB <= WS_ACT, "ws map");
constexpr int CW_TMO = 0;
constexpr int CW_BAR = 4096;
constexpr int CW_CNT = 8192;

constexpr int RING_BYTES = 131072;
constexpr int LDS_TS = RING_BYTES;
constexpr int LDS_MISC = RING_BYTES + 1024;
constexpr int LDS_BYTES = 147456;

#define GAS __attribute__((address_space(1)))
#define LAS __attribute__((address_space(3)))
typedef unsigned short bf16;
typedef unsigned v4u __attribute__((ext_vector_type(4)));
typedef unsigned v2u __attribute__((ext_vector_type(2)));
typedef float f32x4 __attribute__((ext_vector_type(4)));
typedef float f32x16 __attribute__((ext_vector_type(16)));
typedef short bf16x8 __attribute__((ext_vector_type(8)));
typedef short s16x4 __attribute__((ext_vector_type(4)));
typedef GAS unsigned gu32;
#define RLX_AGENT __ATOMIC_RELAXED, __HIP_MEMORY_SCOPE_AGENT
#define LDS_WAIT() asm volatile("s_waitcnt lgkmcnt(0)" ::: "memory")
__device__ __forceinline__ unsigned f2bf(float f) { return (unsigned)__builtin_bit_cast(unsigned short, (__bf16)f); }
__device__ __forceinline__ unsigned pk2(float lo, float hi) { return pg8::cvt_pk_bf16(lo, hi); }
__device__ __forceinline__ float bflo(unsigned w) { return __builtin_bit_cast(float, w << 16); }
__device__ __forceinline__ float bfhi(unsigned w) { return __builtin_bit_cast(float, w & 0xffff0000u); }
__device__ __forceinline__ float bf2f(bf16 b) { return __builtin_bit_cast(float, (unsigned)b << 16); }
__device__ __forceinline__ float fsigmoid(float x) { return __builtin_amdgcn_rcpf(1.0f + __builtin_amdgcn_exp2f(-1.442695041f * x)); }
__device__ __forceinline__ float fsilu(float x) { return x * fsigmoid(x); }
__device__ __forceinline__ float fgelu_tanh(float x) { return x * fsigmoid(1.5957691216f * (x + 0.044715f * x * x * x)); }

#define XB_TMO      128
#define XB_XCNT(j)  (256  + 64 * (j))
#define XB_XSUB(j)  (1280 + 64 * (j))
#define XB_XGEN(j)  (2304 + 64 * (j))
#define XB_TOP      3328
#define XB_TOPGEN   3392
#define XCD_BAR_WORDS 3456
#define XB_SPIN_CAP (1u << 18)
__device__ __forceinline__ unsigned xb_ld(unsigned* p)              { return __hip_atomic_load(p, __ATOMIC_RELAXED, __HIP_MEMORY_SCOPE_AGENT); }
__device__ __forceinline__ unsigned xb_add(unsigned* p, unsigned v) { return __hip_atomic_fetch_add(p, v, __ATOMIC_RELAXED, __HIP_MEMORY_SCOPE_AGENT); }
__device__ __forceinline__ unsigned xb_xcc_id() { return (unsigned)__builtin_amdgcn_s_getreg((3 << 11) | 20) & 0xFu; }
#define XB_SPIN(cond, bar) do { unsigned _sp = 0; while (cond) { __builtin_amdgcn_s_sleep(1); \
    if ((++_sp & 255u) == 0u) { if (xb_ld(&(bar)[XB_TMO])) break; if (_sp > XB_SPIN_CAP) { atomicAdd(&(bar)[XB_TMO], 1u); break; } } } } while (0)
struct XcdBarrier { unsigned* bar; unsigned x; volatile LAS unsigned* st; };
__device__ __forceinline__ XcdBarrier xcd_barrier_post(unsigned* bar, volatile LAS unsigned* st) {
    XcdBarrier b; b.bar = bar; b.x = xb_xcc_id(); b.st = st;
    if (threadIdx.x == 0) (void)xb_add(&bar[XB_XCNT(b.x)], 1u);
    return b;
}
__device__ __forceinline__ void xcd_barrier_complete(unsigned* bar, unsigned x, unsigned& nloc, unsigned& nx) {
    const unsigned G = gridDim.x * gridDim.y * gridDim.z;
    unsigned sum, cnt, mine, sp = 0u;
    for (;;) {
        sum = 0u; cnt = 0u; mine = 0u;
#pragma unroll
        for (unsigned j = 0; j < 16; ++j) { const unsigned c = xb_ld(&bar[XB_XCNT(j)]); sum += c; cnt += (c > 0u) ? 1u : 0u; mine = (j == x) ? c : mine; }
        if (sum == G) break;
        __builtin_amdgcn_s_sleep(1);
        if ((++sp & 255u) == 0u) { if (xb_ld(&bar[XB_TMO])) break; if (sp > XB_SPIN_CAP) { atomicAdd(&bar[XB_TMO], 1u); break; } }
    }
    nloc = mine > 0u ? mine : 1u; nx = cnt > 0u ? cnt : 1u;
}
__device__ __forceinline__ void xcd_barrier(const XcdBarrier& b, const bool leader) {
    asm volatile("s_waitcnt vmcnt(0)" ::: "memory");
    __syncthreads();
    if (leader) {
        unsigned* bar = b.bar;
        __builtin_amdgcn_s_waitcnt(0);
        unsigned nloc = b.st[0], nx = b.st[1];
        if (nloc == 0u) { xcd_barrier_complete(bar, b.x, nloc, nx); b.st[0] = nloc; b.st[1] = nx; }
        const unsigned old = xb_add(&bar[XB_XSUB(b.x)], 1u);
        const unsigned gen = old / nloc;
        if (old + 1u == (gen + 1u) * nloc) {
            __builtin_amdgcn_fence(__ATOMIC_RELEASE, "agent");
            asm volatile("s_waitcnt vmcnt(0)" ::: "memory");
            const unsigned og = xb_add(&bar[XB_TOP], 1u);
            const unsigned tg = og / nx;
            if (og + 1u == (tg + 1u) * nx) xb_add(&bar[XB_TOPGEN], 1u);
            else XB_SPIN(xb_ld(&bar[XB_TOPGEN]) == tg, bar);
            __builtin_amdgcn_fence(__ATOMIC_ACQUIRE, "agent");
            xb_add(&bar[XB_XGEN(b.x)], 1u);
            asm volatile("s_waitcnt vmcnt(0)" ::: "memory");
        } else {
            XB_SPIN(xb_ld(&bar[XB_XGEN(b.x)]) == gen, bar);
            __builtin_amdgcn_fence(__ATOMIC_ACQUIRE, "agent");
            asm volatile("s_waitcnt vmcnt(0)" ::: "memory");
        }
    }
    __syncthreads();
}

enum In { I_X = 0, I_C, I_ADAW, I_ADAB, I_N1G, I_WIN, I_CONVW, I_CONVB, I_RGWA, I_RGBA, I_RGWX, I_RGBX, I_RGLAM, I_GWUP, I_GBUP, I_GNG, I_WBA, I_WBB, I_WOUT, I_N2G,
          I_RW, I_RB, I_EGU, I_EDN, I_SGU, I_SDN, I_FG, N_INPUTS };
struct Args { const float* in[N_INPUTS]; float* out; unsigned char* ws; int ph_lo, ph_hi; };
struct Frame { LAS unsigned char* lds; unsigned char* ws; int tid, lane, wave, vcu, G, bx; };

__device__ __forceinline__ unsigned pk4_fp8(float a, float b, float c, float d) { int w = __builtin_amdgcn_cvt_pk_fp8_f32(a, b, 0, false); return (unsigned)__builtin_amdgcn_cvt_pk_fp8_f32(c, d, w, true); }
__device__ __forceinline__ float wave_sum(float v, int lane) {
#pragma unroll
    for (int o = 1; o < 64; o <<= 1) v += __builtin_bit_cast(float, __builtin_amdgcn_ds_bpermute((lane ^ o) << 2, __builtin_bit_cast(int, v)));
    return v;
}

template <class RowP>
__device__ __forceinline__ void conv_item(const float* W, int K, int N, LAS float* scr, int item, int lane, RowP rowp) {
    const int nblk = (N + 31) / 32, kb = item / nblk, nb = item % nblk, k0 = 64 * kb, n0 = 32 * nb;
    const int cl = n0 + (lane & 31); const bool okc = cl < N;
#pragma unroll 8
    for (int i = 0; i < 32; ++i) { const int kk = 2 * i + (lane >> 5); scr[kk * 33 + (lane & 31)] = okc ? W[(size_t)(k0 + kk) * N + cl] : 0.f; }
    LDS_WAIT(); asm volatile("" ::: "memory");
    const int c = lane & 7;
#pragma unroll
    for (int j = 0; j < 4; ++j) { const int n = (lane >> 3) + 8 * j; const LAS float* s = scr + (8 * c) * 33 + n;
        v4u o; o.x = pk2(s[0 * 33], s[1 * 33]); o.y = pk2(s[2 * 33], s[3 * 33]); o.z = pk2(s[4 * 33], s[5 * 33]); o.w = pk2(s[6 * 33], s[7 * 33]);
        bf16* rp = (n0 + n < N) ? rowp(n0 + n) : (bf16*)nullptr;
        if (rp) *(GAS v4u*)(rp + k0 + 8 * c) = o; }
    LDS_WAIT(); asm volatile("" ::: "memory");
}
template <class RowP>
__device__ __forceinline__ void conv_item8(const float* W, int K, int N, LAS float* scr, int item, int lane, float scale, RowP rowp) {
    const int nblk = (N + 31) / 32, kb = item / nblk, nb = item % nblk, k0 = 64 * kb, n0 = 32 * nb;
    const int cl = n0 + (lane & 31); const bool okc = cl < N;
#pragma unroll 8
    for (int i = 0; i < 32; ++i) { const int kk = 2 * i + (lane >> 5); scr[kk * 33 + (lane & 31)] = okc ? W[(size_t)(k0 + kk) * N + cl] * scale : 0.f; }
    LDS_WAIT(); asm volatile("" ::: "memory");
    const int c = lane & 7;
#pragma unroll
    for (int j = 0; j < 4; ++j) { const int n = (lane >> 3) + 8 * j; const LAS float* s = scr + (8 * c) * 33 + n;
        v2u o; o.x = pk4_fp8(s[0 * 33], s[1 * 33], s[2 * 33], s[3 * 33]); o.y = pk4_fp8(s[4 * 33], s[5 * 33], s[6 * 33], s[7 * 33]);
        unsigned char* rp = (n0 + n < N) ? rowp(n0 + n) : (unsigned char*)nullptr;
        if (rp) *(GAS v2u*)(rp + k0 + 8 * c) = o; }
    LDS_WAIT(); asm volatile("" ::: "memory");
}
template <bool FP8, class RowP>
__device__ __forceinline__ void conv_item64(const float* W, int K, int N, LAS float* scr, int item, int lane, float scale, RowP rowp) {
    asm volatile("" : "+v"(lane));
    const int nblk = (N + 63) / 64, kb = item / nblk, nb = item - kb * nblk, k0 = 64 * kb, n0 = 64 * nb;
    const int l15 = lane & 15, g = lane >> 4, cl = n0 + 4 * l15; const bool okc = cl < N;
    const float* src = W + (size_t)(k0 + g) * N + cl;
    f32x4 v[16];
#pragma unroll
    for (int i = 0; i < 16; ++i) { v[i] = (f32x4){0.f, 0.f, 0.f, 0.f}; if (okc) v[i] = *(const GAS f32x4*)(src + (size_t)(4 * i) * N); }
    __builtin_amdgcn_sched_barrier(0);
#pragma unroll
    for (int i = 0; i < 16; ++i) { const int k = 4 * i + g; LAS float* d = scr + k * 64 + ((4 * l15) ^ (4 * i));
        d[0 ^ g] = v[i].x * scale; d[1 ^ g] = v[i].y * scale; d[2 ^ g] = v[i].z * scale; d[3 ^ g] = v[i].w * scale; }
    LDS_WAIT(); asm volatile("" ::: "memory");
    asm volatile("" : "+v"(lane));
    if (!FP8) { const int c = lane & 7;
#pragma unroll
        for (int j = 0; j < 8; ++j) { const int n = (lane >> 3) + 8 * j, bn = n ^ (8 * c); const LAS float* s = scr + (8 * c) * 64;
            v4u o; o.x = pk2(s[0 * 64 + (bn ^ 0)], s[1 * 64 + (bn ^ 1)]); o.y = pk2(s[2 * 64 + (bn ^ 2)], s[3 * 64 + (bn ^ 3)]);
            o.z = pk2(s[4 * 64 + (bn ^ 4)], s[5 * 64 + (bn ^ 5)]); o.w = pk2(s[6 * 64 + (bn ^ 6)], s[7 * 64 + (bn ^ 7)]);
            auto rp = rowp((n0 + n < N) ? n0 + n : -1);
            if (rp) *(GAS v4u*)((unsigned char*)rp + (size_t)(k0 + 8 * c) * 2) = o; } }
    else { const int c = lane & 3;
#pragma unroll
        for (int j = 0; j < 4; ++j) { const int n = (lane >> 2) + 16 * j, bn = n ^ (16 * c); const LAS float* s = scr + (16 * c) * 64;
            v4u o; o.x = pk4_fp8(s[0 * 64 + (bn ^ 0)], s[1 * 64 + (bn ^ 1)], s[2 * 64 + (bn ^ 2)], s[3 * 64 + (bn ^ 3)]);
            o.y = pk4_fp8(s[4 * 64 + (bn ^ 4)], s[5 * 64 + (bn ^ 5)], s[6 * 64 + (bn ^ 6)], s[7 * 64 + (bn ^ 7)]);
            o.z = pk4_fp8(s[8 * 64 + (bn ^ 8)], s[9 * 64 + (bn ^ 9)], s[10 * 64 + (bn ^ 10)], s[11 * 64 + (bn ^ 11)]);
            o.w = pk4_fp8(s[12 * 64 + (bn ^ 12)], s[13 * 64 + (bn ^ 13)], s[14 * 64 + (bn ^ 14)], s[15 * 64 + (bn ^ 15)]);
            auto rp = rowp((n0 + n < N) ? n0 + n : -1);
            if (rp) *(GAS v4u*)((unsigned char*)rp + (size_t)(k0 + 16 * c)) = o; } }
    LDS_WAIT(); asm volatile("" ::: "memory");
}
__device__ __forceinline__ int ydrow(int c) { const int cc = c & 255; return (c & ~255) + 128 * ((cc >> 3) & 1) + 32 * (cc >> 6) + 8 * ((cc >> 4) & 3) + (cc & 7); }
__device__ __forceinline__ bf16* winrow(int c, bf16* win, bf16* wlr) {
    if (c >= 5120 && c < 5136) return wlr + (size_t)(c - 5120) * D;
    int d = (c < 5120) ? c : c - 16;
    if (d >= 2048 && d < 2560) { const int p = d & 15, g = (p >> 2) & 3; const int pp = (g == 1) ? p + 4 : (g == 2) ? p - 4 : p; d = (d & ~15) | pp; }
    else if (d < 2048 || d >= 4096) d = ydrow(d);
    return win + (size_t)d * D;
}
__device__ __forceinline__ int glurow(int c) { return 256 * ((c & 255) >> 7) + 128 * (c >> 8) + (c & 127); }

__device__ __forceinline__ void p0_prologue(const Frame& F, const Args& a) {
    unsigned char* ws = F.ws;
    __syncthreads();
    if (F.vcu < 96) {
        LAS float* cact = (LAS float*)F.lds;
        LAS float* part = (LAS float*)(F.lds + 65536);
        for (int i = F.tid; i < 16 * 1024; i += NTHR) { const int b = i >> 10, k = i & 1023; const float x = a.in[I_C][i]; cact[k * 16 + b] = fsilu(x); }
        __syncthreads();
        const int l = F.wave >> 2, kq = F.wave & 3, n = F.vcu * 64 + F.lane;
        float acc[16];
#pragma unroll
        for (int b = 0; b < 16; ++b) acc[b] = 0.f;
        const float* w = a.in[I_ADAW] + (size_t)l * 1024 * 6144 + n;
#pragma unroll 4
        for (int k = kq * 256; k < kq * 256 + 256; ++k) { const float wv = w[(size_t)k * 6144];
#pragma unroll
            for (int q = 0; q < 4; ++q) { const f32x4 cv = *(const LAS f32x4*)(cact + k * 16 + 4 * q); acc[4 * q] += wv * cv.x; acc[4 * q + 1] += wv * cv.y; acc[4 * q + 2] += wv * cv.z; acc[4 * q + 3] += wv * cv.w; } }
#pragma unroll
        for (int b = 0; b < 16; ++b) part[(F.wave * 16 + b) * 64 + F.lane] = acc[b];
        __syncthreads();
        for (int i = F.tid; i < 2 * 16 * 64; i += NTHR) { const int ll = i >> 10, b = (i >> 6) & 15, nn = i & 63; float s = a.in[I_ADAB][ll * 6144 + F.vcu * 64 + nn];
#pragma unroll
            for (int q = 0; q < 4; ++q) s += part[((ll * 4 + q) * 16 + b) * 64 + nn];
            ((float*)(ws + WS_MOD))[((size_t)ll * 16 + b) * 6144 + F.vcu * 64 + nn] = s; }
        __syncthreads();
    }
    LAS float* scr = (LAS float*)(F.lds + F.wave * 16384);
    const int gw = F.vcu * NWAVES + F.wave, NGW = F.G * NWAVES;
    constexpr int NB_IN = (N_IN + 63) / 64;
    constexpr int I_IN = 16 * NB_IN, I_SQ = 16 * 16, I_R = 16 * 2, I_SG = 16 * 8, I_SD = 4 * 16, I_RGI = 2 * 8 * 4, I_EG = 16 * 8, I_ED = 4 * 16;
    constexpr int PER_L = I_IN + 3 * I_SQ + I_R + I_SG + I_SD + I_RGI + NE * I_EG + NE * I_ED;
    int f8from = MK_FP8_EXP1_FROM; asm volatile("" : "+s"(f8from));
    for (int it = gw; it < DEPTH * PER_L; it += NGW) {
        const int l = it / PER_L; int r = it - l * PER_L;
        if (r < I_IN) { bf16* win = nullptr; bf16* wlr = (bf16*)(ws + WS_WLR) + (size_t)l * 16 * D;
            if (r % NB_IN == 5120 / 64)
                conv_item64<false>(a.in[I_WIN] + (size_t)l * D * N_IN, D, N_IN, scr, r, F.lane, 1.0f, [=](int c) { return (c >= 5120 && c < 5136) ? winrow(c, win, wlr) : (bf16*)nullptr; });
            unsigned char* win8 = ws + WS_WIN8 + (size_t)l * NSEC * D;
            conv_item64<true>(a.in[I_WIN] + (size_t)l * D * N_IN, D, N_IN, scr, r, F.lane, 64.0f, [=](int c) { return (c < 0 || (c >= 5120 && c < 5136)) ? (unsigned char*)nullptr : win8 + (size_t)(winrow(c, (bf16*)nullptr, (bf16*)nullptr) - (bf16*)nullptr); }); continue; } r -= I_IN;
        if (r < 3 * I_SQ) { const int w = r / I_SQ; r -= w * I_SQ; const float* src = a.in[w == 0 ? I_WBA : (w == 1 ? I_WBB : I_WOUT)] + (size_t)l * D * D;
            bf16* dst = (bf16*)(ws + (w == 0 ? WS_WA : (w == 1 ? WS_WB : WS_WO))) + (size_t)l * D * D;
            conv_item64<false>(src, D, D, scr, r, F.lane, 1.0f, [=](int c) { return c < 0 ? (bf16*)nullptr : dst + (size_t)c * D; }); continue; } r -= 3 * I_SQ;
        if (r < I_R) { bf16* dst = (bf16*)(ws + WS_ROUT) + (size_t)l * 256 * D;
            conv_item64<false>(a.in[I_RW] + (size_t)l * D * NE, D, NE, scr, r, F.lane, 1.0f, [=](int c) { return c < 0 ? (bf16*)nullptr : dst + (size_t)c * D; }); continue; } r -= I_R;
        if (r < I_SG) { bf16* dst = (bf16*)(ws + WS_SGU) + (size_t)l * 512 * D; unsigned char* dst8 = ws + WS_SGU + (size_t)l * 512 * D * 2;
            if (l >= f8from) conv_item64<true>(a.in[I_SGU] + (size_t)l * D * 512, D, 512, scr, r, F.lane, 64.0f, [=](int c) { return c < 0 ? (unsigned char*)nullptr : dst8 + (size_t)glurow(c) * D; });
            else conv_item64<false>(a.in[I_SGU] + (size_t)l * D * 512, D, 512, scr, r, F.lane, 1.0f, [=](int c) { return c < 0 ? (bf16*)nullptr : dst + (size_t)glurow(c) * D; }); continue; } r -= I_SG;
        if (r < I_SD) { bf16* dst = (bf16*)(ws + WS_SDN) + (size_t)l * D * DE;
            conv_item64<false>(a.in[I_SDN] + (size_t)l * DE * D, DE, D, scr, r, F.lane, 16.0f, [=](int c) { return c < 0 ? (bf16*)nullptr : dst + (size_t)ydrow(c) * DE; }); continue; } r -= I_SD;
        if (r < I_RGI) { const int which = r / 32; r -= which * 32; const int hb = r / 4; r -= hb * 4;
            bf16* dst = (bf16*)(ws + WS_RGW) + ((size_t)(l * 8 + hb) * 256 + which * 128) * 128;
            conv_item64<false>(a.in[which ? I_RGWX : I_RGWA] + ((size_t)l * 8 + hb) * 128 * 128, 128, 128, scr, r, F.lane, 1.0f, [=](int c) { return c < 0 ? (bf16*)nullptr : dst + (size_t)c * 128; }); continue; } r -= I_RGI;
        if (r < NE * I_EG) { const int e = r / I_EG; r -= e * I_EG; bf16* dst = (bf16*)(ws + WS_EGU) + ((size_t)l * NE + e) * 512 * D; unsigned char* dst8 = ws + WS_EGU + (size_t)l * NE * 512 * D * 2 + (size_t)e * 512 * D;
            if (l >= f8from) conv_item64<true>(a.in[I_EGU] + ((size_t)l * NE + e) * D * 512, D, 512, scr, r, F.lane, 64.0f, [=](int c) { return c < 0 ? (unsigned char*)nullptr : dst8 + (size_t)glurow(c) * D; });
            else conv_item64<false>(a.in[I_EGU] + ((size_t)l * NE + e) * D * 512, D, 512, scr, r, F.lane, 1.0f, [=](int c) { return c < 0 ? (bf16*)nullptr : dst + (size_t)glurow(c) * D; }); continue; } r -= NE * I_EG;
        { const int e = r / I_ED; r -= e * I_ED; bf16* dst = (bf16*)(ws + WS_EDN) + ((size_t)l * NE + e) * D * DE;
            conv_item64<false>(a.in[I_EDN] + ((size_t)l * NE + e) * DE * D, DE, D, scr, r, F.lane, 16.0f, [=](int c) { return c < 0 ? (bf16*)nullptr : dst + (size_t)ydrow(c) * DE; }); }
    }
    { const int gt = F.vcu * NTHR + F.tid, NT = F.G * NTHR;
      for (int i = gt; i < 2 * 128 * D / 8; i += NT) { const int l = i / (128 * D / 8), r = i - l * (128 * D / 8);
          *(GAS v4u*)((bf16*)(ws + WS_ROUT) + ((size_t)l * 256 + 128) * D + (size_t)r * 8) = (v4u){0u, 0u, 0u, 0u}; }
      if (gt < D / 8) *(GAS v4u*)((bf16*)(ws + WS_U) + (size_t)T * D + gt * 8) = (v4u){0u, 0u, 0u, 0u}; }
}

template <bool FINAL, bool IN_BF16>
__device__ __forceinline__ void norm_phase(const Frame& F, const void* hv_, const float* gain, const float* sc, const float* sh, bf16* U, float* outf, unsigned char* U8 = nullptr) {
    constexpr int RB = IN_BF16 ? 8 : 4;
    const int gw = F.vcu * NWAVES + F.wave, NGW = F.G * NWAVES;
    const int c0 = 16 * F.lane;
    for (int blk = gw; blk < T / 32; blk += NGW) {
        const int b = (blk * 32) / SEQ;
        f32x4 scl[4], sft[4];
#pragma unroll
        for (int j = 0; j < 4; ++j) { const int c = c0 + 4 * j; const f32x4 g = *(const f32x4*)(gain + c);
            if (FINAL) { scl[j] = g; sft[j] = (f32x4){0.f, 0.f, 0.f, 0.f}; }
            else { const f32x4 s1 = *(const f32x4*)(sc + (size_t)b * 6144 + c); sft[j] = *(const f32x4*)(sh + (size_t)b * 6144 + c); scl[j] = g * (s1 + 1.0f); } }
#pragma unroll 1
        for (int r8 = 0; r8 < 32; r8 += RB) {
            const size_t row0 = (size_t)blk * 32 + r8;
            v4u w[RB][IN_BF16 ? 2 : 4];
            if (IN_BF16) { const unsigned char* hb = (const unsigned char*)hv_ + row0 * (D * 2); const unsigned vo = 32u * F.lane;
#pragma unroll
                for (int rr = 0; rr < RB; ++rr) { w[rr][0] = *(const GAS v4u*)(hb + rr * (D * 2) + vo); w[rr][1] = *(const GAS v4u*)(hb + rr * (D * 2) + vo + 16); } }
            else { const unsigned char* hb = (const unsigned char*)hv_ + row0 * (D * 4); const unsigned vo = 64u * F.lane;
#pragma unroll
                for (int rr = 0; rr < RB; ++rr)
#pragma unroll
                    for (int j = 0; j < (IN_BF16 ? 2 : 4); ++j) w[rr][j] = *(const GAS v4u*)(hb + rr * (D * 4) + vo + 16 * j); }
            __builtin_amdgcn_sched_barrier(0);
#pragma unroll
            for (int rr = 0; rr < RB; ++rr) { const size_t row = row0 + rr; f32x4 v[4];
                if (IN_BF16) {
#pragma unroll
                    for (int j = 0; j < 2; ++j) { const v4u x = w[rr][j]; v[2 * j] = (f32x4){bflo(x.x), bfhi(x.x), bflo(x.y), bfhi(x.y)}; v[2 * j + 1] = (f32x4){bflo(x.z), bfhi(x.z), bflo(x.w), bfhi(x.w)}; } }
                else {
#pragma unroll
                    for (int j = 0; j < (IN_BF16 ? 2 : 4); ++j) v[j] = __builtin_bit_cast(f32x4, w[rr][j]); }
                float s = 0.f;
#pragma unroll
                for (int j = 0; j < 4; ++j) s += (v[j].x * v[j].x + v[j].y * v[j].y) + (v[j].z * v[j].z + v[j].w * v[j].w);
                const float rs = 1.0f / sqrtf(wave_sum(s, F.lane) * (1.0f / D) + EPS);
                if (FINAL) { GAS f32x4* o = (GAS f32x4*)(outf + row * D + c0);
#pragma unroll
                    for (int j = 0; j < 4; ++j) o[j] = v[j] * rs * scl[j];
                } else { f32x4 y[4];
#pragma unroll
                    for (int j = 0; j < 4; ++j) y[j] = v[j] * rs * scl[j] + sft[j];
                    if (U) { GAS v4u* o = (GAS v4u*)(U + row * D + c0);
                    o[0] = (v4u){pk2(y[0].x, y[0].y), pk2(y[0].z, y[0].w), pk2(y[1].x, y[1].y), pk2(y[1].z, y[1].w)};
                    o[1] = (v4u){pk2(y[2].x, y[2].y), pk2(y[2].z, y[2].w), pk2(y[3].x, y[3].y), pk2(y[3].z, y[3].w)}; }
                    if (U8) *(GAS v4u*)(U8 + row * D + c0) = (v4u){pk4_fp8(y[0].x, y[0].y, y[0].z, y[0].w), pk4_fp8(y[1].x, y[1].y, y[1].z, y[1].w), pk4_fp8(y[2].x, y[2].y, y[2].z, y[2].w), pk4_fp8(y[3].x, y[3].y, y[3].z, y[3].w)}; }
                __builtin_amdgcn_sched_barrier(0); }
        }
    }
}

#define EPI_ROWS_BEGIN _Pragma("unroll") for (int ai = 0; ai < 2; ++ai) _Pragma("unroll") for (int m = 0; m < 4; ++m) { const int rt = ai * 128 + wr * 64 + m * 16 + fr;
#define EPI_ROWS_END }
typedef const pg8::f32x4 (&AccRef)[2][2][4][2];
__device__ __forceinline__ v4u pack8(const f32x4& a, const f32x4& b) { v4u w; w.x = pg8::cvt_pk_bf16(a[0], a[1]); w.y = pg8::cvt_pk_bf16(a[2], a[3]); w.z = pg8::cvt_pk_bf16(b[0], b[1]); w.w = pg8::cvt_pk_bf16(b[2], b[3]); return w; }
template <int ACT> __device__ __forceinline__ f32x4 act4(f32x4 v) {
    if (ACT == 1) { v[0] = fgelu_tanh(v[0]); v[1] = fgelu_tanh(v[1]); v[2] = fgelu_tanh(v[2]); v[3] = fgelu_tanh(v[3]); }
    if (ACT == 2) v = v * 0.08838834764831845f;
    if (ACT == 3) { v[0] = fsilu(v[0]); v[1] = fsilu(v[1]); v[2] = fsilu(v[2]); v[3] = fsilu(v[3]); }
    if (ACT == 4) { v[0] = fsigmoid(v[0]); v[1] = fsigmoid(v[1]); v[2] = fsigmoid(v[2]); v[3] = fsigmoid(v[3]); }
    return v;
}
template <int ACT> __device__ __forceinline__ void store_tile_bf16(AccRef acc, bf16* dst, int ld, size_t row0, int col0, int wr, int wc, int fr, int fq) {
    EPI_ROWS_BEGIN
        bf16* rp = dst + (row0 + rt) * ld + col0 + wc * 32 + 8 * fq;
#pragma unroll
        for (int bj = 0; bj < 2; ++bj) *(GAS v4u*)(rp + bj * 128) = pack8(act4<ACT>(acc[ai][bj][m][0]), act4<ACT>(acc[ai][bj][m][1]));
    EPI_ROWS_END
}
template <int ACT> __device__ __forceinline__ void store_tile_fp8(AccRef acc, unsigned char* dst, size_t row0, int col0, int wr, int wc, int fr, int fq) {
    EPI_ROWS_BEGIN
        const f32x4 a0 = act4<ACT>(acc[ai][0][m][0]) * 16.0f, a1 = act4<ACT>(acc[ai][0][m][1]) * 16.0f, b0 = act4<ACT>(acc[ai][1][m][0]) * 16.0f, b1 = act4<ACT>(acc[ai][1][m][1]) * 16.0f;
        v4u w; w.x = pk4_fp8(a0[0], a0[1], a0[2], a0[3]); w.y = pk4_fp8(a1[0], a1[1], a1[2], a1[3]); w.z = pk4_fp8(b0[0], b0[1], b0[2], b0[3]); w.w = pk4_fp8(b1[0], b1[1], b1[2], b1[3]);
        *(GAS v4u*)(dst + (row0 + rt) * 1024 + col0 + wc * 64 + fq * 16) = w;
    EPI_ROWS_END
}
__device__ __forceinline__ f32x4 fp8x4(unsigned w) { typedef float f2_t __attribute__((ext_vector_type(2))); const f2_t lo = __builtin_amdgcn_cvt_pk_f32_fp8((int)w, false), hi = __builtin_amdgcn_cvt_pk_f32_fp8((int)w, true); return (f32x4){lo.x, lo.y, hi.x, hi.y}; }
struct EpiInProj {
    unsigned char* ws;
    __device__ __forceinline__ void operator()(AccRef acc, const pg8::Unit& u, int wr, int wc, int fr, int fq) const {
        asm volatile("" : "+v"(fr), "+v"(fq));
        const int pn = u.pn; const size_t row0 = (size_t)u.pm * 256;
        if (pn < 4)       store_tile_fp8<0>(acc, ws + WS_XRPRE, row0, pn * 256, wr, wc, fr, fq);
        else if (pn < 8)  store_tile_fp8<1>(acc, ws + WS_RG, row0, (pn - 4) * 256, wr, wc, fr, fq);
        else if (pn < 10) store_tile_bf16<2>(acc, (bf16*)(ws + WS_Q), 512, row0, (pn - 8) * 256, wr, wc, fr, fq);
        else if (pn < 12) store_tile_bf16<0>(acc, (bf16*)(ws + WS_K), 512, row0, (pn - 10) * 256, wr, wc, fr, fq);
        else if (pn < 16) store_tile_bf16<0>(acc, (bf16*)(ws + WS_V), 1024, row0, (pn - 12) * 256, wr, wc, fr, fq);
        else if (pn < 20) store_tile_fp8<3>(acc, ws + WS_OG, row0, (pn - 16) * 256, wr, wc, fr, fq);
        else if (pn < 24) store_tile_fp8<4>(acc, ws + WS_GA, row0, (pn - 20) * 256, wr, wc, fr, fq);
        else              store_tile_fp8<4>(acc, ws + WS_GB, row0, (pn - 24) * 256, wr, wc, fr, fq);
    }
};
template <bool FIRST> struct EpiMerge {
    const unsigned char* gate; bf16* mbuf;
    __device__ __forceinline__ void operator()(AccRef acc, const pg8::Unit& u, int wr, int wc, int fr, int fq) const {
        asm volatile("" : "+v"(fr), "+v"(fq));
        EPI_ROWS_BEGIN
            const size_t o = ((size_t)u.pm * 256 + rt) * 1024 + u.pn * 256 + wc * 32 + 8 * fq;
#pragma unroll
            for (int bj = 0; bj < 2; ++bj) { const v2u gw = *(const GAS v2u*)(gate + o + bj * 128);
                const f32x4 g0 = fp8x4(gw.x) * 0.0625f, g1 = fp8x4(gw.y) * 0.0625f;
                f32x4 r0 = g0 * acc[ai][bj][m][0], r1 = g1 * acc[ai][bj][m][1];
                if (!FIRST) { const v4u mw = *(const GAS v4u*)(mbuf + o + bj * 128);
                    r0 += (f32x4){bflo(mw.x), bfhi(mw.x), bflo(mw.y), bfhi(mw.y)}; r1 += (f32x4){bflo(mw.z), bfhi(mw.z), bflo(mw.w), bfhi(mw.w)}; }
                *(GAS v4u*)(mbuf + o + bj * 128) = pack8(r0, r1); }
        EPI_ROWS_END
    }
};
template <bool HIN_F32> struct EpiRes {
    const void* hin; bf16* hout; const float* gate;
    __device__ __forceinline__ void operator()(AccRef acc, const pg8::Unit& u, int wr, int wc, int fr, int fq) const {
        asm volatile("" : "+v"(fr), "+v"(fq));
        const int b = (u.pm * 256) / SEQ; const int cb = u.pn * 256 + wc * 32 + 8 * fq;
        f32x4 gv[2][2];
#pragma unroll
        for (int bj = 0; bj < 2; ++bj)
#pragma unroll
            for (int n = 0; n < 2; ++n) gv[bj][n] = *(const GAS f32x4*)(gate + (size_t)b * 6144 + cb + bj * 128 + 4 * n);
        EPI_ROWS_BEGIN
            const size_t o = ((size_t)u.pm * 256 + rt) * 1024 + cb;
#pragma unroll
            for (int bj = 0; bj < 2; ++bj) { f32x4 h0, h1;
                if (HIN_F32) { h0 = *(const GAS f32x4*)((const float*)hin + o + bj * 128); h1 = *(const GAS f32x4*)((const float*)hin + o + bj * 128 + 4); }
                else { const v4u w = *(const GAS v4u*)((const bf16*)hin + o + bj * 128); h0 = (f32x4){bflo(w.x), bfhi(w.x), bflo(w.y), bfhi(w.y)}; h1 = (f32x4){bflo(w.z), bfhi(w.z), bflo(w.w), bfhi(w.w)}; }
                *(GAS v4u*)(hout + o + bj * 128) = pack8(h0 + gv[bj][0] * acc[ai][bj][m][0], h1 + gv[bj][1] * acc[ai][bj][m][1]); }
        EPI_ROWS_END
    }
};
struct EpiLogit {
    float* lg;
    __device__ __forceinline__ void operator()(AccRef acc, const pg8::Unit& u, int wr, int wc, int fr, int fq) const {
        asm volatile("" : "+v"(fr), "+v"(fq));
        EPI_ROWS_BEGIN
            float* rp = lg + ((size_t)u.pm * 256 + rt) * 128 + wc * 32 + 8 * fq;
            *(GAS f32x4*)(rp) = acc[ai][0][m][0]; *(GAS f32x4*)(rp + 4) = acc[ai][0][m][1];
        EPI_ROWS_END
    }
};
struct EpiGlu {
    bf16* act;
    __device__ __forceinline__ void operator()(AccRef acc, const pg8::Unit& u, int wr, int wc, int fr, int fq) const {
        asm volatile("" : "+v"(fr), "+v"(fq));
        const int j = u.pn & 1;
        EPI_ROWS_BEGIN
            f32x4 r0 = act4<3>(acc[ai][0][m][0]) * acc[ai][1][m][0], r1 = act4<3>(acc[ai][0][m][1]) * acc[ai][1][m][1];
            *(GAS v4u*)(act + ((size_t)u.pm * 256 + rt) * 256 + j * 128 + wc * 32 + 8 * fq) = pack8(r0, r1);
        EPI_ROWS_END
    }
};
struct EpiPlain {
    bf16* o;
    __device__ __forceinline__ void operator()(AccRef acc, const pg8::Unit& u, int wr, int wc, int fr, int fq) const {
        asm volatile("" : "+v"(fr), "+v"(fq));
        store_tile_bf16<0>(acc, o, 1024, (size_t)u.pm * 256, u.pn * 256, wr, wc, fr, fq);
    }
};
struct EpiY {
    unsigned char* y;
    __device__ __forceinline__ void operator()(AccRef acc, const pg8::Unit& u, int wr, int wc, int fr, int fq) const {
        asm volatile("" : "+v"(fr), "+v"(fq));
        EPI_ROWS_BEGIN
            const f32x4 a0 = acc[ai][0][m][0], a1 = acc[ai][0][m][1], b0 = acc[ai][1][m][0], b1 = acc[ai][1][m][1];
            v4u w; w.x = pk4_fp8(a0[0], a0[1], a0[2], a0[3]); w.y = pk4_fp8(a1[0], a1[1], a1[2], a1[3]); w.z = pk4_fp8(b0[0], b0[1], b0[2], b0[3]); w.w = pk4_fp8(b1[0], b1[1], b1[2], b1[3]);
            *(GAS v4u*)(y + ((size_t)u.pm * 256 + rt) * 1024 + (u.pn & 3) * 256 + wc * 64 + fq * 16) = w;
        EPI_ROWS_END
    }
};

__device__ __forceinline__ int swz16(int row, int ch) { return row * 256 + ((ch ^ (row & 15)) << 4); }
__device__ __forceinline__ void rg_gate_phase(const Frame& F, const Args& a, int l, const int hb, const int t0, const int nt) {
    unsigned char* ws = F.ws;
    __syncthreads();
    LAS unsigned char* Ws = F.lds; LAS unsigned char* Xs = F.lds + 65536; LAS float* prm = (LAS float*)(F.lds + 98304);
    const unsigned char* xpre = ws + WS_XRPRE; bf16* loga = (bf16*)(ws + WS_LOGA); bf16* ixo = (bf16*)(ws + WS_IX);
    { const bf16* wsrc = (const bf16*)(ws + WS_RGW) + (size_t)(l * 8 + hb) * 256 * 128;
#pragma unroll
      for (int j = 0; j < 8; ++j) { const int ck = F.tid + NTHR * j, n = ck >> 4, ch = ck & 15; *(LAS v4u*)(Ws + swz16(n, ch)) = *(const GAS v4u*)(wsrc + (size_t)ck * 8); }
      if (F.tid < 128) { const int c = l * D + hb * 128 + F.tid; prm[F.tid] = a.in[I_RGBA][c]; prm[128 + F.tid] = a.in[I_RGBX][c];
          const float lam = a.in[I_RGLAM][c]; prm[256 + F.tid] = fmaxf(-lam, 0.f) + log1pf(__expf(-fabsf(lam))); } }
    const int c8 = F.tid & 15, rg4 = F.tid >> 4, chan0 = hb * 128 + 8 * c8;
    float cw[4][8], cb[8];
#pragma unroll
    for (int j = 0; j < 8; ++j) { cb[j] = a.in[I_CONVB][l * D + chan0 + j];
#pragma unroll
        for (int q = 0; q < 4; ++q) cw[q][j] = a.in[I_CONVW][((size_t)l * 4 + q) * D + chan0 + j]; }
    const int fr = F.lane & 15, fq = F.lane >> 4;
    v2u wq[7];
#define RG_LOAD_ROWS(ii) do { const size_t r0g_ = (size_t)(t0 + (ii)) * 128 + 4 * rg4; const int tp_ = (int)(r0g_ & (SEQ - 1)); \
        _Pragma("unroll") for (int q = 0; q < 7; ++q) { wq[q] = (v2u){0u, 0u}; if (tp_ + q - 3 >= 0) wq[q] = *(const GAS v2u*)(xpre + (size_t)((long)r0g_ + q - 3) * D + chan0); } } while (0)
    RG_LOAD_ROWS(0);
    for (int i = 0; i < nt; ++i) {
        const int rt = t0 + i; const size_t row0 = (size_t)rt * 128;
        __syncthreads();
        {
            const int r0 = 4 * rg4;
            float x[7][8];
#pragma unroll
            for (int q = 0; q < 7; ++q) { const f32x4 lo = fp8x4(wq[q].x) * 0.0625f, hi = fp8x4(wq[q].y) * 0.0625f;
                x[q][0] = lo.x; x[q][1] = lo.y; x[q][2] = lo.z; x[q][3] = lo.w; x[q][4] = hi.x; x[q][5] = hi.y; x[q][6] = hi.z; x[q][7] = hi.w; }
#pragma unroll
            for (int rr = 0; rr < 4; ++rr) { float y[8];
#pragma unroll
                for (int j = 0; j < 8; ++j) y[j] = cb[j] + cw[0][j] * x[rr][j] + cw[1][j] * x[rr + 1][j] + cw[2][j] * x[rr + 2][j] + cw[3][j] * x[rr + 3][j];
                v4u o; o.x = pk2(y[0], y[1]); o.y = pk2(y[2], y[3]); o.z = pk2(y[4], y[5]); o.w = pk2(y[6], y[7]);
                *(LAS v4u*)(Xs + swz16(r0 + rr, c8)) = o; }
        }
        if (i + 1 < nt) RG_LOAD_ROWS(i + 1);
        __syncthreads();
        f32x4 acc[16];
#pragma unroll
        for (int nb = 0; nb < 16; ++nb) acc[nb] = (f32x4){0.f, 0.f, 0.f, 0.f};
        const int arow = 16 * F.wave + fr;
#pragma unroll
        for (int ks = 0; ks < 4; ++ks) { const bf16x8 af = *(const LAS bf16x8*)(Xs + swz16(arow, 4 * ks + fq));
#pragma unroll
            for (int nb = 0; nb < 16; ++nb) { const bf16x8 bfv = *(const LAS bf16x8*)(Ws + swz16(16 * nb + fr, 4 * ks + fq));
                acc[nb] = __builtin_amdgcn_mfma_f32_16x16x32_bf16(bfv, af, acc[nb], 0, 0, 0); } }
        const size_t grow = row0 + arow; const bool tzero = (grow & (SEQ - 1)) == 0;
#pragma unroll
        for (int nb = 0; nb < 8; ++nb) { const int c = 16 * nb + 4 * fq;
            const f32x4 ba = *(const LAS f32x4*)(prm + c), bx = *(const LAS f32x4*)(prm + 128 + c), sp = *(const LAS f32x4*)(prm + 256 + c);
            const v2u xw = *(const LAS v2u*)(Xs + swz16(arow, c >> 3) + (c & 7) * 2);
            const float xv[4] = {bflo(xw.x), bfhi(xw.x), bflo(xw.y), bfhi(xw.y)};
            float om[4], bt[4];
#pragma unroll
            for (int j = 0; j < 4; ++j) { const float r = fsigmoid(acc[nb][j] + ba[j]), ii = fsigmoid(acc[nb + 8][j] + bx[j]); const float la = -8.0f * r * sp[j];
                const float o1 = 1.0f - __builtin_amdgcn_exp2f(1.442695041f * la), o2 = -la * (1.0f + la * (0.5f + la * 0.16666667f));
                om[j] = (la > -0.01f) ? o2 : o1; float mult = __builtin_amdgcn_sqrtf(om[j] * (2.0f - om[j])); if (tzero) mult = 1.0f; bt[j] = mult * ii * xv[j]; }
            const size_t o = grow * D + hb * 128 + c;
            *(GAS v2u*)(loga + o) = (v2u){pk2(om[0], om[1]), pk2(om[2], om[3])};
            *(GAS v2u*)(ixo + o) = (v2u){pk2(bt[0], bt[1]), pk2(bt[2], bt[3])}; }
    }
    __syncthreads();
}

typedef float f32x2 __attribute__((ext_vector_type(2)));
__device__ __forceinline__ void unpack8(const v4u w, float (&o)[8]) { o[0] = bflo(w.x); o[1] = bfhi(w.x); o[2] = bflo(w.y); o[3] = bfhi(w.y); o[4] = bflo(w.z); o[5] = bfhi(w.z); o[6] = bflo(w.w); o[7] = bfhi(w.w); }
__device__ __forceinline__ void scan_pass1(const Frame& F, int unit) {
    unsigned char* ws = F.ws;
    LAS f32x2* pe = (LAS f32x2*)F.lds;
    const int g = F.tid >> 7, c8 = F.tid & 127, ch = 8 * c8;
    const unsigned voff = (unsigned)(16 * g * D + ch) * 2u;
    const unsigned char* omb = ws + WS_LOGA + (size_t)unit * 64 * D * 2; const unsigned char* btb = ws + WS_IX + (size_t)unit * 64 * D * 2;
    v4u ow[16], bw[16];
#pragma unroll
    for (int r = 0; r < 16; ++r) { ow[r] = *(const GAS v4u*)(omb + r * (D * 2) + voff); bw[r] = *(const GAS v4u*)(btb + r * (D * 2) + voff); }
    __builtin_amdgcn_sched_barrier(0);
    float P[8], E[8];
#pragma unroll
    for (int j = 0; j < 8; ++j) { P[j] = 1.f; E[j] = 0.f; }
#pragma unroll
    for (int r = 0; r < 16; ++r) { float a[8], bt[8]; unpack8(ow[r], a); unpack8(bw[r], bt);
#pragma unroll
        for (int j = 0; j < 8; ++j) { const float av = 1.0f - a[j]; E[j] = av * E[j] + bt[j]; P[j] *= av; } }
    __syncthreads();
#pragma unroll
    for (int j = 0; j < 8; ++j) pe[g * 1024 + ch + j] = (f32x2){P[j], E[j]};
    __syncthreads();
    if (g == 0) { f32x4 Po[2], Eo[2];
#pragma unroll
        for (int j = 0; j < 8; ++j) { float p = P[j], e = E[j];
#pragma unroll
            for (int q = 1; q < 4; ++q) { const f32x2 x = pe[q * 1024 + ch + j]; e = x.x * e + x.y; p *= x.x; }
            Po[j >> 2][j & 3] = p; Eo[j >> 2][j & 3] = e; }
        GAS f32x4* spp = (GAS f32x4*)((float*)(ws + WS_SP) + (size_t)unit * D + ch); GAS f32x4* sep = (GAS f32x4*)((float*)(ws + WS_SE) + (size_t)unit * D + ch);
        spp[0] = Po[0]; spp[1] = Po[1]; sep[0] = Eo[0]; sep[1] = Eo[1]; }
}
__device__ __forceinline__ void scan_pass3(const Frame& F, int unit) {
    unsigned char* ws = F.ws;
    const size_t row0 = (size_t)unit * 64; const int ch = 2 * F.tid;
    const GAS unsigned* om = (const GAS unsigned*)((const bf16*)(ws + WS_LOGA) + row0 * D + ch); GAS unsigned* bp = (GAS unsigned*)((bf16*)(ws + WS_IX) + row0 * D + ch);
    const GAS unsigned short* rg = (const GAS unsigned short*)(ws + WS_RG + row0 * D + ch);
    float h0 = 0.f, h1 = 0.f;
    { const int seg = unit & 63; const GAS f32x2* sp = (const GAS f32x2*)((const float*)(ws + WS_SP) + (size_t)(unit - seg) * D + ch); const GAS f32x2* se = (const GAS f32x2*)((const float*)(ws + WS_SE) + (size_t)(unit - seg) * D + ch);
#pragma unroll 8
      for (int s = 0; s < seg; ++s) { const f32x2 p = sp[(size_t)s * (D / 2)], e = se[(size_t)s * (D / 2)]; h0 = p.x * h0 + e.x; h1 = p.y * h1 + e.y; } }
#pragma unroll 16
    for (int r = 0; r < 64; ++r) { const unsigned ow = om[(size_t)r * (D / 2)], bw = bp[(size_t)r * (D / 2)]; const f32x4 gt = fp8x4((unsigned)rg[(size_t)r * (D / 2)]);
        h0 = (1.0f - bflo(ow)) * h0 + bflo(bw); h1 = (1.0f - bfhi(ow)) * h1 + bfhi(bw); bp[(size_t)r * (D / 2)] = pk2(h0 * gt.x * 0.0625f, h1 * gt.y * 0.0625f); }
}
#if MK_SCAN3_NEW
__device__ __forceinline__ void scan_pass3_panel(const Frame& F, int pm) {
    unsigned char* ws = F.ws;
    LAS f32x2* pe = (LAS f32x2*)F.lds; LAS float* cin = (LAS float*)(F.lds + 32768);
    const int g = F.tid >> 7, c8 = F.tid & 127, ch = 8 * c8;
    __syncthreads();
    { const int u0 = 4 * pm, seg0 = u0 & 63, qn = (seg0 + 3) >> 2, sb = g * qn, sen = (sb + qn < seg0) ? sb + qn : seg0;
      f32x4 P0 = {1.f, 1.f, 1.f, 1.f}, P1 = P0, E0 = {0.f, 0.f, 0.f, 0.f}, E1 = E0;
      const float* spb = (const float*)(ws + WS_SP) + (size_t)(u0 - seg0) * D + ch; const float* seb = (const float*)(ws + WS_SE) + (size_t)(u0 - seg0) * D + ch;
#pragma unroll 4
      for (int s = sb; s < sen; ++s) { const f32x4 p0 = *(const GAS f32x4*)(spb + (size_t)s * D), p1 = *(const GAS f32x4*)(spb + (size_t)s * D + 4), e0 = *(const GAS f32x4*)(seb + (size_t)s * D), e1 = *(const GAS f32x4*)(seb + (size_t)s * D + 4);
          E0 = p0 * E0 + e0; P0 *= p0; E1 = p1 * E1 + e1; P1 *= p1; }
#pragma unroll
      for (int j = 0; j < 4; ++j) { pe[g * 1024 + ch + j] = (f32x2){P0[j], E0[j]}; pe[g * 1024 + ch + 4 + j] = (f32x2){P1[j], E1[j]}; }
      __syncthreads();
      if (g == 0) {
#pragma unroll
          for (int j = 0; j < 8; ++j) { float h = 0.f;
#pragma unroll
              for (int q = 0; q < 4; ++q) { const f32x2 x = pe[q * 1024 + ch + j]; h = x.x * h + x.y; }
              cin[ch + j] = h; } } }
    for (int k = 0; k < 4; ++k) {
        const int unit = 4 * pm + k;
        const unsigned voff = (unsigned)(16 * g * D + ch) * 2u, voffg = (unsigned)(16 * g * D + ch);
        const unsigned char* omb = ws + WS_LOGA + (size_t)unit * 64 * D * 2; unsigned char* btb = ws + WS_IX + (size_t)unit * 64 * D * 2;
        const unsigned char* rgb = ws + WS_RG + (size_t)unit * 64 * D;
        v4u ow[16], bw[16]; v2u gw[16];
#pragma unroll
        for (int r = 0; r < 16; ++r) { ow[r] = *(const GAS v4u*)(omb + r * (D * 2) + voff); bw[r] = *(const GAS v4u*)(btb + r * (D * 2) + voff); gw[r] = *(const GAS v2u*)(rgb + r * D + voffg); }
        __builtin_amdgcn_sched_barrier(0);
        float P[8], E[8];
#pragma unroll
        for (int j = 0; j < 8; ++j) { P[j] = 1.f; E[j] = 0.f; }
#pragma unroll
        for (int r = 0; r < 16; ++r) { float a[8], bt[8]; unpack8(ow[r], a); unpack8(bw[r], bt);
#pragma unroll
            for (int j = 0; j < 8; ++j) { const float av = 1.0f - a[j]; E[j] = av * E[j] + bt[j]; P[j] *= av; asm volatile("" : "+v"(P[j]), "+v"(E[j])); }
            __builtin_amdgcn_sched_barrier(0); }
        __syncthreads();
#pragma unroll
        for (int j = 0; j < 8; ++j) pe[g * 1024 + ch + j] = (f32x2){P[j], E[j]};
        __syncthreads();
#pragma unroll
        for (int r = 0; r < 16; ++r) asm volatile("" : "+v"(ow[r]), "+v"(bw[r]));
        float h[8];
#pragma unroll
        for (int j = 0; j < 8; ++j) { float e = cin[ch + j];
#pragma unroll
            for (int q = 0; q < 3; ++q) if (q < g) { const f32x2 x = pe[q * 1024 + ch + j]; e = x.x * e + x.y; }
            h[j] = e; }
#pragma unroll
        for (int r = 0; r < 16; ++r) { float a[8], bt[8]; unpack8(ow[r], a); unpack8(bw[r], bt); const f32x4 g0 = fp8x4(gw[r].x) * 0.0625f, g1 = fp8x4(gw[r].y) * 0.0625f;
            float o[8];
#pragma unroll
            for (int j = 0; j < 8; ++j) { h[j] = (1.0f - a[j]) * h[j] + bt[j]; o[j] = h[j] * (j < 4 ? g0[j & 3] : g1[j & 3]); }
            *(GAS v4u*)(btb + r * (D * 2) + voff) = (v4u){pk2(o[0], o[1]), pk2(o[2], o[3]), pk2(o[4], o[5]), pk2(o[6], o[7])};
            __builtin_amdgcn_sched_barrier(0); }
        __syncthreads();
        if (g == 3) {
#pragma unroll
            for (int j = 0; j < 8; ++j) cin[ch + j] = h[j]; }
    }
}
#endif

__device__ __forceinline__ float flogsig16(float x) {
    const float e = __builtin_amdgcn_exp2f(-1.442695041f * fabsf(x));
    return (fminf(x, 0.f) - 0.6931471806f * __builtin_amdgcn_logf(1.0f + e)) * 0.0625f;
}
__device__ __forceinline__ void gla_prep(const Frame& F, const Args& a, int l, int unit) {
    unsigned char* ws = F.ws;
    LAS float* lrs = (LAS float*)F.lds; LAS float* psum = (LAS float*)(F.lds + 8192); LAS unsigned char* kds = F.lds + 16384;
    const size_t row0 = (size_t)unit * 64;
    const int fr = F.lane & 15, fq = F.lane >> 4;
    __syncthreads();
    { const int rb = F.wave & 3, kh = F.wave >> 2;
      const unsigned char* up = ws + WS_U8 + (row0 + 16 * rb + fr) * D + kh * 512 + 8 * fq;
      const bf16* wp = (const bf16*)(ws + WS_WLR) + ((size_t)l * 16 + fr) * D + kh * 512 + 8 * fq;
      f32x4 acc = {0.f, 0.f, 0.f, 0.f};
      v2u aw[16];
#pragma unroll
      for (int ks = 0; ks < 16; ++ks) aw[ks] = *(const GAS v2u*)(up + 32 * ks);
#pragma unroll
      for (int ks = 0; ks < 16; ++ks) { const bf16x8 bfv = *(const GAS bf16x8*)(wp + 32 * ks);
          const f32x4 lo = fp8x4(aw[ks].x), hi = fp8x4(aw[ks].y);
          const v4u ap = (v4u){pk2(lo.x, lo.y), pk2(lo.z, lo.w), pk2(hi.x, hi.y), pk2(hi.z, hi.w)};
          acc = __builtin_amdgcn_mfma_f32_16x16x32_bf16(__builtin_bit_cast(bf16x8, ap), bfv, acc, 0, 0, 0); }
#pragma unroll
      for (int j = 0; j < 4; ++j) lrs[(kh * 64 + 16 * rb + 4 * fq + j) * 16 + fr] = acc[j]; }
    __syncthreads();
    const int cp = F.tid & 255, th = F.tid >> 8, c0 = 2 * cp;
    float wu0[16], wu1[16];
#pragma unroll
    for (int r = 0; r < 16; ++r) { const f32x2 w = *(const GAS f32x2*)(a.in[I_GWUP] + ((size_t)l * 16 + r) * 512 + c0); wu0[r] = w.x; wu1[r] = w.y; }
    const f32x2 bu = *(const GAS f32x2*)(a.in[I_GBUP] + l * 512 + c0);
    float la0[32], la1[32]; float s0 = 0.f, s1 = 0.f;
#pragma unroll
    for (int tt = 0; tt < 32; ++tt) { const int t = 32 * th + tt; float g0 = bu.x, g1 = bu.y;
#pragma unroll
        for (int q = 0; q < 4; ++q) { const f32x4 x = *(const LAS f32x4*)(lrs + t * 16 + 4 * q) + *(const LAS f32x4*)(lrs + (64 + t) * 16 + 4 * q);
            g0 += x.x * wu0[4 * q] + x.y * wu0[4 * q + 1] + x.z * wu0[4 * q + 2] + x.w * wu0[4 * q + 3];
            g1 += x.x * wu1[4 * q] + x.y * wu1[4 * q + 1] + x.z * wu1[4 * q + 2] + x.w * wu1[4 * q + 3]; }
        la0[tt] = flogsig16(g0); la1[tt] = flogsig16(g1); s0 += la0[tt]; s1 += la1[tt]; }
    *(LAS f32x2*)(psum + th * 512 + c0) = (f32x2){s0, s1};
    __syncthreads();
    const f32x2 oth = *(const LAS f32x2*)(psum + (th ^ 1) * 512 + c0);
    const float tot0 = s0 + oth.x, tot1 = s1 + oth.y;
    if (th == 0) *(GAS f32x2*)((float*)(ws + WS_TOT) + (size_t)unit * 512 + c0) = (f32x2){tot0, tot1};
    float cum0 = th ? oth.x : 0.f, cum1 = th ? oth.y : 0.f;
    const GAS unsigned* kp = (const GAS unsigned*)((const bf16*)(ws + WS_K) + (row0 + 32 * th) * 512 + c0);
#pragma unroll
    for (int t8 = 0; t8 < 4; ++t8) { float o0[8], o1[8];
#pragma unroll
        for (int tt = 0; tt < 8; ++tt) { const unsigned kw = kp[(size_t)(8 * t8 + tt) * 256]; cum0 += la0[8 * t8 + tt]; cum1 += la1[8 * t8 + tt];
            o0[tt] = bflo(kw) * __builtin_amdgcn_exp2f(1.442695041f * (tot0 - cum0)); o1[tt] = bfhi(kw) * __builtin_amdgcn_exp2f(1.442695041f * (tot1 - cum1)); }
        *(LAS v4u*)(kds + c0 * 144 + (32 * th + 8 * t8) * 2) = (v4u){pk2(o0[0], o0[1]), pk2(o0[2], o0[3]), pk2(o0[4], o0[5]), pk2(o0[6], o0[7])};
        *(LAS v4u*)(kds + (c0 + 1) * 144 + (32 * th + 8 * t8) * 2) = (v4u){pk2(o1[0], o1[1]), pk2(o1[2], o1[3]), pk2(o1[4], o1[5]), pk2(o1[6], o1[7])}; }
    __syncthreads();
    GAS unsigned char* kd = (GAS unsigned char*)((bf16*)(ws + WS_KDEC) + (size_t)unit * 512 * 64);
#pragma unroll
    for (int j = 0; j < 8; ++j) { const int ck = F.tid + NTHR * j; *(GAS v4u*)(kd + (size_t)ck * 16) = *(const LAS v4u*)(kds + (ck >> 3) * 144 + (ck & 7) * 16); }
}

constexpr int GQ_OFF = 0, GK_OFF = 64 * 272, GV_OFF = GK_OFF + 128 * 144, GD_OFF = GV_OFF + 64 * 256, GBUF = GD_OFF + 512;
__device__ __forceinline__ unsigned voff_b(unsigned row, unsigned ch) { return 256u * row + 16u * (ch ^ (((row & 3) << 2) | ((row >> 2) & 3))); }
__device__ __forceinline__ bf16x8 pack_step(const f32x16& x, int s) {
    v4u p; p.x = pk2(x[8 * s], x[8 * s + 1]); p.y = pk2(x[8 * s + 2], x[8 * s + 3]); p.z = pk2(x[8 * s + 4], x[8 * s + 5]); p.w = pk2(x[8 * s + 6], x[8 * s + 7]);
    return __builtin_bit_cast(bf16x8, p);
}
struct GlaRegs { v4u qv[4], kv[4], vv[4]; float dv; };
__device__ __forceinline__ void gla_load(const Frame& F, int b, int h, int vh, int n, GlaRegs& R) {
    unsigned char* ws = F.ws; int lt = F.tid - 256; asm volatile("" : "+v"(lt));
    const size_t row0 = (size_t)b * SEQ + (size_t)n * 64;
    const GAS char* qp = (const GAS char*)((const bf16*)(ws + WS_Q) + row0 * 512 + h * 128);
    const GAS char* vp = (const GAS char*)((const bf16*)(ws + WS_V) + row0 * D + h * 256 + vh * 128);
    const GAS char* kp = (const GAS char*)((const bf16*)(ws + WS_KDEC) + (((size_t)b * 64 + n) * 512 + h * 128) * 64);
#pragma unroll
    for (int j = 0; j < 4; ++j) { const unsigned ck = (unsigned)lt + 256u * j;
        R.qv[j] = *(const GAS v4u*)(qp + ((ck >> 4) * 1024u + (ck & 15u) * 16u));
        R.vv[j] = *(const GAS v4u*)(vp + ((ck >> 4) * 2048u + (ck & 15u) * 16u));
        R.kv[j] = *(const GAS v4u*)(kp + ck * 16u); }
    R.dv = 0.f; if (lt < 128) R.dv = ((const float*)(ws + WS_TOT))[((size_t)b * 64 + n) * 512 + h * 128 + lt];
}
__device__ __forceinline__ void gla_put(const Frame& F, const GlaRegs& R, LAS unsigned char* buf) {
    int lt = F.tid - 256; asm volatile("" : "+v"(lt));
#pragma unroll
    for (int j = 0; j < 4; ++j) { const unsigned ck = (unsigned)lt + 256u * j;
        *(LAS v4u*)(buf + GQ_OFF + (ck >> 4) * 272u + (ck & 15u) * 16u) = R.qv[j];
        *(LAS v4u*)(buf + GV_OFF + voff_b(ck >> 4, ck & 15u)) = R.vv[j];
        *(LAS v4u*)(buf + GK_OFF + (ck >> 3) * 144u + (ck & 7u) * 16u) = R.kv[j]; }
    if (lt < 128) ((LAS float*)(buf + GD_OFF))[lt] = __expf(R.dv);
}
__device__ __forceinline__ void gla_rec(const Frame& F, int unit) {
    unsigned char* ws = F.ws;
    const int b = unit >> 3, h = (unit >> 1) & 3, vh = unit & 1;
    const int w = F.wave;
#define GLA_BAR() do { asm volatile("s_waitcnt lgkmcnt(0)" ::: "memory"); __builtin_amdgcn_s_barrier(); asm volatile("" ::: "memory"); } while (0)
    __syncthreads();
    if (w >= 4) {
        GlaRegs Ra, Rb;
        gla_load(F, b, h, vh, 0, Ra); gla_put(F, Ra, F.lds); gla_load(F, b, h, vh, 1, Ra); gla_load(F, b, h, vh, 2, Rb);
        GLA_BAR();
#pragma unroll 1
        for (int n = 0; n < NCH; n += 2) {
            gla_put(F, Ra, F.lds + GBUF); if (n + 3 < NCH) gla_load(F, b, h, vh, n + 3, Ra);
            GLA_BAR();
            if (n + 2 < NCH) { gla_put(F, Rb, F.lds); if (n + 4 < NCH) gla_load(F, b, h, vh, n + 4, Rb); }
            GLA_BAR();
        }
    } else {
        f32x16 S[4];
#pragma unroll
        for (int kt = 0; kt < 4; ++kt)
#pragma unroll
            for (int i = 0; i < 16; ++i) S[kt][i] = 0.f;
        GLA_BAR();
#pragma unroll 1
        for (int n = 0; n < NCH; ++n) {
            int lane = F.lane; asm volatile("" : "+v"(lane));
            const int r = lane & 31, hh = lane >> 5;
            const unsigned blk = (lane >> 4) & 1, q4 = (lane & 15) >> 2, p4 = lane & 3;
            LAS unsigned char* buf = F.lds + (n & 1) * GBUF;
            const LAS unsigned char* kbase = buf + GK_OFF + r * 144 + hh * 16;
            const LAS unsigned char* qbase = buf + GQ_OFF + r * 272 + hh * 16;
            const LAS unsigned char* dbase = buf + GD_OFF + hh * 16;
            const unsigned chv = 4u * (unsigned)w + 2u * blk + (p4 >> 1);
            const unsigned vb0 = (unsigned)(size_t)(buf + GV_OFF) + 256u * (8u * hh + q4) + 16u * (chv ^ ((q4 << 2) | ((2u * hh) & 3u))) + 8u * (p4 & 1u);
            const unsigned vb1 = (unsigned)(size_t)(buf + GV_OFF) + 256u * (8u * hh + 4u + q4) + 16u * (chv ^ ((q4 << 2) | ((2u * hh + 1u) & 3u))) + 8u * (p4 & 1u);
            s16x4 l0, h0, l1, h1, l2, h2, l3, h3;
            asm volatile("ds_read_b64_tr_b16 %0, %8\n\tds_read_b64_tr_b16 %1, %9\n\tds_read_b64_tr_b16 %2, %8 offset:4096\n\tds_read_b64_tr_b16 %3, %9 offset:4096\n\t"
                         "ds_read_b64_tr_b16 %4, %8 offset:8192\n\tds_read_b64_tr_b16 %5, %9 offset:8192\n\tds_read_b64_tr_b16 %6, %8 offset:12288\n\tds_read_b64_tr_b16 %7, %9 offset:12288\n\ts_waitcnt lgkmcnt(0)"
                         : "=&v"(l0), "=&v"(h0), "=&v"(l1), "=&v"(h1), "=&v"(l2), "=&v"(h2), "=&v"(l3), "=&v"(h3) : "v"(vb0), "v"(vb1) : "memory");
            bf16x8 vbf[4];
            vbf[0] = __builtin_shufflevector(l0, h0, 0, 1, 2, 3, 4, 5, 6, 7); vbf[1] = __builtin_shufflevector(l1, h1, 0, 1, 2, 3, 4, 5, 6, 7);
            vbf[2] = __builtin_shufflevector(l2, h2, 0, 1, 2, 3, 4, 5, 6, 7); vbf[3] = __builtin_shufflevector(l3, h3, 0, 1, 2, 3, 4, 5, 6, 7);
#pragma unroll
            for (int kt = 0; kt < 4; ++kt)
#pragma unroll
                for (int g = 0; g < 4; ++g) { const f32x4 dq = *(const LAS f32x4*)(dbase + kt * 128 + g * 32);
                    S[kt][4 * g] *= dq.x; S[kt][4 * g + 1] *= dq.y; S[kt][4 * g + 2] *= dq.z; S[kt][4 * g + 3] *= dq.w; }
#pragma unroll
            for (int ts = 0; ts < 4; ++ts)
#pragma unroll
                for (int kt = 0; kt < 4; ++kt) { const bf16x8 ka = *(const LAS bf16x8*)(kbase + kt * 4608 + ts * 32);
                    S[kt] = __builtin_amdgcn_mfma_f32_32x32x16_bf16(ka, vbf[ts], S[kt], 0, 0, 0); }
            f32x16 O[2];
#pragma unroll
            for (int tb = 0; tb < 2; ++tb)
#pragma unroll
                for (int i = 0; i < 16; ++i) O[tb][i] = 0.f;
#pragma unroll
            for (int kt = 0; kt < 4; ++kt)
#pragma unroll
                for (int s = 0; s < 2; ++s) { const bf16x8 sb = pack_step(S[kt], s);
#pragma unroll
                    for (int tb = 0; tb < 2; ++tb) { const bf16x8 qa = *(const LAS bf16x8*)(qbase + tb * 8704 + kt * 64 + s * 32);
                        O[tb] = __builtin_amdgcn_mfma_f32_32x32x16_bf16(qa, sb, O[tb], 0, 0, 0); } }
            GAS bf16* op = (GAS bf16*)((bf16*)(ws + WS_O) + ((size_t)b * SEQ + (size_t)n * 64 + 4 * hh) * D + h * 256 + vh * 128 + 32 * w + r);
#pragma unroll
            for (int tb = 0; tb < 2; ++tb)
#pragma unroll
                for (int i = 0; i < 16; ++i) { const int t = 32 * tb + (i & 3) + 8 * (i >> 2); op[(size_t)t * D] = (bf16)f2bf(O[tb][i]); }
            GLA_BAR();
        }
    }
#undef GLA_BAR
    asm volatile("s_waitcnt vmcnt(0)" ::: "memory");
}
__device__ __forceinline__ float row16_sum(float v) {
    v += __builtin_bit_cast(float, __builtin_amdgcn_update_dpp(0, __builtin_bit_cast(int, v), 0x128, 0xf, 0xf, false));
    v += __builtin_bit_cast(float, __builtin_amdgcn_update_dpp(0, __builtin_bit_cast(int, v), 0x124, 0xf, 0xf, false));
    v += __builtin_bit_cast(float, __builtin_amdgcn_update_dpp(0, __builtin_bit_cast(int, v), 0x122, 0xf, 0xf, false));
    v += __builtin_bit_cast(float, __builtin_amdgcn_update_dpp(0, __builtin_bit_cast(int, v), 0x121, 0xf, 0xf, false));
    return v;
}
__device__ __forceinline__ void gla_norm(const Frame& F, const Args& a, int l) {
    unsigned char* ws = F.ws;
    const int gw = F.vcu * NWAVES + F.wave, NGW = F.G * NWAVES;
    f32x4 g[4];
#pragma unroll
    for (int q = 0; q < 4; ++q) g[q] = *(const GAS f32x4*)(a.in[I_GNG] + (size_t)l * 1024 + 16 * F.lane + 4 * q) * 0.0625f;
    const unsigned vo = 32u * F.lane, vg = 16u * F.lane;
    for (int blk = gw; blk < T / 32; blk += NGW)
#pragma unroll 1
        for (int r8 = 0; r8 < 32; r8 += 8) {
            unsigned char* ob = ws + WS_O + ((size_t)blk * 32 + r8) * (D * 2); const unsigned char* gb = ws + WS_OG + ((size_t)blk * 32 + r8) * D;
            v4u o0[8], o1[8], og[8];
#pragma unroll
            for (int rr = 0; rr < 8; ++rr) { o0[rr] = *(const GAS v4u*)(ob + rr * (D * 2) + vo); o1[rr] = *(const GAS v4u*)(ob + rr * (D * 2) + vo + 16); og[rr] = *(const GAS v4u*)(gb + rr * D + vg); }
            __builtin_amdgcn_sched_barrier(0);
#pragma unroll
            for (int rr = 0; rr < 8; ++rr) {
                f32x4 o[4];
                o[0] = (f32x4){bflo(o0[rr].x), bfhi(o0[rr].x), bflo(o0[rr].y), bfhi(o0[rr].y)}; o[1] = (f32x4){bflo(o0[rr].z), bfhi(o0[rr].z), bflo(o0[rr].w), bfhi(o0[rr].w)};
                o[2] = (f32x4){bflo(o1[rr].x), bfhi(o1[rr].x), bflo(o1[rr].y), bfhi(o1[rr].y)}; o[3] = (f32x4){bflo(o1[rr].z), bfhi(o1[rr].z), bflo(o1[rr].w), bfhi(o1[rr].w)};
                float s = 0.f;
#pragma unroll
                for (int q = 0; q < 4; ++q) s += (o[q].x * o[q].x + o[q].y * o[q].y) + (o[q].z * o[q].z + o[q].w * o[q].w);
                const float rs = 1.0f / sqrtf(row16_sum(s) * (1.0f / 256.0f) + EPS);
                f32x4 y[4];
                y[0] = o[0] * rs * g[0] * fp8x4(og[rr].x); y[1] = o[1] * rs * g[1] * fp8x4(og[rr].y); y[2] = o[2] * rs * g[2] * fp8x4(og[rr].z); y[3] = o[3] * rs * g[3] * fp8x4(og[rr].w);
                *(GAS v4u*)(ob + rr * (D * 2) + vo) = (v4u){pk2(y[0].x, y[0].y), pk2(y[0].z, y[0].w), pk2(y[1].x, y[1].y), pk2(y[1].z, y[1].w)};
                *(GAS v4u*)(ob + rr * (D * 2) + vo + 16) = (v4u){pk2(y[2].x, y[2].y), pk2(y[2].z, y[2].w), pk2(y[3].x, y[3].y), pk2(y[3].z, y[3].w)};
                __builtin_amdgcn_sched_barrier(0); }
        }
}

__device__ __forceinline__ void topk_phase(const Frame& F, const Args& a, int l, int cset) {
    unsigned char* ws = F.ws;
    LAS int* hist = (LAS int*)F.lds; LAS int* base = hist + 128; LAS float* bias = (LAS float*)(hist + 256);
    LAS float* xv = (LAS float*)(F.lds + 2048); LAS float* xs = xv + 2048; LAS int* xi = (LAS int*)(xs + 2048);
    __syncthreads();
    if (F.tid < 128) { hist[F.tid] = 0; bias[F.tid] = a.in[I_RB][l * NE + F.tid]; }
    __syncthreads();
    const int tok = F.tid & 255, half = F.tid >> 8, t = F.vcu * 256 + tok; const bool act = half == 0;
    float val[8], scv[8]; int idx[8], rank[8];
#pragma unroll
    for (int j = 0; j < 8; ++j) { val[j] = -1e30f; scv[j] = 0.f; idx[j] = 0; rank[j] = 0; }
#define TOPK_INSERT(v_, sc_, e_) do { _Pragma("unroll") for (int j = 7; j >= 0; --j) { if ((v_) > val[j]) { if (j < 7) { val[j + 1] = val[j]; scv[j + 1] = scv[j]; idx[j + 1] = idx[j]; } val[j] = (v_); scv[j] = (sc_); idx[j] = (e_); } } } while (0)
    { const float* lg = (const float*)(ws + WS_LOGIT) + (size_t)t * NE + 64 * half;
#pragma unroll 1
      for (int e16 = 0; e16 < 4; ++e16) { f32x4 x[4];
#pragma unroll
          for (int r = 0; r < 4; ++r) x[r] = *(const GAS f32x4*)(lg + 16 * e16 + 4 * r);
#pragma unroll
          for (int r = 0; r < 4; ++r)
#pragma unroll
              for (int q = 0; q < 4; ++q) { const int e = 64 * half + 16 * e16 + 4 * r + q; const float sc = 1.0f / (1.0f + __expf(-x[r][q])); const float v = sc + bias[e]; TOPK_INSERT(v, sc, e); } } }
    if (!act) {
#pragma unroll
        for (int j = 0; j < 8; ++j) { xv[j * 256 + tok] = val[j]; xs[j * 256 + tok] = scv[j]; xi[j * 256 + tok] = idx[j]; } }
    __syncthreads();
    if (act) {
#pragma unroll
        for (int c = 0; c < 8; ++c) { const float v = xv[c * 256 + tok], sc = xs[c * 256 + tok]; const int e = xi[c * 256 + tok]; TOPK_INSERT(v, sc, e); }
#pragma unroll
        for (int j = 0; j < 8; ++j) rank[j] = __hip_atomic_fetch_add(&hist[idx[j]], 1, __ATOMIC_RELAXED, __HIP_MEMORY_SCOPE_WORKGROUP);
    }
#undef TOPK_INSERT
    __syncthreads();
    if (F.tid < 128) base[F.tid] = (int)atomicAdd((unsigned*)(ws + WS_CTL) + CW_CNT + cset * NE + F.tid, (unsigned)hist[F.tid]);
    __syncthreads();
    if (act) { float ssum = 0.f;
#pragma unroll
        for (int j = 0; j < 8; ++j) ssum += scv[j];
        const float inv = 2.5f / ssum;
#pragma unroll
        for (int j = 0; j < 8; ++j) { ((unsigned*)(ws + WS_PK))[(size_t)t * 8 + j] = ((unsigned)idx[j] << 24) | (unsigned)(base[idx[j]] + rank[j]); ((float*)(ws + WS_WTS))[(size_t)t * 8 + j] = scv[j] * inv; } }
    __syncthreads();
}
__device__ __forceinline__ void moe_tiles(const Frame& F, int l) {
    LAS int* ts = (LAS int*)(F.lds + LDS_TS);
    __syncthreads();
    if (F.tid == 0) { const unsigned* cnt = (const unsigned*)(F.ws + WS_CTL) + CW_CNT + l * NE; int s = 0;
        for (int e = 0; e < NE; ++e) { ts[e] = s; s += (int)((__hip_atomic_load(cnt + e, RLX_AGENT) + 255u) >> 8); } ts[NE] = s; }
    __syncthreads();
}
__device__ __forceinline__ void scatter_phase(const Frame& F, int l) {
    unsigned char* ws = F.ws;
    moe_tiles(F, l);
    const LAS int* ts = (const LAS int*)(F.lds + LDS_TS);
    if (F.tid < 256) { const int t = F.vcu * 256 + F.tid;
#pragma unroll
        for (int j = 0; j < 8; ++j) { const unsigned pk = ((const unsigned*)(ws + WS_PK))[(size_t)t * 8 + j]; const int e = (int)(pk >> 24), p = ts[e] * 256 + (int)(pk & 0xffffffu);
            ((int*)(ws + WS_POS))[(size_t)t * 8 + j] = p; ((int*)(ws + WS_SORT))[p] = t; } }
}
template <int MODE>
__device__ __forceinline__ void combine_phase(const Frame& F, bf16* h, const float* gate, float* outf, const float* ng, const float* sc, const float* sh, bf16* U) {
    unsigned char* ws = F.ws;
    const int gw = F.vcu * NWAVES + F.wave, NGW = F.G * NWAVES;
    typedef float f2_t __attribute__((ext_vector_type(2)));
    for (int blk = gw; blk < T / 32; blk += NGW) {
        const int b = (blk * 32) / SEQ;
        f32x4 gv[4], scl[4], sft[4];
#pragma unroll
        for (int n = 0; n < 4; ++n) { const int c = 16 * F.lane + 4 * n; gv[n] = *(const GAS f32x4*)(gate + (size_t)b * 6144 + c); const f32x4 g = *(const GAS f32x4*)(ng + c);
            if (MODE == 0) { scl[n] = g * (*(const GAS f32x4*)(sc + (size_t)b * 6144 + c) + 1.0f); sft[n] = *(const GAS f32x4*)(sh + (size_t)b * 6144 + c); } else { scl[n] = g; sft[n] = (f32x4){0.f, 0.f, 0.f, 0.f}; } }
        const size_t tl = (size_t)blk * 32 + (F.lane & 31);
        const v4u pq = *(const GAS v4u*)((const int*)(ws + WS_POS) + tl * 8 + 4 * (F.lane >> 5)); const f32x4 wq = *(const GAS f32x4*)((const float*)(ws + WS_WTS) + tl * 8 + 4 * (F.lane >> 5));
        for (int rr = 0; rr < 32; rr += 2) {
            v4u yw[2][8], ys[2]; float wk[2][8]; f32x4 hv[2][4];
#pragma unroll
            for (int q = 0; q < 2; ++q) {
#pragma unroll
                for (int k = 0; k < 8; ++k) { const int src = rr + q + 32 * (k >> 2);
                    const int p = __builtin_amdgcn_readlane((int)pq[k & 3], src); wk[q][k] = __builtin_bit_cast(float, __builtin_amdgcn_readlane(__builtin_bit_cast(int, wq[k & 3]), src)) * 0.0625f;
                    yw[q][k] = *(const GAS v4u*)(ws + WS_Y + (size_t)p * 1024 + 16 * F.lane); }
                const bf16* hr = h + ((size_t)blk * 32 + rr + q) * D + 16 * F.lane;
                { const v4u w0 = *(const GAS v4u*)(hr), w1 = *(const GAS v4u*)(hr + 8);
                  hv[q][0] = (f32x4){bflo(w0.x), bfhi(w0.x), bflo(w0.y), bfhi(w0.y)}; hv[q][1] = (f32x4){bflo(w0.z), bfhi(w0.z), bflo(w0.w), bfhi(w0.w)};
                  hv[q][2] = (f32x4){bflo(w1.x), bfhi(w1.x), bflo(w1.y), bfhi(w1.y)}; hv[q][3] = (f32x4){bflo(w1.z), bfhi(w1.z), bflo(w1.w), bfhi(w1.w)}; }
                ys[q] = *(const GAS v4u*)(ws + WS_YS + ((size_t)blk * 32 + rr + q) * D + 16 * F.lane); }
#pragma unroll
            for (int q = 0; q < 2; ++q) { f32x4 acc[4];
#pragma unroll
                for (int n = 0; n < 4; ++n) acc[n] = fp8x4(ys[q][n]) * 0.0625f;
#pragma unroll
                for (int k = 0; k < 8; ++k)
#pragma unroll
                    for (int n = 0; n < 4; ++n) { const f2_t lo = __builtin_amdgcn_cvt_pk_f32_fp8((int)yw[q][k][n], false), hi = __builtin_amdgcn_cvt_pk_f32_fp8((int)yw[q][k][n], true);
                        acc[n] += (f32x4){lo.x, lo.y, hi.x, hi.y} * wk[q][k]; }
                const size_t row = (size_t)blk * 32 + rr + q; float s = 0.f;
#pragma unroll
                for (int n = 0; n < 4; ++n) { acc[n] = hv[q][n] + gv[n] * acc[n]; s += (acc[n].x * acc[n].x + acc[n].y * acc[n].y) + (acc[n].z * acc[n].z + acc[n].w * acc[n].w); }
                const float rs = 1.0f / sqrtf(wave_sum(s, F.lane) * (1.0f / D) + EPS);
                if (MODE == 0) {
                    GAS v4u* hp = (GAS v4u*)(h + row * D + 16 * F.lane);
                    hp[0] = (v4u){pk2(acc[0].x, acc[0].y), pk2(acc[0].z, acc[0].w), pk2(acc[1].x, acc[1].y), pk2(acc[1].z, acc[1].w)};
                    hp[1] = (v4u){pk2(acc[2].x, acc[2].y), pk2(acc[2].z, acc[2].w), pk2(acc[3].x, acc[3].y), pk2(acc[3].z, acc[3].w)};
                    f32x4 y[4];
#pragma unroll
                    for (int n = 0; n < 4; ++n) y[n] = acc[n] * rs * scl[n] + sft[n];
                    (void)U;
                    *(GAS v4u*)(ws + WS_U8 + row * D + 16 * F.lane) = (v4u){pk4_fp8(y[0].x, y[0].y, y[0].z, y[0].w), pk4_fp8(y[1].x, y[1].y, y[1].z, y[1].w), pk4_fp8(y[2].x, y[2].y, y[2].z, y[2].w), pk4_fp8(y[3].x, y[3].y, y[3].z, y[3].w)};
                } else {
                    float* orow = outf + row * D + 16 * F.lane;
#pragma unroll
                    for (int n = 0; n < 4; ++n) *(GAS f32x4*)(orow + 4 * n) = acc[n] * rs * scl[n];
                } }
        }
    }
}

__device__ __forceinline__ void stagger(int bx, int us) {
    const unsigned long long t0 = __builtin_amdgcn_s_memrealtime(); const unsigned long long wait = (unsigned long long)(((bx >> 3) & 3) * us) * 100ull;
    while (__builtin_amdgcn_s_memrealtime() - t0 < wait) __builtin_amdgcn_s_sleep(8);
}
#ifndef MK_STAG_IN
#define MK_STAG_IN 0
#endif
__device__ __forceinline__ void wg_seam(int tid) {
    asm volatile("s_waitcnt vmcnt(0)" ::: "memory");
    __syncthreads();
    if (tid < 64) { __builtin_amdgcn_fence(__ATOMIC_ACQUIRE, "agent"); asm volatile("s_waitcnt vmcnt(0)" ::: "memory"); }
    __syncthreads();
}
constexpr int NPH_L = 15, NPHASE = 1 + DEPTH * NPH_L + 1;
#ifndef MK_DBG_A
#define MK_DBG_A -1
#define MK_DBG_B -1
#endif
__global__ void __launch_bounds__(NTHR, 2) mk_fwd(Args args) {
    extern __shared__ __attribute__((aligned(16))) unsigned char lds_raw[];
    Frame F;
    F.lds = (LAS unsigned char*)lds_raw; F.ws = args.ws;
    F.tid = threadIdx.x; F.lane = F.tid & 63; F.wave = __builtin_amdgcn_readfirstlane(F.tid >> 6);
    F.G = gridDim.x; { const int bx = blockIdx.x; F.bx = bx; F.vcu = (F.G % 8 == 0) ? (bx % 8) * (F.G / 8) + bx / 8 : bx; }
    volatile LAS unsigned* misc = (volatile LAS unsigned*)(F.lds + LDS_MISC);
    if (F.tid < 64) misc[F.tid] = 0u;
    __syncthreads();
    XcdBarrier bar; bar.bar = (unsigned*)(args.ws + WS_CTL) + CW_BAR; bar.x = 0; bar.st = nullptr;
    if (!MK_PER_PHASE) bar = xcd_barrier_post((unsigned*)(args.ws + WS_CTL) + CW_BAR, misc + 8);
    const int lo = args.ph_lo, hi = args.ph_hi;
    if (MK_DBG_A >= 0 && F.tid == 0) misc[15] = (unsigned)__builtin_amdgcn_s_memrealtime();
#ifndef MK_G4_FROM_U
#define MK_G4_FROM_U 0
#endif
#ifndef MK_G3B_FIRST
#define MK_G3B_FIRST false
#endif
#ifndef MK_MASK
#define MK_MASK 0x7ffff
#endif
#define EN(j) (((MK_MASK) >> (j)) & 1)
#ifndef MK_REP_MASK
#define MK_REP_MASK 0
#endif
#define REP(j) for (int rep_ = 0; rep_ < 1 + (((MK_REP_MASK) >> (j)) & 1); ++rep_)
#define IN(k) (lo <= (k) && (k) < hi)
#define FRESH_TID(t_) int t_; { int l_; asm volatile("v_mbcnt_lo_u32_b32 %0, -1, 0\n\tv_mbcnt_hi_u32_b32 %0, -1, %0" : "=v"(l_)); int wv_ = F.wave; asm volatile("" : "+s"(wv_)); t_ = wv_ * 64 + l_; }
#define FRESH(P) Frame P = F; { FRESH_TID(t_); P.tid = t_; P.lane = t_ & 63; unsigned char* w_ = args.ws; asm volatile("" : "+s"(w_)); P.ws = w_; int g_ = F.G, v_ = F.vcu, b_ = F.bx; asm volatile("" : "+s"(g_), "+s"(v_), "+s"(b_)); P.G = g_; P.vcu = v_; P.bx = b_; } unsigned char* ws = P.ws
#define LSEAM(k) do { if (IN(k) && IN((k) + 1)) { FRESH_TID(tl_); wg_seam(tl_); } } while (0)
#define SEAM(k) do { if (IN(k) && IN((k) + 1)) { FRESH_TID(tb_); xcd_barrier(bar, tb_ == 0); \
    if (MK_DBG_A >= 0 && tb_ == 0 && F.bx == 0) { const unsigned now_ = (unsigned)__builtin_amdgcn_s_memrealtime(); misc[16 + (k)] = now_ - misc[15]; misc[15] = now_; } } } while (0)
    bf16* H = (bf16*)(args.ws + WS_H);
    if (MK_TLB_WARM) { for (unsigned p = F.tid; p < (unsigned)(WS_END >> 21); p += NTHR) (void)*(const volatile unsigned*)(args.ws + ((size_t)p << 21) + 64u * (unsigned)(F.bx & 63)); }
    if (EN(15) && IN(0)) REP(15) { FRESH(P); (void)ws; p0_prologue(P, args); } SEAM(0);
#pragma unroll 1
    for (int l = 0; l < DEPTH; ++l) {
        const int p0 = 1 + NPH_L * l;
        int f8from = MK_FP8_EXP1_FROM; asm volatile("" : "+s"(f8from));
#define MODP ((const float*)(ws + WS_MOD) + (size_t)l * 16 * 6144)
        if (l == 0) { if (EN(0) && IN(p0 + 0)) REP(0) { FRESH(P); norm_phase<false, false>(P, args.in[I_X], args.in[I_N1G] + l * D, MODP + 1024, MODP + 0, (bf16*)nullptr, nullptr, ws + WS_U8); }
            SEAM(p0 + 0); }
        if (EN(1) && IN(p0 + 1)) REP(1) { FRESH(P); pg8::Gemm g{(const bf16*)(ws + WS_U8), (const bf16*)(ws + WS_WIN8 + (size_t)l * NSEC * D), D / 2, nullptr}; pg8::StaticOrder S; S.init(T, NSEC, P.G, P.bx);
            EpiInProj E{ws}; pg8::gemm_phase<EpiInProj, pg8::StaticOrder, true, true, false, true>(P.lds, g, S, E, P.tid, P.wave); }
        SEAM(p0 + 1);
        if (EN(2) && IN(p0 + 2)) REP(2) { FRESH(P); (void)ws; if (EN(17)) REP(20) for (int u = P.vcu; u < 1024; u += P.G) gla_prep(P, args, l, u); }
        SEAM(p0 + 2);
        if (EN(3) && IN(p0 + 3)) REP(3) { FRESH(P); (void)ws;
            const bool light = P.vcu < 128; const int j = P.vcu & 127, hb = j & 7, grp = j >> 3;
            const int t0 = light ? 16 * (32 - MK_RG_LIGHT) + grp * MK_RG_LIGHT : grp * (32 - MK_RG_LIGHT), nt = light ? MK_RG_LIGHT : 32 - MK_RG_LIGHT;
            if (light && EN(17)) gla_rec(P, P.vcu);
            if (EN(18) && nt > 0) rg_gate_phase(P, args, l, hb, t0, nt); }
        SEAM(p0 + 3);
        if (EN(4) && IN(p0 + 4)) REP(4) { FRESH(P); (void)ws; if (EN(18)) for (int u = P.vcu; u < 1024; u += P.G) scan_pass1(P, u); }
        SEAM(p0 + 4);
        if (EN(5) && IN(p0 + 5)) { FRESH(P); (void)ws; if (EN(18)) {
#if MK_SCAN3_NEW
            scan_pass3_panel(P, P.vcu);
#else
            for (int k = 0; k < 4; ++k) scan_pass3(P, 4 * P.vcu + k);
#endif
            } if (EN(17)) gla_norm(P, args, l); }
        LSEAM(p0 + 5);
        if (EN(6) && IN(p0 + 6)) REP(6) {
            { FRESH(P); pg8::PanelOrder S{P.vcu, 4};
              pg8::Gemm g{(const bf16*)(ws + WS_IX), (const bf16*)(ws + WS_WA) + (size_t)l * D * D, D, nullptr}; EpiMerge<true> E{ws + WS_GA, (bf16*)(ws + WS_MBUF)};
              pg8::gemm_phase<EpiMerge<true>, pg8::PanelOrder, true, true, false>(P.lds, g, S, E, P.tid, P.wave); }
            { FRESH(P); pg8::PanelOrder S{P.vcu, 4};
              pg8::Gemm g{(const bf16*)(ws + WS_O), (const bf16*)(ws + WS_WB) + (size_t)l * D * D, D, nullptr}; EpiMerge<MK_G3B_FIRST> E{ws + WS_GB, (bf16*)(ws + WS_MBUF)};
              pg8::gemm_phase<EpiMerge<MK_G3B_FIRST>, pg8::PanelOrder, true, true, false>(P.lds, g, S, E, P.tid, P.wave); } }
        LSEAM(p0 + 6);
        if (EN(7) && IN(p0 + 7)) { FRESH(P); pg8::PanelOrder S{P.vcu, 4};
            pg8::Gemm g{(const bf16*)(ws + WS_MBUF), (const bf16*)(ws + WS_WO) + (size_t)l * D * D, D, nullptr};
            if (l == 0) { EpiRes<true> E{args.in[I_X], H, MODP + 2048}; pg8::gemm_phase<EpiRes<true>, pg8::PanelOrder, true, true, false>(P.lds, g, S, E, P.tid, P.wave); }
            else { EpiRes<false> E{H, H, MODP + 2048}; pg8::gemm_phase<EpiRes<false>, pg8::PanelOrder, true, true, false>(P.lds, g, S, E, P.tid, P.wave); } }
        LSEAM(p0 + 7);
        if (EN(8) && IN(p0 + 8)) REP(8) { FRESH(P); norm_phase<false, true>(P, H, args.in[I_N2G] + l * D, MODP + 4096, MODP + 3072, (bf16*)(ws + WS_U), nullptr, (l >= f8from) ? (unsigned char*)args.out : (unsigned char*)nullptr);
            if (l >= f8from && P.vcu == 0 && P.tid < D / 16) { unsigned z_ = 0u; asm volatile("" : "+v"(z_)); *(GAS v4u*)((unsigned char*)args.out + (size_t)T * D + P.tid * 16) = (v4u){z_, z_, z_, z_}; }
            for (int i = P.vcu * NTHR + P.tid; i < PMAX; i += P.G * NTHR) ((int*)(ws + WS_SORT))[i] = T; }
        LSEAM(p0 + 8);
        if (EN(9) && IN(p0 + 9)) REP(9) { FRESH(P); pg8::PanelOrder S{P.vcu, 1};
            pg8::Gemm g{(const bf16*)(ws + WS_U), (const bf16*)(ws + WS_ROUT) + (size_t)l * 256 * D, D, nullptr}; EpiLogit E{(float*)(ws + WS_LOGIT)};
            pg8::gemm_phase<EpiLogit, pg8::PanelOrder, true, true, false>(P.lds, g, S, E, P.tid, P.wave); }
        LSEAM(p0 + 9);
        if (EN(10) && IN(p0 + 10)) { if ((MK_REP_MASK >> 23) & 1) { FRESH(P); (void)ws; topk_phase(P, args, l, l + 2); } { FRESH(P); (void)ws; topk_phase(P, args, l, l); } }
        SEAM(p0 + 10);
        if (EN(11) && IN(p0 + 11)) REP(11) { FRESH(P); (void)ws; scatter_phase(P, l); }
        SEAM(p0 + 11);
        if (EN(12) && IN(p0 + 12)) REP(12) {
            if (l >= f8from) {
              { FRESH(P); moe_tiles(P, l); const LAS int* ts = (const LAS int*)(P.lds + LDS_TS);
                pg8::MoeOrder S{ts, 2, P.G, P.vcu, ts[NE] * 2};
                pg8::Gemm g{(const bf16*)args.out, (const bf16*)(ws + WS_EGU + (size_t)l * NE * 512 * D * 2), D / 2, (const int*)(ws + WS_SORT)}; EpiGlu E{(bf16*)(ws + WS_ACT)};
                pg8::gemm_phase<EpiGlu, pg8::MoeOrder, true, true, true, true>(P.lds, g, S, E, P.tid, P.wave); }
              { FRESH(P); pg8::StaticOrder S; S.init(T, 512, P.G, P.bx);
                pg8::Gemm g{(const bf16*)args.out, (const bf16*)(ws + WS_SGU + (size_t)l * 512 * D * 2), D / 2, nullptr}; EpiGlu E{(bf16*)(ws + WS_ACTS)};
                pg8::gemm_phase<EpiGlu, pg8::StaticOrder, true, true, false, true>(P.lds, g, S, E, P.tid, P.wave); }
            } else {
              { FRESH(P); moe_tiles(P, l); const LAS int* ts = (const LAS int*)(P.lds + LDS_TS);
                pg8::MoeOrder S{ts, 2, P.G, P.vcu, ts[NE] * 2};
                pg8::Gemm g{(const bf16*)(ws + WS_U), (const bf16*)(ws + WS_EGU) + (size_t)l * NE * 512 * D, D, (const int*)(ws + WS_SORT)}; EpiGlu E{(bf16*)(ws + WS_ACT)};
                pg8::gemm_phase<EpiGlu, pg8::MoeOrder, true, true, true>(P.lds, g, S, E, P.tid, P.wave); }
              { FRESH(P); pg8::StaticOrder S; S.init(T, 512, P.G, P.bx);
                pg8::Gemm g{(const bf16*)(ws + WS_U), (const bf16*)(ws + WS_SGU) + (size_t)l * 512 * D, D, nullptr}; EpiGlu E{(bf16*)(ws + WS_ACTS)};
                pg8::gemm_phase<EpiGlu, pg8::StaticOrder, true, true, false>(P.lds, g, S, E, P.tid, P.wave); } } }
        SEAM(p0 + 12);
        if (EN(13) && IN(p0 + 13)) {
            REP(21) { FRESH(P); moe_tiles(P, l); const LAS int* ts = (const LAS int*)(P.lds + LDS_TS);
              pg8::MoeOrder S{ts, 4, P.G, P.vcu, ts[NE] * 4};
              pg8::Gemm g{(const bf16*)(ws + WS_ACT), (const bf16*)(ws + WS_EDN) + (size_t)l * NE * D * DE, DE, nullptr}; EpiY E{ws + WS_Y};
              pg8::gemm_phase<EpiY, pg8::MoeOrder, true, true, false>(P.lds, g, S, E, P.tid, P.wave); }
            { FRESH(P); pg8::StaticOrder S; S.init(T, D, P.G, P.bx);
              pg8::Gemm g{(const bf16*)(ws + WS_ACTS), (const bf16*)(ws + WS_SDN) + (size_t)l * D * DE, DE, nullptr}; EpiY E{ws + WS_YS};
              pg8::gemm_phase<EpiY, pg8::StaticOrder, true, true, false>(P.lds, g, S, E, P.tid, P.wave); } }
        SEAM(p0 + 13);
        if (EN(14) && IN(p0 + 14)) { FRESH(P);
            if (l + 1 < DEPTH) { const float* modn = (const float*)(ws + WS_MOD) + (size_t)(l + 1) * 16 * 6144;
                combine_phase<0>(P, H, MODP + 5120, nullptr, args.in[I_N1G] + (l + 1) * D, modn + 1024, modn + 0, (bf16*)(ws + WS_U)); }
            else combine_phase<1>(P, H, MODP + 5120, args.out, args.in[I_FG], nullptr, nullptr, nullptr); }
        if (l + 1 < DEPTH) SEAM(p0 + 14);
    }
    if (MK_DBG_A >= 0 && F.bx == 0) {
        __syncthreads(); asm volatile("s_waitcnt vmcnt(0)" ::: "memory");
        if (F.tid == 0) { const unsigned now_ = (unsigned)__builtin_amdgcn_s_memrealtime(); misc[16 + NPHASE - 2] = now_ - misc[15]; }
        __syncthreads();
        const int sa = MK_DBG_A, sb = MK_DBG_B;
        const float dA = (sa == 15) ? misc[16] * 0.01f : (misc[16 + 1 + sa] + misc[16 + 1 + NPH_L + sa]) * 0.01f;
        const float dB = (sb == 15) ? misc[16] * 0.01f : (misc[16 + 1 + sb] + misc[16 + 1 + NPH_L + sb]) * 0.01f;
        if (F.tid == 0) args.out[0] = 10.0f * dA; else if (F.tid <= 670) args.out[F.tid] = dB;
    }
#undef MODP
#undef IN
#undef SEAM
}

#ifndef MK_SKIP_LO
#define MK_SKIP_LO 0
#define MK_SKIP_HI 0
#endif
#ifndef MK_NLAUNCH
#define MK_NLAUNCH NPHASE
#endif
extern "C" void kernel_launch(void* const* d_in, const int* in_sizes, int n_in, void* d_out, int out_size, void* d_ws, size_t ws_size, hipStream_t stream) {
    static int grid = 0;
    if (grid == 0) {
        if (n_in != N_INPUTS || out_size != T * D || ws_size < WS_END) { fprintf(stderr, "kernel_launch: unexpected problem shape (n_in %d out %d ws %zu, need %zu)\n", n_in, out_size, ws_size, (size_t)WS_END); grid = -1; return; }
        int dev = 0, cus = 0, per_cu = 0;
        if (hipGetDevice(&dev) != hipSuccess || hipDeviceGetAttribute(&cus, hipDeviceAttributeMultiprocessorCount, dev) != hipSuccess) { grid = -1; return; }
        if (hipFuncSetAttribute((const void*)mk_fwd, hipFuncAttributeMaxDynamicSharedMemorySize, LDS_BYTES) != hipSuccess) { fprintf(stderr, "kernel_launch: hipFuncSetAttribute failed\n"); grid = -1; return; }
        if (hipOccupancyMaxActiveBlocksPerMultiprocessor(&per_cu, (const void*)mk_fwd, NTHR, LDS_BYTES) != hipSuccess || per_cu < 1) { fprintf(stderr, "kernel_launch: occupancy query says %d\n", per_cu); }
        (void)hipGetLastError();
        if (cus != T / 256) { fprintf(stderr, "kernel_launch: built for %d CUs (one 256-row panel per workgroup), device has %d\n", T / 256, cus); grid = -1; return; }
        grid = cus;
    }
    if (grid < 0) return;
    if (hipMemsetAsync((char*)d_ws + WS_CTL, 0, CTL_ZERO_BYTES, stream) != hipSuccess) return;
    Args a{};
    for (int i = 0; i < N_INPUTS; ++i) a.in[i] = (const float*)d_in[i];
    a.out = (float*)d_out; a.ws = (unsigned char*)d_ws;
#if MK_PER_PHASE
    for (int p = 0; p < MK_NLAUNCH; ++p) { if (p >= MK_SKIP_LO && p < MK_SKIP_HI) continue; a.ph_lo = p; a.ph_hi = p + 1; hipLaunchKernelGGL(mk_fwd, dim3(grid), dim3(NTHR), LDS_BYTES, stream, a); }
#else
    a.ph_lo = 0; a.ph_hi = NPHASE; hipLaunchKernelGGL(mk_fwd, dim3(grid), dim3(NTHR), LDS_BYTES, stream, a);
#endif
}
```

```cpp
#include <hip/hip_runtime.h>
#include <cstdio>
#include <cstdint>

#ifndef MK_PER_PHASE
#define MK_PER_PHASE 0
#define MK_SCAN3_NEW 1
#ifndef MK_FP8_EXP1_FROM
#define MK_FP8_EXP1_FROM 0
#endif
#ifndef MK_RG_LIGHT
#define MK_RG_LIGHT 4
#endif
#endif

namespace pg8 {
#define PG8_LAS __attribute__((address_space(3)))
typedef unsigned short bf16_t;
typedef short bf16x8 __attribute__((ext_vector_type(8)));
typedef float f32x4 __attribute__((ext_vector_type(4)));
typedef unsigned u32x4 __attribute__((ext_vector_type(4)));
constexpr int BM = 256, BK = 64, HALF = 128, HTB = HALF * BK * 2, STAGE_BYTES = 8 * HTB, NXCD = 8, WGM = 8;

__host__ __device__ __forceinline__ int lds_byte(int r, int c) { const int st = (r >> 4) * 2 + (c >> 5), rr = r & 15, cc = c & 31, ob = rr * 64 + cc * 2; return st * 1024 + (ob ^ (((ob >> 9) & 1) << 5)); }
__host__ __device__ __forceinline__ void stage_rc(int b, int& R, int& C) { const int st = b / 1024, sb = b % 1024, swz = sb ^ (((sb >> 9) & 1) << 5); R = (st >> 1) * 16 + swz / 64; C = (st & 1) * 32 + (swz % 64) / 2; }
__host__ __device__ __forceinline__ int perm32(int rho) { const int n = rho >> 4, i = rho & 15; return 8 * (i >> 2) + 4 * n + (i & 3); }

struct Unit { int pm, pn; };
struct Gemm { const bf16_t* A; const bf16_t* Bt; int K; const int* rowidx; };

struct StaticOrder {
    int nM, nN, nwg, G, c;
    __host__ __device__ void init(int M, int N, int G_, int c_) { nM = M / BM; nN = N / BM; nwg = nM * nN; G = G_; c = c_; }
    __host__ __device__ bool next(int i, Unit& u) const {
        const long L = (long)i * G + c; if (L >= nwg) return false;
        int wgid = (int)L; { const int q = nwg / NXCD, r = nwg % NXCD, xcd = wgid % NXCD, off = wgid / NXCD; wgid = (xcd < r ? xcd * (q + 1) : r * (q + 1) + (xcd - r) * q) + off; }
        const int nig = WGM * nN, gid = wgid / nig, fm = gid * WGM, gsz = (nM - fm) < WGM ? (nM - fm) : WGM;
        u.pm = fm + ((wgid % nig) % gsz); u.pn = (wgid % nig) / gsz; return true;
    }
};
struct PanelOrder {
    int pm, nN;
    __device__ __forceinline__ bool next(int i, Unit& u) const { if (i >= nN) return false; u.pm = pm; u.pn = i; return true; }
};
struct MoeOrder {
    const PG8_LAS int* ts; int npn, G, c, total;
    __device__ __forceinline__ bool next(int i, Unit& u) const {
        const int L = i * G + c; if (L >= total) return false;
        const int tile = L / npn, j = L - tile * npn;
        int lo = 0, hi = 128;
        while (hi - lo > 1) { const int mid = (lo + hi) >> 1; if (ts[mid] <= tile) lo = mid; else hi = mid; }
        u.pm = tile; u.pn = lo * npn + j; return true;
    }
};

__device__ __forceinline__ unsigned cvt_pk_bf16(float lo, float hi) { typedef __bf16 bf2_t __attribute__((ext_vector_type(2))); typedef float f2_t __attribute__((ext_vector_type(2)));
    return __builtin_bit_cast(unsigned, __builtin_convertvector((f2_t){lo, hi}, bf2_t)); }

template <class Epi, class Sched, bool ALIGN_EPI, bool SP2, bool GATHER, bool FP8 = false>
__device__ __forceinline__ void gemm_phase(PG8_LAS unsigned char* lds, const Gemm g, const Sched& S, const Epi& E, const int tid, const int wid) {
    const int lane = tid & 63, wr = wid >> 2, wc = wid & 3, fr = lane & 15, fq = lane >> 4;
    const int K = g.K, nt = K / BK;
    unsigned voffA[2], voffB[2];
#pragma unroll
    for (int i = 0; i < 2; ++i) { int R, C; stage_rc(tid * 16 + i * 8192, R, C); const int Rb = (R & ~31) + perm32(R & 31);
        voffA[i] = (unsigned)(R * K + C) * 2u; voffB[i] = (unsigned)(Rb * K + C) * 2u; }
    const size_t kstep = (size_t)(BK * 2);
    const size_t hstep = (size_t)HALF * K * 2;
    const size_t tstep = 2 * hstep;
    const unsigned ldsw = (unsigned)wid * 1024u;
    const int aoff = lds_byte(wr * 64 + fr, fq * 8), boff = lds_byte(wc * 32 + fr, fq * 8);
    unsigned gc[2][2], gn[2][2];
#define PG8_SA(b, h) (((b) * 2 + (h)) * HTB)
#define PG8_SB(b, h) ((4 + (b) * 2 + (h)) * HTB)
#define PG8_STAGE(bufoff, gbase, voff) do { _Pragma("unroll") for (int _i = 0; _i < 2; ++_i) \
        __builtin_amdgcn_global_load_lds((const unsigned*)((const char*)(gbase) + (voff)[_i]), (PG8_LAS unsigned*)(lds + (bufoff) + ldsw + _i * 8192), 16, 0, 0); } while (0)
#define PG8_STAGE_A(bufoff, kb, h, NX) do { if constexpr (GATHER) { _Pragma("unroll") for (int _i = 0; _i < 2; ++_i) { const unsigned _o = (NX) ? gn[h][_i] : gc[h][_i]; \
        __builtin_amdgcn_global_load_lds((const unsigned*)((const char*)(kb) + _o), (PG8_LAS unsigned*)(lds + (bufoff) + ldsw + _i * 8192), 16, 0, 0); } } \
        else { PG8_STAGE(bufoff, (const char*)(kb) + ((h) ? hstep : (size_t)0), voffA); } } while (0)
#define PG8_LD32(dst, off) do { const v4i_ lo_ = *(const PG8_LAS v4i_*)(lds + (off)), hi_ = *(const PG8_LAS v4i_*)(lds + (off) + 1024); dst = __builtin_shufflevector(lo_, hi_, 0, 1, 2, 3, 4, 5, 6, 7); } while (0)
#define PG8_LDA(dst, b, h) do { if constexpr (FP8) { _Pragma("unroll") for (int m = 0; m < 4; ++m) PG8_LD32(dst##8[m], PG8_SA(b, h) + aoff + m * 2048); } \
        else { _Pragma("unroll") for (int m = 0; m < 4; ++m) _Pragma("unroll") for (int k = 0; k < 2; ++k) dst[m][k] = *(const PG8_LAS bf16x8*)(lds + PG8_SA(b, h) + aoff + m * 2048 + k * 1024); } } while (0)
#define PG8_LDB(dst, b, h) do { if constexpr (FP8) { _Pragma("unroll") for (int n = 0; n < 2; ++n) PG8_LD32(dst##8[n], PG8_SB(b, h) + boff + n * 2048); } \
        else { _Pragma("unroll") for (int n = 0; n < 2; ++n) _Pragma("unroll") for (int k = 0; k < 2; ++k) dst[n][k] = *(const PG8_LAS bf16x8*)(lds + PG8_SB(b, h) + boff + n * 2048 + k * 1024); } } while (0)
#define PG8_MMA(ai, bj, At, Bt) do { __builtin_amdgcn_s_setprio(1); if constexpr (FP8) { _Pragma("unroll") for (int m = 0; m < 4; ++m) _Pragma("unroll") for (int n = 0; n < 2; ++n) \
        asm volatile("v_mfma_scale_f32_16x16x128_f8f6f4 %0, %1, %2, %0, %3, %4 op_sel_hi:[0,0,0]" : "+v"(acc[ai][bj][m][n]) : "v"(Bt##8[n]), "v"(At##8[m]), "v"(0x79797979), "v"(0x7F7F7F7F)); } \
    else { _Pragma("unroll") for (int m = 0; m < 4; ++m) _Pragma("unroll") for (int n = 0; n < 2; ++n) _Pragma("unroll") for (int k = 0; k < 2; ++k) \
        acc[ai][bj][m][n] = __builtin_amdgcn_mfma_f32_16x16x32_bf16(Bt[n][k], At[m][k], acc[ai][bj][m][n], 0, 0, 0); } __builtin_amdgcn_s_setprio(0); } while (0)
#define PG8_WAIT_V(n) asm volatile("s_waitcnt vmcnt(" #n ")" ::: "memory")
#define PG8_WAIT_L(n) asm volatile("s_waitcnt lgkmcnt(" #n ")" ::: "memory")
#define PG8_BAR __builtin_amdgcn_s_barrier()
#define PG8_SCHED __builtin_amdgcn_sched_barrier(0)
#define PG8_LOAD_ROWS(dst, un) do { int _ln; asm volatile("v_mbcnt_lo_u32_b32 %0, -1, 0\n\tv_mbcnt_hi_u32_b32 %0, -1, %0" : "=v"(_ln)); const int _t = wid * 64 + _ln; \
        _Pragma("unroll") for (int _i = 0; _i < 2; ++_i) { int _R, _C; stage_rc(_t * 16 + _i * 8192, _R, _C); _Pragma("unroll") for (int _h = 0; _h < 2; ++_h) { \
        const int _tok = ((const __attribute__((address_space(1))) int*)g.rowidx)[(un).pm * BM + _h * HALF + _R]; dst[_h][_i] = (unsigned)_tok * (unsigned)(K * 2) + (unsigned)_C * 2u; } } } while (0)
#define PG8_ROWS_ISSUE(tk, un) do { int _ln; asm volatile("v_mbcnt_lo_u32_b32 %0, -1, 0\n\tv_mbcnt_hi_u32_b32 %0, -1, %0" : "=v"(_ln)); const int _t = wid * 64 + _ln; \
        _Pragma("unroll") for (int _i = 0; _i < 2; ++_i) { int _R, _C; stage_rc(_t * 16 + _i * 8192, _R, _C); _Pragma("unroll") for (int _h = 0; _h < 2; ++_h) \
        tk[_h][_i] = ((const __attribute__((address_space(1))) int*)g.rowidx)[(un).pm * BM + _h * HALF + _R]; } } while (0)
#define PG8_ROWS_FINISH(dst, tk) do { int _ln; asm volatile("v_mbcnt_lo_u32_b32 %0, -1, 0\n\tv_mbcnt_hi_u32_b32 %0, -1, %0" : "=v"(_ln)); const int _t = wid * 64 + _ln; \
        _Pragma("unroll") for (int _i = 0; _i < 2; ++_i) { int _R, _C; stage_rc(_t * 16 + _i * 8192, _R, _C); _Pragma("unroll") for (int _h = 0; _h < 2; ++_h) \
        dst[_h][_i] = (unsigned)tk[_h][_i] * (unsigned)(K * 2) + (unsigned)_C * 2u; } } while (0)
    Unit cur, nxt, nx2; int ui = 0;
    if (!S.next(0, cur)) return;
    bool has_next = S.next(1, nxt);
    f32x4 acc[2][2][4][2];
#pragma unroll
    for (int a = 0; a < 2; ++a)
#pragma unroll
        for (int b = 0; b < 2; ++b)
#pragma unroll
            for (int m = 0; m < 4; ++m)
#pragma unroll
                for (int n = 0; n < 2; ++n) acc[a][b][m][n] = (f32x4){0.f, 0.f, 0.f, 0.f};
    bf16x8 At[4][2], B0[2][2], B1[2][2];
    typedef int v4i_ __attribute__((ext_vector_type(4))); typedef int v8i_ __attribute__((ext_vector_type(8)));
    v8i_ At8[4], B08[2], B18[2];
    const char* cA = GATHER ? (const char*)g.A : (const char*)g.A + (size_t)cur.pm * tstep; const char* cB = (const char*)g.Bt + (size_t)cur.pn * tstep;
    if constexpr (GATHER) { PG8_LOAD_ROWS(gc, cur); if (has_next) { PG8_LOAD_ROWS(gn, nxt); } else {
#pragma unroll
        for (int _h = 0; _h < 2; ++_h)
#pragma unroll
            for (int _i = 0; _i < 2; ++_i) gn[_h][_i] = gc[_h][_i]; } }
    if constexpr (SP2) {
        PG8_STAGE(PG8_SB(0, 0), cB, voffB); PG8_STAGE(PG8_SB(0, 1), cB + hstep, voffB); PG8_STAGE_A(PG8_SA(0, 0), cA, 0, false); PG8_STAGE_A(PG8_SA(0, 1), cA, 1, false);
        if (wr == 1) PG8_BAR;
        PG8_WAIT_V(2); PG8_BAR;
        PG8_STAGE(PG8_SB(1, 0), cB + kstep, voffB); PG8_STAGE_A(PG8_SA(1, 0), cA + kstep, 0, false); PG8_STAGE(PG8_SB(1, 1), cB + hstep + kstep, voffB);
        PG8_WAIT_V(6); PG8_BAR;
    } else {
        PG8_STAGE(PG8_SB(0, 0), cB, voffB); PG8_STAGE_A(PG8_SA(0, 0), cA, 0, false); PG8_STAGE(PG8_SB(0, 1), cB + hstep, voffB); PG8_STAGE_A(PG8_SA(0, 1), cA, 1, false);
        if (wr == 1) PG8_BAR;
        PG8_WAIT_V(4); PG8_BAR;
        PG8_STAGE(PG8_SB(1, 0), cB + kstep, voffB); PG8_STAGE_A(PG8_SA(1, 0), cA + kstep, 0, false); PG8_STAGE(PG8_SB(1, 1), cB + hstep + kstep, voffB);
        PG8_WAIT_V(6); PG8_BAR;
    }
    for (;;) {
        const char* nA = GATHER ? (const char*)g.A : (has_next ? (const char*)g.A + (size_t)nxt.pm * tstep : cA); const char* nB = has_next ? (const char*)g.Bt + (size_t)nxt.pn * tstep : cB;
#pragma unroll 1
        for (int t = 0; t < nt; t += 2) {
            const bool last = (t == nt - 2);
            const char* a1 = cA + (size_t)(t + 1) * kstep;
            const char* a2 = last ? nA : cA + (size_t)(t + 2) * kstep; const char* b2 = last ? nB : cB + (size_t)(t + 2) * kstep;
            const char* a3 = a2 + kstep; const char* b3 = b2 + kstep;
            if constexpr (SP2) {
            PG8_LDB(B0, 0, 0); PG8_LDB(B1, 0, 1); PG8_SCHED; PG8_LDA(At, 0, 0); PG8_STAGE_A(PG8_SA(1, 1), a1, 1, false);
            PG8_WAIT_V(8); PG8_WAIT_L(0); PG8_BAR; PG8_MMA(0, 0, At, B0); PG8_MMA(0, 1, At, B1); PG8_BAR; PG8_SCHED;
            PG8_LDA(At, 0, 1); PG8_STAGE(PG8_SB(0, 0), b2, voffB); PG8_STAGE(PG8_SB(0, 1), b2 + hstep, voffB); PG8_STAGE_A(PG8_SA(0, 0), a2, 0, last);
            PG8_WAIT_V(8); PG8_WAIT_L(0); PG8_BAR; PG8_MMA(1, 0, At, B0); PG8_MMA(1, 1, At, B1); PG8_BAR; PG8_SCHED;
            PG8_LDB(B0, 1, 0); PG8_LDB(B1, 1, 1); PG8_SCHED; PG8_LDA(At, 1, 0); PG8_STAGE_A(PG8_SA(0, 1), a2, 1, last);
            PG8_WAIT_V(8); PG8_WAIT_L(0); PG8_BAR; PG8_MMA(0, 0, At, B0); PG8_MMA(0, 1, At, B1); PG8_BAR; PG8_SCHED;
            PG8_LDA(At, 1, 1); PG8_STAGE(PG8_SB(1, 0), b3, voffB); PG8_STAGE(PG8_SB(1, 1), b3 + hstep, voffB); PG8_STAGE_A(PG8_SA(1, 0), a3, 0, last);
            PG8_WAIT_V(8); PG8_WAIT_L(0); PG8_BAR; PG8_MMA(1, 0, At, B0); PG8_MMA(1, 1, At, B1); PG8_BAR; PG8_SCHED;
            } else {
            PG8_LDB(B0, 0, 0); PG8_SCHED; PG8_LDA(At, 0, 0); PG8_STAGE_A(PG8_SA(1, 1), a1, 1, false);
            PG8_WAIT_L(8); PG8_BAR; PG8_WAIT_L(0); PG8_MMA(0, 0, At, B0); PG8_BAR; PG8_SCHED;
            PG8_LDB(B1, 0, 1); PG8_STAGE(PG8_SB(0, 0), b2, voffB);
            PG8_BAR; PG8_WAIT_L(0); PG8_MMA(0, 1, At, B1); PG8_BAR;
            PG8_LDA(At, 0, 1); PG8_STAGE_A(PG8_SA(0, 0), a2, 0, last);
            PG8_BAR; PG8_WAIT_L(0); PG8_MMA(1, 0, At, B0); PG8_BAR; PG8_SCHED;
            PG8_STAGE(PG8_SB(0, 1), b2 + hstep, voffB);
            PG8_WAIT_V(6); PG8_BAR; PG8_MMA(1, 1, At, B1); PG8_BAR;
            PG8_LDB(B0, 1, 0); PG8_SCHED; PG8_LDA(At, 1, 0); PG8_STAGE_A(PG8_SA(0, 1), a2, 1, last);
            PG8_WAIT_L(8); PG8_BAR; PG8_WAIT_L(0); PG8_MMA(0, 0, At, B0); PG8_BAR; PG8_SCHED;
            PG8_LDB(B1, 1, 1); PG8_STAGE(PG8_SB(1, 0), b3, voffB);
            PG8_BAR; PG8_WAIT_L(0); PG8_MMA(0, 1, At, B1); PG8_BAR;
            PG8_LDA(At, 1, 1); PG8_STAGE_A(PG8_SA(1, 0), a3, 0, last);
            PG8_BAR; PG8_WAIT_L(0); PG8_MMA(1, 0, At, B0); PG8_BAR; PG8_SCHED;
            PG8_STAGE(PG8_SB(1, 1), b3 + hstep, voffB);
            PG8_WAIT_V(6); PG8_BAR; PG8_MMA(1, 1, At, B1); PG8_BAR;
            }
        }
        const bool has_nx2 = has_next && S.next(ui + 2, nx2);
        int tk[2][2];
        if constexpr (GATHER) { if (has_nx2) { PG8_ROWS_ISSUE(tk, nx2); } }
        if constexpr (ALIGN_EPI) { if (wr == 0) PG8_BAR; }
        if constexpr (FP8) asm volatile("s_nop 15\n\ts_nop 15" ::: "memory");
        E(acc, cur, wr, wc, fr, fq);
        if (!has_next) break;
#pragma unroll
        for (int a = 0; a < 2; ++a)
#pragma unroll
            for (int b = 0; b < 2; ++b)
#pragma unroll
                for (int m = 0; m < 4; ++m)
#pragma unroll
                    for (int n = 0; n < 2; ++n) acc[a][b][m][n] = (f32x4){0.f, 0.f, 0.f, 0.f};
        cur = nxt; cA = nA; cB = nB; ++ui;
        if constexpr (GATHER) {
#pragma unroll
            for (int _h = 0; _h < 2; ++_h)
#pragma unroll
                for (int _i = 0; _i < 2; ++_i) gc[_h][_i] = gn[_h][_i];
            if (has_nx2) { PG8_ROWS_FINISH(gn, tk); } }
        nxt = nx2; has_next = has_nx2;
        if constexpr (ALIGN_EPI) { if (wr == 1) PG8_BAR; }
    }
    PG8_WAIT_V(0);
    if constexpr (!ALIGN_EPI) { if (wr == 0) PG8_BAR; }
    PG8_BAR;
#undef PG8_SA
#undef PG8_SB
#undef PG8_STAGE
#undef PG8_STAGE_A
#undef PG8_LDA
#undef PG8_LD32
#undef PG8_LDB
#undef PG8_MMA
#undef PG8_WAIT_V
#undef PG8_ROWS_ISSUE
#undef PG8_ROWS_FINISH
#undef PG8_WAIT_L
#undef PG8_BAR
#undef PG8_SCHED
#undef PG8_LOAD_ROWS
}
}

constexpr int NWAVES = 8, NTHR = 512;
constexpr int D = 1024, BATCH = 16, SEQ = 4096, T = BATCH * SEQ, DEPTH = 2;
constexpr int CHUNK = 64, NCH = SEQ / CHUNK;
constexpr int NSEC = 7168;
constexpr int N_IN = 7184;
constexpr int NE = 128, TOPK = 8, DE = 256;
constexpr int PMAX = T * TOPK + NE * 256;
constexpr float EPS = 1e-6f;

constexpr size_t MiB = 1u << 20;
constexpr size_t WS_CTL = 0, CTL_ZERO_BYTES = 1 * MiB;
constexpr size_t WS_MOD = 1 * MiB;
constexpr size_t WS_WLR = 2 * MiB;
constexpr size_t WS_RGW = 3 * MiB;
constexpr size_t WS_WIN8 = 4 * MiB;
constexpr size_t WS_WA = 32 * MiB, WS_WB = 36 * MiB, WS_WO = 40 * MiB;
constexpr size_t WS_ROUT = 44 * MiB;
constexpr size_t WS_SGU = 45 * MiB;
constexpr size_t WS_SDN = 47 * MiB;
constexpr size_t WS_EGU = 48 * MiB;
constexpr size_t WS_EDN = 304 * MiB;
constexpr size_t WS_U = 432 * MiB;
constexpr size_t WS_SP = 561 * MiB, WS_SE = 565 * MiB, WS_CIN = 569 * MiB;
constexpr size_t WS_TOT = 573 * MiB;
constexpr size_t WS_PK = 575 * MiB;
constexpr size_t WS_POS = 577 * MiB;
constexpr size_t WS_WTS = 579 * MiB;
constexpr size_t WS_SORT = 581 * MiB;
constexpr size_t WS_BIG = 592 * MiB;
constexpr size_t WS_XRPRE = WS_BIG + 192 * MiB, WS_RG = WS_BIG + 128 * MiB, WS_Q = WS_BIG + 256 * MiB, WS_K = WS_BIG + 320 * MiB, WS_V = WS_BIG + 384 * MiB,
                 WS_OG = WS_BIG + 512 * MiB, WS_GA = WS_BIG + 640 * MiB, WS_GB = WS_BIG + 768 * MiB, WS_LOGA = WS_BIG + 896 * MiB, WS_IX = WS_BIG + 1024 * MiB,
                 WS_KDEC = WS_BIG + 1152 * MiB;
constexpr size_t WS_U8 = WS_BIG + 960 * MiB;
constexpr size_t WS_O = WS_BIG;
constexpr size_t WS_MBUF = WS_LOGA;
constexpr size_t WS_Y = WS_BIG;
constexpr size_t WS_YS = WS_BIG + 544 * MiB;
constexpr size_t WS_LOGIT = WS_BIG + 1392 * MiB;
constexpr size_t WS_ACT = WS_BIG + 672 * MiB;
constexpr size_t WS_H = WS_BIG + 1216 * MiB;
constexpr size_t WS_ACTS = WS_BIG + 1360 * MiB;
constexpr size_t WS_END = WS_BIG + 1424 * MiB;
static_assert((size_t)PMAX * 1024 <= 544 * MiB && (size_t)PMAX * 256 * 2 <= 272 * MiB && WS_KDEC + 64 * MiB <= WS_H && WS_H + 128 * MiB <= WS_ACTS && WS_ACT + 272 * MiB <= WS_H && WS_YS + 128 * MiB <= WS_ACT, "ws map");
constexpr int CW_TMO = 0;
constexpr int CW_BAR = 4096;
constexpr int CW_CNT = 8192;

constexpr int RING_BYTES = 131072;
constexpr int LDS_TS = RING_BYTES;
constexpr int LDS_MISC = RING_BYTES + 1024;
constexpr int LDS_BYTES = 147456;

#define GAS __attribute__((address_space(1)))
#define LAS __attribute__((address_space(3)))
typedef unsigned short bf16;
typedef unsigned v4u __attribute__((ext_vector_type(4)));
typedef unsigned v2u __attribute__((ext_vector_type(2)));
typedef float f32x4 __attribute__((ext_vector_type(4)));
typedef float f32x16 __attribute__((ext_vector_type(16)));
typedef short bf16x8 __attribute__((ext_vector_type(8)));
typedef short s16x4 __attribute__((ext_vector_type(4)));
typedef GAS unsigned gu32;
#define RLX_AGENT __ATOMIC_RELAXED, __HIP_MEMORY_SCOPE_AGENT
#define LDS_WAIT() asm volatile("s_waitcnt lgkmcnt(0)" ::: "memory")
__device__ __forceinline__ unsigned f2bf(float f) { return (unsigned)__builtin_bit_cast(unsigned short, (__bf16)f); }
__device__ __forceinline__ unsigned pk2(float lo, float hi) { return pg8::cvt_pk_bf16(lo, hi); }
__device__ __forceinline__ float bflo(unsigned w) { return __builtin_bit_cast(float, w << 16); }
__device__ __forceinline__ float bfhi(unsigned w) { return __builtin_bit_cast(float, w & 0xffff0000u); }
__device__ __forceinline__ float bf2f(bf16 b) { return __builtin_bit_cast(float, (unsigned)b << 16); }
__device__ __forceinline__ float fsigmoid(float x) { return __builtin_amdgcn_rcpf(1.0f + __builtin_amdgcn_exp2f(-1.442695041f * x)); }
__device__ __forceinline__ float fsilu(float x) { return x * fsigmoid(x); }
__device__ __forceinline__ float fgelu_tanh(float x) { return x * fsigmoid(1.5957691216f * (x + 0.044715f * x * x * x)); }

#define XB_TMO      128
#define XB_XCNT(j)  (256  + 64 * (j))
#define XB_XSUB(j)  (1280 + 64 * (j))
#define XB_XGEN(j)  (2304 + 64 * (j))
#define XB_TOP      3328
#define XB_TOPGEN   3392
#define XCD_BAR_WORDS 3456
#define XB_SPIN_CAP (1u << 18)
__device__ __forceinline__ unsigned xb_ld(unsigned* p)              { return __hip_atomic_load(p, __ATOMIC_RELAXED, __HIP_MEMORY_SCOPE_AGENT); }
__device__ __forceinline__ unsigned xb_add(unsigned* p, unsigned v) { return __hip_atomic_fetch_add(p, v, __ATOMIC_RELAXED, __HIP_MEMORY_SCOPE_AGENT); }
__device__ __forceinline__ unsigned xb_xcc_id() { return (unsigned)__builtin_amdgcn_s_getreg((3 << 11) | 20) & 0xFu; }
#define XB_SPIN(cond, bar) do { unsigned _sp = 0; while (cond) { __builtin_amdgcn_s_sleep(1); \
    if ((++_sp & 255u) == 0u) { if (xb_ld(&(bar)[XB_TMO])) break; if (_sp > XB_SPIN_CAP) { atomicAdd(&(bar)[XB_TMO], 1u); break; } } } } while (0)
struct XcdBarrier { unsigned* bar; unsigned x; volatile LAS unsigned* st; };
__device__ __forceinline__ XcdBarrier xcd_barrier_post(unsigned* bar, volatile LAS unsigned* st) {
    XcdBarrier b; b.bar = bar; b.x = xb_xcc_id(); b.st = st;
    if (threadIdx.x == 0) (void)xb_add(&bar[XB_XCNT(b.x)], 1u);
    return b;
}
__device__ __forceinline__ void xcd_barrier_complete(unsigned* bar, unsigned x, unsigned& nloc, unsigned& nx) {
    const unsigned G = gridDim.x * gridDim.y * gridDim.z;
    unsigned sum, cnt, mine, sp = 0u;
    for (;;) {
        sum = 0u; cnt = 0u; mine = 0u;
#pragma unroll
        for (unsigned j = 0; j < 16; ++j) { const unsigned c = xb_ld(&bar[XB_XCNT(j)]); sum += c; cnt += (c > 0u) ? 1u : 0u; mine = (j == x) ? c : mine; }
        if (sum == G) break;
        __builtin_amdgcn_s_sleep(1);
        if ((++sp & 255u) == 0u) { if (xb_ld(&bar[XB_TMO])) break; if (sp > XB_SPIN_CAP) { atomicAdd(&bar[XB_TMO], 1u); break; } }
    }
    nloc = mine > 0u ? mine : 1u; nx = cnt > 0u ? cnt : 1u;
}
__device__ __forceinline__ void xcd_barrier(const XcdBarrier& b, const bool leader) {
    asm volatile("s_waitcnt vmcnt(0)" ::: "memory");
    __syncthreads();
    if (leader) {
        unsigned* bar = b.bar;
        __builtin_amdgcn_s_waitcnt(0);
        unsigned nloc = b.st[0], nx = b.st[1];
        if (nloc == 0u) { xcd_barrier_complete(bar, b.x, nloc, nx); b.st[0] = nloc; b.st[1] = nx; }
        const unsigned old = xb_add(&bar[XB_XSUB(b.x)], 1u);
        const unsigned gen = old / nloc;
        if (old + 1u == (gen + 1u) * nloc) {
            __builtin_amdgcn_fence(__ATOMIC_RELEASE, "agent");
            asm volatile("s_waitcnt vmcnt(0)" ::: "memory");
            const unsigned og = xb_add(&bar[XB_TOP], 1u);
            const unsigned tg = og / nx;
            if (og + 1u == (tg + 1u) * nx) xb_add(&bar[XB_TOPGEN], 1u);
            else XB_SPIN(xb_ld(&bar[XB_TOPGEN]) == tg, bar);
            __builtin_amdgcn_fence(__ATOMIC_ACQUIRE, "agent");
            xb_add(&bar[XB_XGEN(b.x)], 1u);
            asm volatile("s_waitcnt vmcnt(0)" ::: "memory");
        } else {
            XB_SPIN(xb_ld(&bar[XB_XGEN(b.x)]) == gen, bar);
            __builtin_amdgcn_fence(__ATOMIC_ACQUIRE, "agent");
            asm volatile("s_waitcnt vmcnt(0)" ::: "memory");
        }
    }
    __syncthreads();
}

enum In { I_X = 0, I_C, I_ADAW, I_ADAB, I_N1G, I_WIN, I_CONVW, I_CONVB, I_RGWA, I_RGBA, I_RGWX, I_RGBX, I_RGLAM, I_GWUP, I_GBUP, I_GNG, I_WBA, I_WBB, I_WOUT, I_N2G,
          I_RW, I_RB, I_EGU, I_EDN, I_SGU, I_SDN, I_FG, N_INPUTS };
struct Args { const float* in[N_INPUTS]; float* out; unsigned char* ws; int ph_lo, ph_hi; };
struct Frame { LAS unsigned char* lds; unsigned char* ws; int tid, lane, wave, vcu, G, bx; };

__device__ __forceinline__ unsigned pk4_fp8(float a, float b, float c, float d) { int w = __builtin_amdgcn_cvt_pk_fp8_f32(a, b, 0, false); return (unsigned)__builtin_amdgcn_cvt_pk_fp8_f32(c, d, w, true); }
__device__ __forceinline__ float wave_sum(float v, int lane) {
#pragma unroll
    for (int o = 1; o < 64; o <<= 1) v += __builtin_bit_cast(float, __builtin_amdgcn_ds_bpermute((lane ^ o) << 2, __builtin_bit_cast(int, v)));
    return v;
}

template <class RowP>
__device__ __forceinline__ void conv_item(const float* W, int K, int N, LAS float* scr, int item, int lane, RowP rowp) {
    const int nblk = (N + 31) / 32, kb = item / nblk, nb = item % nblk, k0 = 64 * kb, n0 = 32 * nb;
    const int cl = n0 + (lane & 31); const bool okc = cl < N;
#pragma unroll 8
    for (int i = 0; i < 32; ++i) { const int kk = 2 * i + (lane >> 5); scr[kk * 33 + (lane & 31)] = okc ? W[(size_t)(k0 + kk) * N + cl] : 0.f; }
    LDS_WAIT(); asm volatile("" ::: "memory");
    const int c = lane & 7;
#pragma unroll
    for (int j = 0; j < 4; ++j) { const int n = (lane >> 3) + 8 * j; const LAS float* s = scr + (8 * c) * 33 + n;
        v4u o; o.x = pk2(s[0 * 33], s[1 * 33]); o.y = pk2(s[2 * 33], s[3 * 33]); o.z = pk2(s[4 * 33], s[5 * 33]); o.w = pk2(s[6 * 33], s[7 * 33]);
        bf16* rp = (n0 + n < N) ? rowp(n0 + n) : (bf16*)nullptr;
        if (rp) *(GAS v4u*)(rp + k0 + 8 * c) = o; }
    LDS_WAIT(); asm volatile("" ::: "memory");
}
template <class RowP>
__device__ __forceinline__ void conv_item8(const float* W, int K, int N, LAS float* scr, int item, int lane, float scale, RowP rowp) {
    const int nblk = (N + 31) / 32, kb = item / nblk, nb = item % nblk, k0 = 64 * kb, n0 = 32 * nb;
    const int cl = n0 + (lane & 31); const bool okc = cl < N;
#pragma unroll 8
    for (int i = 0; i < 32; ++i) { const int kk = 2 * i + (lane >> 5); scr[kk * 33 + (lane & 31)] = okc ? W[(size_t)(k0 + kk) * N + cl] * scale : 0.f; }
    LDS_WAIT(); asm volatile("" ::: "memory");
    const int c = lane & 7;
#pragma unroll
    for (int j = 0; j < 4; ++j) { const int n = (lane >> 3) + 8 * j; const LAS float* s = scr + (8 * c) * 33 + n;
        v2u o; o.x = pk4_fp8(s[0 * 33], s[1 * 33], s[2 * 33], s[3 * 33]); o.y = pk4_fp8(s[4 * 33], s[5 * 33], s[6 * 33], s[7 * 33]);
        unsigned char* rp = (n0 + n < N) ? rowp(n0 + n) : (unsigned char*)nullptr;
        if (rp) *(GAS v2u*)(rp + k0 + 8 * c) = o; }
    LDS_WAIT(); asm volatile("" ::: "memory");
}
template <bool FP8, class RowP>
__device__ __forceinline__ void conv_item64(const float* W, int K, int N, LAS float* scr, int item, int lane, float scale, RowP rowp) {
    asm volatile("" : "+v"(lane));
    const int nblk = (N + 63) / 64, kb = item / nblk, nb = item - kb * nblk, k0 = 64 * kb, n0 = 64 * nb;
    const int l15 = lane & 15, g = lane >> 4, cl = n0 + 4 * l15; const bool okc = cl < N;
    const float* src = W + (size_t)(k0 + g) * N + cl;
    f32x4 v[16];
#pragma unroll
    for (int i = 0; i < 16; ++i) { v[i] = (f32x4){0.f, 0.f, 0.f, 0.f}; if (okc) v[i] = *(const GAS f32x4*)(src + (size_t)(4 * i) * N); }
    __builtin_amdgcn_sched_barrier(0);
#pragma unroll
    for (int i = 0; i < 16; ++i) { const int k = 4 * i + g; LAS float* d = scr + k * 64 + ((4 * l15) ^ (4 * i));
        d[0 ^ g] = v[i].x * scale; d[1 ^ g] = v[i].y * scale; d[2 ^ g] = v[i].z * scale; d[3 ^ g] = v[i].w * scale; }
    LDS_WAIT(); asm volatile("" ::: "memory");
    asm volatile("" : "+v"(lane));
    if (!FP8) { const int c = lane & 7;
#pragma unroll
        for (int j = 0; j < 8; ++j) { const int n = (lane >> 3) + 8 * j, bn = n ^ (8 * c); const LAS float* s = scr + (8 * c) * 64;
            v4u o; o.x = pk2(s[0 * 64 + (bn ^ 0)], s[1 * 64 + (bn ^ 1)]); o.y = pk2(s[2 * 64 + (bn ^ 2)], s[3 * 64 + (bn ^ 3)]);
            o.z = pk2(s[4 * 64 + (bn ^ 4)], s[5 * 64 + (bn ^ 5)]); o.w = pk2(s[6 * 64 + (bn ^ 6)], s[7 * 64 + (bn ^ 7)]);
            auto rp = rowp((n0 + n < N) ? n0 + n : -1);
            if (rp) *(GAS v4u*)((unsigned char*)rp + (size_t)(k0 + 8 * c) * 2) = o; } }
    else { const int c = lane & 3;
#pragma unroll
        for (int j = 0; j < 4; ++j) { const int n = (lane >> 2) + 16 * j, bn = n ^ (16 * c); const LAS float* s = scr + (16 * c) * 64;
            v4u o; o.x = pk4_fp8(s[0 * 64 + (bn ^ 0)], s[1 * 64 + (bn ^ 1)], s[2 * 64 + (bn ^ 2)], s[3 * 64 + (bn ^ 3)]);
            o.y = pk4_fp8(s[4 * 64 + (bn ^ 4)], s[5 * 64 + (bn ^ 5)], s[6 * 64 + (bn ^ 6)], s[7 * 64 + (bn ^ 7)]);
            o.z = pk4_fp8(s[8 * 64 + (bn ^ 8)], s[9 * 64 + (bn ^ 9)], s[10 * 64 + (bn ^ 10)], s[11 * 64 + (bn ^ 11)]);
            o.w = pk4_fp8(s[12 * 64 + (bn ^ 12)], s[13 * 64 + (bn ^ 13)], s[14 * 64 + (bn ^ 14)], s[15 * 64 + (bn ^ 15)]);
            auto rp = rowp((n0 + n < N) ? n0 + n : -1);
            if (rp) *(GAS v4u*)((unsigned char*)rp + (size_t)(k0 + 16 * c)) = o; } }
    LDS_WAIT(); asm volatile("" ::: "memory");
}
__device__ __forceinline__ int ydrow(int c) { const int cc = c & 255; return (c & ~255) + 128 * ((cc >> 3) & 1) + 32 * (cc >> 6) + 8 * ((cc >> 4) & 3) + (cc & 7); }
__device__ __forceinline__ bf16* winrow(int c, bf16* win, bf16* wlr) {
    if (c >= 5120 && c < 5136) return wlr + (size_t)(c - 5120) * D;
    int d = (c < 5120) ? c : c - 16;
    if (d >= 2048 && d < 2560) { const int p = d & 15, g = (p >> 2) & 3; const int pp = (g == 1) ? p + 4 : (g == 2) ? p - 4 : p; d = (d & ~15) | pp; }
    else if (d < 2048 || d >= 4096) d = ydrow(d);
    return win + (size_t)d * D;
}
__device__ __forceinline__ int glurow(int c) { return 256 * ((c & 255) >> 7) + 128 * (c >> 8) + (c & 127); }

__device__ __forceinline__ void p0_prologue(const Frame& F, const Args& a) {
    unsigned char* ws = F.ws;
    __syncthreads();
    if (F.vcu < 96) {
        LAS float* cact = (LAS float*)F.lds;
        LAS float* part = (LAS float*)(F.lds + 65536);
        for (int i = F.tid; i < 16 * 1024; i += NTHR) { const int b = i >> 10, k = i & 1023; const float x = a.in[I_C][i]; cact[k * 16 + b] = fsilu(x); }
        __syncthreads();
        const int l = F.wave >> 2, kq = F.wave & 3, n = F.vcu * 64 + F.lane;
        float acc[16];
#pragma unroll
        for (int b = 0; b < 16; ++b) acc[b] = 0.f;
        const float* w = a.in[I_ADAW] + (size_t)l * 1024 * 6144 + n;
#pragma unroll 8
        for (int k = kq * 256; k < kq * 256 + 256; ++k) { const float wv = w[(size_t)k * 6144];
#pragma unroll
            for (int q = 0; q < 4; ++q) { const f32x4 cv = *(const LAS f32x4*)(cact + k * 16 + 4 * q); acc[4 * q] += wv * cv.x; acc[4 * q + 1] += wv * cv.y; acc[4 * q + 2] += wv * cv.z; acc[4 * q + 3] += wv * cv.w; } }
#pragma unroll
        for (int b = 0; b < 16; ++b) part[(F.wave * 16 + b) * 64 + F.lane] = acc[b];
        __syncthreads();
        for (int i = F.tid; i < 2 * 16 * 64; i += NTHR) { const int ll = i >> 10, b = (i >> 6) & 15, nn = i & 63; float s = a.in[I_ADAB][ll * 6144 + F.vcu * 64 + nn];
#pragma unroll
            for (int q = 0; q < 4; ++q) s += part[((ll * 4 + q) * 16 + b) * 64 + nn];
            ((float*)(ws + WS_MOD))[((size_t)ll * 16 + b) * 6144 + F.vcu * 64 + nn] = s; }
        __syncthreads();
    }
    LAS float* scr = (LAS float*)(F.lds + F.wave * 16384);
    const int gw = F.vcu * NWAVES + F.wave, NGW = F.G * NWAVES;
    constexpr int NB_IN = (N_IN + 63) / 64;
    constexpr int I_IN = 16 * NB_IN, I_SQ = 16 * 16, I_R = 16 * 2, I_SG = 16 * 8, I_SD = 4 * 16, I_RGI = 2 * 8 * 4, I_EG = 16 * 8, I_ED = 4 * 16;
    constexpr int PER_L = I_IN + 3 * I_SQ + I_R + I_SG + I_SD + I_RGI + NE * I_EG + NE * I_ED;
    int f8from = MK_FP8_EXP1_FROM; asm volatile("" : "+s"(f8from));
    for (int it = gw; it < DEPTH * PER_L; it += NGW) {
        const int l = it / PER_L; int r = it - l * PER_L;
        if (r < I_IN) { bf16* win = nullptr; bf16* wlr = (bf16*)(ws + WS_WLR) + (size_t)l * 16 * D;
            if (r % NB_IN == 5120 / 64)
                conv_item64<false>(a.in[I_WIN] + (size_t)l * D * N_IN, D, N_IN, scr, r, F.lane, 1.0f, [=](int c) { return (c >= 5120 && c < 5136) ? winrow(c, win, wlr) : (bf16*)nullptr; });
            unsigned char* win8 = ws + WS_WIN8 + (size_t)l * NSEC * D;
            conv_item64<true>(a.in[I_WIN] + (size_t)l * D * N_IN, D, N_IN, scr, r, F.lane, 64.0f, [=](int c) { return (c < 0 || (c >= 5120 && c < 5136)) ? (unsigned char*)nullptr : win8 + (size_t)(winrow(c, (bf16*)nullptr, (bf16*)nullptr) - (bf16*)nullptr); }); continue; } r -= I_IN;
        if (r < 3 * I_SQ) { const int w = r / I_SQ; r -= w * I_SQ; const float* src = a.in[w == 0 ? I_WBA : (w == 1 ? I_WBB : I_WOUT)] + (size_t)l * D * D;
            bf16* dst = (bf16*)(ws + (w == 0 ? WS_WA : (w == 1 ? WS_WB : WS_WO))) + (size_t)l * D * D;
            conv_item64<false>(src, D, D, scr, r, F.lane, 1.0f, [=](int c) { return c < 0 ? (bf16*)nullptr : dst + (size_t)c * D; }); continue; } r -= 3 * I_SQ;
        if (r < I_R) { bf16* dst = (bf16*)(ws + WS_ROUT) + (size_t)l * 256 * D;
            conv_item64<false>(a.in[I_RW] + (size_t)l * D * NE, D, NE, scr, r, F.lane, 1.0f, [=](int c) { return c < 0 ? (bf16*)nullptr : dst + (size_t)c * D; }); continue; } r -= I_R;
        if (r < I_SG) { bf16* dst = (bf16*)(ws + WS_SGU) + (size_t)l * 512 * D; unsigned char* dst8 = ws + WS_SGU + (size_t)l * 512 * D * 2;
            if (l >= f8from) conv_item64<true>(a.in[I_SGU] + (size_t)l * D * 512, D, 512, scr, r, F.lane, 64.0f, [=](int c) { return c < 0 ? (unsigned char*)nullptr : dst8 + (size_t)glurow(c) * D; });
            else conv_item64<false>(a.in[I_SGU] + (size_t)l * D * 512, D, 512, scr, r, F.lane, 1.0f, [=](int c) { return c < 0 ? (bf16*)nullptr : dst + (size_t)glurow(c) * D; }); continue; } r -= I_SG;
        if (r < I_SD) { bf16* dst = (bf16*)(ws + WS_SDN) + (size_t)l * D * DE;
            conv_item64<false>(a.in[I_SDN] + (size_t)l * DE * D, DE, D, scr, r, F.lane, 16.0f, [=](int c) { return c < 0 ? (bf16*)nullptr : dst + (size_t)ydrow(c) * DE; }); continue; } r -= I_SD;
        if (r < I_RGI) { const int which = r / 32; r -= which * 32; const int hb = r / 4; r -= hb * 4;
            bf16* dst = (bf16*)(ws + WS_RGW) + ((size_t)(l * 8 + hb) * 256 + which * 128) * 128;
            conv_item64<false>(a.in[which ? I_RGWX : I_RGWA] + ((size_t)l * 8 + hb) * 128 * 128, 128, 128, scr, r, F.lane, 1.0f, [=](int c) { return c < 0 ? (bf16*)nullptr : dst + (size_t)c * 128; }); continue; } r -= I_RGI;
        if (r < NE * I_EG) { const int e = r / I_EG; r -= e * I_EG; bf16* dst = (bf16*)(ws + WS_EGU) + ((size_t)l * NE + e) * 512 * D; unsigned char* dst8 = ws + WS_EGU + (size_t)l * NE * 512 * D * 2 + (size_t)e * 512 * D;
            if (l >= f8from) conv_item64<true>(a.in[I_EGU] + ((size_t)l * NE + e) * D * 512, D, 512, scr, r, F.lane, 64.0f, [=](int c) { return c < 0 ? (unsigned char*)nullptr : dst8 + (size_t)glurow(c) * D; });
            else conv_item64<false>(a.in[I_EGU] + ((size_t)l * NE + e) * D * 512, D, 512, scr, r, F.lane, 1.0f, [=](int c) { return c < 0 ? (bf16*)nullptr : dst + (size_t)glurow(c) * D; }); continue; } r -= NE * I_EG;
        { const int e = r / I_ED; r -= e * I_ED; bf16* dst = (bf16*)(ws + WS_EDN) + ((size_t)l * NE + e) * D * DE;
            conv_item64<false>(a.in[I_EDN] + ((size_t)l * NE + e) * DE * D, DE, D, scr, r, F.lane, 16.0f, [=](int c) { return c < 0 ? (bf16*)nullptr : dst + (size_t)ydrow(c) * DE; }); }
    }
    { const int gt = F.vcu * NTHR + F.tid, NT = F.G * NTHR;
      for (int i = gt; i < 2 * 128 * D / 8; i += NT) { const int l = i / (128 * D / 8), r = i - l * (128 * D / 8);
          *(GAS v4u*)((bf16*)(ws + WS_ROUT) + ((size_t)l * 256 + 128) * D + (size_t)r * 8) = (v4u){0u, 0u, 0u, 0u}; }
      if (gt < D / 8) *(GAS v4u*)((bf16*)(ws + WS_U) + (size_t)T * D + gt * 8) = (v4u){0u, 0u, 0u, 0u}; }
}

template <bool FINAL, bool IN_BF16>
__device__ __forceinline__ void norm_phase(const Frame& F, const void* hv_, const float* gain, const float* sc, const float* sh, bf16* U, float* outf, unsigned char* U8 = nullptr) {
    constexpr int RB = IN_BF16 ? 8 : 4;
    const int gw = F.vcu * NWAVES + F.wave, NGW = F.G * NWAVES;
    const int c0 = 16 * F.lane;
    for (int blk = gw; blk < T / 32; blk += NGW) {
        const int b = (blk * 32) / SEQ;
        f32x4 scl[4], sft[4];
#pragma unroll
        for (int j = 0; j < 4; ++j) { const int c = c0 + 4 * j; const f32x4 g = *(const f32x4*)(gain + c);
            if (FINAL) { scl[j] = g; sft[j] = (f32x4){0.f, 0.f, 0.f, 0.f}; }
            else { const f32x4 s1 = *(const f32x4*)(sc + (size_t)b * 6144 + c); sft[j] = *(const f32x4*)(sh + (size_t)b * 6144 + c); scl[j] = g * (s1 + 1.0f); } }
#pragma unroll 1
        for (int r8 = 0; r8 < 32; r8 += RB) {
            const size_t row0 = (size_t)blk * 32 + r8;
            v4u w[RB][IN_BF16 ? 2 : 4];
            if (IN_BF16) { const unsigned char* hb = (const unsigned char*)hv_ + row0 * (D * 2); const unsigned vo = 32u * F.lane;
#pragma unroll
                for (int rr = 0; rr < RB; ++rr) { w[rr][0] = *(const GAS v4u*)(hb + rr * (D * 2) + vo); w[rr][1] = *(const GAS v4u*)(hb + rr * (D * 2) + vo + 16); } }
            else { const unsigned char* hb = (const unsigned char*)hv_ + row0 * (D * 4); const unsigned vo = 64u * F.lane;
#pragma unroll
                for (int rr = 0; rr < RB; ++rr)
#pragma unroll
                    for (int j = 0; j < (IN_BF16 ? 2 : 4); ++j) w[rr][j] = *(const GAS v4u*)(hb + rr * (D * 4) + vo + 16 * j); }
            __builtin_amdgcn_sched_barrier(0);
#pragma unroll
            for (int rr = 0; rr < RB; ++rr) { const size_t row = row0 + rr; f32x4 v[4];
                if (IN_BF16) {
#pragma unroll
                    for (int j = 0; j < 2; ++j) { const v4u x = w[rr][j]; v[2 * j] = (f32x4){bflo(x.x), bfhi(x.x), bflo(x.y), bfhi(x.y)}; v[2 * j + 1] = (f32x4){bflo(x.z), bfhi(x.z), bflo(x.w), bfhi(x.w)}; } }
                else {
#pragma unroll
                    for (int j = 0; j < (IN_BF16 ? 2 : 4); ++j) v[j] = __builtin_bit_cast(f32x4, w[rr][j]); }
                float s = 0.f;
#pragma unroll
                for (int j = 0; j < 4; ++j) s += (v[j].x * v[j].x + v[j].y * v[j].y) + (v[j].z * v[j].z + v[j].w * v[j].w);
                const float rs = 1.0f / sqrtf(wave_sum(s, F.lane) * (1.0f / D) + EPS);
                if (FINAL) { GAS f32x4* o = (GAS f32x4*)(outf + row * D + c0);
#pragma unroll
                    for (int j = 0; j < 4; ++j) o[j] = v[j] * rs * scl[j];
                } else { f32x4 y[4];
#pragma unroll
                    for (int j = 0; j < 4; ++j) y[j] = v[j] * rs * scl[j] + sft[j];
                    if (U) { GAS v4u* o = (GAS v4u*)(U + row * D + c0);
                    o[0] = (v4u){pk2(y[0].x, y[0].y), pk2(y[0].z, y[0].w), pk2(y[1].x, y[1].y), pk2(y[1].z, y[1].w)};
                    o[1] = (v4u){pk2(y[2].x, y[2].y), pk2(y[2].z, y[2].w), pk2(y[3].x, y[3].y), pk2(y[3].z, y[3].w)}; }
                    if (U8) *(GAS v4u*)(U8 + row * D + c0) = (v4u){pk4_fp8(y[0].x, y[0].y, y[0].z, y[0].w), pk4_fp8(y[1].x, y[1].y, y[1].z, y[1].w), pk4_fp8(y[2].x, y[2].y, y[2].z, y[2].w), pk4_fp8(y[3].x, y[3].y, y[3].z, y[3].w)}; }
                __builtin_amdgcn_sched_barrier(0); }
        }
    }
}

#define EPI_ROWS_BEGIN _Pragma("unroll") for (int ai = 0; ai < 2; ++ai) _Pragma("unroll") for (int m = 0; m < 4; ++m) { const int rt = ai * 128 + wr * 64 + m * 16 + fr;
#define EPI_ROWS_END }
typedef const pg8::f32x4 (&AccRef)[2][2][4][2];
__device__ __forceinline__ v4u pack8(const f32x4& a, const f32x4& b) { v4u w; w.x = pg8::cvt_pk_bf16(a[0], a[1]); w.y = pg8::cvt_pk_bf16(a[2], a[3]); w.z = pg8::cvt_pk_bf16(b[0], b[1]); w.w = pg8::cvt_pk_bf16(b[2], b[3]); return w; }
template <int ACT> __device__ __forceinline__ f32x4 act4(f32x4 v) {
    if (ACT == 1) { v[0] = fgelu_tanh(v[0]); v[1] = fgelu_tanh(v[1]); v[2] = fgelu_tanh(v[2]); v[3] = fgelu_tanh(v[3]); }
    if (ACT == 2) v = v * 0.08838834764831845f;
    if (ACT == 3) { v[0] = fsilu(v[0]); v[1] = fsilu(v[1]); v[2] = fsilu(v[2]); v[3] = fsilu(v[3]); }
    if (ACT == 4) { v[0] = fsigmoid(v[0]); v[1] = fsigmoid(v[1]); v[2] = fsigmoid(v[2]); v[3] = fsigmoid(v[3]); }
    return v;
}
template <int ACT> __device__ __forceinline__ void store_tile_bf16(AccRef acc, bf16* dst, int ld, size_t row0, int col0, int wr, int wc, int fr, int fq) {
    EPI_ROWS_BEGIN
        bf16* rp = dst + (row0 + rt) * ld + col0 + wc * 32 + 8 * fq;
#pragma unroll
        for (int bj = 0; bj < 2; ++bj) *(GAS v4u*)(rp + bj * 128) = pack8(act4<ACT>(acc[ai][bj][m][0]), act4<ACT>(acc[ai][bj][m][1]));
    EPI_ROWS_END
}
template <int ACT> __device__ __forceinline__ void store_tile_fp8(AccRef acc, unsigned char* dst, size_t row0, int col0, int wr, int wc, int fr, int fq) {
    EPI_ROWS_BEGIN
        const f32x4 a0 = act4<ACT>(acc[ai][0][m][0]) * 16.0f, a1 = act4<ACT>(acc[ai][0][m][1]) * 16.0f, b0 = act4<ACT>(acc[ai][1][m][0]) * 16.0f, b1 = act4<ACT>(acc[ai][1][m][1]) * 16.0f;
        v4u w; w.x = pk4_fp8(a0[0], a0[1], a0[2], a0[3]); w.y = pk4_fp8(a1[0], a1[1], a1[2], a1[3]); w.z = pk4_fp8(b0[0], b0[1], b0[2], b0[3]); w.w = pk4_fp8(b1[0], b1[1], b1[2], b1[3]);
        *(GAS v4u*)(dst + (row0 + rt) * 1024 + col0 + wc * 64 + fq * 16) = w;
    EPI_ROWS_END
}
__device__ __forceinline__ f32x4 fp8x4(unsigned w) { typedef float f2_t __attribute__((ext_vector_type(2))); const f2_t lo = __builtin_amdgcn_cvt_pk_f32_fp8((int)w, false), hi = __builtin_amdgcn_cvt_pk_f32_fp8((int)w, true); return (f32x4){lo.x, lo.y, hi.x, hi.y}; }
struct EpiInProj {
    unsigned char* ws;
    __device__ __forceinline__ void operator()(AccRef acc, const pg8::Unit& u, int wr, int wc, int fr, int fq) const {
        asm volatile("" : "+v"(fr), "+v"(fq));
        const int pn = u.pn; const size_t row0 = (size_t)u.pm * 256;
        if (pn < 4)       store_tile_fp8<0>(acc, ws + WS_XRPRE, row0, pn * 256, wr, wc, fr, fq);
        else if (pn < 8)  store_tile_fp8<1>(acc, ws + WS_RG, row0, (pn - 4) * 256, wr, wc, fr, fq);
        else if (pn < 10) store_tile_bf16<2>(acc, (bf16*)(ws + WS_Q), 512, row0, (pn - 8) * 256, wr, wc, fr, fq);
        else if (pn < 12) store_tile_bf16<0>(acc, (bf16*)(ws + WS_K), 512, row0, (pn - 10) * 256, wr, wc, fr, fq);
        else if (pn < 16) store_tile_bf16<0>(acc, (bf16*)(ws + WS_V), 1024, row0, (pn - 12) * 256, wr, wc, fr, fq);
        else if (pn < 20) store_tile_fp8<3>(acc, ws + WS_OG, row0, (pn - 16) * 256, wr, wc, fr, fq);
        else if (pn < 24) store_tile_fp8<4>(acc, ws + WS_GA, row0, (pn - 20) * 256, wr, wc, fr, fq);
        else              store_tile_fp8<4>(acc, ws + WS_GB, row0, (pn - 24) * 256, wr, wc, fr, fq);
    }
};
template <bool FIRST> struct EpiMerge {
    const unsigned char* gate; bf16* mbuf;
    __device__ __forceinline__ void operator()(AccRef acc, const pg8::Unit& u, int wr, int wc, int fr, int fq) const {
        asm volatile("" : "+v"(fr), "+v"(fq));
        EPI_ROWS_BEGIN
            const size_t o = ((size_t)u.pm * 256 + rt) * 1024 + u.pn * 256 + wc * 32 + 8 * fq;
#pragma unroll
            for (int bj = 0; bj < 2; ++bj) { const v2u gw = *(const GAS v2u*)(gate + o + bj * 128);
                const f32x4 g0 = fp8x4(gw.x) * 0.0625f, g1 = fp8x4(gw.y) * 0.0625f;
                f32x4 r0 = g0 * acc[ai][bj][m][0], r1 = g1 * acc[ai][bj][m][1];
                if (!FIRST) { const v4u mw = *(const GAS v4u*)(mbuf + o + bj * 128);
                    r0 += (f32x4){bflo(mw.x), bfhi(mw.x), bflo(mw.y), bfhi(mw.y)}; r1 += (f32x4){bflo(mw.z), bfhi(mw.z), bflo(mw.w), bfhi(mw.w)}; }
                *(GAS v4u*)(mbuf + o + bj * 128) = pack8(r0, r1); }
        EPI_ROWS_END
    }
};
template <bool HIN_F32> struct EpiRes {
    const void* hin; bf16* hout; const float* gate;
    __device__ __forceinline__ void operator()(AccRef acc, const pg8::Unit& u, int wr, int wc, int fr, int fq) const {
        asm volatile("" : "+v"(fr), "+v"(fq));
        const int b = (u.pm * 256) / SEQ; const int cb = u.pn * 256 + wc * 32 + 8 * fq;
        f32x4 gv[2][2];
#pragma unroll
        for (int bj = 0; bj < 2; ++bj)
#pragma unroll
            for (int n = 0; n < 2; ++n) gv[bj][n] = *(const GAS f32x4*)(gate + (size_t)b * 6144 + cb + bj * 128 + 4 * n);
        EPI_ROWS_BEGIN
            const size_t o = ((size_t)u.pm * 256 + rt) * 1024 + cb;
#pragma unroll
            for (int bj = 0; bj < 2; ++bj) { f32x4 h0, h1;
                if (HIN_F32) { h0 = *(const GAS f32x4*)((const float*)hin + o + bj * 128); h1 = *(const GAS f32x4*)((const float*)hin + o + bj * 128 + 4); }
                else { const v4u w = *(const GAS v4u*)((const bf16*)hin + o + bj * 128); h0 = (f32x4){bflo(w.x), bfhi(w.x), bflo(w.y), bfhi(w.y)}; h1 = (f32x4){bflo(w.z), bfhi(w.z), bflo(w.w), bfhi(w.w)}; }
                *(GAS v4u*)(hout + o + bj * 128) = pack8(h0 + gv[bj][0] * acc[ai][bj][m][0], h1 + gv[bj][1] * acc[ai][bj][m][1]); }
        EPI_ROWS_END
    }
};
struct EpiLogit {
    float* lg;
    __device__ __forceinline__ void operator()(AccRef acc, const pg8::Unit& u, int wr, int wc, int fr, int fq) const {
        asm volatile("" : "+v"(fr), "+v"(fq));
        EPI_ROWS_BEGIN
            float* rp = lg + ((size_t)u.pm * 256 + rt) * 128 + wc * 32 + 8 * fq;
            *(GAS f32x4*)(rp) = acc[ai][0][m][0]; *(GAS f32x4*)(rp + 4) = acc[ai][0][m][1];
        EPI_ROWS_END
    }
};
struct EpiGlu {
    bf16* act;
    __device__ __forceinline__ void operator()(AccRef acc, const pg8::Unit& u, int wr, int wc, int fr, int fq) const {
        asm volatile("" : "+v"(fr), "+v"(fq));
        const int j = u.pn & 1;
        EPI_ROWS_BEGIN
            f32x4 r0 = act4<3>(acc[ai][0][m][0]) * acc[ai][1][m][0], r1 = act4<3>(acc[ai][0][m][1]) * acc[ai][1][m][1];
            *(GAS v4u*)(act + ((size_t)u.pm * 256 + rt) * 256 + j * 128 + wc * 32 + 8 * fq) = pack8(r0, r1);
        EPI_ROWS_END
    }
};
struct EpiPlain {
    bf16* o;
    __device__ __forceinline__ void operator()(AccRef acc, const pg8::Unit& u, int wr, int wc, int fr, int fq) const {
        asm volatile("" : "+v"(fr), "+v"(fq));
        store_tile_bf16<0>(acc, o, 1024, (size_t)u.pm * 256, u.pn * 256, wr, wc, fr, fq);
    }
};
struct EpiY {
    unsigned char* y;
    __device__ __forceinline__ void operator()(AccRef acc, const pg8::Unit& u, int wr, int wc, int fr, int fq) const {
        asm volatile("" : "+v"(fr), "+v"(fq));
        EPI_ROWS_BEGIN
            const f32x4 a0 = acc[ai][0][m][0], a1 = acc[ai][0][m][1], b0 = acc[ai][1][m][0], b1 = acc[ai][1][m][1];
            v4u w; w.x = pk4_fp8(a0[0], a0[1], a0[2], a0[3]); w.y = pk4_fp8(a1[0], a1[1], a1[2], a1[3]); w.z = pk4_fp8(b0[0], b0[1], b0[2], b0[3]); w.w = pk4_fp8(b1[0], b1[1], b1[2], b1[3]);
            __builtin_nontemporal_store(w, (GAS v4u*)(y + ((size_t)u.pm * 256 + rt) * 1024 + (u.pn & 3) * 256 + wc * 64 + fq * 16));
        EPI_ROWS_END
    }
};

__device__ __forceinline__ int swz16(int row, int ch) { return row * 256 + ((ch ^ (row & 15)) << 4); }
__device__ __forceinline__ void rg_gate_phase(const Frame& F, const Args& a, int l, const int hb, const int t0, const int nt) {
    unsigned char* ws = F.ws;
    __syncthreads();
    LAS unsigned char* Ws = F.lds; LAS unsigned char* Xs = F.lds + 65536; LAS float* prm = (LAS float*)(F.lds + 98304);
    const unsigned char* xpre = ws + WS_XRPRE; bf16* loga = (bf16*)(ws + WS_LOGA); bf16* ixo = (bf16*)(ws + WS_IX);
    { const bf16* wsrc = (const bf16*)(ws + WS_RGW) + (size_t)(l * 8 + hb) * 256 * 128;
#pragma unroll
      for (int j = 0; j < 8; ++j) { const int ck = F.tid + NTHR * j, n = ck >> 4, ch = ck & 15; *(LAS v4u*)(Ws + swz16(n, ch)) = *(const GAS v4u*)(wsrc + (size_t)ck * 8); }
      if (F.tid < 128) { const int c = l * D + hb * 128 + F.tid; prm[F.tid] = a.in[I_RGBA][c]; prm[128 + F.tid] = a.in[I_RGBX][c];
          const float lam = a.in[I_RGLAM][c]; prm[256 + F.tid] = fmaxf(-lam, 0.f) + log1pf(__expf(-fabsf(lam))); } }
    const int c8 = F.tid & 15, rg4 = F.tid >> 4, chan0 = hb * 128 + 8 * c8;
    float cw[4][8], cb[8];
#pragma unroll
    for (int j = 0; j < 8; ++j) { cb[j] = a.in[I_CONVB][l * D + chan0 + j];
#pragma unroll
        for (int q = 0; q < 4; ++q) cw[q][j] = a.in[I_CONVW][((size_t)l * 4 + q) * D + chan0 + j]; }
    const int fr = F.lane & 15, fq = F.lane >> 4;
    v2u wq[7];
#define RG_LOAD_ROWS(ii) do { const size_t r0g_ = (size_t)(t0 + (ii)) * 128 + 4 * rg4; const int tp_ = (int)(r0g_ & (SEQ - 1)); \
        _Pragma("unroll") for (int q = 0; q < 7; ++q) { wq[q] = (v2u){0u, 0u}; if (tp_ + q - 3 >= 0) wq[q] = *(const GAS v2u*)(xpre + (size_t)((long)r0g_ + q - 3) * D + chan0); } } while (0)
    RG_LOAD_ROWS(0);
    for (int i = 0; i < nt; ++i) {
        const int rt = t0 + i; const size_t row0 = (size_t)rt * 128;
        __syncthreads();
        {
            const int r0 = 4 * rg4;
            float x[7][8];
#pragma unroll
            for (int q = 0; q < 7; ++q) { const f32x4 lo = fp8x4(wq[q].x) * 0.0625f, hi = fp8x4(wq[q].y) * 0.0625f;
                x[q][0] = lo.x; x[q][1] = lo.y; x[q][2] = lo.z; x[q][3] = lo.w; x[q][4] = hi.x; x[q][5] = hi.y; x[q][6] = hi.z; x[q][7] = hi.w; }
#pragma unroll
            for (int rr = 0; rr < 4; ++rr) { float y[8];
#pragma unroll
                for (int j = 0; j < 8; ++j) y[j] = cb[j] + cw[0][j] * x[rr][j] + cw[1][j] * x[rr + 1][j] + cw[2][j] * x[rr + 2][j] + cw[3][j] * x[rr + 3][j];
                v4u o; o.x = pk2(y[0], y[1]); o.y = pk2(y[2], y[3]); o.z = pk2(y[4], y[5]); o.w = pk2(y[6], y[7]);
                *(LAS v4u*)(Xs + swz16(r0 + rr, c8)) = o; }
        }
        if (i + 1 < nt) RG_LOAD_ROWS(i + 1);
        __syncthreads();
        f32x4 acc[16];
#pragma unroll
        for (int nb = 0; nb < 16; ++nb) acc[nb] = (f32x4){0.f, 0.f, 0.f, 0.f};
        const int arow = 16 * F.wave + fr;
#pragma unroll
        for (int ks = 0; ks < 4; ++ks) { const bf16x8 af = *(const LAS bf16x8*)(Xs + swz16(arow, 4 * ks + fq));
#pragma unroll
            for (int nb = 0; nb < 16; ++nb) { const bf16x8 bfv = *(const LAS bf16x8*)(Ws + swz16(16 * nb + fr, 4 * ks + fq));
                acc[nb] = __builtin_amdgcn_mfma_f32_16x16x32_bf16(bfv, af, acc[nb], 0, 0, 0); } }
        const size_t grow = row0 + arow; const bool tzero = (grow & (SEQ - 1)) == 0;
#pragma unroll
        for (int nb = 0; nb < 8; ++nb) { const int c = 16 * nb + 4 * fq;
            const f32x4 ba = *(const LAS f32x4*)(prm + c), bx = *(const LAS f32x4*)(prm + 128 + c), sp = *(const LAS f32x4*)(prm + 256 + c);
            const v2u xw = *(const LAS v2u*)(Xs + swz16(arow, c >> 3) + (c & 7) * 2);
            const float xv[4] = {bflo(xw.x), bfhi(xw.x), bflo(xw.y), bfhi(xw.y)};
            float om[4], bt[4];
#pragma unroll
            for (int j = 0; j < 4; ++j) { const float r = fsigmoid(acc[nb][j] + ba[j]), ii = fsigmoid(acc[nb + 8][j] + bx[j]); const float la = -8.0f * r * sp[j];
                const float o1 = 1.0f - __builtin_amdgcn_exp2f(1.442695041f * la), o2 = -la * (1.0f + la * (0.5f + la * 0.16666667f));
                om[j] = (la > -0.01f) ? o2 : o1; float mult = __builtin_amdgcn_sqrtf(om[j] * (2.0f - om[j])); if (tzero) mult = 1.0f; bt[j] = mult * ii * xv[j]; }
            const size_t o = grow * D + hb * 128 + c;
            *(GAS v2u*)(loga + o) = (v2u){pk2(om[0], om[1]), pk2(om[2], om[3])};
            *(GAS v2u*)(ixo + o) = (v2u){pk2(bt[0], bt[1]), pk2(bt[2], bt[3])}; }
    }
    __syncthreads();
}

typedef float f32x2 __attribute__((ext_vector_type(2)));
__device__ __forceinline__ void unpack8(const v4u w, float (&o)[8]) { o[0] = bflo(w.x); o[1] = bfhi(w.x); o[2] = bflo(w.y); o[3] = bfhi(w.y); o[4] = bflo(w.z); o[5] = bfhi(w.z); o[6] = bflo(w.w); o[7] = bfhi(w.w); }
__device__ __forceinline__ void scan_pass1(const Frame& F, int unit) {
    unsigned char* ws = F.ws;
    LAS f32x2* pe = (LAS f32x2*)F.lds;
    const int g = F.tid >> 7, c8 = F.tid & 127, ch = 8 * c8;
    const unsigned voff = (unsigned)(16 * g * D + ch) * 2u;
    const unsigned char* omb = ws + WS_LOGA + (size_t)unit * 64 * D * 2; const unsigned char* btb = ws + WS_IX + (size_t)unit * 64 * D * 2;
    v4u ow[16], bw[16];
#pragma unroll
    for (int r = 0; r < 16; ++r) { ow[r] = *(const GAS v4u*)(omb + r * (D * 2) + voff); bw[r] = *(const GAS v4u*)(btb + r * (D * 2) + voff); }
    __builtin_amdgcn_sched_barrier(0);
    float P[8], E[8];
#pragma unroll
    for (int j = 0; j < 8; ++j) { P[j] = 1.f; E[j] = 0.f; }
#pragma unroll
    for (int r = 0; r < 16; ++r) { float a[8], bt[8]; unpack8(ow[r], a); unpack8(bw[r], bt);
#pragma unroll
        for (int j = 0; j < 8; ++j) { const float av = 1.0f - a[j]; E[j] = av * E[j] + bt[j]; P[j] *= av; } }
    __syncthreads();
#pragma unroll
    for (int j = 0; j < 8; ++j) pe[g * 1024 + ch + j] = (f32x2){P[j], E[j]};
    __syncthreads();
    if (g == 0) { f32x4 Po[2], Eo[2];
#pragma unroll
        for (int j = 0; j < 8; ++j) { float p = P[j], e = E[j];
#pragma unroll
            for (int q = 1; q < 4; ++q) { const f32x2 x = pe[q * 1024 + ch + j]; e = x.x * e + x.y; p *= x.x; }
            Po[j >> 2][j & 3] = p; Eo[j >> 2][j & 3] = e; }
        GAS f32x4* spp = (GAS f32x4*)((float*)(ws + WS_SP) + (size_t)unit * D + ch); GAS f32x4* sep = (GAS f32x4*)((float*)(ws + WS_SE) + (size_t)unit * D + ch);
        spp[0] = Po[0]; spp[1] = Po[1]; sep[0] = Eo[0]; sep[1] = Eo[1]; }
}
__device__ __forceinline__ void scan_pass3(const Frame& F, int unit) {
    unsigned char* ws = F.ws;
    const size_t row0 = (size_t)unit * 64; const int ch = 2 * F.tid;
    const GAS unsigned* om = (const GAS unsigned*)((const bf16*)(ws + WS_LOGA) + row0 * D + ch); GAS unsigned* bp = (GAS unsigned*)((bf16*)(ws + WS_IX) + row0 * D + ch);
    const GAS unsigned short* rg = (const GAS unsigned short*)(ws + WS_RG + row0 * D + ch);
    float h0 = 0.f, h1 = 0.f;
    { const int seg = unit & 63; const GAS f32x2* sp = (const GAS f32x2*)((const float*)(ws + WS_SP) + (size_t)(unit - seg) * D + ch); const GAS f32x2* se = (const GAS f32x2*)((const float*)(ws + WS_SE) + (size_t)(unit - seg) * D + ch);
#pragma unroll 8
      for (int s = 0; s < seg; ++s) { const f32x2 p = sp[(size_t)s * (D / 2)], e = se[(size_t)s * (D / 2)]; h0 = p.x * h0 + e.x; h1 = p.y * h1 + e.y; } }
#pragma unroll 16
    for (int r = 0; r < 64; ++r) { const unsigned ow = om[(size_t)r * (D / 2)], bw = bp[(size_t)r * (D / 2)]; const f32x4 gt = fp8x4((unsigned)rg[(size_t)r * (D / 2)]);
        h0 = (1.0f - bflo(ow)) * h0 + bflo(bw); h1 = (1.0f - bfhi(ow)) * h1 + bfhi(bw); bp[(size_t)r * (D / 2)] = pk2(h0 * gt.x * 0.0625f, h1 * gt.y * 0.0625f); }
}
#if MK_SCAN3_NEW
__device__ __forceinline__ void scan_pass3_panel(const Frame& F, int pm) {
    unsigned char* ws = F.ws;
    LAS f32x2* pe = (LAS f32x2*)F.lds; LAS float* cin = (LAS float*)(F.lds + 32768);
    const int g = F.tid >> 7, c8 = F.tid & 127, ch = 8 * c8;
    __syncthreads();
    { const int u0 = 4 * pm, seg0 = u0 & 63, qn = (seg0 + 3) >> 2, sb = g * qn, sen = (sb + qn < seg0) ? sb + qn : seg0;
      f32x4 P0 = {1.f, 1.f, 1.f, 1.f}, P1 = P0, E0 = {0.f, 0.f, 0.f, 0.f}, E1 = E0;
      const float* spb = (const float*)(ws + WS_SP) + (size_t)(u0 - seg0) * D + ch; const float* seb = (const float*)(ws + WS_SE) + (size_t)(u0 - seg0) * D + ch;
#pragma unroll 4
      for (int s = sb; s < sen; ++s) { const f32x4 p0 = *(const GAS f32x4*)(spb + (size_t)s * D), p1 = *(const GAS f32x4*)(spb + (size_t)s * D + 4), e0 = *(const GAS f32x4*)(seb + (size_t)s * D), e1 = *(const GAS f32x4*)(seb + (size_t)s * D + 4);
          E0 = p0 * E0 + e0; P0 *= p0; E1 = p1 * E1 + e1; P1 *= p1; }
#pragma unroll
      for (int j = 0; j < 4; ++j) { pe[g * 1024 + ch + j] = (f32x2){P0[j], E0[j]}; pe[g * 1024 + ch + 4 + j] = (f32x2){P1[j], E1[j]}; }
      __syncthreads();
      if (g == 0) {
#pragma unroll
          for (int j = 0; j < 8; ++j) { float h = 0.f;
#pragma unroll
              for (int q = 0; q < 4; ++q) { const f32x2 x = pe[q * 1024 + ch + j]; h = x.x * h + x.y; }
              cin[ch + j] = h; } } }
    for (int k = 0; k < 4; ++k) {
        const int unit = 4 * pm + k;
        const unsigned voff = (unsigned)(16 * g * D + ch) * 2u, voffg = (unsigned)(16 * g * D + ch);
        const unsigned char* omb = ws + WS_LOGA + (size_t)unit * 64 * D * 2; unsigned char* btb = ws + WS_IX + (size_t)unit * 64 * D * 2;
        const unsigned char* rgb = ws + WS_RG + (size_t)unit * 64 * D;
        v4u ow[16], bw[16]; v2u gw[16];
#pragma unroll
        for (int r = 0; r < 16; ++r) { ow[r] = *(const GAS v4u*)(omb + r * (D * 2) + voff); bw[r] = *(const GAS v4u*)(btb + r * (D * 2) + voff); gw[r] = *(const GAS v2u*)(rgb + r * D + voffg); }
        __builtin_amdgcn_sched_barrier(0);
        float P[8], E[8];
#pragma unroll
        for (int j = 0; j < 8; ++j) { P[j] = 1.f; E[j] = 0.f; }
#pragma unroll
        for (int r = 0; r < 16; ++r) { float a[8], bt[8]; unpack8(ow[r], a); unpack8(bw[r], bt);
#pragma unroll
            for (int j = 0; j < 8; ++j) { const float av = 1.0f - a[j]; E[j] = av * E[j] + bt[j]; P[j] *= av; asm volatile("" : "+v"(P[j]), "+v"(E[j])); }
            __builtin_amdgcn_sched_barrier(0); }
        __syncthreads();
#pragma unroll
        for (int j = 0; j < 8; ++j) pe[g * 1024 + ch + j] = (f32x2){P[j], E[j]};
        __syncthreads();
#pragma unroll
        for (int r = 0; r < 16; ++r) asm volatile("" : "+v"(ow[r]), "+v"(bw[r]));
        float h[8];
#pragma unroll
        for (int j = 0; j < 8; ++j) { float e = cin[ch + j];
#pragma unroll
            for (int q = 0; q < 3; ++q) if (q < g) { const f32x2 x = pe[q * 1024 + ch + j]; e = x.x * e + x.y; }
            h[j] = e; }
#pragma unroll
        for (int r = 0; r < 16; ++r) { float a[8], bt[8]; unpack8(ow[r], a); unpack8(bw[r], bt); const f32x4 g0 = fp8x4(gw[r].x) * 0.0625f, g1 = fp8x4(gw[r].y) * 0.0625f;
            float o[8];
#pragma unroll
            for (int j = 0; j < 8; ++j) { h[j] = (1.0f - a[j]) * h[j] + bt[j]; o[j] = h[j] * (j < 4 ? g0[j & 3] : g1[j & 3]); }
            *(GAS v4u*)(btb + r * (D * 2) + voff) = (v4u){pk2(o[0], o[1]), pk2(o[2], o[3]), pk2(o[4], o[5]), pk2(o[6], o[7])};
            __builtin_amdgcn_sched_barrier(0); }
        __syncthreads();
        if (g == 3) {
#pragma unroll
            for (int j = 0; j < 8; ++j) cin[ch + j] = h[j]; }
    }
}
#endif

__device__ __forceinline__ float flogsig16(float x) {
    const float e = __builtin_amdgcn_exp2f(-1.442695041f * fabsf(x));
    return (fminf(x, 0.f) - 0.6931471806f * __builtin_amdgcn_logf(1.0f + e)) * 0.0625f;
}
__device__ __forceinline__ void gla_prep(const Frame& F, const Args& a, int l, int unit) {
    unsigned char* ws = F.ws;
    LAS float* lrs = (LAS float*)F.lds; LAS float* psum = (LAS float*)(F.lds + 8192); LAS unsigned char* kds = F.lds + 16384;
    const size_t row0 = (size_t)unit * 64;
    const int fr = F.lane & 15, fq = F.lane >> 4;
    __syncthreads();
    { const int rb = F.wave & 3, kh = F.wave >> 2;
      const unsigned char* up = ws + WS_U8 + (row0 + 16 * rb + fr) * D + kh * 512 + 8 * fq;
      const bf16* wp = (const bf16*)(ws + WS_WLR) + ((size_t)l * 16 + fr) * D + kh * 512 + 8 * fq;
      f32x4 acc = {0.f, 0.f, 0.f, 0.f};
      v2u aw[16];
#pragma unroll
      for (int ks = 0; ks < 16; ++ks) aw[ks] = *(const GAS v2u*)(up + 32 * ks);
#pragma unroll
      for (int ks = 0; ks < 16; ++ks) { const bf16x8 bfv = *(const GAS bf16x8*)(wp + 32 * ks);
          const f32x4 lo = fp8x4(aw[ks].x), hi = fp8x4(aw[ks].y);
          const v4u ap = (v4u){pk2(lo.x, lo.y), pk2(lo.z, lo.w), pk2(hi.x, hi.y), pk2(hi.z, hi.w)};
          acc = __builtin_amdgcn_mfma_f32_16x16x32_bf16(__builtin_bit_cast(bf16x8, ap), bfv, acc, 0, 0, 0); }
#pragma unroll
      for (int j = 0; j < 4; ++j) lrs[(kh * 64 + 16 * rb + 4 * fq + j) * 16 + fr] = acc[j]; }
    __syncthreads();
    const int cp = F.tid & 255, th = F.tid >> 8, c0 = 2 * cp;
    float wu0[16], wu1[16];
#pragma unroll
    for (int r = 0; r < 16; ++r) { const f32x2 w = *(const GAS f32x2*)(a.in[I_GWUP] + ((size_t)l * 16 + r) * 512 + c0); wu0[r] = w.x; wu1[r] = w.y; }
    const f32x2 bu = *(const GAS f32x2*)(a.in[I_GBUP] + l * 512 + c0);
    float la0[32], la1[32]; float s0 = 0.f, s1 = 0.f;
#pragma unroll
    for (int tt = 0; tt < 32; ++tt) { const int t = 32 * th + tt; float g0 = bu.x, g1 = bu.y;
#pragma unroll
        for (int q = 0; q < 4; ++q) { const f32x4 x = *(const LAS f32x4*)(lrs + t * 16 + 4 * q) + *(const LAS f32x4*)(lrs + (64 + t) * 16 + 4 * q);
            g0 += x.x * wu0[4 * q] + x.y * wu0[4 * q + 1] + x.z * wu0[4 * q + 2] + x.w * wu0[4 * q + 3];
            g1 += x.x * wu1[4 * q] + x.y * wu1[4 * q + 1] + x.z * wu1[4 * q + 2] + x.w * wu1[4 * q + 3]; }
        la0[tt] = flogsig16(g0); la1[tt] = flogsig16(g1); s0 += la0[tt]; s1 += la1[tt]; }
    *(LAS f32x2*)(psum + th * 512 + c0) = (f32x2){s0, s1};
    __syncthreads();
    const f32x2 oth = *(const LAS f32x2*)(psum + (th ^ 1) * 512 + c0);
    const float tot0 = s0 + oth.x, tot1 = s1 + oth.y;
    if (th == 0) *(GAS f32x2*)((float*)(ws + WS_TOT) + (size_t)unit * 512 + c0) = (f32x2){tot0, tot1};
    float cum0 = th ? oth.x : 0.f, cum1 = th ? oth.y : 0.f;
    const GAS unsigned* kp = (const GAS unsigned*)((const bf16*)(ws + WS_K) + (row0 + 32 * th) * 512 + c0);
#pragma unroll
    for (int t8 = 0; t8 < 4; ++t8) { float o0[8], o1[8];
#pragma unroll
        for (int tt = 0; tt < 8; ++tt) { const unsigned kw = kp[(size_t)(8 * t8 + tt) * 256]; cum0 += la0[8 * t8 + tt]; cum1 += la1[8 * t8 + tt];
            o0[tt] = bflo(kw) * __builtin_amdgcn_exp2f(1.442695041f * (tot0 - cum0)); o1[tt] = bfhi(kw) * __builtin_amdgcn_exp2f(1.442695041f * (tot1 - cum1)); }
        *(LAS v4u*)(kds + c0 * 144 + (32 * th + 8 * t8) * 2) = (v4u){pk2(o0[0], o0[1]), pk2(o0[2], o0[3]), pk2(o0[4], o0[5]), pk2(o0[6], o0[7])};
        *(LAS v4u*)(kds + (c0 + 1) * 144 + (32 * th + 8 * t8) * 2) = (v4u){pk2(o1[0], o1[1]), pk2(o1[2], o1[3]), pk2(o1[4], o1[5]), pk2(o1[6], o1[7])}; }
    __syncthreads();
    GAS unsigned char* kd = (GAS unsigned char*)((bf16*)(ws + WS_KDEC) + (size_t)unit * 512 * 64);
#pragma unroll
    for (int j = 0; j < 8; ++j) { const int ck = F.tid + NTHR * j; *(GAS v4u*)(kd + (size_t)ck * 16) = *(const LAS v4u*)(kds + (ck >> 3) * 144 + (ck & 7) * 16); }
}

constexpr int GQ_OFF = 0, GK_OFF = 64 * 272, GV_OFF = GK_OFF + 128 * 144, GD_OFF = GV_OFF + 64 * 256, GBUF = GD_OFF + 512;
__device__ __forceinline__ unsigned voff_b(unsigned row, unsigned ch) { return 256u * row + 16u * (ch ^ (((row & 3) << 2) | ((row >> 2) & 3))); }
__device__ __forceinline__ bf16x8 pack_step(const f32x16& x, int s) {
    v4u p; p.x = pk2(x[8 * s], x[8 * s + 1]); p.y = pk2(x[8 * s + 2], x[8 * s + 3]); p.z = pk2(x[8 * s + 4], x[8 * s + 5]); p.w = pk2(x[8 * s + 6], x[8 * s + 7]);
    return __builtin_bit_cast(bf16x8, p);
}
struct GlaRegs { v4u qv[4], kv[4], vv[4]; float dv; };
__device__ __forceinline__ void gla_load(const Frame& F, int b, int h, int vh, int n, GlaRegs& R) {
    unsigned char* ws = F.ws; int lt = F.tid - 256; asm volatile("" : "+v"(lt));
    const size_t row0 = (size_t)b * SEQ + (size_t)n * 64;
    const GAS char* qp = (const GAS char*)((const bf16*)(ws + WS_Q) + row0 * 512 + h * 128);
    const GAS char* vp = (const GAS char*)((const bf16*)(ws + WS_V) + row0 * D + h * 256 + vh * 128);
    const GAS char* kp = (const GAS char*)((const bf16*)(ws + WS_KDEC) + (((size_t)b * 64 + n) * 512 + h * 128) * 64);
#pragma unroll
    for (int j = 0; j < 4; ++j) { const unsigned ck = (unsigned)lt + 256u * j;
        R.qv[j] = *(const GAS v4u*)(qp + ((ck >> 4) * 1024u + (ck & 15u) * 16u));
        R.vv[j] = *(const GAS v4u*)(vp + ((ck >> 4) * 2048u + (ck & 15u) * 16u));
        R.kv[j] = *(const GAS v4u*)(kp + ck * 16u); }
    R.dv = 0.f; if (lt < 128) R.dv = ((const float*)(ws + WS_TOT))[((size_t)b * 64 + n) * 512 + h * 128 + lt];
}
__device__ __forceinline__ void gla_put(const Frame& F, const GlaRegs& R, LAS unsigned char* buf) {
    int lt = F.tid - 256; asm volatile("" : "+v"(lt));
#pragma unroll
    for (int j = 0; j < 4; ++j) { const unsigned ck = (unsigned)lt + 256u * j;
        *(LAS v4u*)(buf + GQ_OFF + (ck >> 4) * 272u + (ck & 15u) * 16u) = R.qv[j];
        *(LAS v4u*)(buf + GV_OFF + voff_b(ck >> 4, ck & 15u)) = R.vv[j];
        *(LAS v4u*)(buf + GK_OFF + (ck >> 3) * 144u + (ck & 7u) * 16u) = R.kv[j]; }
    if (lt < 128) ((LAS float*)(buf + GD_OFF))[lt] = __expf(R.dv);
}
__device__ __forceinline__ void gla_rec(const Frame& F, int unit) {
    unsigned char* ws = F.ws;
    const int b = unit >> 3, h = (unit >> 1) & 3, vh = unit & 1;
    const int w = F.wave;
#define GLA_BAR() do { asm volatile("s_waitcnt lgkmcnt(0)" ::: "memory"); __builtin_amdgcn_s_barrier(); asm volatile("" ::: "memory"); } while (0)
    __syncthreads();
    if (w >= 4) {
        GlaRegs Ra, Rb;
        gla_load(F, b, h, vh, 0, Ra); gla_put(F, Ra, F.lds); gla_load(F, b, h, vh, 1, Ra); gla_load(F, b, h, vh, 2, Rb);
        GLA_BAR();
#pragma unroll 1
        for (int n = 0; n < NCH; n += 2) {
            gla_put(F, Ra, F.lds + GBUF); if (n + 3 < NCH) gla_load(F, b, h, vh, n + 3, Ra);
            GLA_BAR();
            if (n + 2 < NCH) { gla_put(F, Rb, F.lds); if (n + 4 < NCH) gla_load(F, b, h, vh, n + 4, Rb); }
            GLA_BAR();
        }
    } else {
        f32x16 S[4];
#pragma unroll
        for (int kt = 0; kt < 4; ++kt)
#pragma unroll
            for (int i = 0; i < 16; ++i) S[kt][i] = 0.f;
        GLA_BAR();
#pragma unroll 1
        for (int n = 0; n < NCH; ++n) {
            int lane = F.lane; asm volatile("" : "+v"(lane));
            const int r = lane & 31, hh = lane >> 5;
            const unsigned blk = (lane >> 4) & 1, q4 = (lane & 15) >> 2, p4 = lane & 3;
            LAS unsigned char* buf = F.lds + (n & 1) * GBUF;
            const LAS unsigned char* kbase = buf + GK_OFF + r * 144 + hh * 16;
            const LAS unsigned char* qbase = buf + GQ_OFF + r * 272 + hh * 16;
            const LAS unsigned char* dbase = buf + GD_OFF + hh * 16;
            const unsigned chv = 4u * (unsigned)w + 2u * blk + (p4 >> 1);
            const unsigned vb0 = (unsigned)(size_t)(buf + GV_OFF) + 256u * (8u * hh + q4) + 16u * (chv ^ ((q4 << 2) | ((2u * hh) & 3u))) + 8u * (p4 & 1u);
            const unsigned vb1 = (unsigned)(size_t)(buf + GV_OFF) + 256u * (8u * hh + 4u + q4) + 16u * (chv ^ ((q4 << 2) | ((2u * hh + 1u) & 3u))) + 8u * (p4 & 1u);
            s16x4 l0, h0, l1, h1, l2, h2, l3, h3;
            asm volatile("ds_read_b64_tr_b16 %0, %8\n\tds_read_b64_tr_b16 %1, %9\n\tds_read_b64_tr_b16 %2, %8 offset:4096\n\tds_read_b64_tr_b16 %3, %9 offset:4096\n\t"
                         "ds_read_b64_tr_b16 %4, %8 offset:8192\n\tds_read_b64_tr_b16 %5, %9 offset:8192\n\tds_read_b64_tr_b16 %6, %8 offset:12288\n\tds_read_b64_tr_b16 %7, %9 offset:12288\n\ts_waitcnt lgkmcnt(0)"
                         : "=&v"(l0), "=&v"(h0), "=&v"(l1), "=&v"(h1), "=&v"(l2), "=&v"(h2), "=&v"(l3), "=&v"(h3) : "v"(vb0), "v"(vb1) : "memory");
            bf16x8 vbf[4];
            vbf[0] = __builtin_shufflevector(l0, h0, 0, 1, 2, 3, 4, 5, 6, 7); vbf[1] = __builtin_shufflevector(l1, h1, 0, 1, 2, 3, 4, 5, 6, 7);
            vbf[2] = __builtin_shufflevector(l2, h2, 0, 1, 2, 3, 4, 5, 6, 7); vbf[3] = __builtin_shufflevector(l3, h3, 0, 1, 2, 3, 4, 5, 6, 7);
#pragma unroll
            for (int kt = 0; kt < 4; ++kt)
#pragma unroll
                for (int g = 0; g < 4; ++g) { const f32x4 dq = *(const LAS f32x4*)(dbase + kt * 128 + g * 32);
                    S[kt][4 * g] *= dq.x; S[kt][4 * g + 1] *= dq.y; S[kt][4 * g + 2] *= dq.z; S[kt][4 * g + 3] *= dq.w; }
#pragma unroll
            for (int ts = 0; ts < 4; ++ts)
#pragma unroll
                for (int kt = 0; kt < 4; ++kt) { const bf16x8 ka = *(const LAS bf16x8*)(kbase + kt * 4608 + ts * 32);
                    S[kt] = __builtin_amdgcn_mfma_f32_32x32x16_bf16(ka, vbf[ts], S[kt], 0, 0, 0); }
            f32x16 O[2];
#pragma unroll
            for (int tb = 0; tb < 2; ++tb)
#pragma unroll
                for (int i = 0; i < 16; ++i) O[tb][i] = 0.f;
#pragma unroll
            for (int kt = 0; kt < 4; ++kt)
#pragma unroll
                for (int s = 0; s < 2; ++s) { const bf16x8 sb = pack_step(S[kt], s);
#pragma unroll
                    for (int tb = 0; tb < 2; ++tb) { const bf16x8 qa = *(const LAS bf16x8*)(qbase + tb * 8704 + kt * 64 + s * 32);
                        O[tb] = __builtin_amdgcn_mfma_f32_32x32x16_bf16(qa, sb, O[tb], 0, 0, 0); } }
            GAS bf16* op = (GAS bf16*)((bf16*)(ws + WS_O) + ((size_t)b * SEQ + (size_t)n * 64 + 4 * hh) * D + h * 256 + vh * 128 + 32 * w + r);
#pragma unroll
            for (int tb = 0; tb < 2; ++tb)
#pragma unroll
                for (int i = 0; i < 16; ++i) { const int t = 32 * tb + (i & 3) + 8 * (i >> 2); op[(size_t)t * D] = (bf16)f2bf(O[tb][i]); }
            GLA_BAR();
        }
    }
#undef GLA_BAR
    asm volatile("s_waitcnt vmcnt(0)" ::: "memory");
}
__device__ __forceinline__ float row16_sum(float v) {
    v += __builtin_bit_cast(float, __builtin_amdgcn_update_dpp(0, __builtin_bit_cast(int, v), 0x128, 0xf, 0xf, false));
    v += __builtin_bit_cast(float, __builtin_amdgcn_update_dpp(0, __builtin_bit_cast(int, v), 0x124, 0xf, 0xf, false));
    v += __builtin_bit_cast(float, __builtin_amdgcn_update_dpp(0, __builtin_bit_cast(int, v), 0x122, 0xf, 0xf, false));
    v += __builtin_bit_cast(float, __builtin_amdgcn_update_dpp(0, __builtin_bit_cast(int, v), 0x121, 0xf, 0xf, false));
    return v;
}
__device__ __forceinline__ void gla_norm(const Frame& F, const Args& a, int l) {
    unsigned char* ws = F.ws;
    const int gw = F.vcu * NWAVES + F.wave, NGW = F.G * NWAVES;
    f32x4 g[4];
#pragma unroll
    for (int q = 0; q < 4; ++q) g[q] = *(const GAS f32x4*)(a.in[I_GNG] + (size_t)l * 1024 + 16 * F.lane + 4 * q) * 0.0625f;
    const unsigned vo = 32u * F.lane, vg = 16u * F.lane;
    for (int blk = gw; blk < T / 32; blk += NGW)
#pragma unroll 1
        for (int r8 = 0; r8 < 32; r8 += 8) {
            unsigned char* ob = ws + WS_O + ((size_t)blk * 32 + r8) * (D * 2); const unsigned char* gb = ws + WS_OG + ((size_t)blk * 32 + r8) * D;
            v4u o0[8], o1[8], og[8];
#pragma unroll
            for (int rr = 0; rr < 8; ++rr) { o0[rr] = *(const GAS v4u*)(ob + rr * (D * 2) + vo); o1[rr] = *(const GAS v4u*)(ob + rr * (D * 2) + vo + 16); og[rr] = *(const GAS v4u*)(gb + rr * D + vg); }
            __builtin_amdgcn_sched_barrier(0);
#pragma unroll
            for (int rr = 0; rr < 8; ++rr) {
                f32x4 o[4];
                o[0] = (f32x4){bflo(o0[rr].x), bfhi(o0[rr].x), bflo(o0[rr].y), bfhi(o0[rr].y)}; o[1] = (f32x4){bflo(o0[rr].z), bfhi(o0[rr].z), bflo(o0[rr].w), bfhi(o0[rr].w)};
                o[2] = (f32x4){bflo(o1[rr].x), bfhi(o1[rr].x), bflo(o1[rr].y), bfhi(o1[rr].y)}; o[3] = (f32x4){bflo(o1[rr].z), bfhi(o1[rr].z), bflo(o1[rr].w), bfhi(o1[rr].w)};
                float s = 0.f;
#pragma unroll
                for (int q = 0; q < 4; ++q) s += (o[q].x * o[q].x + o[q].y * o[q].y) + (o[q].z * o[q].z + o[q].w * o[q].w);
                const float rs = 1.0f / sqrtf(row16_sum(s) * (1.0f / 256.0f) + EPS);
                f32x4 y[4];
                y[0] = o[0] * rs * g[0] * fp8x4(og[rr].x); y[1] = o[1] * rs * g[1] * fp8x4(og[rr].y); y[2] = o[2] * rs * g[2] * fp8x4(og[rr].z); y[3] = o[3] * rs * g[3] * fp8x4(og[rr].w);
                *(GAS v4u*)(ob + rr * (D * 2) + vo) = (v4u){pk2(y[0].x, y[0].y), pk2(y[0].z, y[0].w), pk2(y[1].x, y[1].y), pk2(y[1].z, y[1].w)};
                *(GAS v4u*)(ob + rr * (D * 2) + vo + 16) = (v4u){pk2(y[2].x, y[2].y), pk2(y[2].z, y[2].w), pk2(y[3].x, y[3].y), pk2(y[3].z, y[3].w)};
                __builtin_amdgcn_sched_barrier(0); }
        }
}

__device__ __forceinline__ void topk_phase(const Frame& F, const Args& a, int l, int cset) {
    unsigned char* ws = F.ws;
    LAS int* hist = (LAS int*)F.lds; LAS int* base = hist + 128; LAS float* bias = (LAS float*)(hist + 256);
    LAS float* xv = (LAS float*)(F.lds + 2048); LAS float* xs = xv + 2048; LAS int* xi = (LAS int*)(xs + 2048);
    __syncthreads();
    if (F.tid < 128) { hist[F.tid] = 0; bias[F.tid] = a.in[I_RB][l * NE + F.tid]; }
    __syncthreads();
    const int tok = F.tid & 255, half = F.tid >> 8, t = F.vcu * 256 + tok; const bool act = half == 0;
    float val[8], scv[8]; int idx[8], rank[8];
#pragma unroll
    for (int j = 0; j < 8; ++j) { val[j] = -1e30f; scv[j] = 0.f; idx[j] = 0; rank[j] = 0; }
#define TOPK_INSERT(v_, sc_, e_) do { _Pragma("unroll") for (int j = 7; j >= 0; --j) { if ((v_) > val[j]) { if (j < 7) { val[j + 1] = val[j]; scv[j + 1] = scv[j]; idx[j + 1] = idx[j]; } val[j] = (v_); scv[j] = (sc_); idx[j] = (e_); } } } while (0)
    { const float* lg = (const float*)(ws + WS_LOGIT) + (size_t)t * NE + 64 * half;
#pragma unroll 1
      for (int e16 = 0; e16 < 4; ++e16) { f32x4 x[4];
#pragma unroll
          for (int r = 0; r < 4; ++r) x[r] = *(const GAS f32x4*)(lg + 16 * e16 + 4 * r);
#pragma unroll
          for (int r = 0; r < 4; ++r)
#pragma unroll
              for (int q = 0; q < 4; ++q) { const int e = 64 * half + 16 * e16 + 4 * r + q; const float sc = 1.0f / (1.0f + __expf(-x[r][q])); const float v = sc + bias[e]; TOPK_INSERT(v, sc, e); } } }
    if (!act) {
#pragma unroll
        for (int j = 0; j < 8; ++j) { xv[j * 256 + tok] = val[j]; xs[j * 256 + tok] = scv[j]; xi[j * 256 + tok] = idx[j]; } }
    __syncthreads();
    if (act) {
#pragma unroll
        for (int c = 0; c < 8; ++c) { const float v = xv[c * 256 + tok], sc = xs[c * 256 + tok]; const int e = xi[c * 256 + tok]; TOPK_INSERT(v, sc, e); }
#pragma unroll
        for (int j = 0; j < 8; ++j) rank[j] = __hip_atomic_fetch_add(&hist[idx[j]], 1, __ATOMIC_RELAXED, __HIP_MEMORY_SCOPE_WORKGROUP);
    }
#undef TOPK_INSERT
    __syncthreads();
    if (F.tid < 128) base[F.tid] = (int)atomicAdd((unsigned*)(ws + WS_CTL) + CW_CNT + cset * NE + F.tid, (unsigned)hist[F.tid]);
    __syncthreads();
    if (act) { float ssum = 0.f;
#pragma unroll
        for (int j = 0; j < 8; ++j) ssum += scv[j];
        const float inv = 2.5f / ssum;
#pragma unroll
        for (int j = 0; j < 8; ++j) { ((unsigned*)(ws + WS_PK))[(size_t)t * 8 + j] = ((unsigned)idx[j] << 24) | (unsigned)(base[idx[j]] + rank[j]); ((float*)(ws + WS_WTS))[(size_t)t * 8 + j] = scv[j] * inv; } }
    __syncthreads();
}
__device__ __forceinline__ void moe_tiles(const Frame& F, int l) {
    LAS int* ts = (LAS int*)(F.lds + LDS_TS);
    __syncthreads();
    if (F.tid == 0) { const unsigned* cnt = (const unsigned*)(F.ws + WS_CTL) + CW_CNT + l * NE; int s = 0;
        for (int e = 0; e < NE; ++e) { ts[e] = s; s += (int)((__hip_atomic_load(cnt + e, RLX_AGENT) + 255u) >> 8); } ts[NE] = s; }
    __syncthreads();
}
__device__ __forceinline__ void scatter_phase(const Frame& F, int l) {
    unsigned char* ws = F.ws;
    moe_tiles(F, l);
    const LAS int* ts = (const LAS int*)(F.lds + LDS_TS);
    if (F.tid < 256) { const int t = F.vcu * 256 + F.tid;
#pragma unroll
        for (int j = 0; j < 8; ++j) { const unsigned pk = ((const unsigned*)(ws + WS_PK))[(size_t)t * 8 + j]; const int e = (int)(pk >> 24), p = ts[e] * 256 + (int)(pk & 0xffffffu);
            ((int*)(ws + WS_POS))[(size_t)t * 8 + j] = p; ((int*)(ws + WS_SORT))[p] = t; } }
}
template <int MODE>
__device__ __forceinline__ void combine_phase(const Frame& F, bf16* h, const float* gate, float* outf, const float* ng, const float* sc, const float* sh, bf16* U) {
    unsigned char* ws = F.ws;
    const int gw = F.vcu * NWAVES + F.wave, NGW = F.G * NWAVES;
    typedef float f2_t __attribute__((ext_vector_type(2)));
    for (int blk = gw; blk < T / 32; blk += NGW) {
        const int b = (blk * 32) / SEQ;
        f32x4 gv[4], scl[4], sft[4];
#pragma unroll
        for (int n = 0; n < 4; ++n) { const int c = 16 * F.lane + 4 * n; gv[n] = *(const GAS f32x4*)(gate + (size_t)b * 6144 + c); const f32x4 g = *(const GAS f32x4*)(ng + c);
            if (MODE == 0) { scl[n] = g * (*(const GAS f32x4*)(sc + (size_t)b * 6144 + c) + 1.0f); sft[n] = *(const GAS f32x4*)(sh + (size_t)b * 6144 + c); } else { scl[n] = g; sft[n] = (f32x4){0.f, 0.f, 0.f, 0.f}; } }
        const size_t tl = (size_t)blk * 32 + (F.lane & 31);
        const v4u pq = *(const GAS v4u*)((const int*)(ws + WS_POS) + tl * 8 + 4 * (F.lane >> 5)); const f32x4 wq = *(const GAS f32x4*)((const float*)(ws + WS_WTS) + tl * 8 + 4 * (F.lane >> 5));
        for (int rr = 0; rr < 32; rr += 2) {
            v4u yw[2][8], ys[2]; float wk[2][8]; f32x4 hv[2][4];
#pragma unroll
            for (int q = 0; q < 2; ++q) {
#pragma unroll
                for (int k = 0; k < 8; ++k) { const int src = rr + q + 32 * (k >> 2);
                    const int p = __builtin_amdgcn_readlane((int)pq[k & 3], src); wk[q][k] = __builtin_bit_cast(float, __builtin_amdgcn_readlane(__builtin_bit_cast(int, wq[k & 3]), src)) * 0.0625f;
                    yw[q][k] = *(const GAS v4u*)(ws + WS_Y + (size_t)p * 1024 + 16 * F.lane); }
                const bf16* hr = h + ((size_t)blk * 32 + rr + q) * D + 16 * F.lane;
                { const v4u w0 = *(const GAS v4u*)(hr), w1 = *(const GAS v4u*)(hr + 8);
                  hv[q][0] = (f32x4){bflo(w0.x), bfhi(w0.x), bflo(w0.y), bfhi(w0.y)}; hv[q][1] = (f32x4){bflo(w0.z), bfhi(w0.z), bflo(w0.w), bfhi(w0.w)};
                  hv[q][2] = (f32x4){bflo(w1.x), bfhi(w1.x), bflo(w1.y), bfhi(w1.y)}; hv[q][3] = (f32x4){bflo(w1.z), bfhi(w1.z), bflo(w1.w), bfhi(w1.w)}; }
                ys[q] = *(const GAS v4u*)(ws + WS_YS + ((size_t)blk * 32 + rr + q) * D + 16 * F.lane); }
#pragma unroll
            for (int q = 0; q < 2; ++q) { f32x4 acc[4];
#pragma unroll
                for (int n = 0; n < 4; ++n) acc[n] = fp8x4(ys[q][n]) * 0.0625f;
#pragma unroll
                for (int k = 0; k < 8; ++k)
#pragma unroll
                    for (int n = 0; n < 4; ++n) { const f2_t lo = __builtin_amdgcn_cvt_pk_f32_fp8((int)yw[q][k][n], false), hi = __builtin_amdgcn_cvt_pk_f32_fp8((int)yw[q][k][n], true);
                        acc[n] += (f32x4){lo.x, lo.y, hi.x, hi.y} * wk[q][k]; }
                const size_t row = (size_t)blk * 32 + rr + q; float s = 0.f;
#pragma unroll
                for (int n = 0; n < 4; ++n) { acc[n] = hv[q][n] + gv[n] * acc[n]; s += (acc[n].x * acc[n].x + acc[n].y * acc[n].y) + (acc[n].z * acc[n].z + acc[n].w * acc[n].w); }
                const float rs = 1.0f / sqrtf(wave_sum(s, F.lane) * (1.0f / D) + EPS);
                if (MODE == 0) {
                    GAS v4u* hp = (GAS v4u*)(h + row * D + 16 * F.lane);
                    hp[0] = (v4u){pk2(acc[0].x, acc[0].y), pk2(acc[0].z, acc[0].w), pk2(acc[1].x, acc[1].y), pk2(acc[1].z, acc[1].w)};
                    hp[1] = (v4u){pk2(acc[2].x, acc[2].y), pk2(acc[2].z, acc[2].w), pk2(acc[3].x, acc[3].y), pk2(acc[3].z, acc[3].w)};
                    f32x4 y[4];
#pragma unroll
                    for (int n = 0; n < 4; ++n) y[n] = acc[n] * rs * scl[n] + sft[n];
                    (void)U;
                    *(GAS v4u*)(ws + WS_U8 + row * D + 16 * F.lane) = (v4u){pk4_fp8(y[0].x, y[0].y, y[0].z, y[0].w), pk4_fp8(y[1].x, y[1].y, y[1].z, y[1].w), pk4_fp8(y[2].x, y[2].y, y[2].z, y[2].w), pk4_fp8(y[3].x, y[3].y, y[3].z, y[3].w)};
                } else {
                    float* orow = outf + row * D + 16 * F.lane;
#pragma unroll
                    for (int n = 0; n < 4; ++n) *(GAS f32x4*)(orow + 4 * n) = acc[n] * rs * scl[n];
                } }
        }
    }
}

__device__ __forceinline__ void stagger(int bx, int us) {
    const unsigned long long t0 = __builtin_amdgcn_s_memrealtime(); const unsigned long long wait = (unsigned long long)(((bx >> 3) & 3) * us) * 100ull;
    while (__builtin_amdgcn_s_memrealtime() - t0 < wait) __builtin_amdgcn_s_sleep(8);
}
#ifndef MK_STAG_IN
#define MK_STAG_IN 0
#endif
__device__ __forceinline__ void wg_seam(int tid) {
    asm volatile("s_waitcnt vmcnt(0)" ::: "memory");
    __syncthreads();
    if (tid < 64) { __builtin_amdgcn_fence(__ATOMIC_ACQUIRE, "agent"); asm volatile("s_waitcnt vmcnt(0)" ::: "memory"); }
    __syncthreads();
}
constexpr int NPH_L = 15, NPHASE = 1 + DEPTH * NPH_L + 1;
#ifndef MK_DBG_A
#define MK_DBG_A -1
#define MK_DBG_B -1
#endif
__global__ void __launch_bounds__(NTHR, 2) mk_fwd(Args args) {
    extern __shared__ __attribute__((aligned(16))) unsigned char lds_raw[];
    Frame F;
    F.lds = (LAS unsigned char*)lds_raw; F.ws = args.ws;
    F.tid = threadIdx.x; F.lane = F.tid & 63; F.wave = __builtin_amdgcn_readfirstlane(F.tid >> 6);
    F.G = gridDim.x; { const int bx = blockIdx.x; F.bx = bx; F.vcu = (F.G % 8 == 0) ? (bx % 8) * (F.G / 8) + bx / 8 : bx; }
    volatile LAS unsigned* misc = (volatile LAS unsigned*)(F.lds + LDS_MISC);
    if (F.tid < 64) misc[F.tid] = 0u;
    __syncthreads();
    XcdBarrier bar; bar.bar = (unsigned*)(args.ws + WS_CTL) + CW_BAR; bar.x = 0; bar.st = nullptr;
    if (!MK_PER_PHASE) bar = xcd_barrier_post((unsigned*)(args.ws + WS_CTL) + CW_BAR, misc + 8);
    const int lo = args.ph_lo, hi = args.ph_hi;
    if (MK_DBG_A >= 0 && F.tid == 0) misc[15] = (unsigned)__builtin_amdgcn_s_memrealtime();
#ifndef MK_G4_FROM_U
#define MK_G4_FROM_U 0
#endif
#ifndef MK_G3B_FIRST
#define MK_G3B_FIRST false
#endif
#ifndef MK_MASK
#define MK_MASK 0x7ffff
#endif
#define EN(j) (((MK_MASK) >> (j)) & 1)
#ifndef MK_REP_MASK
#define MK_REP_MASK 0
#endif
#define REP(j) for (int rep_ = 0; rep_ < 1 + (((MK_REP_MASK) >> (j)) & 1); ++rep_)
#define IN(k) (lo <= (k) && (k) < hi)
#define FRESH_TID(t_) int t_; { int l_; asm volatile("v_mbcnt_lo_u32_b32 %0, -1, 0\n\tv_mbcnt_hi_u32_b32 %0, -1, %0" : "=v"(l_)); int wv_ = F.wave; asm volatile("" : "+s"(wv_)); t_ = wv_ * 64 + l_; }
#define FRESH(P) Frame P = F; { FRESH_TID(t_); P.tid = t_; P.lane = t_ & 63; unsigned char* w_ = args.ws; asm volatile("" : "+s"(w_)); P.ws = w_; int g_ = F.G, v_ = F.vcu, b_ = F.bx; asm volatile("" : "+s"(g_), "+s"(v_), "+s"(b_)); P.G = g_; P.vcu = v_; P.bx = b_; } unsigned char* ws = P.ws
#define LSEAM(k) do { if (IN(k) && IN((k) + 1)) { FRESH_TID(tl_); wg_seam(tl_); } } while (0)
#define SEAM(k) do { if (IN(k) && IN((k) + 1)) { FRESH_TID(tb_); xcd_barrier(bar, tb_ == 0); \
    if (MK_DBG_A >= 0 && tb_ == 0 && F.bx == 0) { const unsigned now_ = (unsigned)__builtin_amdgcn_s_memrealtime(); misc[16 + (k)] = now_ - misc[15]; misc[15] = now_; } } } while (0)
    bf16* H = (bf16*)(args.ws + WS_H);
    if (EN(15) && IN(0)) REP(15) { FRESH(P); (void)ws; p0_prologue(P, args); } SEAM(0);
#pragma unroll 1
    for (int l = 0; l < DEPTH; ++l) {
        const int p0 = 1 + NPH_L * l;
        int f8from = MK_FP8_EXP1_FROM; asm volatile("" : "+s"(f8from));
#define MODP ((const float*)(ws + WS_MOD) + (size_t)l * 16 * 6144)
        if (l == 0) { if (EN(0) && IN(p0 + 0)) REP(0) { FRESH(P); norm_phase<false, false>(P, args.in[I_X], args.in[I_N1G] + l * D, MODP + 1024, MODP + 0, (bf16*)nullptr, nullptr, ws + WS_U8); }
            SEAM(p0 + 0); }
        if (EN(1) && IN(p0 + 1)) REP(1) { FRESH(P); pg8::Gemm g{(const bf16*)(ws + WS_U8), (const bf16*)(ws + WS_WIN8 + (size_t)l * NSEC * D), D / 2, nullptr}; pg8::StaticOrder S; S.init(T, NSEC, P.G, P.bx);
            EpiInProj E{ws}; pg8::gemm_phase<EpiInProj, pg8::StaticOrder, true, true, false, true>(P.lds, g, S, E, P.tid, P.wave); }
        SEAM(p0 + 1);
        if (EN(2) && IN(p0 + 2)) REP(2) { FRESH(P); (void)ws; if (EN(17)) REP(20) for (int u = P.vcu; u < 1024; u += P.G) gla_prep(P, args, l, u); }
        SEAM(p0 + 2);
        if (EN(3) && IN(p0 + 3)) REP(3) { FRESH(P); (void)ws;
            const bool light = P.vcu < 128; const int j = P.vcu & 127, hb = j & 7, grp = j >> 3;
            const int t0 = light ? 16 * (32 - MK_RG_LIGHT) + grp * MK_RG_LIGHT : grp * (32 - MK_RG_LIGHT), nt = light ? MK_RG_LIGHT : 32 - MK_RG_LIGHT;
            if (light && EN(17)) gla_rec(P, P.vcu);
            if (EN(18) && nt > 0) rg_gate_phase(P, args, l, hb, t0, nt); }
        SEAM(p0 + 3);
        if (EN(4) && IN(p0 + 4)) REP(4) { FRESH(P); (void)ws; if (EN(18)) for (int u = P.vcu; u < 1024; u += P.G) scan_pass1(P, u); }
        SEAM(p0 + 4);
        if (EN(5) && IN(p0 + 5)) { FRESH(P); (void)ws; if (EN(18)) {
#if MK_SCAN3_NEW
            scan_pass3_panel(P, P.vcu);
#else
            for (int k = 0; k < 4; ++k) scan_pass3(P, 4 * P.vcu + k);
#endif
            } if (EN(17)) gla_norm(P, args, l); }
        LSEAM(p0 + 5);
        if (EN(6) && IN(p0 + 6)) REP(6) {
            { FRESH(P); pg8::PanelOrder S{P.vcu, 4};
              pg8::Gemm g{(const bf16*)(ws + WS_IX), (const bf16*)(ws + WS_WA) + (size_t)l * D * D, D, nullptr}; EpiMerge<true> E{ws + WS_GA, (bf16*)(ws + WS_MBUF)};
              pg8::gemm_phase<EpiMerge<true>, pg8::PanelOrder, true, true, false>(P.lds, g, S, E, P.tid, P.wave); }
            { FRESH(P); pg8::PanelOrder S{P.vcu, 4};
              pg8::Gemm g{(const bf16*)(ws + WS_O), (const bf16*)(ws + WS_WB) + (size_t)l * D * D, D, nullptr}; EpiMerge<MK_G3B_FIRST> E{ws + WS_GB, (bf16*)(ws + WS_MBUF)};
              pg8::gemm_phase<EpiMerge<MK_G3B_FIRST>, pg8::PanelOrder, true, true, false>(P.lds, g, S, E, P.tid, P.wave); } }
        LSEAM(p0 + 6);
        if (EN(7) && IN(p0 + 7)) { FRESH(P); pg8::PanelOrder S{P.vcu, 4};
            pg8::Gemm g{(const bf16*)(ws + WS_MBUF), (const bf16*)(ws + WS_WO) + (size_t)l * D * D, D, nullptr};
            if (l == 0) { EpiRes<true> E{args.in[I_X], H, MODP + 2048}; pg8::gemm_phase<EpiRes<true>, pg8::PanelOrder, true, true, false>(P.lds, g, S, E, P.tid, P.wave); }
            else { EpiRes<false> E{H, H, MODP + 2048}; pg8::gemm_phase<EpiRes<false>, pg8::PanelOrder, true, true, false>(P.lds, g, S, E, P.tid, P.wave); } }
        LSEAM(p0 + 7);
        if (EN(8) && IN(p0 + 8)) REP(8) { FRESH(P); norm_phase<false, true>(P, H, args.in[I_N2G] + l * D, MODP + 4096, MODP + 3072, (bf16*)(ws + WS_U), nullptr, (l >= f8from) ? (unsigned char*)args.out : (unsigned char*)nullptr);
            if (l >= f8from && P.vcu == 0 && P.tid < D / 16) { unsigned z_ = 0u; asm volatile("" : "+v"(z_)); *(GAS v4u*)((unsigned char*)args.out + (size_t)T * D + P.tid * 16) = (v4u){z_, z_, z_, z_}; }
            for (int i = P.vcu * NTHR + P.tid; i < PMAX; i += P.G * NTHR) ((int*)(ws + WS_SORT))[i] = T; }
        LSEAM(p0 + 8);
        if (EN(9) && IN(p0 + 9)) REP(9) { FRESH(P); pg8::PanelOrder S{P.vcu, 1};
            pg8::Gemm g{(const bf16*)(ws + WS_U), (const bf16*)(ws + WS_ROUT) + (size_t)l * 256 * D, D, nullptr}; EpiLogit E{(float*)(ws + WS_LOGIT)};
            pg8::gemm_phase<EpiLogit, pg8::PanelOrder, true, true, false>(P.lds, g, S, E, P.tid, P.wave); }
        LSEAM(p0 + 9);
        if (EN(10) && IN(p0 + 10)) { if ((MK_REP_MASK >> 23) & 1) { FRESH(P); (void)ws; topk_phase(P, args, l, l + 2); } { FRESH(P); (void)ws; topk_phase(P, args, l, l); } }
        SEAM(p0 + 10);
        if (EN(11) && IN(p0 + 11)) REP(11) { FRESH(P); (void)ws; scatter_phase(P, l); }
        SEAM(p0 + 11);
        if (EN(12) && IN(p0 + 12)) REP(12) {
            if (l >= f8from) {
              { FRESH(P); moe_tiles(P, l); const LAS int* ts = (const LAS int*)(P.lds + LDS_TS);
                pg8::MoeOrder S{ts, 2, P.G, P.vcu, ts[NE] * 2};
                pg8::Gemm g{(const bf16*)args.out, (const bf16*)(ws + WS_EGU + (size_t)l * NE * 512 * D * 2), D / 2, (const int*)(ws + WS_SORT)}; EpiGlu E{(bf16*)(ws + WS_ACT)};
                pg8::gemm_phase<EpiGlu, pg8::MoeOrder, true, true, true, true>(P.lds, g, S, E, P.tid, P.wave); }
              { FRESH(P); pg8::StaticOrder S; S.init(T, 512, P.G, P.bx);
                pg8::Gemm g{(const bf16*)args.out, (const bf16*)(ws + WS_SGU + (size_t)l * 512 * D * 2), D / 2, nullptr}; EpiGlu E{(bf16*)(ws + WS_ACTS)};
                pg8::gemm_phase<EpiGlu, pg8::StaticOrder, true, true, false, true>(P.lds, g, S, E, P.tid, P.wave); }
            } else {
              { FRESH(P); moe_tiles(P, l); const LAS int* ts = (const LAS int*)(P.lds + LDS_TS);
                pg8::MoeOrder S{ts, 2, P.G, P.vcu, ts[NE] * 2};
                pg8::Gemm g{(const bf16*)(ws + WS_U), (const bf16*)(ws + WS_EGU) + (size_t)l * NE * 512 * D, D, (const int*)(ws + WS_SORT)}; EpiGlu E{(bf16*)(ws + WS_ACT)};
                pg8::gemm_phase<EpiGlu, pg8::MoeOrder, true, true, true>(P.lds, g, S, E, P.tid, P.wave); }
              { FRESH(P); pg8::StaticOrder S; S.init(T, 512, P.G, P.bx);
                pg8::Gemm g{(const bf16*)(ws + WS_U), (const bf16*)(ws + WS_SGU) + (size_t)l * 512 * D, D, nullptr}; EpiGlu E{(bf16*)(ws + WS_ACTS)};
                pg8::gemm_phase<EpiGlu, pg8::StaticOrder, true, true, false>(P.lds, g, S, E, P.tid, P.wave); } } }
        SEAM(p0 + 12);
        if (EN(13) && IN(p0 + 13)) {
            REP(21) { FRESH(P); moe_tiles(P, l); const LAS int* ts = (const LAS int*)(P.lds + LDS_TS);
              pg8::MoeOrder S{ts, 4, P.G, P.vcu, ts[NE] * 4};
              pg8::Gemm g{(const bf16*)(ws + WS_ACT), (const bf16*)(ws + WS_EDN) + (size_t)l * NE * D * DE, DE, nullptr}; EpiY E{ws + WS_Y};
              pg8::gemm_phase<EpiY, pg8::MoeOrder, true, true, false>(P.lds, g, S, E, P.tid, P.wave); }
            { FRESH(P); pg8::StaticOrder S; S.init(T, D, P.G, P.bx);
              pg8::Gemm g{(const bf16*)(ws + WS_ACTS), (const bf16*)(ws + WS_SDN) + (size_t)l * D * DE, DE, nullptr}; EpiY E{ws + WS_YS};
              pg8::gemm_phase<EpiY, pg8::StaticOrder, true, true, false>(P.lds, g, S, E, P.tid, P.wave); } }
        SEAM(p0 + 13);
        if (EN(14) && IN(p0 + 14)) { FRESH(P);
            if (l + 1 < DEPTH) { const float* modn = (const float*)(ws + WS_MOD) + (size_t)(l + 1) * 16 * 6144;
                combine_phase<0>(P, H, MODP + 5120, nullptr, args.in[I_N1G] + (l + 1) * D, modn + 1024, modn + 0, (bf16*)(ws + WS_U)); }
            else combine_phase<1>(P, H, MODP + 5120, args.out, args.in[I_FG], nullptr, nullptr, nullptr); }
        if (l + 1 < DEPTH) SEAM(p0 + 14);
    }
    if (MK_DBG_A >= 0 && F.bx == 0) {
        __syncthreads(); asm volatile("s_waitcnt vmcnt(0)" ::: "memory");
        if (F.tid == 0) { const unsigned now_ = (unsigned)__builtin_amdgcn_s_memrealtime(); misc[16 + NPHASE - 2] = now_ - misc[15]; }
        __syncthreads();
        const int sa = MK_DBG_A, sb = MK_DBG_B;
        const float dA = (sa == 15) ? misc[16] * 0.01f : (misc[16 + 1 + sa] + misc[16 + 1 + NPH_L + sa]) * 0.01f;
        const float dB = (sb == 15) ? misc[16] * 0.01f : (misc[16 + 1 + sb] + misc[16 + 1 + NPH_L + sb]) * 0.01f;
        if (F.tid == 0) args.out[0] = 10.0f * dA; else if (F.tid <= 670) args.out[F.tid] = dB;
    }
#undef MODP
#undef IN
#undef SEAM
}

#ifndef MK_SKIP_LO
#define MK_SKIP_LO 0
#define MK_SKIP_HI 0
#endif
#ifndef MK_NLAUNCH
#define MK_NLAUNCH NPHASE
#endif
extern "C" void kernel_launch(void* const* d_in, const int* in_sizes, int n_in, void* d_out, int out_size, void* d_ws, size_t ws_size, hipStream_t stream) {
    static int grid = 0;
    if (grid == 0) {
        if (n_in != N_INPUTS || out_size != T * D || ws_size < WS_END) { fprintf(stderr, "kernel_launch: unexpected problem shape (n_in %d out %d ws %zu, need %zu)\n", n_in, out_size, ws_size, (size_t)WS_END); grid = -1; return; }
        int dev = 0, cus = 0, per_cu = 0;
        if (hipGetDevice(&dev) != hipSuccess || hipDeviceGetAttribute(&cus, hipDeviceAttributeMultiprocessorCount, dev) != hipSuccess) { grid = -1; return; }
        if (hipFuncSetAttribute((const void*)mk_fwd, hipFuncAttributeMaxDynamicSharedMemorySize, LDS_BYTES) != hipSuccess) { fprintf(stderr, "kernel_launch: hipFuncSetAttribute failed\n"); grid = -1; return; }
        if (hipOccupancyMaxActiveBlocksPerMultiprocessor(&per_cu, (const void*)mk_fwd, NTHR, LDS_BYTES) != hipSuccess || per_cu < 1) { fprintf(stderr, "kernel_launch: occupancy query says %d\n", per_cu); }
        (void)hipGetLastError();
        if (cus != T / 256) { fprintf(stderr, "kernel_launch: built for %d CUs (one 256-row panel per workgroup), device has %d\n", T / 256, cus); grid = -1; return; }
        grid = cus;
    }
    if (grid < 0) return;
    if (hipMemsetAsync((char*)d_ws + WS_CTL, 0, CTL_ZERO_BYTES, stream) != hipSuccess) return;
    Args a{};
    for (int i = 0; i < N_INPUTS; ++i) a.in[i] = (const float*)d_in[i];
    a.out = (float*)d_out; a.ws = (unsigned char*)d_ws;
#if MK_PER_PHASE
    for (int p = 0; p < MK_NLAUNCH; ++p) { if (p >= MK_SKIP_LO && p < MK_SKIP_HI) continue; a.ph_lo = p; a.ph_hi = p + 1; hipLaunchKernelGGL(mk_fwd, dim3(grid), dim3(NTHR), LDS_BYTES, stream, a); }
#else
    a.ph_lo = 0; a.ph_hi = NPHASE; hipLaunchKernelGGL(mk_fwd, dim3(grid), dim3(NTHR), LDS_BYTES, stream, a);
#endif
}
```
